# Optimizing an MI355X kernel written in HIP

```python
import math
import jax, jax.numpy as jnp
from jax import lax
import numpy as np

D_MODEL = 1024
BATCH = 4
SEQ = 4096
DEPTH = 2

GRID_W = 64
CTX_LEN = 256

DA_HEADS = 4
DA_QK = 32
DA_V = 64
GLA_HEADS = 6
GLA_DK = 32
GLA_DV = 64
GLA_RANK = 16
GLA_TAU = 16.0
GLA_CHUNK = 64
RW_HEADS = 6
RW_D = 64
RW_DECAY_RANK = 64
RW_A_RANK = 64
RW_GATE_RANK = 128
RW_GN_EPS = 64e-5
N_EXPERTS = 32
TOP_K = 4
D_EXPERT = 1024
SWIGLU_LIMIT = 7.0
SWIGLU_ALPHA = 1.702
MOE_BLOCK = 256
ROPE_BASE = 10000.0
Q_BLOCK = 128
LN_EPS = 1e-5
DEEPNORM_ALPHA = (2 * DEPTH) ** 0.25
DEEPNORM_BETA = (8 * DEPTH) ** -0.25

DA_W = DA_HEADS * DA_V
GLA_W = GLA_HEADS * GLA_DV
RW_W = RW_HEADS * RW_D
MIX_W = DA_W + GLA_W + RW_W

IN_SPLITS = (
    ("da_q", DA_HEADS * 2 * DA_QK),
    ("da_k", DA_HEADS * 2 * DA_QK),
    ("da_v", DA_HEADS * DA_V),
    ("gla_q", GLA_HEADS * GLA_DK),
    ("gla_k", GLA_HEADS * GLA_DK),
    ("gla_v", GLA_HEADS * GLA_DV),
    ("gla_gf", GLA_RANK),
    ("gla_gb", GLA_RANK),
    ("gla_r", GLA_HEADS * GLA_DV),
    ("rw_rkv", 3 * RW_W),
    ("rw_wf", RW_DECAY_RANK),
    ("rw_wb", RW_DECAY_RANK),
    ("rw_af", RW_A_RANK),
    ("rw_ab", RW_A_RANK),
    ("rw_g", RW_GATE_RANK),
)
D_IN = sum(n for _, n in IN_SPLITS)

kernel_name = "hybrid_diffattn_gla_rwkv7_moe_dit"


def _layer_norm(x, g, b, eps=LN_EPS):
    xf = x.astype(jnp.float32)
    mu = xf.mean(-1, keepdims=True)
    var = jnp.square(xf - mu).mean(-1, keepdims=True)
    return ((xf - mu) * lax.rsqrt(var + eps)).astype(x.dtype) * g + b


def _rms_norm(x, g, eps=LN_EPS):
    xf = x.astype(jnp.float32)
    return (xf * lax.rsqrt(jnp.mean(xf * xf, -1, keepdims=True) + eps)).astype(x.dtype) * g


def _split_in(z):
    idx = np.cumsum([n for _, n in IN_SPLITS])[:-1].tolist()
    return dict(zip([k for k, _ in IN_SPLITS], jnp.split(z, idx, axis=-1)))


def _axial_rope_tables(rows, dim):
    row = jnp.repeat(jnp.arange(rows), GRID_W).astype(jnp.float32)
    col = jnp.tile(jnp.arange(GRID_W), rows).astype(jnp.float32)
    quarter = dim // 4
    inv = ROPE_BASE ** (-jnp.arange(quarter, dtype=jnp.float32) / quarter)
    ang_r = row[:, None] * inv
    ang_c = col[:, None] * inv
    ang = jnp.concatenate([ang_r, ang_r, ang_c, ang_c], -1)
    return jnp.cos(ang), jnp.sin(ang)


def _apply_axial_rope(x, cos, sin):
    xr = x.reshape(x.shape[:-1] + (2, 2, x.shape[-1] // 4))
    rot = jnp.stack([-xr[..., 1, :], xr[..., 0, :]], axis=-2).reshape(x.shape)
    c = cos[None, :, None, None, :].astype(x.dtype)
    s = sin[None, :, None, None, :].astype(x.dtype)
    return x * c + rot * s


def _diff_softmax_attend(q, k, v, lam):
    s = jnp.einsum('bqhmd,bkhmd->bhmqk', q, k).astype(jnp.float32) * (DA_QK ** -0.5)
    p = jax.nn.softmax(s, axis=-1)
    w = p[:, :, 0] - lam * p[:, :, 1]
    return jnp.einsum('bhqk,bkhe->bqhe', w.astype(v.dtype), v)


def _diff_attn_mixer(pl, pc, lam_q1, lam_k1, lam_q2, lam_k2, subln_g, layer_idx, cos, sin, need_ctx_out):
    dtype = pl["da_v"].dtype
    lam_init = 0.8 - 0.6 * math.exp(-0.3 * layer_idx)
    f32 = jnp.float32
    lam = (jnp.exp(jnp.sum(lam_q1.astype(f32) * lam_k1.astype(f32)))
           - jnp.exp(jnp.sum(lam_q2.astype(f32) * lam_k2.astype(f32))) + lam_init)

    def heads(p):
        B, L, _ = p["da_q"].shape
        return (p["da_q"].reshape(B, L, DA_HEADS, 2, DA_QK),
                p["da_k"].reshape(B, L, DA_HEADS, 2, DA_QK),
                p["da_v"].reshape(B, L, DA_HEADS, DA_V))

    def post(o):
        o = _rms_norm(o, subln_g) * (1.0 - lam_init)
        return o.reshape(o.shape[:2] + (DA_W,)).astype(dtype)

    q, k, v = heads(pl)
    qc, kc, vc = heads(pc)
    q = _apply_axial_rope(q, cos, sin)
    k = _apply_axial_rope(k, cos, sin)
    k_all = jnp.concatenate([kc, k], axis=1)
    v_all = jnp.concatenate([vc, v], axis=1)
    B, S = q.shape[:2]
    nb = S // Q_BLOCK
    qb = q.reshape((B, nb, Q_BLOCK) + q.shape[2:]).swapaxes(0, 1)
    ob = lax.map(lambda blk: _diff_softmax_attend(blk, k_all, v_all, lam), qb)
    out_l = post(ob.swapaxes(0, 1).reshape(B, S, DA_HEADS, DA_V))
    out_c = post(_diff_softmax_attend(qc, kc, vc, lam)) if need_ctx_out else None
    return out_l, out_c


def _bidirectional(scan_fn, ctx_f, lat_f, ctx_b, lat_b, s0, axis, emit_ctx):
    flip = lambda ts: tuple(jnp.flip(t, axis) for t in ts)
    s_f, yc_f = scan_fn(*ctx_f, s0, emit_ctx)
    _, y_f = scan_fn(*lat_f, s_f, True)
    s_b, yc_b = scan_fn(*flip(ctx_b), s0, emit_ctx)
    _, y_b = scan_fn(*flip(lat_b), s_b, True)
    y_lat = y_f + jnp.flip(y_b, axis)
    y_ctx = (yc_f + jnp.flip(yc_b, axis)) if emit_ctx else None
    return y_lat, y_ctx


def _gla_chunk_scan(q, k, v, g, s0, emit):
    B, H, L, _ = q.shape
    dv = v.shape[-1]
    n = L // GLA_CHUNK
    ch = lambda t: t.reshape(B, H, n, GLA_CHUNK, t.shape[-1]).transpose(2, 0, 1, 3, 4)
    lower = jnp.tril(jnp.ones((GLA_CHUNK, GLA_CHUNK), bool))[:, :, None]

    def step(S, xs):
        qc, kc, vc, gc = xs
        b = jnp.cumsum(gc, axis=-2)
        b_last = b[..., -1:, :]
        S_new = (S * jnp.exp(b_last)[..., 0, :, None]
                 + jnp.einsum('bhsk,bhsv->bhkv', kc * jnp.exp(b_last - b), vc))
        if not emit:
            return S_new, None
        inter = jnp.einsum('bhtk,bhkv->bhtv', qc * jnp.exp(b), S)
        dec = jnp.exp(jnp.where(lower, b[..., :, None, :] - b[..., None, :, :], -jnp.inf))
        att = jnp.einsum('bhtk,bhsk,bhtsk->bhts', qc, kc, dec)
        return S_new, inter + jnp.einsum('bhts,bhsv->bhtv', att, vc)

    S_fin, o = lax.scan(step, s0, (ch(q), ch(k), ch(v), ch(g)))
    if emit:
        o = o.transpose(1, 2, 0, 3, 4).reshape(B, H, L, dv)
    return S_fin, o


def _gla_mixer(pl, pc, gate_w2, gate_b, norm_g, need_ctx_out):
    dtype = pl["gla_r"].dtype
    f32 = jnp.float32

    def prep(p):
        B, L, _ = p["gla_q"].shape
        hd = lambda t, d: t.astype(f32).reshape(B, L, GLA_HEADS, d).transpose(0, 2, 1, 3)
        q = hd(p["gla_q"], GLA_DK) * (GLA_DK ** -0.5)
        k = hd(p["gla_k"], GLA_DK)
        v = hd(p["gla_v"], GLA_DV)
        gs = [hd(jax.nn.log_sigmoid((p[nm] @ gate_w2[i] + gate_b[i]).astype(f32)) / GLA_TAU, GLA_DK)
              for i, nm in enumerate(("gla_gf", "gla_gb"))]
        return (q, k, v, gs[0]), (q, k, v, gs[1])

    lat_f, lat_b = prep(pl)
    ctx_f, ctx_b = prep(pc)
    B = lat_f[0].shape[0]
    s0 = jnp.zeros((B, GLA_HEADS, GLA_DK, GLA_DV), f32)
    o_l, o_c = _bidirectional(_gla_chunk_scan, ctx_f, lat_f, ctx_b, lat_b, s0, 2, need_ctx_out)

    def post(o, r):
        B_, H, L, _ = o.shape
        o = _rms_norm(o.transpose(0, 2, 1, 3), norm_g).reshape(B_, L, GLA_W)
        return (o * jax.nn.silu(r.astype(f32))).astype(dtype)

    out_l = post(o_l, pl["gla_r"])
    out_c = post(o_c, pc["gla_r"]) if need_ctx_out else None
    return out_l, out_c


def _centred_conv3(x, w):
    xp = jnp.pad(x, ((0, 0), (1, 1), (0, 0)))
    return xp[:, :-2] * w[0] + xp[:, 1:-1] * w[1] + xp[:, 2:] * w[2]


def _rwkv7_scan(r, decay, kk, a, k, v, s0, emit):
    tm = lambda t: jnp.moveaxis(t, 1, 0)

    def step(S, xs):
        r_t, w_t, kk_t, a_t, k_t, v_t = xs
        sa = jnp.einsum('bhvk,bhk->bhv', S, -kk_t)
        S = (S * w_t[:, :, None, :] + sa[..., None] * (kk_t * a_t)[:, :, None, :]
             + v_t[..., None] * k_t[:, :, None, :])
        return S, (jnp.einsum('bhvk,bhk->bhv', S, r_t) if emit else None)

    S, y = lax.scan(step, s0, tuple(tm(t) for t in (r, decay, kk, a, k, v)))
    return S, (jnp.moveaxis(y, 0, 1) if emit else None)


def _rwkv7_mixer(pl, pc, conv_w, w2, w0, a2, a0, g2, k_k, k_a, r_k, lnx_g, lnx_b, need_ctx_out):
    dtype = pl["rw_rkv"].dtype
    f32 = jnp.float32

    def prep(p):
        B, L, _ = p["rw_rkv"].shape
        r, k, v = jnp.split(_centred_conv3(p["rw_rkv"], conv_w), 3, axis=-1)
        hd = lambda t: t.astype(f32).reshape(B, L, RW_HEADS, RW_D)
        kk = hd(k * k_k)
        kk = kk / jnp.maximum(jnp.linalg.norm(kk, axis=-1, keepdims=True), 1e-12)
        r, v = hd(r), hd(v)
        dirs = []
        for i, (wn, an) in enumerate((("rw_wf", "rw_af"), ("rw_wb", "rw_ab"))):
            w_raw = (w0[i] + jnp.tanh(p[wn]) @ w2[i]).astype(f32)
            decay = jnp.exp(-jnp.exp(-jax.nn.softplus(-w_raw) - 0.5))
            a = jax.nn.sigmoid((a0[i] + p[an] @ a2[i]).astype(f32))
            k_mod = k.astype(f32) * (1.0 + (a - 1.0) * k_a)
            dirs.append((r, hd(decay), kk, hd(a), hd(k_mod), v))
        g = jax.nn.sigmoid(p["rw_g"]) @ g2
        return dirs, g

    (lat_f, lat_b), g_l = prep(pl)
    (ctx_f, ctx_b), g_c = prep(pc)
    B = g_l.shape[0]
    s0 = jnp.zeros((B, RW_HEADS, RW_D, RW_D), f32)
    y_l, y_c = _bidirectional(_rwkv7_scan, ctx_f, lat_f, ctx_b, lat_b, s0, 1, need_ctx_out)

    def post(y, df, db, g):
        r, _, _, _, kf, v = df
        kb = db[4]
        B_, L = y.shape[:2]
        yn = _layer_norm(y, lnx_g.reshape(RW_HEADS, RW_D), lnx_b.reshape(RW_HEADS, RW_D), eps=RW_GN_EPS)
        bonus = (jnp.sum(r * kf * r_k, -1, keepdims=True) + jnp.sum(r * kb * r_k, -1, keepdims=True)) * v
        return ((yn + bonus).reshape(B_, L, RW_W) * g).astype(dtype)

    out_l = post(y_l, lat_f, lat_b, g_l)
    out_c = post(y_c, ctx_f, ctx_b, g_c) if need_ctx_out else None
    return out_l, out_c


def _moe(h, router_w, router_b, w_gate, b_gate, w_up, b_up, w_down, b_down):
    T, D = h.shape
    logits = (h @ router_w + router_b).astype(jnp.float32)
    top_v, top_i = lax.top_k(logits, TOP_K)
    gates = jax.nn.softmax(top_v, axis=-1)
    n_assign = T * TOP_K
    flat_e = top_i.reshape(-1)
    order = jnp.argsort(flat_e)
    e_sorted = flat_e[order]
    tok_sorted = order // TOP_K
    counts = jnp.bincount(flat_e, length=N_EXPERTS)
    start = jnp.cumsum(counts) - counts
    padded = (counts + MOE_BLOCK - 1) // MOE_BLOCK * MOE_BLOCK
    pad_end = jnp.cumsum(padded)
    pad_start = pad_end - padded
    dest = pad_start[e_sorted] + jnp.arange(n_assign) - start[e_sorted]
    n_blocks = -(-n_assign // MOE_BLOCK) + N_EXPERTS
    cap = n_blocks * MOE_BLOCK
    slot_tok = jnp.full((cap,), T, jnp.int32).at[dest].set(tok_sorted.astype(jnp.int32))
    block_expert = jnp.minimum(
        jnp.searchsorted(pad_end, jnp.arange(n_blocks) * MOE_BLOCK, side='right'), N_EXPERTS - 1)
    h_pad = jnp.concatenate([h, jnp.zeros((1, D), h.dtype)], axis=0)
    xb = h_pad[slot_tok].reshape(n_blocks, MOE_BLOCK, D)

    def run_block(args):
        xs, e = args
        gt = jnp.minimum(xs @ w_gate[e] + b_gate[e], SWIGLU_LIMIT)
        up = jnp.clip(xs @ w_up[e] + b_up[e], -SWIGLU_LIMIT, SWIGLU_LIMIT)
        return ((up + 1.0) * gt * jax.nn.sigmoid(SWIGLU_ALPHA * gt)) @ w_down[e] + b_down[e]

    yb = lax.map(run_block, (xb, block_expert)).reshape(cap, D)
    w_assign = gates.reshape(-1)[order].astype(h.dtype)
    return jax.ops.segment_sum(yb[dest] * w_assign[:, None], tok_sorted, num_segments=T)


def setup_inputs(seed: int = 0) -> dict:
    key = jax.random.key(seed)
    ks = iter(jax.random.split(key, 64))
    nrm = lambda shape, std: std * jax.random.normal(next(ks), shape, jnp.float32)
    L, D, E, F = DEPTH, D_MODEL, N_EXPERTS, D_EXPERT
    GK = GLA_HEADS * GLA_DK
    return {
        "x": nrm((BATCH, SEQ, D), 1.0),
        "c": nrm((BATCH, D), 1.0),
        "ctx": nrm((BATCH, CTX_LEN, D), 1.0),
        "c_ctx": nrm((D,), 1.0),
        "ln_in_g": 1.0 + nrm((D,), 0.05),
        "ln_in_b": nrm((D,), 0.02),
        "ada_w": nrm((L, D, 6 * D), 0.5 * D ** -0.5),
        "ada_b": nrm((L, 6 * D), 0.02),
        "w_in": nrm((L, D, D_IN), D ** -0.5),
        "lam_q1": nrm((L, DA_QK), 0.1),
        "lam_k1": nrm((L, DA_QK), 0.1),
        "lam_q2": nrm((L, DA_QK), 0.1),
        "lam_k2": nrm((L, DA_QK), 0.1),
        "da_subln_g": 1.0 + nrm((L, DA_V), 0.05),
        "gla_gate_w2": nrm((L, 2, GLA_RANK, GK), GLA_RANK ** -0.5),
        "gla_gate_b": nrm((L, 2, GK), 0.02),
        "gla_norm_g": 1.0 + nrm((L, GLA_DV), 0.05),
        "rw_conv_w": jnp.array([0.0, 1.0, 0.0], jnp.float32)[None, :, None] + nrm((L, 3, 3 * RW_W), 0.3),
        "rw_w2": nrm((L, 2, RW_DECAY_RANK, RW_W), 0.1),
        "rw_w0": nrm((L, 2, RW_W), 1.0) - 1.0,
        "rw_a2": nrm((L, 2, RW_A_RANK, RW_W), 0.5 * RW_A_RANK ** -0.5),
        "rw_a0": nrm((L, 2, RW_W), 0.5),
        "rw_g2": nrm((L, RW_GATE_RANK, RW_W), RW_GATE_RANK ** -0.5),
        "rw_k_k": 0.85 + nrm((L, RW_W), 0.05),
        "rw_k_a": 1.0 + nrm((L, RW_W), 0.05),
        "rw_r_k": nrm((L, RW_HEADS, RW_D), 0.1),
        "rw_lnx_g": 1.0 + nrm((L, RW_W), 0.05),
        "rw_lnx_b": nrm((L, RW_W), 0.02),
        "w_out": nrm((L, MIX_W, D), DEEPNORM_BETA * MIX_W ** -0.5),
        "ln1_g": 1.0 + nrm((L, D), 0.05),
        "ln1_b": nrm((L, D), 0.02),
        "router_w": nrm((L, D, E), D ** -0.5),
        "router_b": nrm((L, E), 0.01),
        "moe_w_gate": nrm((L, E, D, F), D ** -0.5),
        "moe_b_gate": nrm((L, E, F), 0.02),
        "moe_w_up": nrm((L, E, D, F), D ** -0.5),
        "moe_b_up": nrm((L, E, F), 0.02),
        "moe_w_down": nrm((L, E, F, D), DEEPNORM_BETA * F ** -0.5),
        "moe_b_down": nrm((L, E, D), 0.02),
        "ln2_g": 1.0 + nrm((L, D), 0.05),
        "ln2_b": nrm((L, D), 0.02),
    }


def reference(x, c, ctx, c_ctx, ln_in_g, ln_in_b, ada_w, ada_b, w_in, lam_q1, lam_k1, lam_q2, lam_k2,
              da_subln_g, gla_gate_w2, gla_gate_b, gla_norm_g, rw_conv_w, rw_w2, rw_w0, rw_a2, rw_a0,
              rw_g2, rw_k_k, rw_k_a, rw_r_k, rw_lnx_g, rw_lnx_b, w_out, ln1_g, ln1_b, router_w, router_b,
              moe_w_gate, moe_b_gate, moe_w_up, moe_b_up, moe_w_down, moe_b_down, ln2_g, ln2_b):
    B, S, D = x.shape
    Lc = ctx.shape[1]
    ROWS = S // GRID_W
    cos, sin = _axial_rope_tables(ROWS, DA_QK)
    h_lat = _layer_norm(x, ln_in_g, ln_in_b)
    h_ctx = _layer_norm(ctx, ln_in_g, ln_in_b)
    for l in range(DEPTH):
        need_ctx = l < DEPTH - 1
        mod = jax.nn.silu(c) @ ada_w[l] + ada_b[l]
        mod_c = jax.nn.silu(c_ctx) @ ada_w[l] + ada_b[l]
        sh1, sc1, g1, sh2, sc2, g2 = jnp.split(mod[:, None, :], 6, axis=-1)
        sh1c, sc1c, g1c, sh2c, sc2c, g2c = jnp.split(mod_c, 6, axis=-1)

        pl = _split_in((h_lat * (1.0 + sc1) + sh1) @ w_in[l])
        pc = _split_in((h_ctx * (1.0 + sc1c) + sh1c) @ w_in[l])
        a_l, a_c = _diff_attn_mixer(pl, pc, lam_q1[l], lam_k1[l], lam_q2[l], lam_k2[l], da_subln_g[l],
                                    l, cos, sin, need_ctx)
        b_l, b_c = _gla_mixer(pl, pc, gla_gate_w2[l], gla_gate_b[l], gla_norm_g[l], need_ctx)
        r_l, r_c = _rwkv7_mixer(pl, pc, rw_conv_w[l], rw_w2[l], rw_w0[l], rw_a2[l], rw_a0[l], rw_g2[l],
                                rw_k_k[l], rw_k_a[l], rw_r_k[l], rw_lnx_g[l], rw_lnx_b[l], need_ctx)
        mix_l = jnp.concatenate([a_l, b_l, r_l], axis=-1) @ w_out[l]
        h_lat = _layer_norm(DEEPNORM_ALPHA * h_lat + g1 * mix_l, ln1_g[l], ln1_b[l])

        m_lat = (h_lat * (1.0 + sc2) + sh2).reshape(B * S, D)
        if need_ctx:
            mix_c = jnp.concatenate([a_c, b_c, r_c], axis=-1) @ w_out[l]
            h_ctx = _layer_norm(DEEPNORM_ALPHA * h_ctx + g1c * mix_c, ln1_g[l], ln1_b[l])
            m_in = jnp.concatenate([m_lat, (h_ctx * (1.0 + sc2c) + sh2c).reshape(B * Lc, D)], axis=0)
        else:
            m_in = m_lat
        f = _moe(m_in, router_w[l], router_b[l], moe_w_gate[l], moe_b_gate[l], moe_w_up[l], moe_b_up[l],
                 moe_w_down[l], moe_b_down[l])
        h_lat = _layer_norm(DEEPNORM_ALPHA * h_lat + g2 * f[:B * S].reshape(B, S, D), ln2_g[l], ln2_b[l])
        if need_ctx:
            h_ctx = _layer_norm(DEEPNORM_ALPHA * h_ctx + g2c * f[B * S:].reshape(B, Lc, D), ln2_g[l], ln2_b[l])
    return h_lat
```

```cpp
#include <hip/hip_runtime.h>
#include <cstdint>
#include <cstdio>

#define LAS __attribute__((address_space(3)))
typedef unsigned short bf16_t;
typedef short bf16x8 __attribute__((ext_vector_type(8)));
typedef float f32x4 __attribute__((ext_vector_type(4)));
typedef float f32x2 __attribute__((ext_vector_type(2)));
typedef unsigned u32x4 __attribute__((ext_vector_type(4)));
typedef unsigned u32x2 __attribute__((ext_vector_type(2)));

constexpr int D = 1024, NB = 4, SEQ = 4096, LCX = 256, NLAT = NB * SEQ, NCX = NB * LCX, NTOK = NLAT + NCX;
constexpr int DIN = 3488, DINP = 3584;
constexpr int NE = 32, FF = 1024;
constexpr int CAP_BLK = 304, CAP = CAP_BLK * 256;
constexpr int NTHR = 512;
constexpr int ZQ = 0, ZK = 256, ZV = 512, ZGQ = 768, ZGK = 960, ZGV = 1152, ZGF = 1536, ZGB = 1552, ZGR = 1568, ZRKV = 1952, ZWF = 3104, ZWB = 3168, ZAF = 3232, ZAB = 3296, ZG = 3360;
constexpr int NKT = 136;
constexpr int NCHUNK = 272;
constexpr float LN_EPS = 1e-5f, RW_GN_EPS = 64e-5f;
constexpr float DN_ALPHA = 1.41421356237f;

constexpr size_t MiB = 1u << 20;
constexpr size_t WS_CTL = 0, CTL_BYTES = 1 * MiB;
constexpr size_t WS_MOD = 1 * MiB;
constexpr size_t WS_TOP = 2 * MiB;
constexpr size_t TOP_STRIDE = (size_t)NTOK * 4 * 4;
constexpr size_t WS_BGU = 4 * MiB;
constexpr size_t WS_H = 5 * MiB;
constexpr size_t WS_XM = 73 * MiB;
constexpr size_t WS_CAT = 107 * MiB;
constexpr size_t WS_Z = 141 * MiB;
constexpr size_t WS_WIN = 260 * MiB;
constexpr size_t WS_WOUT = 274 * MiB;
constexpr size_t WS_WGU = 278 * MiB;
constexpr size_t WS_WDN = 534 * MiB;
constexpr size_t WS_SCR = 662 * MiB;
constexpr size_t WS_END = 966 * MiB;
static_assert(WS_H + (size_t)NTOK * D * 4 <= WS_XM && WS_XM + (size_t)NTOK * D * 2 <= WS_CAT && WS_CAT + (size_t)NTOK * D * 2 <= WS_Z, "ws map");
static_assert(WS_Z + (size_t)NTOK * DINP * 2 <= WS_WIN && WS_WIN + (size_t)2 * DINP * D * 2 <= WS_WOUT && WS_WOUT + (size_t)2 * D * D * 2 <= WS_WGU, "ws map");
static_assert(WS_WGU + (size_t)2 * 32 * 2048 * 1024 * 2 <= WS_WDN && WS_WDN + (size_t)2 * 32 * 1024 * 1024 * 2 <= WS_SCR, "ws map");
constexpr size_t SC_XB = 0, SC_ACT = (size_t)CAP * D * 2;
static_assert(WS_SCR + 2 * SC_ACT <= WS_END, "ws map");
constexpr size_t SZ_T384B = (size_t)NTOK * 384 * 2, SZ_T384F = (size_t)NTOK * 384 * 4, SZ_T192F = (size_t)NTOK * 192 * 4;
constexpr size_t SC_KVREC = 0;
constexpr size_t SC_GBF = SC_KVREC + (size_t)16 * NKT * 8192;
constexpr size_t SC_GBB = SC_GBF + SZ_T192F;
constexpr size_t SC_KVC = SC_GBB + SZ_T192F;
constexpr size_t SZ_KVC = (size_t)NCHUNK * 6 * 2 * 2048 * 4;
constexpr size_t SC_SC = SC_KVC + SZ_KVC;
constexpr size_t SC_DC = SC_SC + SZ_KVC;
constexpr size_t SC_R = SC_DC + (size_t)NCHUNK * 6 * 2 * 32 * 4;
constexpr size_t SC_KK = SC_R + SZ_T384B, SC_V = SC_KK + SZ_T384B, SC_BKF = SC_V + SZ_T384B, SC_BKB = SC_BKF + SZ_T384B, SC_KMF = SC_BKB + SZ_T384B, SC_KMB = SC_KMF + SZ_T384B, SC_G = SC_KMB + SZ_T384B;
constexpr size_t SC_WF = SC_G + SZ_T384B, SC_WB = SC_WF + SZ_T384F, SC_YF = SC_WB + SZ_T384F, SC_YB = SC_YF + SZ_T384F, SC_BON = SC_YB + SZ_T384F;
constexpr size_t SC_MIX_END = SC_BON + (size_t)NTOK * 8 * 4;
static_assert(WS_SCR + SC_MIX_END <= WS_END, "mixer scratch");
constexpr int CW_BAR = 4096, CW_CNT = 8192, CW_QHEAD = 8448  , CW_KMAX = 9216;
static_assert(CW_BAR + 3456 <= CW_CNT && CW_CNT + 128 <= CW_QHEAD && CW_QHEAD + 8 * 64 <= CW_KMAX && (CW_KMAX + 64) * 4 <= (int)CTL_BYTES, "control words");

constexpr int LDS_BYTES = 163840, LDS_CTL_OFF = LDS_BYTES - 256;

__device__ __forceinline__ int lane_id_() { return (int)__builtin_amdgcn_mbcnt_hi(~0u, __builtin_amdgcn_mbcnt_lo(~0u, 0u)); }
#define WAVE_ID_SGPR() (__builtin_amdgcn_readfirstlane((int)(threadIdx.x >> 6)))

__device__ __forceinline__ unsigned f2bf(float f) { unsigned u = __builtin_bit_cast(unsigned, f); return (u + 0x7fffu + ((u >> 16) & 1u)) >> 16; }
__device__ __forceinline__ unsigned pk2(float lo, float hi) { return f2bf(lo) | (f2bf(hi) << 16); }
__device__ __forceinline__ float bf2f(bf16_t h) { return __builtin_bit_cast(float, (unsigned)h << 16); }
__device__ __forceinline__ float bflo(unsigned u) { return __builtin_bit_cast(float, u << 16); }
__device__ __forceinline__ float bfhi(unsigned u) { return __builtin_bit_cast(float, u & 0xffff0000u); }
__device__ __forceinline__ float wave_sum(float v) {
#pragma unroll
    for (int o = 1; o < 64; o <<= 1) v += __shfl_xor(v, o);
    return v;
}
__device__ __forceinline__ float sigmoidf_(float x) { return 1.f / (1.f + __expf(-x)); }
__device__ __forceinline__ float siluf_(float x) { return x / (1.f + __expf(-x)); }
template <int CTRL> __device__ __forceinline__ float dpp_f(float v) {
    return __builtin_bit_cast(float, __builtin_amdgcn_update_dpp(0, __builtin_bit_cast(int, v), CTRL, 0xF, 0xF, true));
}
__device__ __forceinline__ float red16(float v) {
    v += dpp_f<0xB1>(v);
    v += dpp_f<0x4E>(v);
    v += dpp_f<0x141>(v);
    v += dpp_f<0x140>(v);
    return v;
}

namespace pg8 {
constexpr int BM = 256, BK = 64, HALF = 128, HTB = HALF * BK * 2, STAGE_BYTES = 8 * HTB, NXCD = 8, WGM = 8;
__host__ __device__ __forceinline__ int lds_byte(int r, int c) { const int st = (r >> 4) * 2 + (c >> 5), rr = r & 15, cc = c & 31, ob = rr * 64 + cc * 2; return st * 1024 + (ob ^ (((ob >> 9) & 1) << 5)); }
__host__ __device__ __forceinline__ void stage_rc(int b, int& R, int& C) { const int st = b / 1024, sb = b % 1024, swz = sb ^ (((sb >> 9) & 1) << 5); R = (st >> 1) * 16 + swz / 64; C = (st & 1) * 32 + (swz % 64) / 2; }
__host__ __device__ __forceinline__ int perm32(int rho) { const int n = rho >> 4, i = rho & 15; return 8 * (i >> 2) + 4 * n + (i & 3); }

struct Unit { int pm, pn, e; size_t boff; };
struct Gemm { const bf16_t* A; const bf16_t* Bt; int M, N, K; };

struct StaticOrder {
    int nM, nN, nwg, G, c; size_t tstep;
    __device__ void init(int M, int N, int K, int G_, int c_) { nM = M / BM; nN = N / BM; nwg = nM * nN; G = G_; c = c_; tstep = (size_t)BM * K * 2; }
    __device__ bool next(int i, Unit& u) const {
        const long L = (long)i * G + c; if (L >= nwg) return false;
        int wgid = (int)L; { const int q = nwg / NXCD, r = nwg % NXCD, xcd = wgid % NXCD, off = wgid / NXCD; wgid = (xcd < r ? xcd * (q + 1) : r * (q + 1) + (xcd - r) * q) + off; }
        const int nig = WGM * nN, gid = wgid / nig, fm = gid * WGM, gsz = (nM - fm) < WGM ? (nM - fm) : WGM;
        u.pm = fm + ((wgid % nig) % gsz); u.pn = (wgid % nig) / gsz; u.e = 0; u.boff = (size_t)u.pn * tstep; return true;
    }
};
template <int NPN> struct GroupOrder {
    int G, c, nblk; const LAS int* blk2e;
    __device__ __forceinline__ bool next(int i, Unit& u) const {
        const int L = i * G + c; if (L >= nblk * NPN) return false;
        const int blk = L / NPN; u.pn = L % NPN; u.pm = blk;
        const int e = blk2e[blk];
        u.e = e; u.boff = (size_t)(e * NPN + u.pn) * ((size_t)256 * 1024 * 2); return true;
    }
};

__device__ __forceinline__ unsigned cvt_pk_bf16(float lo, float hi) { unsigned r; asm volatile("v_cvt_pk_bf16_f32 %0, %1, %2" : "=v"(r) : "v"(lo), "v"(hi)); return r; }

struct EpiBf16 {
    bf16_t* O; int ldc; const float* bias; int bias_estride;
    __device__ __forceinline__ void operator()(const f32x4 (&acc)[2][2][4][2], const Unit& u, int wr, int wc, int fr, int fq) const {
        const int row0 = u.pm * BM + wr * 64 + fr; const int col0 = u.pn * BM + wc * 32 + 8 * fq;
        f32x4 bv[2][2];
#pragma unroll
        for (int bj = 0; bj < 2; ++bj)
#pragma unroll
            for (int n = 0; n < 2; ++n) bv[bj][n] = bias ? *(const f32x4*)(bias + (size_t)u.e * bias_estride + col0 + bj * HALF + 4 * n) : (f32x4){0.f, 0.f, 0.f, 0.f};
#pragma unroll
        for (int ai = 0; ai < 2; ++ai)
#pragma unroll
            for (int m = 0; m < 4; ++m) { bf16_t* rowp = O + (size_t)(row0 + ai * HALF + m * 16) * ldc + col0;
#pragma unroll
                for (int bj = 0; bj < 2; ++bj) { const f32x4 v0 = acc[ai][bj][m][0] + bv[bj][0], v1 = acc[ai][bj][m][1] + bv[bj][1];
                    u32x4 w; w.x = cvt_pk_bf16(v0[0], v0[1]); w.y = cvt_pk_bf16(v0[2], v0[3]); w.z = cvt_pk_bf16(v1[0], v1[1]); w.w = cvt_pk_bf16(v1[2], v1[3]);
                    *(u32x4*)(rowp + bj * HALF) = w; } }
    }
};
struct EpiSwiglu {
    bf16_t* O; const float* bias;
    __device__ __forceinline__ static float act(float g, float u) {
        g = fminf(g, 7.f); u = fminf(fmaxf(u, -7.f), 7.f);
        return (u + 1.f) * g / (1.f + __expf(-1.702f * g));
    }
    __device__ __forceinline__ void operator()(const f32x4 (&acc)[2][2][4][2], const Unit& u, int wr, int wc, int fr, int fq) const {
        const int row0 = u.pm * BM + wr * 64 + fr; const int col0 = u.pn * BM + wc * 32 + 8 * fq;
        f32x4 bv[2][2];
#pragma unroll
        for (int bj = 0; bj < 2; ++bj)
#pragma unroll
            for (int n = 0; n < 2; ++n) bv[bj][n] = *(const f32x4*)(bias + (size_t)u.e * 2048 + col0 + bj * HALF + 4 * n);
#pragma unroll
        for (int ai = 0; ai < 2; ++ai)
#pragma unroll
            for (int m = 0; m < 4; ++m) { bf16_t* rowp = O + (size_t)(row0 + ai * HALF + m * 16) * 1024 + (col0 >> 1);
#pragma unroll
                for (int bj = 0; bj < 2; ++bj) { const f32x4 v0 = acc[ai][bj][m][0] + bv[bj][0], v1 = acc[ai][bj][m][1] + bv[bj][1];
                    u32x2 w; w.x = cvt_pk_bf16(act(v0[0], v0[1]), act(v0[2], v0[3])); w.y = cvt_pk_bf16(act(v1[0], v1[1]), act(v1[2], v1[3]));
                    *(u32x2*)(rowp + bj * (HALF / 2)) = w; } }
    }
};

template <class Epi, class Sched>
__device__ __forceinline__ void gemm_phase(LAS unsigned char* lds, const Gemm g, const Sched& S, const Epi& E, const int wave_s) {
    int tid = wave_s * 64 + lane_id_(); asm volatile("" : "+v"(tid));
    const int wid = __builtin_amdgcn_readfirstlane(tid >> 6), lane = tid & 63, wr = wid >> 2, wc = wid & 3, fr = lane & 15, fq = lane >> 4;
    const int K = g.K, nt = K / BK;
    unsigned voffA[2], voffB[2];
#pragma unroll
    for (int i = 0; i < 2; ++i) { int R, C; stage_rc(tid * 16 + i * 8192, R, C); const int Rb = (R & ~31) + perm32(R & 31);
        voffA[i] = (unsigned)(R * K + C) * 2u; voffB[i] = (unsigned)(Rb * K + C) * 2u; }
    const size_t kstep = (size_t)(BK * 2);
    const size_t hstep = (size_t)HALF * K * 2;
    const size_t tstep = 2 * hstep;
    const unsigned ldsw = (unsigned)wid * 1024u;
    const int aoff = lds_byte(wr * 64 + fr, fq * 8), boff = lds_byte(wc * 32 + fr, fq * 8);
#define PG8_SA(b, h) (((b) * 2 + (h)) * HTB)
#define PG8_SB(b, h) ((4 + (b) * 2 + (h)) * HTB)
#define PG8_STAGE(bufoff, gbase, voff) do { _Pragma("unroll") for (int _i = 0; _i < 2; ++_i) \
        __builtin_amdgcn_global_load_lds((const unsigned*)((const char*)(gbase) + (voff)[_i]), (LAS unsigned*)(lds + (bufoff) + ldsw + _i * 8192), 16, 0, 0); } while (0)
#define PG8_LDA(dst, b, h) do { _Pragma("unroll") for (int m = 0; m < 4; ++m) _Pragma("unroll") for (int k = 0; k < 2; ++k) dst[m][k] = *(const LAS bf16x8*)(lds + PG8_SA(b, h) + aoff + m * 2048 + k * 1024); } while (0)
#define PG8_LDB(dst, b, h) do { _Pragma("unroll") for (int n = 0; n < 2; ++n) _Pragma("unroll") for (int k = 0; k < 2; ++k) dst[n][k] = *(const LAS bf16x8*)(lds + PG8_SB(b, h) + boff + n * 2048 + k * 1024); } while (0)
#define PG8_MMA(ai, bj, At, Bt) do { __builtin_amdgcn_s_setprio(1); _Pragma("unroll") for (int m = 0; m < 4; ++m) _Pragma("unroll") for (int n = 0; n < 2; ++n) _Pragma("unroll") for (int k = 0; k < 2; ++k) \
        acc[ai][bj][m][n] = __builtin_amdgcn_mfma_f32_16x16x32_bf16(Bt[n][k], At[m][k], acc[ai][bj][m][n], 0, 0, 0); __builtin_amdgcn_s_setprio(0); } while (0)
#define PG8_WAIT_V(n) asm volatile("s_waitcnt vmcnt(" #n ")" ::: "memory")
#define PG8_WAIT_L(n) asm volatile("s_waitcnt lgkmcnt(" #n ")" ::: "memory")
#define PG8_BAR __builtin_amdgcn_s_barrier()
#define PG8_SCHED __builtin_amdgcn_sched_barrier(0)
    Unit cur, nxt; int ui = 0;
    if (!S.next(0, cur)) return;
    f32x4 acc[2][2][4][2];
#pragma unroll
    for (int a = 0; a < 2; ++a)
#pragma unroll
        for (int b = 0; b < 2; ++b)
#pragma unroll
            for (int m = 0; m < 4; ++m)
#pragma unroll
                for (int n = 0; n < 2; ++n) acc[a][b][m][n] = (f32x4){0.f, 0.f, 0.f, 0.f};
    bf16x8 At[4][2], B0[2][2], B1[2][2];
    const char* cA = (const char*)g.A + (size_t)cur.pm * tstep; const char* cB = (const char*)g.Bt + cur.boff;
    PG8_STAGE(PG8_SB(0, 0), cB, voffB); PG8_STAGE(PG8_SB(0, 1), cB + hstep, voffB); PG8_STAGE(PG8_SA(0, 0), cA, voffA); PG8_STAGE(PG8_SA(0, 1), cA + hstep, voffA);
    if (wr == 1) PG8_BAR;
    PG8_WAIT_V(2); PG8_BAR;
    PG8_STAGE(PG8_SB(1, 0), cB + kstep, voffB); PG8_STAGE(PG8_SA(1, 0), cA + kstep, voffA); PG8_STAGE(PG8_SB(1, 1), cB + hstep + kstep, voffB);
    PG8_WAIT_V(6); PG8_BAR;
    for (;;) {
        const bool has_next = S.next(ui + 1, nxt);
        const char* nA = has_next ? (const char*)g.A + (size_t)nxt.pm * tstep : cA; const char* nB = has_next ? (const char*)g.Bt + nxt.boff : cB;
        for (int t = 0; t < nt; t += 2) {
            const bool last = (t == nt - 2);
            const char* a1 = cA + (size_t)(t + 1) * kstep;
            const char* a2 = last ? nA : cA + (size_t)(t + 2) * kstep; const char* b2 = last ? nB : cB + (size_t)(t + 2) * kstep;
            const char* a3 = a2 + kstep; const char* b3 = b2 + kstep;
            PG8_LDB(B0, 0, 0); PG8_LDB(B1, 0, 1); PG8_SCHED; PG8_LDA(At, 0, 0); PG8_STAGE(PG8_SA(1, 1), a1 + hstep, voffA);
            PG8_WAIT_V(8); PG8_WAIT_L(0); PG8_BAR; PG8_MMA(0, 0, At, B0); PG8_MMA(0, 1, At, B1); PG8_BAR; PG8_SCHED;
            PG8_LDA(At, 0, 1); PG8_STAGE(PG8_SB(0, 0), b2, voffB); PG8_STAGE(PG8_SB(0, 1), b2 + hstep, voffB); PG8_STAGE(PG8_SA(0, 0), a2, voffA);
            PG8_WAIT_V(8); PG8_WAIT_L(0); PG8_BAR; PG8_MMA(1, 0, At, B0); PG8_MMA(1, 1, At, B1); PG8_BAR; PG8_SCHED;
            PG8_LDB(B0, 1, 0); PG8_LDB(B1, 1, 1); PG8_SCHED; PG8_LDA(At, 1, 0); PG8_STAGE(PG8_SA(0, 1), a2 + hstep, voffA);
            PG8_WAIT_V(8); PG8_WAIT_L(0); PG8_BAR; PG8_MMA(0, 0, At, B0); PG8_MMA(0, 1, At, B1); PG8_BAR; PG8_SCHED;
            PG8_LDA(At, 1, 1); PG8_STAGE(PG8_SB(1, 0), b3, voffB); PG8_STAGE(PG8_SB(1, 1), b3 + hstep, voffB); PG8_STAGE(PG8_SA(1, 0), a3, voffA);
            PG8_WAIT_V(8); PG8_WAIT_L(0); PG8_BAR; PG8_MMA(1, 0, At, B0); PG8_MMA(1, 1, At, B1); PG8_BAR; PG8_SCHED;
        }
        if (wr == 0) PG8_BAR;
        { int tz = wave_s * 64 + lane_id_(); asm volatile("" : "+v"(tz)); const int l2 = tz & 63; E(acc, cur, wave_s >> 2, wave_s & 3, l2 & 15, l2 >> 4); }
        if (!has_next) break;
#pragma unroll
        for (int a = 0; a < 2; ++a)
#pragma unroll
            for (int b = 0; b < 2; ++b)
#pragma unroll
                for (int m = 0; m < 4; ++m)
#pragma unroll
                    for (int n = 0; n < 2; ++n) acc[a][b][m][n] = (f32x4){0.f, 0.f, 0.f, 0.f};
        cur = nxt; cA = nA; cB = nB; ++ui;
        if (wr == 1) PG8_BAR;
    }
    PG8_WAIT_V(0);
    PG8_BAR;
#undef PG8_SA
#undef PG8_SB
#undef PG8_STAGE
#undef PG8_LDA
#undef PG8_LDB
#undef PG8_MMA
#undef PG8_WAIT_V
#undef PG8_WAIT_L
#undef PG8_BAR
#undef PG8_SCHED
}
}
#define XB_TMO      128
#define XB_XCNT(j)  (256  + 64 * (j))
#define XB_XSUB(j)  (1280 + 64 * (j))
#define XB_XGEN(j)  (2304 + 64 * (j))
#define XB_TOP      3328
#define XB_TOPGEN   3392
#define XCD_BAR_WORDS 3456
#define XB_SPIN_CAP (1u << 18)

__device__ __forceinline__ unsigned xb_ld(unsigned* p)              { return __hip_atomic_load(p, __ATOMIC_RELAXED, __HIP_MEMORY_SCOPE_AGENT); }
__device__ __forceinline__ unsigned xb_add(unsigned* p, unsigned v) { return __hip_atomic_fetch_add(p, v, __ATOMIC_RELAXED, __HIP_MEMORY_SCOPE_AGENT); }
__device__ __forceinline__ unsigned xb_xcc_id() { return (unsigned)__builtin_amdgcn_s_getreg((3 << 11) | 20) & 0xFu; }
#define XB_SPIN(cond, bar) do { unsigned _sp = 0; while (cond) { __builtin_amdgcn_s_sleep(1); \
    if ((++_sp & 255u) == 0u) { if (xb_ld(&(bar)[XB_TMO])) break; if (_sp > XB_SPIN_CAP) { atomicAdd(&(bar)[XB_TMO], 1u); break; } } } } while (0)

struct XcdBarrier {
    unsigned* bar; unsigned x; int w;
    volatile LAS unsigned* st;
};

__device__ __forceinline__ XcdBarrier xcd_barrier_post(unsigned* bar, volatile LAS unsigned* st, int wave_s) {
    XcdBarrier b; b.bar = bar; b.x = xb_xcc_id(); b.st = st; b.w = wave_s;
    if (wave_s == 0 && lane_id_() == 0) (void)xb_add(&bar[XB_XCNT(b.x)], 1u);
    return b;
}
__device__ __forceinline__ void xcd_barrier_complete(unsigned* bar, unsigned x, unsigned& nloc, unsigned& nx) {
    const unsigned G = gridDim.x * gridDim.y * gridDim.z;
    unsigned sum, cnt, mine, sp = 0u;
    for (;;) {
        sum = 0u; cnt = 0u; mine = 0u;
#pragma unroll
        for (unsigned j = 0; j < 16; ++j) { const unsigned c = xb_ld(&bar[XB_XCNT(j)]); sum += c; cnt += (c > 0u) ? 1u : 0u; mine = (j == x) ? c : mine; }
        if (sum == G) break;
        __builtin_amdgcn_s_sleep(1);
        if ((++sp & 255u) == 0u) { if (xb_ld(&bar[XB_TMO])) break; if (sp > XB_SPIN_CAP) { atomicAdd(&bar[XB_TMO], 1u); break; } }
    }
    nloc = mine > 0u ? mine : 1u; nx = cnt > 0u ? cnt : 1u;
}

__device__ __forceinline__ void xcd_barrier(const XcdBarrier& b) {
    asm volatile("s_waitcnt vmcnt(0)" ::: "memory");
    __syncthreads();
    if (b.w == 0 && lane_id_() == 0) {
        unsigned* bar = b.bar;
        __builtin_amdgcn_s_waitcnt(0);
        unsigned nloc = b.st[0], nx = b.st[1];
        if (nloc == 0u) { xcd_barrier_complete(bar, b.x, nloc, nx); b.st[0] = nloc; b.st[1] = nx; }
        const unsigned old = xb_add(&bar[XB_XSUB(b.x)], 1u);
        const unsigned gen = old / nloc;
        if (old + 1u == (gen + 1u) * nloc) {
            __builtin_amdgcn_fence(__ATOMIC_RELEASE, "agent");
            asm volatile("s_waitcnt vmcnt(0)" ::: "memory");
            const unsigned og = xb_add(&bar[XB_TOP], 1u);
            const unsigned tg = og / nx;
            if (og + 1u == (tg + 1u) * nx) xb_add(&bar[XB_TOPGEN], 1u);
            else XB_SPIN(xb_ld(&bar[XB_TOPGEN]) == tg, bar);
            __builtin_amdgcn_fence(__ATOMIC_ACQUIRE, "agent");
            xb_add(&bar[XB_XGEN(b.x)], 1u);
            asm volatile("s_waitcnt vmcnt(0)" ::: "memory");
        } else {
            XB_SPIN(xb_ld(&bar[XB_XGEN(b.x)]) == gen, bar);
            __builtin_amdgcn_fence(__ATOMIC_ACQUIRE, "agent");
            asm volatile("s_waitcnt vmcnt(0)" ::: "memory");
        }
    }
    __syncthreads();
}

__device__ const float ROPE_COS[64][8] = {
1.0f, 1.0f, 1.0f, 1.0f, 1.0f, 1.0f, 1.0f, 1.0f,
0.540302277f, 0.950415254f, 0.995004177f, 0.999500036f, 0.999949992f, 0.999994993f, 0.999999523f, 0.99999994f,
-0.416146845f, 0.806578398f, 0.980066597f, 0.998000681f, 0.999800026f, 0.999979973f, 0.999997973f, 0.999999821f,
-0.989992499f, 0.582753658f, 0.955336511f, 0.995503366f, 0.999550045f, 0.999954998f, 0.99999553f, 0.999999523f,
-0.653643608f, 0.301137477f, 0.921060979f, 0.992010653f, 0.999200106f, 0.999920011f, 0.999992013f, 0.999999225f,
0.2836622f, -0.0103423381f, 0.87758255f, 0.987526f, 0.998750269f, 0.999875009f, 0.999987483f, 0.999998748f,
0.960170269f, -0.3207964f, 0.825335622f, 0.982053936f, 0.998200536f, 0.999819994f, 0.999981999f, 0.999998212f,
0.753902256f, -0.599437475f, 0.764842212f, 0.975599885f, 0.997551024f, 0.999755025f, 0.999975502f, 0.999997556f,
-0.145500034f, -0.818632424f, 0.696706712f, 0.968170285f, 0.996801734f, 0.999680042f, 0.999967992f, 0.999996781f,
-0.91113025f, -0.956644177f, 0.621609926f, 0.959772646f, 0.995952725f, 0.999595046f, 0.999959528f, 0.999995947f,
-0.839071512f, -0.999786079f, 0.540302277f, 0.950415313f, 0.995004177f, 0.999500036f, 0.999949992f, 0.999994993f,
0.00442569796f, -0.943779767f, 0.453596085f, 0.940107584f, 0.993956089f, 0.999395072f, 0.999939501f, 0.99999392f,
0.843853951f, -0.79417938f, 0.362357706f, 0.92885989f, 0.99280864f, 0.999280095f, 0.999927998f, 0.999992788f,
0.907446802f, -0.565820515f, 0.267498761f, 0.916683376f, 0.99156189f, 0.999155104f, 0.999915481f, 0.999991536f,
0.136737213f, -0.28134948f, 0.16996716f, 0.903590262f, 0.990216017f, 0.999020159f, 0.99990201f, 0.999990225f,
-0.759687901f, 0.0310223512f, 0.070737198f, 0.889593601f, 0.988771081f, 0.998875201f, 0.999887526f, 0.999988735f,
-0.957659483f, 0.340318173f, -0.0291995462f, 0.87470746f, 0.987227261f, 0.998720288f, 0.999872029f, 0.999987185f,
-0.275163352f, 0.615864813f, -0.128844544f, 0.858946681f, 0.985584795f, 0.998555362f, 0.999855518f, 0.999985576f,
0.660316706f, 0.830336154f, -0.227202162f, 0.842327058f, 0.983843684f, 0.998380423f, 0.999837995f, 0.999983788f,
0.988704622f, 0.962463796f, -0.323289543f, 0.824865162f, 0.982004225f, 0.998195529f, 0.999819517f, 0.99998194f,
0.408082068f, 0.999144375f, -0.416146845f, 0.806578457f, 0.980066597f, 0.998000681f, 0.999800026f, 0.999979973f,
-0.547729254f, 0.936740458f, -0.504846215f, 0.787485182f, 0.97803092f, 0.99779582f, 0.999779522f, 0.999977946f,
-0.99996084f, 0.781440377f, -0.588501155f, 0.767604589f, 0.975897431f, 0.997581005f, 0.999758005f, 0.999975801f,
-0.53283304f, 0.548645258f, -0.666275978f, 0.746956408f, 0.97366637f, 0.997356176f, 0.999735534f, 0.999973536f,
0.424179018f, 0.261441678f, -0.737393796f, 0.725561321f, 0.971337974f, 0.997121394f, 0.99971199f, 0.999971211f,
0.991202831f, -0.0516893305f, -0.801143587f, 0.703440726f, 0.968912423f, 0.996876657f, 0.999687493f, 0.999968767f,
0.64691931f, -0.359694332f, -0.856888831f, 0.680616796f, 0.966389954f, 0.996621907f, 0.999662042f, 0.999966204f,
-0.292138815f, -0.632028639f, -0.904072165f, 0.6571123f, 0.963770926f, 0.996357203f, 0.999635518f, 0.999963522f,
-0.962605894f, -0.841684937f, -0.942222297f, 0.632950664f, 0.961055458f, 0.996082544f, 0.99960804f, 0.99996078f,
-0.748057544f, -0.967871487f, -0.970958173f, 0.608156204f, 0.958243906f, 0.995797932f, 0.999579549f, 0.999957979f,
0.154251456f, -0.998075247f, -0.989992499f, 0.582753658f, 0.955336511f, 0.995503366f, 0.999550045f, 0.999954998f,
0.914742351f, -0.929300308f, -0.999135137f, 0.556768358f, 0.95233357f, 0.995198846f, 0.999519527f, 0.999951959f,
0.83422339f, -0.768367112f, -0.998294771f, 0.53022635f, 0.949235439f, 0.994884372f, 0.999488056f, 0.9999488f,
-0.0132767474f, -0.531235278f, -0.987479806f, 0.503154159f, 0.946042359f, 0.994559944f, 0.999455571f, 0.999945521f,
-0.848570287f, -0.241421118f, -0.966798186f, 0.475578904f, 0.942754686f, 0.994225562f, 0.999422073f, 0.999942183f,
-0.903692186f, 0.0723346695f, -0.93645668f, 0.447528064f, 0.939372718f, 0.993881226f, 0.999387562f, 0.999938726f,
-0.127963692f, 0.378916174f, -0.896758378f, 0.419029742f, 0.935896814f, 0.993526995f, 0.999352098f, 0.99993521f,
0.765414059f, 0.647921681f, -0.848100007f, 0.39011243f, 0.93232733f, 0.993162811f, 0.99931556f, 0.999931574f,
0.955073655f, 0.852673113f, -0.790967762f, 0.360805035f, 0.928664625f, 0.992788672f, 0.999278069f, 0.999927819f,
0.266642928f, 0.972865343f, -0.72593224f, 0.331136853f, 0.924909055f, 0.99240464f, 0.999239624f, 0.999923944f,
-0.666938066f, 0.996578991f, -0.653643608f, 0.301137596f, 0.921060979f, 0.992010653f, 0.999200106f, 0.999920011f,
-0.987339258f, 0.921462357f, -0.574824035f, 0.270837069f, 0.917120814f, 0.991606772f, 0.999159634f, 0.999915957f,
-0.399985313f, 0.754965365f, -0.490260571f, 0.240265876f, 0.913088918f, 0.991192937f, 0.999118149f, 0.999911785f,
0.555113316f, 0.513598442f, -0.400799006f, 0.209454417f, 0.908965766f, 0.990769207f, 0.999075651f, 0.999907553f,
0.999843299f, 0.221298173f, -0.307332784f, 0.178433523f, 0.904751658f, 0.990335584f, 0.99903214f, 0.999903202f,
0.52532196f, -0.0929481089f, -0.210795805f, 0.147234216f, 0.90044713f, 0.989892066f, 0.998987675f, 0.999898732f,
-0.432177931f, -0.397976756f, -0.112152621f, 0.115887694f, 0.89605248f, 0.989438653f, 0.998942196f, 0.999894202f,
-0.992335498f, -0.663538277f, -0.0123883775f, 0.0844252855f, 0.891568303f, 0.988975346f, 0.998895705f, 0.999889553f,
-0.640144348f, -0.863296509f, 0.0874991715f, 0.0528784581f, 0.886994898f, 0.988502085f, 0.9988482f, 0.999884784f,
0.300592542f, -0.977442741f, 0.18651247f, 0.0212787576f, 0.882332861f, 0.98801899f, 0.998799741f, 0.999879956f,
0.964965999f, -0.994656444f, 0.2836622f, -0.0103422189f, 0.87758255f, 0.987526f, 0.998750269f, 0.999875009f,
0.742154181f, -0.913230121f, 0.377977669f, -0.0419528559f, 0.872744501f, 0.987023175f, 0.998699784f, 0.999869943f,
-0.162990779f, -0.741239965f, 0.468516916f, -0.0735215396f, 0.86781919f, 0.986510456f, 0.998648286f, 0.999864817f,
-0.918282807f, -0.495741814f, 0.554374516f, -0.105016708f, 0.862807095f, 0.985987842f, 0.998595834f, 0.999859571f,
-0.829309821f, -0.201079622f, 0.634692967f, -0.136406869f, 0.857708693f, 0.985455394f, 0.998542368f, 0.999854207f,
0.0221267566f, 0.113521777f, 0.708669782f, -0.167660639f, 0.852524519f, 0.984913111f, 0.99848789f, 0.999848783f,
0.853220105f, 0.416867077f, 0.775565803f, -0.198746875f, 0.847255111f, 0.984360933f, 0.998432398f, 0.99984318f,
0.899866819f, 0.678870201f, 0.834712923f, -0.22963427f, 0.841901004f, 0.983798921f, 0.998375952f, 0.999837577f,
0.119180135f, 0.873550534f, 0.885519624f, -0.260292053f, 0.836462677f, 0.983227074f, 0.998318493f, 0.999831796f,
-0.771080196f, 0.981602073f, 0.927478492f, -0.290689558f, 0.830940723f, 0.982645452f, 0.998260021f, 0.999825954f,
-0.952412963f, 0.992308319f, 0.960170269f, -0.3207964f, 0.825335622f, 0.982053936f, 0.998200536f, 0.999819994f,
-0.258101642f, 0.904607594f, 0.98326844f, -0.350582451f, 0.819648027f, 0.981452644f, 0.998140097f, 0.999813974f,
0.673507154f, 0.727198064f, 0.996542096f, -0.380017966f, 0.813878477f, 0.980841517f, 0.998078644f, 0.999807835f,
0.985896587f, 0.477671444f, 0.999858618f, -0.409073502f, 0.808027506f, 0.980220556f, 0.998016179f, 0.999801576f
};
__device__ const float ROPE_SIN[64][8] = {
0.0f, 0.0f, 0.0f, 0.0f, 0.0f, 0.0f, 0.0f, 0.0f,
0.841470957f, 0.310983598f, 0.0998334214f, 0.0316175036f, 0.00999983307f, 0.00316227227f, 0.000999999931f, 0.000316227757f,
0.909297407f, 0.591127098f, 0.198669329f, 0.0632033944f, 0.0199986659f, 0.00632451288f, 0.0019999987f, 0.000632455456f,
0.141120002f, 0.812648892f, 0.295520216f, 0.0947260857f, 0.0299954992f, 0.00948669016f, 0.0029999956f, 0.000948683126f,
-0.756802499f, 0.953580737f, 0.389418334f, 0.126154065f, 0.0399893336f, 0.0126487734f, 0.00399998948f, 0.00126491068f,
-0.958924294f, 0.999946535f, 0.47942555f, 0.157455876f, 0.0499791652f, 0.0158107281f, 0.0049999794f, 0.00158113812f,
-0.279415488f, 0.947148204f, 0.564642489f, 0.188600272f, 0.0599640049f, 0.0189725272f, 0.0059999642f, 0.00189736532f,
0.656986594f, 0.800421596f, 0.64421767f, 0.219556093f, 0.0699428469f, 0.0221341345f, 0.00699994294f, 0.00221359241f,
0.989358246f, 0.574317753f, 0.717356086f, 0.250292331f, 0.0799146891f, 0.0252955221f, 0.0079999147f, 0.00252981926f,
0.412118495f, 0.291259229f, 0.783326924f, 0.280778319f, 0.0898785442f, 0.0284566563f, 0.00899987947f, 0.00284604589f,
-0.54402113f, -0.0206835698f, 0.841470957f, 0.310983568f, 0.099833414f, 0.0316175036f, 0.009999834f, 0.00316227227f,
-0.999990225f, -0.33057496f, 0.891207397f, 0.340877861f, 0.1097783f, 0.0347780399f, 0.0109997792f, 0.00347849843f,
-0.536572933f, -0.60768342f, 0.932039082f, 0.370431304f, 0.119712204f, 0.0379382223f, 0.0119997123f, 0.00379472389f,
0.420167029f, -0.824528456f, 0.963558197f, 0.399614304f, 0.129634142f, 0.0410980321f, 0.0129996343f, 0.00411094911f,
0.990607381f, -0.959605396f, 0.985449731f, 0.428397775f, 0.139543116f, 0.0442574248f, 0.0139995432f, 0.00442717411f,
0.650287867f, -0.999518692f, 0.997494996f, 0.456752867f, 0.149438128f, 0.0474163815f, 0.0149994381f, 0.00474339863f,
-0.287903309f, -0.940310359f, 0.999573588f, 0.484651238f, 0.159318209f, 0.0505748577f, 0.015999319f, 0.00505962269f,
-0.961397469f, -0.78785187f, 0.991664827f, 0.512064993f, 0.169182345f, 0.0537328273f, 0.0169991814f, 0.00537584582f,
-0.750987232f, -0.557262897f, 0.973847628f, 0.538966715f, 0.179029569f, 0.0568902642f, 0.0179990288f, 0.00569206895f,
0.149877205f, -0.271410108f, 0.946300089f, 0.565329552f, 0.188858896f, 0.060047131f, 0.0189988576f, 0.00600829115f,
0.912945271f, 0.0413582884f, 0.909297407f, 0.591127038f, 0.198669314f, 0.0632033944f, 0.0199986678f, 0.00632451288f,
0.836655617f, 0.35002476f, 0.863209307f, 0.616333544f, 0.208459899f, 0.0663590282f, 0.0209984574f, 0.00664073415f,
-0.00885130931f, 0.623979926f, 0.808496356f, 0.640923738f, 0.218229622f, 0.0695140064f, 0.0219982266f, 0.00695695449f,
-0.846220434f, 0.836055279f, 0.745705247f, 0.664873064f, 0.227977514f, 0.0726682767f, 0.0229979735f, 0.00727317436f,
-0.905578375f, 0.965219259f, 0.67546314f, 0.688157499f, 0.237702623f, 0.0758218244f, 0.0239976961f, 0.0075893933f,
-0.132351756f, 0.998663187f, 0.598472118f, 0.710753918f, 0.247403964f, 0.0789746121f, 0.0249973964f, 0.00790561177f,
0.76255846f, 0.933070183f, 0.515501261f, 0.732639611f, 0.257080555f, 0.0821266174f, 0.0259970706f, 0.00822182931f,
0.956375957f, 0.774945021f, 0.427379847f, 0.753792703f, 0.266731411f, 0.0852777958f, 0.0269967206f, 0.00853804592f,
0.270905793f, 0.539968967f, 0.334988207f, 0.774192095f, 0.276355654f, 0.0884281173f, 0.0279963426f, 0.0088542616f,
-0.663633883f, 0.251445323f, 0.239249229f, 0.793817401f, 0.28595221f, 0.0915775672f, 0.0289959367f, 0.00917047635f,
-0.988031626f, -0.0620148405f, 0.141120002f, 0.812648892f, 0.295520186f, 0.0947260931f, 0.029995501f, 0.00948669016f,
-0.404037654f, -0.369325012f, 0.0415805206f, 0.830667794f, 0.305058628f, 0.0978736654f, 0.0309950355f, 0.00980290305f,
0.551426709f, -0.640009403f, -0.0583741926f, 0.847856104f, 0.314566553f, 0.101020269f, 0.0319945402f, 0.0101191159f,
0.999911845f, -0.847224355f, -0.157745644f, 0.864196658f, 0.324043006f, 0.10416586f, 0.0329940096f, 0.010435327f,
0.529082716f, -0.97042042f, -0.255541205f, 0.879673064f, 0.333487093f, 0.107310407f, 0.0339934528f, 0.010751537f,
-0.428182662f, -0.997380435f, -0.350783229f, 0.894269884f, 0.342897803f, 0.110453881f, 0.034992855f, 0.0110677453f,
-0.991778851f, -0.925431013f, -0.442520559f, 0.907972515f, 0.352274209f, 0.113596253f, 0.0359922275f, 0.0113839535f,
-0.643538117f, -0.761706948f, -0.529836178f, 0.920767248f, 0.361615449f, 0.116737492f, 0.036991559f, 0.0117001599f,
0.296368569f, -0.522444785f, -0.611857831f, 0.932641268f, 0.370920479f, 0.119877554f, 0.0379908569f, 0.0120163653f,
0.963795364f, -0.231372014f, -0.687766254f, 0.943582714f, 0.380188406f, 0.123016424f, 0.0389901139f, 0.0123325698f,
0.745113134f, 0.0826458037f, -0.756802499f, 0.953580678f, 0.389418334f, 0.126154065f, 0.0399893373f, 0.0126487734f,
-0.158622667f, 0.388467699f, -0.818277061f, 0.962625206f, 0.39860931f, 0.129290432f, 0.0409885161f, 0.0129649751f,
-0.916521549f, 0.655764699f, -0.871575892f, 0.970707119f, 0.407760441f, 0.132425532f, 0.0419876575f, 0.0132811759f,
-0.831774771f, 0.858030677f, -0.916166008f, 0.977818429f, 0.416870773f, 0.135559291f, 0.0429867506f, 0.0135973748f,
0.0177019257f, 0.975206196f, -0.951602101f, 0.983951986f, 0.425939471f, 0.138691694f, 0.0439858064f, 0.0139135728f,
0.850903511f, 0.995670974f, -0.977530122f, 0.989101648f, 0.434965521f, 0.141822711f, 0.0449848175f, 0.0142297689f,
0.901788354f, 0.917395473f, -0.993690968f, 0.993262351f, 0.44394809f, 0.144952312f, 0.0459837839f, 0.0145459641f,
0.123573124f, 0.748142362f, -0.999923289f, 0.996429801f, 0.452886283f, 0.148080453f, 0.0469827019f, 0.0148621574f,
-0.768254638f, 0.504697084f, -0.99616462f, 0.99860096f, 0.461779177f, 0.151207119f, 0.0479815714f, 0.0151783489f,
-0.953752637f, 0.211200655f, -0.982452571f, 0.999773562f, 0.470625877f, 0.15433228f, 0.0489803962f, 0.0154945394f,
-0.262374848f, -0.10324046f, -0.958924294f, 0.999946535f, 0.47942555f, 0.157455891f, 0.0499791689f, 0.0158107281f,
0.670229197f, -0.407444149f, -0.925814748f, 0.99911958f, 0.48817724f, 0.160577938f, 0.0509778969f, 0.0161269177f,
0.986627579f, -0.671240151f, -0.883454502f, 0.997293651f, 0.496880114f, 0.163698375f, 0.051976569f, 0.0164431017f,
0.395925164f, -0.868469954f, -0.832267344f, 0.994470477f, 0.505533338f, 0.166817173f, 0.0529751927f, 0.0167592876f,
-0.558789074f, -0.979574919f, -0.772764444f, 0.990652919f, 0.514135957f, 0.169934288f, 0.0539737605f, 0.0170754679f,
-0.999755144f, -0.993535519f, -0.705540299f, 0.985844791f, 0.522687256f, 0.173049718f, 0.0549722798f, 0.01739165f,
-0.521551013f, -0.908967435f, -0.631266713f, 0.980050862f, 0.531186223f, 0.17616342f, 0.0559707358f, 0.0177078284f,
0.436164767f, -0.734258294f, -0.550685287f, 0.973276973f, 0.539632022f, 0.179275364f, 0.0569691435f, 0.0180240069f,
0.992872655f, -0.486733496f, -0.464602023f, 0.965529919f, 0.548023939f, 0.182385504f, 0.0579674877f, 0.0183401816f,
0.636738002f, -0.190938011f, -0.373876572f, 0.956817448f, 0.55636102f, 0.185493827f, 0.0589657798f, 0.0186563563f,
-0.304810613f, 0.12379095f, -0.279415488f, 0.947148204f, 0.564642429f, 0.188600287f, 0.0599640086f, 0.0189725272f,
-0.966117799f, 0.426245421f, -0.182162598f, 0.936531842f, 0.572867453f, 0.191704854f, 0.0609621815f, 0.0192886982f,
-0.739180684f, 0.686427653f, -0.0830891207f, 0.924979091f, 0.581035137f, 0.194807529f, 0.0619602874f, 0.0196048655f,
0.167355701f, 0.878538549f, 0.0168140903f, 0.912501454f, 0.589144766f, 0.197908238f, 0.0629583374f, 0.0199210308f
};

struct Params { const float* in[41]; float* out; unsigned char* ws; };
enum { I_X = 0, I_C, I_CTX, I_CCTX, I_LNG, I_LNB, I_ADAW, I_ADAB, I_WIN, I_LQ1, I_LK1, I_LQ2, I_LK2, I_SUBLN, I_GW2, I_GGB, I_GNG, I_CONV, I_W2, I_W0, I_A2, I_A0, I_G2, I_KK, I_KA, I_RK,
       I_LNXG, I_LNXB, I_WOUT, I_LN1G, I_LN1B, I_RW, I_RB, I_MWG, I_MBG, I_MWU, I_MBU, I_MWD, I_MBD, I_LN2G, I_LN2B };

#define WSP(T, off) ((T*)(p.ws + (off)))
#define SCRP(T, off) ((T*)(p.ws + WS_SCR + (off)))

__device__ __forceinline__ void conv_tile(const float* __restrict__ src, int ld, int nvalid, int k0, int n0, bf16_t* __restrict__ dst, int rs, int ro, LAS float* tile, int tid) {
    {
        const int k = tid >> 3, n8 = (tid & 7) * 8;
        const float* s = src + (size_t)(k0 + k) * ld + n0 + n8;
        f32x4 a = {0.f, 0.f, 0.f, 0.f}, b = {0.f, 0.f, 0.f, 0.f};
        if (n0 + n8 + 8 <= nvalid) { a = *(const f32x4*)s; b = *(const f32x4*)(s + 4); }
        LAS float* t = tile + k * 65 + n8;
        t[0] = a[0]; t[1] = a[1]; t[2] = a[2]; t[3] = a[3]; t[4] = b[0]; t[5] = b[1]; t[6] = b[2]; t[7] = b[3];
    }
    __syncthreads();
    {
        const int n = tid >> 3, k8 = (tid & 7) * 8;
        const LAS float* t = tile + k8 * 65 + n;
        u32x4 o; o.x = pk2(t[0], t[65]); o.y = pk2(t[130], t[195]); o.z = pk2(t[260], t[325]); o.w = pk2(t[390], t[455]);
        *(u32x4*)(dst + ((size_t)(n0 + n) * rs + ro) * 1024 + k0 + k8) = o;
    }
    __syncthreads();
}
constexpr int JW_IN = 16 * 56, JW_OUT = 256, JW_LAYER = JW_IN + JW_OUT + 32 * 768, JW_TOTAL = 2 * JW_LAYER, J_MOD = 48;
__device__ __forceinline__ void conv_job(const Params& p, int j, LAS float* tile, int tid) {
    asm volatile("" : "+v"(tid));
    const int l = j / JW_LAYER; int r = j % JW_LAYER;
    if (r < JW_IN) { const int kt = r / 56, nt = r % 56;
        conv_tile(p.in[I_WIN] + (size_t)l * 1024 * DIN, DIN, DIN, kt * 64, nt * 64, WSP(bf16_t, WS_WIN) + (size_t)l * DINP * 1024, 1, 0, tile, tid); return; }
    r -= JW_IN;
    if (r < JW_OUT) { const int kt = r >> 4, nt = r & 15;
        conv_tile(p.in[I_WOUT] + (size_t)l * 1024 * 1024, 1024, 1024, kt * 64, nt * 64, WSP(bf16_t, WS_WOUT) + (size_t)l * 1024 * 1024, 1, 0, tile, tid); return; }
    r -= JW_OUT;
    const int e = r / 768, q = r % 768, which = q >> 8, t = q & 255, kt = t >> 4, nt = t & 15;
    const size_t eo = (size_t)(l * 32 + e) * 1024 * 1024;
    if (which == 0) conv_tile(p.in[I_MWG] + eo, 1024, 1024, kt * 64, nt * 64, WSP(bf16_t, WS_WGU) + 2 * eo, 2, 0, tile, tid);
    else if (which == 1) conv_tile(p.in[I_MWU] + eo, 1024, 1024, kt * 64, nt * 64, WSP(bf16_t, WS_WGU) + 2 * eo, 2, 1, tile, tid);
    else conv_tile(p.in[I_MWD] + eo, 1024, 1024, kt * 64, nt * 64, WSP(bf16_t, WS_WDN) + eo, 1, 0, tile, tid);
}
__device__ __forceinline__ void mod_job(const Params& p, int job, LAS float* lds, int tid) {
    asm volatile("" : "+v"(tid));
    const int l = job / 24, c0 = (job % 24) * 256;
    LAS float* sv = lds;
    LAS float* part = lds + 5120;
    for (int i = tid; i < 5120; i += NTHR) { const int s = i >> 10, k = i & 1023; const float cv = s < 4 ? p.in[I_C][s * 1024 + k] : p.in[I_CCTX][k]; sv[i] = siluf_(cv); }
    __syncthreads();
    const int n = tid & 255, kh = tid >> 8;
    const float* w = p.in[I_ADAW] + (size_t)l * 1024 * 6144 + (size_t)(kh * 512) * 6144 + c0 + n;
    float a0 = 0.f, a1 = 0.f, a2 = 0.f, a3 = 0.f, a4 = 0.f;
    const LAS float* s0 = sv + kh * 512;
#pragma unroll 8
    for (int k = 0; k < 512; ++k) { const float wv = w[(size_t)k * 6144];
        a0 += s0[k] * wv; a1 += s0[1024 + k] * wv; a2 += s0[2048 + k] * wv; a3 += s0[3072 + k] * wv; a4 += s0[4096 + k] * wv; }
    part[(kh * 5 + 0) * 256 + n] = a0; part[(kh * 5 + 1) * 256 + n] = a1; part[(kh * 5 + 2) * 256 + n] = a2; part[(kh * 5 + 3) * 256 + n] = a3; part[(kh * 5 + 4) * 256 + n] = a4;
    __syncthreads();
    if (kh == 0) { const float bb = p.in[I_ADAB][l * 6144 + c0 + n]; float* mo = WSP(float, WS_MOD);
#pragma unroll
        for (int s = 0; s < 5; ++s) mo[(size_t)(l * 5 + s) * 6144 + c0 + n] = part[s * 256 + n] + part[(5 + s) * 256 + n] + bb; }
    __syncthreads();
}

__device__ __forceinline__ void ln_in_rows(const Params& p, int gw, int ngw, int lane) {
    float* H = WSP(float, WS_H); bf16_t* XM = WSP(bf16_t, WS_XM); const float* MOD = WSP(float, WS_MOD);
    for (int row = gw; row < NTOK; row += ngw) {
        const float* src = row < NLAT ? p.in[I_X] + (size_t)row * D : p.in[I_CTX] + (size_t)(row - NLAT) * D;
        f32x4 v[4]; float s = 0.f;
#pragma unroll
        for (int j = 0; j < 4; ++j) { v[j] = *(const f32x4*)(src + lane * 4 + 256 * j); s += (v[j][0] + v[j][1]) + (v[j][2] + v[j][3]); }
        const float mean = wave_sum(s) * (1.f / D); float s2 = 0.f;
#pragma unroll
        for (int j = 0; j < 4; ++j) { v[j] = v[j] - mean; s2 += (v[j][0] * v[j][0] + v[j][1] * v[j][1]) + (v[j][2] * v[j][2] + v[j][3] * v[j][3]); }
        const float rstd = rsqrtf(wave_sum(s2) * (1.f / D) + LN_EPS);
        const int sidx = row < NLAT ? (row >> 12) : 4; const float* mod = MOD + (size_t)sidx * 6144;
#pragma unroll
        for (int j = 0; j < 4; ++j) { const int c = lane * 4 + 256 * j;
            const f32x4 g = *(const f32x4*)(p.in[I_LNG] + c), bb = *(const f32x4*)(p.in[I_LNB] + c);
            const f32x4 y = v[j] * rstd * g + bb;
            *(f32x4*)(H + (size_t)row * D + c) = y;
            const f32x4 sh = *(const f32x4*)(mod + c), sc = *(const f32x4*)(mod + 1024 + c);
            const f32x4 xm = y * (sc + 1.f) + sh;
            u32x2 o; o.x = pk2(xm[0], xm[1]); o.y = pk2(xm[2], xm[3]);
            *(u32x2*)(XM + (size_t)row * D + c) = o; }
    }
}

__device__ __forceinline__ void unpack8(const u32x4 u, float (&f)[8]) {
    f[0] = bflo(u.x); f[1] = bfhi(u.x); f[2] = bflo(u.y); f[3] = bfhi(u.y); f[4] = bflo(u.z); f[5] = bfhi(u.z); f[6] = bflo(u.w); f[7] = bfhi(u.w);
}
__device__ __forceinline__ void da_job(const Params& p, int l, int b, int kt, LAS unsigned char* lds, int tid) {
    asm volatile("" : "+v"(tid));
    LAS bf16_t* kvt = (LAS bf16_t*)lds;
    const bf16_t* Z = WSP(bf16_t, WS_Z);
    const bool isctx = kt < 8;
    const int rowb = isctx ? NLAT + b * 256 + kt * 32 : b * 4096 + (kt - 8) * 32;
    for (int i = tid; i < 2048; i += NTHR) { const int r = i >> 6, c16 = i & 63;
        *(LAS u32x4*)(kvt + r * 512 + c16 * 8) = *(const u32x4*)(Z + (size_t)(rowb + r) * DINP + ZK + c16 * 8); }
    __syncthreads();
    const int w = tid >> 6, L = tid & 63, fr = L & 15, fq = L >> 4;
    unsigned char* rec = SCRP(unsigned char, SC_KVREC);
    unsigned* kmax = WSP(unsigned, WS_CTL) + CW_KMAX + l * 32;
    for (int h = 0; h < 4; ++h) {
        u32x4 o;
        if (w < 4) {
            const int m = w >> 1, ks = w & 1, key = ks * 16 + fr;
            float ov[8], pv[8];
            unpack8(*(const LAS u32x4*)(kvt + key * 512 + h * 64 + m * 32 + fq * 8), ov);
            unpack8(*(const LAS u32x4*)(kvt + key * 512 + h * 64 + m * 32 + (fq ^ 1) * 8), pv);
            if (!isctx) {
                const int t = (kt - 8) * 32 + key, pos = (fq >> 1) ? (t & 63) : (t >> 6);
                const float sg = (fq & 1) ? 1.f : -1.f;
#pragma unroll
                for (int i = 0; i < 8; ++i) ov[i] = ov[i] * ROPE_COS[pos][i] + sg * pv[i] * ROPE_SIN[pos][i];
            }
            o.x = pk2(ov[0], ov[1]); o.y = pk2(ov[2], ov[3]); o.z = pk2(ov[4], ov[5]); o.w = pk2(ov[6], ov[7]);
            float rv[8]; unpack8(o, rv); float n2 = 0.f;
#pragma unroll
            for (int i = 0; i < 8; ++i) n2 += rv[i] * rv[i];
            n2 += __shfl_xor(n2, 16); n2 += __shfl_xor(n2, 32);
#pragma unroll
            for (int x = 1; x < 16; x <<= 1) n2 = fmaxf(n2, __shfl_xor(n2, x));
            if (L == 0) atomicMax(kmax + (b * 4 + h) * 2 + m, __builtin_bit_cast(unsigned, n2));
        } else {
            const int et = w - 4; unsigned short vv[8];
#pragma unroll
            for (int i = 0; i < 8; ++i) { const int key = (i < 4) ? fq * 4 + i : 16 + fq * 4 + (i - 4); vv[i] = kvt[key * 512 + 256 + h * 64 + et * 16 + fr]; }
            o.x = vv[0] | ((unsigned)vv[1] << 16); o.y = vv[2] | ((unsigned)vv[3] << 16); o.z = vv[4] | ((unsigned)vv[5] << 16); o.w = vv[6] | ((unsigned)vv[7] << 16);
        }
        *(u32x4*)(rec + ((size_t)((b * 4 + h) * NKT + kt)) * 8192 + w * 1024 + L * 16) = o;
    }
    __syncthreads();
}

__device__ __forceinline__ int chunk_row0(int cid) { return cid < 256 ? (cid >> 6) * 4096 + (cid & 63) * 64 : NLAT + ((cid - 256) >> 2) * 256 + ((cid - 256) & 3) * 64; }

__device__ __forceinline__ void gla_job(const Params& p, int l, int cid, int h, LAS unsigned char* lds, int tid) {
    asm volatile("" : "+v"(tid));
    const int r0 = chunk_row0(cid);
    const bf16_t* Z = WSP(bf16_t, WS_Z);
    LAS float* kf = (LAS float*)lds;
    LAS float* vf = kf + 64 * 33;
    LAS float* gi = vf + 4096;
    LAS float* bF = gi + 2048;
    LAS float* bB = bF + 64 * 33;
    LAS float* kdF = bB + 64 * 33;
    LAS float* kdB = kdF + 64 * 33;
    for (int i = tid; i < 2048; i += NTHR) { const int pp = i >> 5, k = i & 31;
        kf[pp * 33 + k] = bf2f(Z[(size_t)(r0 + pp) * DINP + ZGK + h * 32 + k]); gi[pp * 32 + k] = bf2f(Z[(size_t)(r0 + pp) * DINP + ZGF + k]); }
    for (int i = tid; i < 4096; i += NTHR) { const int pp = i >> 6, v = i & 63; vf[i] = bf2f(Z[(size_t)(r0 + pp) * DINP + ZGV + h * 64 + v]); }
    __syncthreads();
    const float* gw2 = p.in[I_GW2] + (size_t)l * 2 * 16 * 192; const float* ggb = p.in[I_GGB] + (size_t)l * 2 * 192;
#pragma unroll 1
    for (int j = 0; j < 8; ++j) { const int i = tid + NTHR * j, dir = i >> 11, pp = (i >> 5) & 63, k = i & 31;
        float x = ggb[dir * 192 + h * 32 + k];
#pragma unroll
        for (int jj = 0; jj < 16; ++jj) x += gi[pp * 32 + dir * 16 + jj] * gw2[(dir * 16 + jj) * 192 + h * 32 + k];
        const float g = (fminf(x, 0.f) - log1pf(__expf(-fabsf(x)))) * (1.f / 16.f);
        (dir ? bB : bF)[pp * 33 + k] = g; }
    __syncthreads();
    if (tid < 64) { const int dir = tid >> 5, k = tid & 31; float run = 0.f;
        if (dir == 0) { for (int pp = 0; pp < 64; ++pp) { run += bF[pp * 33 + k]; bF[pp * 33 + k] = run; } }
        else { for (int pp = 63; pp >= 0; --pp) { run += bB[pp * 33 + k]; bB[pp * 33 + k] = run; } } }
    __syncthreads();
    float* GBF = SCRP(float, SC_GBF); float* GBB = SCRP(float, SC_GBB);
    for (int i = tid; i < 2048; i += NTHR) { const int pp = i >> 5, k = i & 31; const float bf = bF[pp * 33 + k], bb = bB[pp * 33 + k];
        GBF[(size_t)(r0 + pp) * 192 + h * 32 + k] = bf; GBB[(size_t)(r0 + pp) * 192 + h * 32 + k] = bb;
        const float kk = kf[pp * 33 + k];
        kdF[pp * 33 + k] = kk * __expf(bF[63 * 33 + k] - bf); kdB[pp * 33 + k] = kk * __expf(bB[k] - bb); }
    __syncthreads();
    float* KVC = SCRP(float, SC_KVC); float* DC = SCRP(float, SC_DC);
    const int v = tid & 63, g8 = tid >> 6;
#pragma unroll 1
    for (int j = 0; j < 8; ++j) { const int pr = g8 * 8 + j, dir = pr >> 5, k = pr & 31; const LAS float* kd = dir ? kdB : kdF; float acc = 0.f;
#pragma unroll 8
        for (int pp = 0; pp < 64; ++pp) acc += kd[pp * 33 + k] * vf[pp * 64 + v];
        KVC[((size_t)((cid * 6 + h) * 2 + dir)) * 2048 + k * 64 + v] = acc; }
    if (tid < 64) { const int dir = tid >> 5, k = tid & 31; DC[((cid * 6 + h) * 2 + dir) * 32 + k] = __expf(dir ? bB[k] : bF[63 * 33 + k]); }
    __syncthreads();
}

__device__ __forceinline__ float dot64(const float (&w)[64], const LAS float* v) {
    float a0 = 0.f, a1 = 0.f, a2 = 0.f, a3 = 0.f;
#pragma unroll
    for (int j = 0; j < 64; j += 4) { const f32x4 x = *(const LAS f32x4*)(v + j); a0 += w[j] * x[0]; a1 += w[j + 1] * x[1]; a2 += w[j + 2] * x[2]; a3 += w[j + 3] * x[3]; }
    return (a0 + a1) + (a2 + a3);
}
__device__ __forceinline__ void rw_job(const Params& p, int l, int tt, LAS unsigned char* lds, int tid) {
    asm volatile("" : "+v"(tid));
    const int r0 = tt < 512 ? tt * 32 : NLAT + (tt - 512) * 32;
    const int pos = tt < 512 ? (r0 & 4095) : ((r0 - NLAT) & 255), slen = tt < 512 ? 4096 : 256;
    const bool has_prev = pos > 0, has_next = pos + 32 < slen;
    const bf16_t* Z = WSP(bf16_t, WS_Z);
    LAS bf16_t* rkv = (LAS bf16_t*)lds;
    LAS float* lr = (LAS float*)(lds + 78336);
    LAS float* sg = lr + 8192;
    LAS float* invn = sg + 4096;
    LAS float* bonl = invn + 256;
    LAS float* gpart = (LAS float*)lds;
    for (int i = tid; i < 34 * 144; i += NTHR) { const int rr = i / 144, c16 = i % 144; const bool ok = rr == 0 ? has_prev : (rr == 33 ? has_next : true);
        u32x4 v = {0u, 0u, 0u, 0u}; if (ok) v = *(const u32x4*)(Z + (size_t)(r0 - 1 + rr) * DINP + ZRKV + c16 * 8);
        *(LAS u32x4*)(rkv + rr * 1152 + c16 * 8) = v; }
    for (int i = tid; i < 32 * 384; i += NTHR) { const int t = i / 384, c = i % 384; const float v = bf2f(Z[(size_t)(r0 + t) * DINP + ZWF + c]);
        if (c < 128) lr[(c >> 6) * 2048 + t * 64 + (c & 63)] = tanhf(v);
        else if (c < 256) lr[(2 + ((c - 128) >> 6)) * 2048 + t * 64 + (c & 63)] = v;
        else sg[t * 128 + (c - 256)] = sigmoidf_(v); }
    __syncthreads();
    if (tid < 384) {
        const int c = tid, h = c >> 6, lane = c & 63;
        const float* cw = p.in[I_CONV] + (size_t)l * 3 * 1152;
        const float cr0 = cw[c], cr1 = cw[1152 + c], cr2 = cw[2304 + c];
        const float ck0 = cw[384 + c], ck1 = cw[1152 + 384 + c], ck2 = cw[2304 + 384 + c];
        const float cv0 = cw[768 + c], cv1 = cw[1152 + 768 + c], cv2 = cw[2304 + 768 + c];
        const float kkw = p.in[I_KK][l * 384 + c], kaw = p.in[I_KA][l * 384 + c], rkw = p.in[I_RK][l * 384 + c];
        bf16_t* Rg = SCRP(bf16_t, SC_R); bf16_t* KKg = SCRP(bf16_t, SC_KK); bf16_t* Vg = SCRP(bf16_t, SC_V);
        float* BON = SCRP(float, SC_BON);
#define CONV3(t, off, w0, w1, w2) (bf2f(rkv[(t) * 1152 + (off) + c]) * (w0) + bf2f(rkv[((t) + 1) * 1152 + (off) + c]) * (w1) + bf2f(rkv[((t) + 2) * 1152 + (off) + c]) * (w2))
#pragma unroll 1
        for (int t = 0; t < 32; ++t) {
            const float r = CONV3(t, 0, cr0, cr1, cr2), k = CONV3(t, 384, ck0, ck1, ck2), v = CONV3(t, 768, cv0, cv1, cv2);
            const float kr = k * kkw; const float ss = wave_sum(kr * kr); const float inv = 1.f / fmaxf(sqrtf(ss), 1e-12f);
            const size_t o = (size_t)(r0 + t) * 384 + c;
            Rg[o] = (bf16_t)f2bf(r); Vg[o] = (bf16_t)f2bf(v); KKg[o] = (bf16_t)f2bf(kr * inv);
            if (lane == 0) invn[t * 8 + h] = inv;
        }
#pragma unroll 1
        for (int dir = 0; dir < 2; ++dir) {
            float wa[64];
            const float* a2 = p.in[I_A2] + (size_t)(l * 2 + dir) * 64 * 384;
#pragma unroll
            for (int j = 0; j < 64; ++j) wa[j] = a2[j * 384 + c];
            const float a0v = p.in[I_A0][(l * 2 + dir) * 384 + c];
            bf16_t* BK = dir ? SCRP(bf16_t, SC_BKB) : SCRP(bf16_t, SC_BKF); bf16_t* KM = dir ? SCRP(bf16_t, SC_KMB) : SCRP(bf16_t, SC_KMF);
#pragma unroll 1
            for (int t = 0; t < 32; ++t) {
                const float a = sigmoidf_(a0v + dot64(wa, lr + (2 + dir) * 2048 + t * 64));
                const float r = CONV3(t, 0, cr0, cr1, cr2), k = CONV3(t, 384, ck0, ck1, ck2);
                const float kkn = k * kkw * invn[t * 8 + h];
                const float km = k * (1.f + (a - 1.f) * kaw);
                const size_t o = (size_t)(r0 + t) * 384 + c;
                BK[o] = (bf16_t)f2bf(kkn * a); KM[o] = (bf16_t)f2bf(km);
                const float bs = wave_sum(r * km * rkw);
                if (lane == 0) { if (dir == 0) bonl[t * 8 + h] = bs; else BON[(size_t)(r0 + t) * 8 + h] = bonl[t * 8 + h] + bs; }
            }
        }
#pragma unroll 1
        for (int dir = 0; dir < 2; ++dir) {
            float wa[64];
            const float* w2 = p.in[I_W2] + (size_t)(l * 2 + dir) * 64 * 384;
#pragma unroll
            for (int j = 0; j < 64; ++j) wa[j] = w2[j * 384 + c];
            const float w0v = p.in[I_W0][(l * 2 + dir) * 384 + c];
            float* Wd = dir ? SCRP(float, SC_WB) : SCRP(float, SC_WF);
#pragma unroll 1
            for (int t = 0; t < 32; ++t)
                Wd[(size_t)(r0 + t) * 384 + c] = __expf(-0.6065306597f * sigmoidf_(w0v + dot64(wa, lr + dir * 2048 + t * 64)));
        }
    }
    __syncthreads();
    if (tid < 384) {
        const int c = tid; bf16_t* Gg = SCRP(bf16_t, SC_G);
#pragma unroll 1
        for (int hf = 0; hf < 2; ++hf) {
            float wa[64];
            const float* g2 = p.in[I_G2] + (size_t)l * 128 * 384 + (size_t)hf * 64 * 384;
#pragma unroll
            for (int j = 0; j < 64; ++j) wa[j] = g2[j * 384 + c];
#pragma unroll 1
            for (int t = 0; t < 32; ++t) {
                const float g = dot64(wa, sg + t * 128 + hf * 64);
                if (hf == 0) gpart[t * 384 + c] = g; else Gg[(size_t)(r0 + t) * 384 + c] = (bf16_t)f2bf(gpart[t * 384 + c] + g);
            }
        }
#undef CONV3
    }
    __syncthreads();
}

__device__ __forceinline__ int chain_chunk(int b, int dir, int step) {
    if (step < 4) return 256 + b * 4 + (dir ? 3 - step : step);
    const int cl = step - 4; return b * 64 + (dir ? 63 - cl : cl);
}
__device__ __forceinline__ void g2_job(const Params& p, int job, int tid) {
    asm volatile("" : "+v"(tid));
    const int chain = job >> 2, q = job & 3, b = chain / 12, h = (chain % 12) >> 1, dir = chain & 1, e = q * 512 + tid, k = e >> 6;
    const float* __restrict__ KVC = SCRP(float, SC_KVC); const float* __restrict__ DC = SCRP(float, SC_DC); float* __restrict__ SC = SCRP(float, SC_SC);
    float S = 0.f;
#pragma unroll 1
    for (int s4 = 0; s4 < 68; s4 += 4) {
        float dv[4], kv[4]; size_t base[4];
#pragma unroll
        for (int u = 0; u < 4; ++u) { base[u] = (size_t)((chain_chunk(b, dir, s4 + u) * 6 + h) * 2 + dir); dv[u] = DC[base[u] * 32 + k]; kv[u] = KVC[base[u] * 2048 + e]; }
#pragma unroll
        for (int u = 0; u < 4; ++u) { SC[base[u] * 2048 + e] = S; S = S * dv[u] + kv[u]; }
    }
}

__device__ __forceinline__ void scan_job(const Params& p, int chain, int half, LAS unsigned char* lds, int tid) {
    asm volatile("" : "+v"(tid));
    const int b = chain / 12, h = (chain % 12) >> 1, dir = chain & 1;
    const int rl = tid >> 4, kq = tid & 15, vrow = half * 32 + rl, k0 = kq * 4;
    LAS float* buf = (LAS float*)lds;
    const bf16_t* KKg = SCRP(bf16_t, SC_KK); const bf16_t* Rg = SCRP(bf16_t, SC_R); const bf16_t* Vg = SCRP(bf16_t, SC_V);
    const bf16_t* BKg = SCRP(bf16_t, dir ? SC_BKB : SC_BKF); const bf16_t* KMg = SCRP(bf16_t, dir ? SC_KMB : SC_KMF);
    const float* Wg = SCRP(float, dir ? SC_WB : SC_WF); float* Yg = SCRP(float, dir ? SC_YB : SC_YF);
    const int stl = tid >> 4, e4 = (tid & 15) * 4;
    auto blk_row0 = [&](int blk) -> int { const int s = blk * 32;
        if (s < 256) return NLAT + b * 256 + (dir ? 255 - s : s);
        const int t = s - 256; return b * 4096 + (dir ? 4095 - t : t); };
    const int sgn = dir ? -1 : 1;
    u32x2 l_kk, l_bk, l_km, l_r, l_v; f32x4 l_w;
    auto issue = [&](int blk) { const size_t o = (size_t)(blk_row0(blk) + sgn * stl) * 384 + h * 64 + e4;
        l_kk = *(const u32x2*)(KKg + o); l_bk = *(const u32x2*)(BKg + o); l_km = *(const u32x2*)(KMg + o); l_r = *(const u32x2*)(Rg + o); l_v = *(const u32x2*)(Vg + o); l_w = *(const f32x4*)(Wg + o); };
    auto commit = [&](int bi) { LAS float* d = buf + bi * (32 * 384) + stl * 384 + e4;
        *(LAS f32x4*)(d) = (f32x4){bflo(l_kk.x), bfhi(l_kk.x), bflo(l_kk.y), bfhi(l_kk.y)};
        *(LAS f32x4*)(d + 64) = l_w;
        *(LAS f32x4*)(d + 128) = (f32x4){bflo(l_bk.x), bfhi(l_bk.x), bflo(l_bk.y), bfhi(l_bk.y)};
        *(LAS f32x4*)(d + 192) = (f32x4){bflo(l_km.x), bfhi(l_km.x), bflo(l_km.y), bfhi(l_km.y)};
        *(LAS f32x4*)(d + 256) = (f32x4){bflo(l_r.x), bfhi(l_r.x), bflo(l_r.y), bfhi(l_r.y)};
        *(LAS f32x4*)(d + 320) = (f32x4){bflo(l_v.x), bfhi(l_v.x), bflo(l_v.y), bfhi(l_v.y)}; };
    issue(0); commit(0);
    __syncthreads();
    float S0 = 0.f, S1 = 0.f, S2 = 0.f, S3 = 0.f;
#pragma unroll 1
    for (int blk = 0; blk < 136; ++blk) {
        if (blk + 1 < 136) issue(blk + 1);
        const LAS float* cur = buf + (blk & 1) * (32 * 384);
        const int row0 = blk_row0(blk);
#pragma unroll 4
        for (int s = 0; s < 32; ++s) {
            const LAS float* q = cur + s * 384;
            const f32x4 kk = *(const LAS f32x4*)(q + k0), w = *(const LAS f32x4*)(q + 64 + k0), bk = *(const LAS f32x4*)(q + 128 + k0), km = *(const LAS f32x4*)(q + 192 + k0), rr = *(const LAS f32x4*)(q + 256 + k0);
            const float vv = q[320 + vrow];
            float d = (S0 * kk[0] + S1 * kk[1]) + (S2 * kk[2] + S3 * kk[3]);
            d = red16(d);
            const float sa = -d;
            S0 = S0 * w[0] + (sa * bk[0] + vv * km[0]); S1 = S1 * w[1] + (sa * bk[1] + vv * km[1]); S2 = S2 * w[2] + (sa * bk[2] + vv * km[2]); S3 = S3 * w[3] + (sa * bk[3] + vv * km[3]);
            float y = (S0 * rr[0] + S1 * rr[1]) + (S2 * rr[2] + S3 * rr[3]);
            y = red16(y);
            if (kq == 0) Yg[(size_t)(row0 + sgn * s) * 384 + h * 64 + vrow] = y;
        }
        if (blk + 1 < 136) commit((blk + 1) & 1);
        __syncthreads();
    }
}

__device__ __forceinline__ void attn_unit(const Params& p, int l, int b, int h, bool isctx, int qb, LAS unsigned char* lds, int tid) {
    asm volatile("" : "+v"(tid));
    const int w = tid >> 6, L = tid & 63, fr = L & 15, fq = L >> 4;
    const int qrow0 = (isctx ? NLAT + b * 256 : b * 4096) + qb * 128;
    const int nst = isctx ? 4 : 68;
    const unsigned char* rec = SCRP(unsigned char, SC_KVREC) + (size_t)(b * 4 + h) * NKT * 8192;
    const bf16_t* Z = WSP(bf16_t, WS_Z);
    u32x4 ld0 = *(const u32x4*)(rec + tid * 16), ld1 = *(const u32x4*)(rec + 8192 + tid * 16);
    float lam;
    { const float* q1 = p.in[I_LQ1] + l * 32; const float* k1 = p.in[I_LK1] + l * 32; const float* q2 = p.in[I_LQ2] + l * 32; const float* k2 = p.in[I_LK2] + l * 32;
      float s1 = 0.f, s2 = 0.f;
      for (int i = 0; i < 32; ++i) { s1 += q1[i] * k1[i]; s2 += q2[i] * k2[i]; }
      const float lam_init = l == 0 ? 0.2f : 0.35550907f;
      lam = __expf(s1) - __expf(s2) + lam_init; }
    asm volatile("" : "+v"(lam));
    const float one_m_li = l == 0 ? 0.8f : 0.64449093f;
    bf16x8 Qb[2]; f32x4 cinit[2];
    {
        const int row = qrow0 + w * 16 + fr, tpos = qb * 128 + w * 16 + fr;
        const unsigned* kmax = WSP(unsigned, WS_CTL) + CW_KMAX + l * 32 + (b * 4 + h) * 2;
#pragma unroll
        for (int m = 0; m < 2; ++m) {
            float ov[8], pv[8];
            unpack8(*(const u32x4*)(Z + (size_t)row * DINP + ZQ + h * 64 + m * 32 + fq * 8), ov);
            unpack8(*(const u32x4*)(Z + (size_t)row * DINP + ZQ + h * 64 + m * 32 + (fq ^ 1) * 8), pv);
            if (!isctx) {
                const int pos = (fq >> 1) ? (tpos & 63) : (tpos >> 6); const float sg = (fq & 1) ? 1.f : -1.f;
#pragma unroll
                for (int i = 0; i < 8; ++i) ov[i] = ov[i] * ROPE_COS[pos][i] + sg * pv[i] * ROPE_SIN[pos][i];
            }
#pragma unroll
            for (int i = 0; i < 8; ++i) ov[i] *= 0.2550348616f;
            u32x4 o; o.x = pk2(ov[0], ov[1]); o.y = pk2(ov[2], ov[3]); o.z = pk2(ov[4], ov[5]); o.w = pk2(ov[6], ov[7]);
            float rv[8]; unpack8(o, rv); float n2 = 0.f;
#pragma unroll
            for (int i = 0; i < 8; ++i) n2 += rv[i] * rv[i];
            n2 += __shfl_xor(n2, 16); n2 += __shfl_xor(n2, 32);
            const float km = __builtin_bit_cast(float, __hip_atomic_load(kmax + m, __ATOMIC_RELAXED, __HIP_MEMORY_SCOPE_AGENT));
            const float mq = sqrtf(n2) * sqrtf(km);
            Qb[m] = __builtin_bit_cast(bf16x8, o);
            cinit[m] = (f32x4){-mq, -mq, -mq, -mq};
        }
    }
    *(LAS u32x4*)(lds + tid * 16) = ld0; *(LAS u32x4*)(lds + 8192 + tid * 16) = ld1;
    __syncthreads();
    f32x4 O[2][4]; float ls[2] = {0.f, 0.f};
#pragma unroll
    for (int m = 0; m < 2; ++m)
#pragma unroll
        for (int et = 0; et < 4; ++et) O[m][et] = (f32x4){0.f, 0.f, 0.f, 0.f};
#pragma unroll 1
    for (int st = 0; st < nst; ++st) {
        if (st + 1 < nst) { ld0 = *(const u32x4*)(rec + (size_t)(st + 1) * 16384 + tid * 16); ld1 = *(const u32x4*)(rec + (size_t)(st + 1) * 16384 + 8192 + tid * 16); }
        const LAS unsigned char* cur = lds + (st & 1) * 16384;
#pragma unroll
        for (int hf = 0; hf < 2; ++hf) {
            const LAS unsigned char* rp = cur + hf * 8192 + L * 16;
            bf16x8 vb[4];
#pragma unroll
            for (int et = 0; et < 4; ++et) vb[et] = *(const LAS bf16x8*)(rp + (4 + et) * 1024);
#pragma unroll
            for (int m = 0; m < 2; ++m) {
                const bf16x8 ka0 = *(const LAS bf16x8*)(rp + (m * 2) * 1024), ka1 = *(const LAS bf16x8*)(rp + (m * 2 + 1) * 1024);
                const f32x4 s0 = __builtin_amdgcn_mfma_f32_16x16x32_bf16(ka0, Qb[m], cinit[m], 0, 0, 0);
                const f32x4 s1 = __builtin_amdgcn_mfma_f32_16x16x32_bf16(ka1, Qb[m], cinit[m], 0, 0, 0);
                float e[8];
#pragma unroll
                for (int i = 0; i < 4; ++i) { e[i] = __builtin_amdgcn_exp2f(s0[i]); e[4 + i] = __builtin_amdgcn_exp2f(s1[i]); }
                ls[m] += ((e[0] + e[1]) + (e[2] + e[3])) + ((e[4] + e[5]) + (e[6] + e[7]));
                u32x4 pk; pk.x = pg8::cvt_pk_bf16(e[0], e[1]); pk.y = pg8::cvt_pk_bf16(e[2], e[3]); pk.z = pg8::cvt_pk_bf16(e[4], e[5]); pk.w = pg8::cvt_pk_bf16(e[6], e[7]);
                const bf16x8 pa = __builtin_bit_cast(bf16x8, pk);
#pragma unroll
                for (int et = 0; et < 4; ++et) O[m][et] = __builtin_amdgcn_mfma_f32_16x16x32_bf16(pa, vb[et], O[m][et], 0, 0, 0);
            }
        }
        if (st + 1 < nst) { LAS unsigned char* nb = lds + ((st + 1) & 1) * 16384; *(LAS u32x4*)(nb + tid * 16) = ld0; *(LAS u32x4*)(nb + 8192 + tid * 16) = ld1; }
        __syncthreads();
    }
#pragma unroll
    for (int m = 0; m < 2; ++m) { ls[m] += __shfl_xor(ls[m], 16); ls[m] += __shfl_xor(ls[m], 32); }
    const float* sg = p.in[I_SUBLN] + l * 64; bf16_t* CAT = WSP(bf16_t, WS_CAT);
#pragma unroll
    for (int j = 0; j < 4; ++j) {
        const float l0 = __shfl(ls[0], fq * 4 + j), l1 = __shfl(ls[1], fq * 4 + j);
        const float i0 = 1.f / l0, i1 = lam / l1;
        float ov[4], ss = 0.f;
#pragma unroll
        for (int et = 0; et < 4; ++et) { ov[et] = O[0][et][j] * i0 - O[1][et][j] * i1; ss += ov[et] * ov[et]; }
#pragma unroll
        for (int x = 1; x < 16; x <<= 1) ss += __shfl_xor(ss, x);
        const float rs = rsqrtf(ss * (1.f / 64.f) + LN_EPS) * one_m_li;
        const size_t ro = (size_t)(qrow0 + w * 16 + fq * 4 + j) * D + h * 64;
#pragma unroll
        for (int et = 0; et < 4; ++et) CAT[ro + et * 16 + fr] = (bf16_t)f2bf(ov[et] * rs * sg[et * 16 + fr]);
    }
    __syncthreads();
}

__device__ __forceinline__ void g3_job(const Params& p, int l, int cid, int h, LAS unsigned char* lds, int tid) {
    asm volatile("" : "+v"(tid));
    const int r0 = chunk_row0(cid);
    const bf16_t* Z = WSP(bf16_t, WS_Z);
    LAS float* qF = (LAS float*)lds;
    LAS float* kF = qF + 64 * 33;
    LAS float* qB = kF + 64 * 33;
    LAS float* kB = qB + 64 * 33;
    LAS float* vv = kB + 64 * 33;
    LAS float* A = vv + 4096;
    LAS float* SF = A + 64 * 65;
    LAS float* SB = SF + 2048;
    const float* GBF = SCRP(float, SC_GBF); const float* GBB = SCRP(float, SC_GBB); const float* SC = SCRP(float, SC_SC);
    for (int i = tid; i < 2048; i += NTHR) { const int pp = i >> 5, k = i & 31; const size_t zr = (size_t)(r0 + pp) * DINP;
        const float q = bf2f(Z[zr + ZGQ + h * 32 + k]) * 0.17677669529f, kk = bf2f(Z[zr + ZGK + h * 32 + k]);
        const float bf = GBF[(size_t)(r0 + pp) * 192 + h * 32 + k], bb = GBB[(size_t)(r0 + pp) * 192 + h * 32 + k];
        qF[pp * 33 + k] = q * __expf(bf); kF[pp * 33 + k] = kk * __expf(-bf); qB[pp * 33 + k] = q * __expf(bb); kB[pp * 33 + k] = kk * __expf(-bb); }
    for (int i = tid; i < 4096; i += NTHR) { const int pp = i >> 6, v = i & 63; vv[i] = bf2f(Z[(size_t)(r0 + pp) * DINP + ZGV + h * 64 + v]); }
    for (int i = tid; i < 2048; i += NTHR) { SF[i] = SC[((size_t)((cid * 6 + h) * 2 + 0)) * 2048 + i]; SB[i] = SC[((size_t)((cid * 6 + h) * 2 + 1)) * 2048 + i]; }
    __syncthreads();
#pragma unroll 1
    for (int j = 0; j < 8; ++j) { const int i = tid + NTHR * j, pp = i >> 6, ps = i & 63; float a = 0.f;
        if (ps <= pp) {
#pragma unroll 8
            for (int k = 0; k < 32; ++k) a += qF[pp * 33 + k] * kF[ps * 33 + k]; }
        if (ps >= pp) {
#pragma unroll 8
            for (int k = 0; k < 32; ++k) a += qB[pp * 33 + k] * kB[ps * 33 + k]; }
        A[pp * 65 + ps] = a; }
    __syncthreads();
    const int v = tid & 63, pg = tid >> 6;
    const float ng = p.in[I_GNG][l * 64 + v];
    bf16_t* CAT = WSP(bf16_t, WS_CAT);
#pragma unroll 1
    for (int j = 0; j < 8; ++j) { const int pp = pg * 8 + j; float o = 0.f;
#pragma unroll 8
        for (int ps = 0; ps < 64; ++ps) o += A[pp * 65 + ps] * vv[ps * 64 + v];
#pragma unroll 8
        for (int k = 0; k < 32; ++k) o += qF[pp * 33 + k] * SF[k * 64 + v] + qB[pp * 33 + k] * SB[k * 64 + v];
        const float ss = wave_sum(o * o);
        const float rn = o * rsqrtf(ss * (1.f / 64.f) + LN_EPS) * ng;
        const float gr = bf2f(Z[(size_t)(r0 + pp) * DINP + ZGR + h * 64 + v]);
        CAT[(size_t)(r0 + pp) * D + 256 + h * 64 + v] = (bf16_t)f2bf(rn * siluf_(gr)); }
    __syncthreads();
}

__device__ __forceinline__ void rw_post(const Params& p, int l, int nrows, int gw, int ngw, int lane) {
    const float* YF = SCRP(float, SC_YF); const float* YB = SCRP(float, SC_YB); const float* BON = SCRP(float, SC_BON);
    const bf16_t* Vg = SCRP(bf16_t, SC_V); const bf16_t* Gg = SCRP(bf16_t, SC_G); bf16_t* CAT = WSP(bf16_t, WS_CAT);
    for (int it = gw; it < nrows * 6; it += ngw) { const int row = it / 6, h = it % 6, c = h * 64 + lane; const size_t o = (size_t)row * 384 + c;
        const float y = YF[o] + YB[o];
        const float mu = wave_sum(y) * (1.f / 64.f); const float dv = y - mu; const float var = wave_sum(dv * dv) * (1.f / 64.f);
        const float yn = dv * rsqrtf(var + RW_GN_EPS) * p.in[I_LNXG][l * 384 + c] + p.in[I_LNXB][l * 384 + c];
        const float outv = (yn + BON[(size_t)row * 8 + h] * bf2f(Vg[o])) * bf2f(Gg[o]);
        CAT[(size_t)row * D + 640 + c] = (bf16_t)f2bf(outv); }
}

__device__ __forceinline__ void ln1_router(const Params& p, int l, int nrows, LAS unsigned char* lds, int tid, int gw, int ngw, int lane) {
    LAS float* rwt = (LAS float*)lds;
    const float* rw = p.in[I_RW] + (size_t)l * 1024 * 32;
    for (int i = tid; i < 32768; i += NTHR) rwt[(i >> 5) * 33 + (i & 31)] = rw[i];
    __syncthreads();
    float* H = WSP(float, WS_H); bf16_t* XM = WSP(bf16_t, WS_XM); const bf16_t* MIX = WSP(bf16_t, WS_Z); const float* MOD = WSP(float, WS_MOD);
    int* TOPE = WSP(int, WS_TOP); float* TOPG = WSP(float, WS_TOP + TOP_STRIDE); int* TOPR = WSP(int, WS_TOP + 2 * TOP_STRIDE);
    unsigned* cnt = WSP(unsigned, WS_CTL) + CW_CNT + l * 64;
    const float* g1p = p.in[I_LN1G] + l * 1024; const float* b1p = p.in[I_LN1B] + l * 1024; const float* rb = p.in[I_RB] + l * 32;
    for (int row = gw; row < nrows; row += ngw) {
        const int sidx = row < NLAT ? (row >> 12) : 4; const float* mod = MOD + (size_t)(l * 5 + sidx) * 6144;
        float y[16]; float s = 0.f;
#pragma unroll
        for (int i = 0; i < 16; ++i) { const int c = lane + 64 * i; y[i] = DN_ALPHA * H[(size_t)row * D + c] + mod[2048 + c] * bf2f(MIX[(size_t)row * D + c]); s += y[i]; }
        const float mean = wave_sum(s) * (1.f / D); float s2 = 0.f;
#pragma unroll
        for (int i = 0; i < 16; ++i) { y[i] -= mean; s2 += y[i] * y[i]; }
        const float rstd = rsqrtf(wave_sum(s2) * (1.f / D) + LN_EPS);
#pragma unroll
        for (int i = 0; i < 16; ++i) { const int c = lane + 64 * i; const float hn = y[i] * rstd * g1p[c] + b1p[c];
            H[(size_t)row * D + c] = hn; const float m = hn * (1.f + mod[4096 + c]) + mod[3072 + c];
            XM[(size_t)row * D + c] = (bf16_t)f2bf(m); y[i] = m; }
        float lg[32];
#pragma unroll
        for (int e = 0; e < 32; ++e) { float a = 0.f;
#pragma unroll
            for (int i = 0; i < 16; ++i) a += y[i] * rwt[(lane + 64 * i) * 33 + e];
            lg[e] = wave_sum(a) + rb[e]; }
        float tv[4]; int ti[4];
#pragma unroll
        for (int k = 0; k < 4; ++k) { float best = -3.0e38f; int bi = 0;
#pragma unroll
            for (int e = 0; e < 32; ++e) { if (lg[e] > best) { best = lg[e]; bi = e; } }
            tv[k] = best; ti[k] = bi;
#pragma unroll
            for (int e = 0; e < 32; ++e) lg[e] = (e == bi) ? -3.0e38f : lg[e]; }
        if (lane == 0) {
            const float e1 = __expf(tv[1] - tv[0]), e2 = __expf(tv[2] - tv[0]), e3 = __expf(tv[3] - tv[0]); const float inv = 1.f / (1.f + e1 + e2 + e3);
            const float gg[4] = {inv, e1 * inv, e2 * inv, e3 * inv};
#pragma unroll
            for (int k = 0; k < 4; ++k) { TOPE[row * 4 + k] = ti[k]; TOPG[row * 4 + k] = gg[k]; TOPR[row * 4 + k] = (int)atomicAdd(cnt + ti[k], 1u); }
        }
    }
}

__device__ __forceinline__ int moe_tables(const Params& p, int l, LAS int* tab, int tid) {
    if (tid == 0) { const unsigned* cnt = WSP(unsigned, WS_CTL) + CW_CNT + l * 64; int run = 0;
        for (int e = 0; e < 32; ++e) { const int c = (int)__hip_atomic_load(cnt + e, __ATOMIC_RELAXED, __HIP_MEMORY_SCOPE_AGENT); tab[e] = run * 256; tab[32 + e] = c; run += (c + 255) >> 8; tab[64 + e] = run; }
        tab[96] = run; }
    __syncthreads();
    for (int blk = tid; blk < CAP_BLK; blk += NTHR) { int e = 0;
        for (int j = 0; j < 31; ++j) e += (blk >= tab[64 + j]) ? 1 : 0;
        tab[128 + blk] = e; }
    __syncthreads();
    return tab[96];
}

__device__ __forceinline__ void moe_gather(const Params& p, int l, int nrows, LAS int* tab, int gw, int ngw, int lane) {
    const int* TOPE = WSP(int, WS_TOP); const int* TOPR = WSP(int, WS_TOP + 2 * TOP_STRIDE); int* TOPS = WSP(int, WS_TOP + 3 * TOP_STRIDE);
    const bf16_t* XM = WSP(bf16_t, WS_XM); bf16_t* XB = SCRP(bf16_t, SC_XB);
    for (int it = gw; it < nrows * 4; it += ngw) { const int tok = it >> 2, e = TOPE[it], slot = tab[e] + TOPR[it];
        if (lane == 0) TOPS[it] = slot;
        const u32x4* s = (const u32x4*)(XM + (size_t)tok * D); u32x4* d = (u32x4*)(XB + (size_t)slot * D);
        d[lane] = s[lane]; d[64 + lane] = s[64 + lane]; }
    for (int it = gw; it < 32 * 256; it += ngw) { const int e = it >> 8, i = it & 255, c = tab[32 + e], row = tab[e] + c + i, pend = tab[e] + (((c + 255) >> 8) << 8);
        if (row < pend) { u32x4* d = (u32x4*)(XB + (size_t)row * D); d[lane] = (u32x4){0u, 0u, 0u, 0u}; d[64 + lane] = (u32x4){0u, 0u, 0u, 0u}; } }
}

__device__ __forceinline__ void ln2_rows(const Params& p, int l, int nrows, int gw, int ngw, int lane) {
    float* H = WSP(float, WS_H); bf16_t* XM = WSP(bf16_t, WS_XM); const bf16_t* YB = SCRP(bf16_t, SC_XB); const float* MOD = WSP(float, WS_MOD);
    const float* TOPG = WSP(float, WS_TOP + TOP_STRIDE); const int* TOPS = WSP(int, WS_TOP + 3 * TOP_STRIDE);
    const float* g2p = p.in[I_LN2G] + l * 1024; const float* b2p = p.in[I_LN2B] + l * 1024;
    for (int row = gw; row < nrows; row += ngw) {
        const int sidx = row < NLAT ? (row >> 12) : 4; const float* mod = MOD + (size_t)(l * 5 + sidx) * 6144;
        f32x4 f[4];
#pragma unroll
        for (int j = 0; j < 4; ++j) f[j] = (f32x4){0.f, 0.f, 0.f, 0.f};
#pragma unroll
        for (int k = 0; k < 4; ++k) { const float g = TOPG[row * 4 + k]; const bf16_t* yr = YB + (size_t)TOPS[row * 4 + k] * D;
#pragma unroll
            for (int j = 0; j < 4; ++j) { const u32x2 u = *(const u32x2*)(yr + lane * 4 + 256 * j); f[j] += (f32x4){bflo(u.x), bfhi(u.x), bflo(u.y), bfhi(u.y)} * g; } }
        f32x4 y[4]; float s = 0.f;
#pragma unroll
        for (int j = 0; j < 4; ++j) { const int c = lane * 4 + 256 * j; y[j] = *(const f32x4*)(H + (size_t)row * D + c) * DN_ALPHA + *(const f32x4*)(mod + 5120 + c) * f[j]; s += (y[j][0] + y[j][1]) + (y[j][2] + y[j][3]); }
        const float mean = wave_sum(s) * (1.f / D); float s2 = 0.f;
#pragma unroll
        for (int j = 0; j < 4; ++j) { y[j] = y[j] - mean; s2 += (y[j][0] * y[j][0] + y[j][1] * y[j][1]) + (y[j][2] * y[j][2] + y[j][3] * y[j][3]); }
        const float rstd = rsqrtf(wave_sum(s2) * (1.f / D) + LN_EPS);
#pragma unroll
        for (int j = 0; j < 4; ++j) { const int c = lane * 4 + 256 * j;
            const f32x4 hn = y[j] * rstd * *(const f32x4*)(g2p + c) + *(const f32x4*)(b2p + c);
            if (l == 0) { *(f32x4*)(H + (size_t)row * D + c) = hn;
                const float* mod1 = MOD + (size_t)(5 + sidx) * 6144;
                const f32x4 xm = hn * (*(const f32x4*)(mod1 + 1024 + c) + 1.f) + *(const f32x4*)(mod1 + c);
                u32x2 o; o.x = pk2(xm[0], xm[1]); o.y = pk2(xm[2], xm[3]); *(u32x2*)(XM + (size_t)row * D + c) = o; }
            else *(f32x4*)(p.out + (size_t)row * D + c) = hn; }
    }
}

#ifndef PHM
#define PHM 0x3ffff
#endif
constexpr int LDS_TAB_OFF = 131072;
__device__ __forceinline__ int q_next(unsigned* head, volatile LAS int* slot, int wave_s) {
    __syncthreads();
    if (wave_s == 0 && lane_id_() == 0) *slot = (int)atomicAdd(head, 1u);
    __syncthreads();
    return *slot;
}
#define GRID_BAR() do { unsigned char* w_ = p_arg.ws; asm volatile("" : "+s"(w_)); XcdBarrier b_; b_.bar = (unsigned*)(w_ + WS_CTL) + CW_BAR; b_.x = xb_xcc_id(); b_.st = ctlw; b_.w = wave_s; xcd_barrier(b_); } while (0)
#define PHASE_BEGIN_G() Params p = p_arg; asm volatile("" : "+s"(p.ws));
#define PHASE_BEGIN() Params p = p_arg; asm volatile("" : "+s"(p.ws)); \
    int tid = wave_s * 64 + lane_id_(); asm volatile("" : "+v"(tid)); const int lane = tid & 63, gw = bx * 8 + wave_s; (void)lane; (void)gw; (void)p;

__global__ void __launch_bounds__(NTHR, 2) fwd_kernel(Params p_arg) {
    extern __shared__ __attribute__((aligned(16))) unsigned char lds_raw[];
    LAS unsigned char* lds = (LAS unsigned char*)lds_raw;
    const int G = gridDim.x, bx = blockIdx.x, ngw = G * 8;
    const int wave_s = WAVE_ID_SGPR();
    volatile LAS unsigned* ctlw = (volatile LAS unsigned*)(lds + LDS_CTL_OFF);
    if (wave_s == 0) ctlw[lane_id_()] = 0u;
    __syncthreads();
    { PHASE_BEGIN(); (void)xcd_barrier_post(WSP(unsigned, WS_CTL) + CW_BAR, ctlw, wave_s); }
    volatile LAS int* qslot = (volatile LAS int*)(ctlw + 16);
    LAS int* tab = (LAS int*)(lds + LDS_TAB_OFF);

    { PHASE_BEGIN();
#if PHM & 1
      for (int j = bx; j < J_MOD; j += G) mod_job(p, j, (LAS float*)lds, tid);
#endif
#if PHM & 2
      for (int j = bx; j < JW_TOTAL; j += G) conv_job(p, j, (LAS float*)lds, tid);
#endif
      float* bgu = WSP(float, WS_BGU);
      for (int i = bx * NTHR + tid; i < 2 * 32 * 2048; i += G * NTHR) { const int le = i >> 11, c = i & 2047; bgu[i] = (c & 1) ? p.in[I_MBU][le * 1024 + (c >> 1)] : p.in[I_MBG][le * 1024 + (c >> 1)]; } }
    GRID_BAR();
#if PHM & 4
    { PHASE_BEGIN(); ln_in_rows(p, gw, ngw, lane); }
#endif
    GRID_BAR();

#pragma unroll 1
    for (int l = 0; l < 2; ++l) {
        const int nrows = l == 0 ? NTOK : NLAT;
#if PHM & 8
        { PHASE_BEGIN_G();
          pg8::Gemm g{WSP(bf16_t, WS_XM), WSP(bf16_t, WS_WIN) + (size_t)l * DINP * 1024, NTOK, DINP, 1024};
          pg8::StaticOrder S; S.init(NTOK, DINP, 1024, G, bx);
          pg8::EpiBf16 E{WSP(bf16_t, WS_Z), DINP, nullptr, 0};
          pg8::gemm_phase<pg8::EpiBf16, pg8::StaticOrder>(lds, g, S, E, wave_s); }
#endif
        GRID_BAR();
        { PHASE_BEGIN();
          unsigned* head = WSP(unsigned, WS_CTL) + CW_QHEAD + (l * 4 + 0) * 64;
          const int n_rw = 544, n_gla = NCHUNK * 6, n_da = 4 * NKT, n_all = n_rw + n_gla + n_da;
          for (;;) { const int j = q_next(head, qslot, wave_s); if (j >= n_all) break;
#if PHM & 16
              if (j < n_rw) rw_job(p, l, j, lds, tid);
#endif
#if PHM & 32
              if (j >= n_rw && j < n_rw + n_gla) { const int q = j - n_rw; gla_job(p, l, q / 6, q % 6, lds, tid); }
#endif
#if PHM & 64
              if (j >= n_rw + n_gla) { const int q = j - n_rw - n_gla; da_job(p, l, q / NKT, q % NKT, lds, tid); }
#endif
          } }
        GRID_BAR();
#if PHM & 128
        { PHASE_BEGIN(); for (int j = bx; j < 192; j += G) g2_job(p, j, tid); }
#endif
        GRID_BAR();
        { PHASE_BEGIN();
          unsigned* head = WSP(unsigned, WS_CTL) + CW_QHEAD + (l * 4 + 1) * 64;
          const int n_sc = 96, n_att = 512 + (l == 0 ? 32 : 0), n_g3 = (l == 0 ? NCHUNK : 256) * 6, n_all = n_sc + n_att + n_g3;
          for (;;) { const int j = q_next(head, qslot, wave_s); if (j >= n_all) break;
#if PHM & 256
              if (j < n_sc) scan_job(p, j >> 1, j & 1, lds, tid);
#endif
#if PHM & 512
              if (j >= n_sc && j < n_sc + n_att) { const int q = j - n_sc; const bool ic = q >= 512; const int c = q - 512;
                  attn_unit(p, l, ic ? (c >> 3) : (q >> 7), ic ? ((c >> 1) & 3) : ((q >> 5) & 3), ic, ic ? (c & 1) : (q & 31), lds, tid); }
#endif
#if PHM & 1024
              if (j >= n_sc + n_att) { const int q = j - n_sc - n_att; g3_job(p, l, q / 6, q % 6, lds, tid); }
#endif
          } }
        GRID_BAR();
#if PHM & 2048
        { PHASE_BEGIN(); rw_post(p, l, nrows, gw, ngw, lane); }
#endif
        GRID_BAR();
#if PHM & 4096
        { PHASE_BEGIN_G();
          pg8::Gemm g{WSP(bf16_t, WS_CAT), WSP(bf16_t, WS_WOUT) + (size_t)l * 1024 * 1024, nrows, 1024, 1024};
          pg8::StaticOrder S; S.init(nrows, 1024, 1024, G, bx);
          pg8::EpiBf16 E{WSP(bf16_t, WS_Z), 1024, nullptr, 0};
          pg8::gemm_phase<pg8::EpiBf16, pg8::StaticOrder>(lds, g, S, E, wave_s); }
#endif
        GRID_BAR();
#if PHM & 8192
        { PHASE_BEGIN(); ln1_router(p, l, nrows, lds, tid, gw, ngw, lane); }
#endif
        GRID_BAR();
        { PHASE_BEGIN();
          moe_tables(p, l, tab, tid);
#if PHM & 16384
          moe_gather(p, l, nrows, tab, gw, ngw, lane);
#endif
        }
        GRID_BAR();
#if PHM & 32768
        { PHASE_BEGIN_G();
          const int nblk = tab[96];
          pg8::Gemm g{SCRP(bf16_t, SC_XB), WSP(bf16_t, WS_WGU) + (size_t)l * 32 * 2048 * 1024, nblk * 256, 2048, 1024};
          pg8::GroupOrder<8> S{G, bx, nblk, tab + 128};
          pg8::EpiSwiglu E{SCRP(bf16_t, SC_ACT), WSP(float, WS_BGU) + (size_t)l * 32 * 2048};
          pg8::gemm_phase<pg8::EpiSwiglu, pg8::GroupOrder<8>>(lds, g, S, E, wave_s); }
#endif
        GRID_BAR();
#if PHM & 65536
        { PHASE_BEGIN_G();
          const int nblk = tab[96];
          pg8::Gemm g{SCRP(bf16_t, SC_ACT), WSP(bf16_t, WS_WDN) + (size_t)l * 32 * 1024 * 1024, nblk * 256, 1024, 1024};
          pg8::GroupOrder<4> S{G, bx, nblk, tab + 128};
          pg8::EpiBf16 E{SCRP(bf16_t, SC_XB), 1024, p.in[I_MBD] + (size_t)l * 32 * 1024, 1024};
          pg8::gemm_phase<pg8::EpiBf16, pg8::GroupOrder<4>>(lds, g, S, E, wave_s); }
#endif
        GRID_BAR();
#if PHM & 131072
        { PHASE_BEGIN(); ln2_rows(p, l, nrows, gw, ngw, lane); }
#endif
        GRID_BAR();
    }
}

extern "C" void kernel_launch(void* const* d_in, const int* in_sizes, int n_in, void* d_out, int out_size, void* d_ws, size_t ws_size, hipStream_t stream) {
    (void)in_sizes; (void)n_in; (void)out_size; (void)ws_size;
    static int grid = 0;
    if (!grid) {
        (void)hipFuncSetAttribute((const void*)fwd_kernel, hipFuncAttributeMaxDynamicSharedMemorySize, LDS_BYTES);
        int dev = 0, cus = 0; (void)hipGetDevice(&dev); (void)hipDeviceGetAttribute(&cus, hipDeviceAttributeMultiprocessorCount, dev);
        grid = cus > 0 && cus < 256 ? cus : 256;
    }
    (void)hipMemsetAsync(d_ws, 0, CTL_BYTES, stream);
    Params p{};
    for (int i = 0; i < 41; ++i) p.in[i] = (const float*)d_in[i];
    p.out = (float*)d_out; p.ws = (unsigned char*)d_ws;
    hipLaunchKernelGGL(fwd_kernel, dim3(grid), dim3(NTHR), LDS_BYTES, stream, p);
}
```

```cpp
#include <hip/hip_runtime.h>
#include <cstdint>
#include <cstdio>

#define LAS __attribute__((address_space(3)))
typedef unsigned short bf16_t;
typedef short bf16x8 __attribute__((ext_vector_type(8)));
typedef float f32x4 __attribute__((ext_vector_type(4)));
typedef float f32x2 __attribute__((ext_vector_type(2)));
typedef unsigned u32x4 __attribute__((ext_vector_type(4)));
typedef unsigned u32x2 __attribute__((ext_vector_type(2)));

constexpr int D = 1024, NB = 4, SEQ = 4096, LCX = 256, NLAT = NB * SEQ, NCX = NB * LCX, NTOK = NLAT + NCX;
constexpr int DIN = 3488, DINP = 3584;
constexpr int NE = 32, FF = 1024;
constexpr int CAP_BLK = 304, CAP = CAP_BLK * 256;
constexpr int NTHR = 512;
constexpr int ZQ = 0, ZK = 256, ZV = 512, ZGQ = 768, ZGK = 960, ZGV = 1152, ZGF = 1536, ZGB = 1552, ZGR = 1568, ZRKV = 1952, ZWF = 3104, ZWB = 3168, ZAF = 3232, ZAB = 3296, ZG = 3360;
constexpr int NKT = 136;
constexpr int NCHUNK = 272;
constexpr float LN_EPS = 1e-5f, RW_GN_EPS = 64e-5f;
constexpr float DN_ALPHA = 1.41421356237f;

constexpr size_t MiB = 1u << 20;
constexpr size_t WS_CTL = 0, CTL_BYTES = 1 * MiB;
constexpr size_t WS_MOD = 1 * MiB;
constexpr size_t WS_TOP = 2 * MiB;
constexpr size_t TOP_STRIDE = (size_t)NTOK * 4 * 4;
constexpr size_t WS_CNTWG = 3 * MiB + 768 * 1024;
constexpr size_t WS_RWW = 3 * MiB + 128 * 1024;
constexpr size_t RWW_LAYER = 4 * 384 * 64 + 384 * 128;
static_assert(WS_TOP + 4 * TOP_STRIDE <= WS_RWW && WS_RWW + 2 * RWW_LAYER * 2 <= WS_CNTWG && WS_CNTWG + 2 * 256 * 32 * 4 <= 4 * MiB, "ws map");
constexpr size_t WS_BGU = 4 * MiB;
constexpr size_t WS_H = 5 * MiB;
constexpr size_t WS_XM = 73 * MiB;
constexpr size_t WS_CAT = 107 * MiB;
constexpr size_t WS_Z = 141 * MiB;
constexpr size_t WS_WIN = 260 * MiB;
constexpr size_t WS_WOUT = 274 * MiB;
constexpr size_t WS_WGU = 278 * MiB;
constexpr size_t WS_WDN = 534 * MiB;
constexpr size_t WS_SCR = 662 * MiB;
constexpr size_t WS_END = 966 * MiB;
constexpr size_t WS_MREC = 966 * MiB, WS_GREC = 992 * MiB, WS_TOTAL = 1018 * MiB;
static_assert(WS_MREC + (size_t)3264 * 8192 <= WS_GREC && WS_GREC + (size_t)3264 * 8192 <= WS_TOTAL && WS_TOTAL <= 1024 * MiB, "ws map");
static_assert(WS_H + (size_t)NTOK * D * 4 <= WS_XM && WS_XM + (size_t)NTOK * D * 2 <= WS_CAT && WS_CAT + (size_t)NTOK * D * 2 <= WS_Z, "ws map");
static_assert(WS_Z + (size_t)NTOK * DINP * 2 <= WS_WIN && WS_WIN + (size_t)2 * DINP * D * 2 <= WS_WOUT && WS_WOUT + (size_t)2 * D * D * 2 <= WS_WGU, "ws map");
static_assert(WS_WGU + (size_t)2 * 32 * 2048 * 1024 * 2 <= WS_WDN && WS_WDN + (size_t)2 * 32 * 1024 * 1024 * 2 <= WS_SCR, "ws map");
constexpr size_t SC_XB = 0, SC_ACT = (size_t)CAP * D * 2;
static_assert(WS_SCR + 2 * SC_ACT <= WS_END, "ws map");
constexpr size_t SZ_T384B = (size_t)NTOK * 384 * 2, SZ_T384F = (size_t)NTOK * 384 * 4, SZ_T192F = (size_t)NTOK * 192 * 4;
constexpr size_t SC_KVREC = 0;
constexpr size_t SC_GBF = SC_KVREC + (size_t)16 * NKT * 8192;
constexpr size_t SC_GBB = SC_GBF + SZ_T192F;
constexpr size_t SC_KVC = SC_GBB + SZ_T192F;
constexpr size_t SZ_KVC = (size_t)NCHUNK * 6 * 2 * 2048 * 4;
constexpr size_t SC_SC = SC_KVC + SZ_KVC;
constexpr size_t SC_DC = SC_SC + SZ_KVC;
constexpr size_t SC_R = SC_DC + (size_t)NCHUNK * 6 * 2 * 32 * 4;
constexpr size_t SC_KK = SC_R + SZ_T384B, SC_V = SC_KK + SZ_T384B, SC_BKF = SC_V + SZ_T384B, SC_BKB = SC_BKF + SZ_T384B, SC_KMF = SC_BKB + SZ_T384B, SC_KMB = SC_KMF + SZ_T384B, SC_G = SC_KMB + SZ_T384B;
constexpr size_t SC_WF = SC_G + SZ_T384B, SC_WB = SC_WF + SZ_T384F, SC_YF = SC_WB + SZ_T384F, SC_YB = SC_YF + SZ_T384F, SC_BON = SC_YB + SZ_T384F;
constexpr size_t SC_MIX_END = SC_BON + (size_t)NTOK * 8 * 4;
static_assert(WS_SCR + SC_MIX_END <= WS_END, "mixer scratch");
constexpr int CW_BAR = 4096, CW_CNT = 8192, CW_QHEAD = 8448  , CW_KMAX = 9728;
static_assert(CW_BAR + 3456 <= CW_CNT && CW_CNT + 128 <= CW_QHEAD && CW_QHEAD + 16 * 64 <= CW_KMAX && (CW_KMAX + 64) * 4 <= (int)CTL_BYTES, "control words");

constexpr int LDS_BYTES = 163840, LDS_CTL_OFF = LDS_BYTES - 256;

__device__ __forceinline__ int lane_id_() { int r; asm volatile("v_mbcnt_lo_u32_b32 %0, -1, 0\n\tv_mbcnt_hi_u32_b32 %0, -1, %0" : "=v"(r)); return r; }
#define WAVE_ID_SGPR() (__builtin_amdgcn_readfirstlane((int)(threadIdx.x >> 6)))

__device__ __forceinline__ unsigned f2bf(float f) { unsigned u = __builtin_bit_cast(unsigned, f); return (u + 0x7fffu + ((u >> 16) & 1u)) >> 16; }
__device__ __forceinline__ unsigned pk2(float lo, float hi) { return f2bf(lo) | (f2bf(hi) << 16); }
__device__ __forceinline__ float bf2f(bf16_t h) { return __builtin_bit_cast(float, (unsigned)h << 16); }
__device__ __forceinline__ float bflo(unsigned u) { return __builtin_bit_cast(float, u << 16); }
__device__ __forceinline__ float bfhi(unsigned u) { return __builtin_bit_cast(float, u & 0xffff0000u); }
__device__ __forceinline__ float wave_sum(float v) {
#pragma unroll
    for (int o = 1; o < 64; o <<= 1) v += __shfl_xor(v, o);
    return v;
}
__device__ __forceinline__ float sigmoidf_(float x) { return 1.f / (1.f + __expf(-x)); }
__device__ __forceinline__ float siluf_(float x) { return x / (1.f + __expf(-x)); }
template <int CTRL> __device__ __forceinline__ float dpp_f(float v) {
    return __builtin_bit_cast(float, __builtin_amdgcn_update_dpp(0, __builtin_bit_cast(int, v), CTRL, 0xF, 0xF, true));
}
__device__ __forceinline__ float red16(float v) {
    v += dpp_f<0xB1>(v);
    v += dpp_f<0x4E>(v);
    v += dpp_f<0x141>(v);
    v += dpp_f<0x140>(v);
    return v;
}

namespace pg8 {
constexpr int BM = 256, BK = 64, HALF = 128, HTB = HALF * BK * 2, STAGE_BYTES = 8 * HTB, NXCD = 8, WGM = 8;
__host__ __device__ __forceinline__ int lds_byte(int r, int c) { const int st = (r >> 4) * 2 + (c >> 5), rr = r & 15, cc = c & 31, ob = rr * 64 + cc * 2; return st * 1024 + (ob ^ (((ob >> 9) & 1) << 5)); }
__host__ __device__ __forceinline__ void stage_rc(int b, int& R, int& C) { const int st = b / 1024, sb = b % 1024, swz = sb ^ (((sb >> 9) & 1) << 5); R = (st >> 1) * 16 + swz / 64; C = (st & 1) * 32 + (swz % 64) / 2; }
__host__ __device__ __forceinline__ int perm32(int rho) { const int n = rho >> 4, i = rho & 15; return 8 * (i >> 2) + 4 * n + (i & 3); }

struct Unit { int pm, pn, e; size_t boff; };
struct Gemm { const bf16_t* A; const bf16_t* Bt; int M, N, K; };

struct StaticOrder {
    int nM, nN, nwg, G, c; size_t tstep;
    __device__ void init(int M, int N, int K, int G_, int c_) { nM = M / BM; nN = N / BM; nwg = nM * nN; G = G_; c = c_; tstep = (size_t)BM * K * 2; }
    __device__ bool next(int i, Unit& u) const {
        const long L = (long)i * G + c; if (L >= nwg) return false;
        int wgid = (int)L; { const int q = nwg / NXCD, r = nwg % NXCD, xcd = wgid % NXCD, off = wgid / NXCD; wgid = (xcd < r ? xcd * (q + 1) : r * (q + 1) + (xcd - r) * q) + off; }
        const int nig = WGM * nN, gid = wgid / nig, fm = gid * WGM, gsz = (nM - fm) < WGM ? (nM - fm) : WGM;
        u.pm = fm + ((wgid % nig) % gsz); u.pn = (wgid % nig) / gsz; u.e = 0; u.boff = (size_t)u.pn * tstep; return true;
    }
};
template <int NPN> struct GroupOrder {
    int G, c, nblk; const LAS int* blk2e;
    __device__ __forceinline__ bool next(int i, Unit& u) const {
        const int L = i * G + c; if (L >= nblk * NPN) return false;
        const int blk = L / NPN; u.pn = L % NPN; u.pm = blk;
        const int e = blk2e[blk];
        u.e = e; u.boff = (size_t)(e * NPN + u.pn) * ((size_t)256 * 1024 * 2); return true;
    }
};

__device__ __forceinline__ unsigned cvt_pk_bf16(float lo, float hi) { unsigned r; asm volatile("v_cvt_pk_bf16_f32 %0, %1, %2" : "=v"(r) : "v"(lo), "v"(hi)); return r; }

struct EpiBf16 {
    bf16_t* O; int ldc; const float* bias; int bias_estride;
    __device__ __forceinline__ void operator()(const f32x4 (&acc)[2][2][4][2], const Unit& u, int wr, int wc, int fr, int fq) const {
        const int row0 = u.pm * BM + wr * 64 + fr; const int col0 = u.pn * BM + wc * 32 + 8 * fq;
        f32x4 bv[2][2];
#pragma unroll
        for (int bj = 0; bj < 2; ++bj)
#pragma unroll
            for (int n = 0; n < 2; ++n) bv[bj][n] = bias ? *(const f32x4*)(bias + (size_t)u.e * bias_estride + col0 + bj * HALF + 4 * n) : (f32x4){0.f, 0.f, 0.f, 0.f};
#pragma unroll
        for (int ai = 0; ai < 2; ++ai)
#pragma unroll
            for (int m = 0; m < 4; ++m) { bf16_t* rowp = O + (size_t)(row0 + ai * HALF + m * 16) * ldc + col0;
#pragma unroll
                for (int bj = 0; bj < 2; ++bj) { const f32x4 v0 = acc[ai][bj][m][0] + bv[bj][0], v1 = acc[ai][bj][m][1] + bv[bj][1];
                    u32x4 w; w.x = cvt_pk_bf16(v0[0], v0[1]); w.y = cvt_pk_bf16(v0[2], v0[3]); w.z = cvt_pk_bf16(v1[0], v1[1]); w.w = cvt_pk_bf16(v1[2], v1[3]);
                    *(u32x4*)(rowp + bj * HALF) = w; } }
    }
};
struct EpiSwiglu {
    bf16_t* O; const float* bias;
    __device__ __forceinline__ static float act(float g, float u) {
        g = fminf(g, 7.f); u = fminf(fmaxf(u, -7.f), 7.f);
        return (u + 1.f) * g / (1.f + __expf(-1.702f * g));
    }
    __device__ __forceinline__ void operator()(const f32x4 (&acc)[2][2][4][2], const Unit& u, int wr, int wc, int fr, int fq) const {
        const int row0 = u.pm * BM + wr * 64 + fr; const int col0 = u.pn * BM + wc * 32 + 8 * fq;
        f32x4 bv[2][2];
#pragma unroll
        for (int bj = 0; bj < 2; ++bj)
#pragma unroll
            for (int n = 0; n < 2; ++n) bv[bj][n] = *(const f32x4*)(bias + (size_t)u.e * 2048 + col0 + bj * HALF + 4 * n);
#pragma unroll
        for (int ai = 0; ai < 2; ++ai)
#pragma unroll
            for (int m = 0; m < 4; ++m) { bf16_t* rowp = O + (size_t)(row0 + ai * HALF + m * 16) * 1024 + (col0 >> 1);
#pragma unroll
                for (int bj = 0; bj < 2; ++bj) { const f32x4 v0 = acc[ai][bj][m][0] + bv[bj][0], v1 = acc[ai][bj][m][1] + bv[bj][1];
                    u32x2 w; w.x = cvt_pk_bf16(act(v0[0], v0[1]), act(v0[2], v0[3])); w.y = cvt_pk_bf16(act(v1[0], v1[1]), act(v1[2], v1[3]));
                    *(u32x2*)(rowp + bj * (HALF / 2)) = w; } }
    }
};

template <class Epi, class Sched>
__device__ __forceinline__ void gemm_phase(LAS unsigned char* lds, const Gemm g, const Sched& S, const Epi& E, const int wave_s) {
    int tid = wave_s * 64 + lane_id_(); asm volatile("" : "+v"(tid));
    const int wid = __builtin_amdgcn_readfirstlane(tid >> 6), lane = tid & 63, wr = wid >> 2, wc = wid & 3, fr = lane & 15, fq = lane >> 4;
    const int K = g.K, nt = K / BK;
    unsigned voffA[2], voffB[2];
#pragma unroll
    for (int i = 0; i < 2; ++i) { int R, C; stage_rc(tid * 16 + i * 8192, R, C); const int Rb = (R & ~31) + perm32(R & 31);
        voffA[i] = (unsigned)(R * K + C) * 2u; voffB[i] = (unsigned)(Rb * K + C) * 2u; }
    const size_t kstep = (size_t)(BK * 2);
    const size_t hstep = (size_t)HALF * K * 2;
    const size_t tstep = 2 * hstep;
    const unsigned ldsw = (unsigned)wid * 1024u;
    const int aoff = lds_byte(wr * 64 + fr, fq * 8), boff = lds_byte(wc * 32 + fr, fq * 8);
#define PG8_SA(b, h) (((b) * 2 + (h)) * HTB)
#define PG8_SB(b, h) ((4 + (b) * 2 + (h)) * HTB)
#define PG8_STAGE(bufoff, gbase, voff) do { _Pragma("unroll") for (int _i = 0; _i < 2; ++_i) \
        __builtin_amdgcn_global_load_lds((const unsigned*)((const char*)(gbase) + (voff)[_i]), (LAS unsigned*)(lds + (bufoff) + ldsw + _i * 8192), 16, 0, 0); } while (0)
#define PG8_LDA(dst, b, h) do { _Pragma("unroll") for (int m = 0; m < 4; ++m) _Pragma("unroll") for (int k = 0; k < 2; ++k) dst[m][k] = *(const LAS bf16x8*)(lds + PG8_SA(b, h) + aoff + m * 2048 + k * 1024); } while (0)
#define PG8_LDB(dst, b, h) do { _Pragma("unroll") for (int n = 0; n < 2; ++n) _Pragma("unroll") for (int k = 0; k < 2; ++k) dst[n][k] = *(const LAS bf16x8*)(lds + PG8_SB(b, h) + boff + n * 2048 + k * 1024); } while (0)
#define PG8_MMA(ai, bj, At, Bt) do { __builtin_amdgcn_s_setprio(1); _Pragma("unroll") for (int m = 0; m < 4; ++m) _Pragma("unroll") for (int n = 0; n < 2; ++n) _Pragma("unroll") for (int k = 0; k < 2; ++k) \
        acc[ai][bj][m][n] = __builtin_amdgcn_mfma_f32_16x16x32_bf16(Bt[n][k], At[m][k], acc[ai][bj][m][n], 0, 0, 0); __builtin_amdgcn_s_setprio(0); } while (0)
#define PG8_WAIT_V(n) asm volatile("s_waitcnt vmcnt(" #n ")" ::: "memory")
#define PG8_WAIT_L(n) asm volatile("s_waitcnt lgkmcnt(" #n ")" ::: "memory")
#define PG8_BAR __builtin_amdgcn_s_barrier()
#define PG8_SCHED __builtin_amdgcn_sched_barrier(0)
    Unit cur, nxt; int ui = 0;
    if (!S.next(0, cur)) return;
    f32x4 acc[2][2][4][2];
#pragma unroll
    for (int a = 0; a < 2; ++a)
#pragma unroll
        for (int b = 0; b < 2; ++b)
#pragma unroll
            for (int m = 0; m < 4; ++m)
#pragma unroll
                for (int n = 0; n < 2; ++n) acc[a][b][m][n] = (f32x4){0.f, 0.f, 0.f, 0.f};
    bf16x8 At[4][2], B0[2][2], B1[2][2];
    const char* cA = (const char*)g.A + (size_t)cur.pm * tstep; const char* cB = (const char*)g.Bt + cur.boff;
    PG8_STAGE(PG8_SB(0, 0), cB, voffB); PG8_STAGE(PG8_SB(0, 1), cB + hstep, voffB); PG8_STAGE(PG8_SA(0, 0), cA, voffA); PG8_STAGE(PG8_SA(0, 1), cA + hstep, voffA);
    if (wr == 1) PG8_BAR;
    PG8_WAIT_V(2); PG8_BAR;
    PG8_STAGE(PG8_SB(1, 0), cB + kstep, voffB); PG8_STAGE(PG8_SA(1, 0), cA + kstep, voffA); PG8_STAGE(PG8_SB(1, 1), cB + hstep + kstep, voffB);
    PG8_WAIT_V(6); PG8_BAR;
    for (;;) {
        const bool has_next = S.next(ui + 1, nxt);
        const char* nA = has_next ? (const char*)g.A + (size_t)nxt.pm * tstep : cA; const char* nB = has_next ? (const char*)g.Bt + nxt.boff : cB;
        for (int t = 0; t < nt; t += 2) {
            const bool last = (t == nt - 2);
            const char* a1 = cA + (size_t)(t + 1) * kstep;
            const char* a2 = last ? nA : cA + (size_t)(t + 2) * kstep; const char* b2 = last ? nB : cB + (size_t)(t + 2) * kstep;
            const char* a3 = a2 + kstep; const char* b3 = b2 + kstep;
            PG8_LDB(B0, 0, 0); PG8_LDB(B1, 0, 1); PG8_SCHED; PG8_LDA(At, 0, 0); PG8_STAGE(PG8_SA(1, 1), a1 + hstep, voffA);
            PG8_WAIT_V(8); PG8_WAIT_L(0); PG8_BAR; PG8_MMA(0, 0, At, B0); PG8_MMA(0, 1, At, B1); PG8_BAR; PG8_SCHED;
            PG8_LDA(At, 0, 1); PG8_STAGE(PG8_SB(0, 0), b2, voffB); PG8_STAGE(PG8_SB(0, 1), b2 + hstep, voffB); PG8_STAGE(PG8_SA(0, 0), a2, voffA);
            PG8_WAIT_V(8); PG8_WAIT_L(0); PG8_BAR; PG8_MMA(1, 0, At, B0); PG8_MMA(1, 1, At, B1); PG8_BAR; PG8_SCHED;
            PG8_LDB(B0, 1, 0); PG8_LDB(B1, 1, 1); PG8_SCHED; PG8_LDA(At, 1, 0); PG8_STAGE(PG8_SA(0, 1), a2 + hstep, voffA);
            PG8_WAIT_V(8); PG8_WAIT_L(0); PG8_BAR; PG8_MMA(0, 0, At, B0); PG8_MMA(0, 1, At, B1); PG8_BAR; PG8_SCHED;
            PG8_LDA(At, 1, 1); PG8_STAGE(PG8_SB(1, 0), b3, voffB); PG8_STAGE(PG8_SB(1, 1), b3 + hstep, voffB); PG8_STAGE(PG8_SA(1, 0), a3, voffA);
            PG8_WAIT_V(8); PG8_WAIT_L(0); PG8_BAR; PG8_MMA(1, 0, At, B0); PG8_MMA(1, 1, At, B1); PG8_BAR; PG8_SCHED;
        }
        if (wr == 0) PG8_BAR;
        { int tz = wave_s * 64 + lane_id_(); asm volatile("" : "+v"(tz)); const int l2 = tz & 63; E(acc, cur, wave_s >> 2, wave_s & 3, l2 & 15, l2 >> 4); }
        if (!has_next) break;
#pragma unroll
        for (int a = 0; a < 2; ++a)
#pragma unroll
            for (int b = 0; b < 2; ++b)
#pragma unroll
                for (int m = 0; m < 4; ++m)
#pragma unroll
                    for (int n = 0; n < 2; ++n) acc[a][b][m][n] = (f32x4){0.f, 0.f, 0.f, 0.f};
        cur = nxt; cA = nA; cB = nB; ++ui;
        if (wr == 1) PG8_BAR;
    }
    PG8_WAIT_V(0);
    PG8_BAR;
#undef PG8_SA
#undef PG8_SB
#undef PG8_STAGE
#undef PG8_LDA
#undef PG8_LDB
#undef PG8_MMA
#undef PG8_WAIT_V
#undef PG8_WAIT_L
#undef PG8_BAR
#undef PG8_SCHED
}
}
#define XB_TMO      128
#define XB_XCNT(j)  (256  + 64 * (j))
#define XB_XSUB(j)  (1280 + 64 * (j))
#define XB_XGEN(j)  (2304 + 64 * (j))
#define XB_TOP      3328
#define XB_TOPGEN   3392
#define XCD_BAR_WORDS 3456
#define XB_SPIN_CAP (1u << 18)

__device__ __forceinline__ unsigned xb_ld(unsigned* p)              { return __hip_atomic_load(p, __ATOMIC_RELAXED, __HIP_MEMORY_SCOPE_AGENT); }
__device__ __forceinline__ unsigned xb_add(unsigned* p, unsigned v) { return __hip_atomic_fetch_add(p, v, __ATOMIC_RELAXED, __HIP_MEMORY_SCOPE_AGENT); }
__device__ __forceinline__ unsigned xb_xcc_id() { return (unsigned)__builtin_amdgcn_s_getreg((3 << 11) | 20) & 0xFu; }
#define XB_SPIN(cond, bar) do { unsigned _sp = 0; while (cond) { __builtin_amdgcn_s_sleep(1); \
    if ((++_sp & 255u) == 0u) { if (xb_ld(&(bar)[XB_TMO])) break; if (_sp > XB_SPIN_CAP) { atomicAdd(&(bar)[XB_TMO], 1u); break; } } } } while (0)

struct XcdBarrier {
    unsigned* bar; unsigned x; int w;
    volatile LAS unsigned* st;
};

__device__ __forceinline__ XcdBarrier xcd_barrier_post(unsigned* bar, volatile LAS unsigned* st, int wave_s) {
    XcdBarrier b; b.bar = bar; b.x = xb_xcc_id(); b.st = st; b.w = wave_s;
    if (wave_s == 0 && lane_id_() == 0) (void)xb_add(&bar[XB_XCNT(b.x)], 1u);
    return b;
}
__device__ __forceinline__ void xcd_barrier_complete(unsigned* bar, unsigned x, unsigned& nloc, unsigned& nx) {
    const unsigned G = gridDim.x * gridDim.y * gridDim.z;
    unsigned sum, cnt, mine, sp = 0u;
    for (;;) {
        sum = 0u; cnt = 0u; mine = 0u;
#pragma unroll
        for (unsigned j = 0; j < 16; ++j) { const unsigned c = xb_ld(&bar[XB_XCNT(j)]); sum += c; cnt += (c > 0u) ? 1u : 0u; mine = (j == x) ? c : mine; }
        if (sum == G) break;
        __builtin_amdgcn_s_sleep(1);
        if ((++sp & 255u) == 0u) { if (xb_ld(&bar[XB_TMO])) break; if (sp > XB_SPIN_CAP) { atomicAdd(&bar[XB_TMO], 1u); break; } }
    }
    nloc = mine > 0u ? mine : 1u; nx = cnt > 0u ? cnt : 1u;
}

__device__ __forceinline__ void xcd_barrier(const XcdBarrier& b) {
    asm volatile("s_waitcnt vmcnt(0)" ::: "memory");
    __syncthreads();
    if (b.w == 0 && lane_id_() == 0) {
        unsigned* bar = b.bar;
        __builtin_amdgcn_s_waitcnt(0);
        unsigned nloc = b.st[0], nx = b.st[1];
        if (nloc == 0u) { xcd_barrier_complete(bar, b.x, nloc, nx); b.st[0] = nloc; b.st[1] = nx; }
        const unsigned old = xb_add(&bar[XB_XSUB(b.x)], 1u);
        const unsigned gen = old / nloc;
        if (old + 1u == (gen + 1u) * nloc) {
            __builtin_amdgcn_fence(__ATOMIC_RELEASE, "agent");
            asm volatile("s_waitcnt vmcnt(0)" ::: "memory");
            const unsigned og = xb_add(&bar[XB_TOP], 1u);
            const unsigned tg = og / nx;
            if (og + 1u == (tg + 1u) * nx) xb_add(&bar[XB_TOPGEN], 1u);
            else XB_SPIN(xb_ld(&bar[XB_TOPGEN]) == tg, bar);
            __builtin_amdgcn_fence(__ATOMIC_ACQUIRE, "agent");
            xb_add(&bar[XB_XGEN(b.x)], 1u);
            asm volatile("s_waitcnt vmcnt(0)" ::: "memory");
        } else {
            XB_SPIN(xb_ld(&bar[XB_XGEN(b.x)]) == gen, bar);
            __builtin_amdgcn_fence(__ATOMIC_ACQUIRE, "agent");
            asm volatile("s_waitcnt vmcnt(0)" ::: "memory");
        }
    }
    __syncthreads();
}

__device__ const float ROPE_COS[64][8] = {
1.0f, 1.0f, 1.0f, 1.0f, 1.0f, 1.0f, 1.0f, 1.0f,
0.540302277f, 0.950415254f, 0.995004177f, 0.999500036f, 0.999949992f, 0.999994993f, 0.999999523f, 0.99999994f,
-0.416146845f, 0.806578398f, 0.980066597f, 0.998000681f, 0.999800026f, 0.999979973f, 0.999997973f, 0.999999821f,
-0.989992499f, 0.582753658f, 0.955336511f, 0.995503366f, 0.999550045f, 0.999954998f, 0.99999553f, 0.999999523f,
-0.653643608f, 0.301137477f, 0.921060979f, 0.992010653f, 0.999200106f, 0.999920011f, 0.999992013f, 0.999999225f,
0.2836622f, -0.0103423381f, 0.87758255f, 0.987526f, 0.998750269f, 0.999875009f, 0.999987483f, 0.999998748f,
0.960170269f, -0.3207964f, 0.825335622f, 0.982053936f, 0.998200536f, 0.999819994f, 0.999981999f, 0.999998212f,
0.753902256f, -0.599437475f, 0.764842212f, 0.975599885f, 0.997551024f, 0.999755025f, 0.999975502f, 0.999997556f,
-0.145500034f, -0.818632424f, 0.696706712f, 0.968170285f, 0.996801734f, 0.999680042f, 0.999967992f, 0.999996781f,
-0.91113025f, -0.956644177f, 0.621609926f, 0.959772646f, 0.995952725f, 0.999595046f, 0.999959528f, 0.999995947f,
-0.839071512f, -0.999786079f, 0.540302277f, 0.950415313f, 0.995004177f, 0.999500036f, 0.999949992f, 0.999994993f,
0.00442569796f, -0.943779767f, 0.453596085f, 0.940107584f, 0.993956089f, 0.999395072f, 0.999939501f, 0.99999392f,
0.843853951f, -0.79417938f, 0.362357706f, 0.92885989f, 0.99280864f, 0.999280095f, 0.999927998f, 0.999992788f,
0.907446802f, -0.565820515f, 0.267498761f, 0.916683376f, 0.99156189f, 0.999155104f, 0.999915481f, 0.999991536f,
0.136737213f, -0.28134948f, 0.16996716f, 0.903590262f, 0.990216017f, 0.999020159f, 0.99990201f, 0.999990225f,
-0.759687901f, 0.0310223512f, 0.070737198f, 0.889593601f, 0.988771081f, 0.998875201f, 0.999887526f, 0.999988735f,
-0.957659483f, 0.340318173f, -0.0291995462f, 0.87470746f, 0.987227261f, 0.998720288f, 0.999872029f, 0.999987185f,
-0.275163352f, 0.615864813f, -0.128844544f, 0.858946681f, 0.985584795f, 0.998555362f, 0.999855518f, 0.999985576f,
0.660316706f, 0.830336154f, -0.227202162f, 0.842327058f, 0.983843684f, 0.998380423f, 0.999837995f, 0.999983788f,
0.988704622f, 0.962463796f, -0.323289543f, 0.824865162f, 0.982004225f, 0.998195529f, 0.999819517f, 0.99998194f,
0.408082068f, 0.999144375f, -0.416146845f, 0.806578457f, 0.980066597f, 0.998000681f, 0.999800026f, 0.999979973f,
-0.547729254f, 0.936740458f, -0.504846215f, 0.787485182f, 0.97803092f, 0.99779582f, 0.999779522f, 0.999977946f,
-0.99996084f, 0.781440377f, -0.588501155f, 0.767604589f, 0.975897431f, 0.997581005f, 0.999758005f, 0.999975801f,
-0.53283304f, 0.548645258f, -0.666275978f, 0.746956408f, 0.97366637f, 0.997356176f, 0.999735534f, 0.999973536f,
0.424179018f, 0.261441678f, -0.737393796f, 0.725561321f, 0.971337974f, 0.997121394f, 0.99971199f, 0.999971211f,
0.991202831f, -0.0516893305f, -0.801143587f, 0.703440726f, 0.968912423f, 0.996876657f, 0.999687493f, 0.999968767f,
0.64691931f, -0.359694332f, -0.856888831f, 0.680616796f, 0.966389954f, 0.996621907f, 0.999662042f, 0.999966204f,
-0.292138815f, -0.632028639f, -0.904072165f, 0.6571123f, 0.963770926f, 0.996357203f, 0.999635518f, 0.999963522f,
-0.962605894f, -0.841684937f, -0.942222297f, 0.632950664f, 0.961055458f, 0.996082544f, 0.99960804f, 0.99996078f,
-0.748057544f, -0.967871487f, -0.970958173f, 0.608156204f, 0.958243906f, 0.995797932f, 0.999579549f, 0.999957979f,
0.154251456f, -0.998075247f, -0.989992499f, 0.582753658f, 0.955336511f, 0.995503366f, 0.999550045f, 0.999954998f,
0.914742351f, -0.929300308f, -0.999135137f, 0.556768358f, 0.95233357f, 0.995198846f, 0.999519527f, 0.999951959f,
0.83422339f, -0.768367112f, -0.998294771f, 0.53022635f, 0.949235439f, 0.994884372f, 0.999488056f, 0.9999488f,
-0.0132767474f, -0.531235278f, -0.987479806f, 0.503154159f, 0.946042359f, 0.994559944f, 0.999455571f, 0.999945521f,
-0.848570287f, -0.241421118f, -0.966798186f, 0.475578904f, 0.942754686f, 0.994225562f, 0.999422073f, 0.999942183f,
-0.903692186f, 0.0723346695f, -0.93645668f, 0.447528064f, 0.939372718f, 0.993881226f, 0.999387562f, 0.999938726f,
-0.127963692f, 0.378916174f, -0.896758378f, 0.419029742f, 0.935896814f, 0.993526995f, 0.999352098f, 0.99993521f,
0.765414059f, 0.647921681f, -0.848100007f, 0.39011243f, 0.93232733f, 0.993162811f, 0.99931556f, 0.999931574f,
0.955073655f, 0.852673113f, -0.790967762f, 0.360805035f, 0.928664625f, 0.992788672f, 0.999278069f, 0.999927819f,
0.266642928f, 0.972865343f, -0.72593224f, 0.331136853f, 0.924909055f, 0.99240464f, 0.999239624f, 0.999923944f,
-0.666938066f, 0.996578991f, -0.653643608f, 0.301137596f, 0.921060979f, 0.992010653f, 0.999200106f, 0.999920011f,
-0.987339258f, 0.921462357f, -0.574824035f, 0.270837069f, 0.917120814f, 0.991606772f, 0.999159634f, 0.999915957f,
-0.399985313f, 0.754965365f, -0.490260571f, 0.240265876f, 0.913088918f, 0.991192937f, 0.999118149f, 0.999911785f,
0.555113316f, 0.513598442f, -0.400799006f, 0.209454417f, 0.908965766f, 0.990769207f, 0.999075651f, 0.999907553f,
0.999843299f, 0.221298173f, -0.307332784f, 0.178433523f, 0.904751658f, 0.990335584f, 0.99903214f, 0.999903202f,
0.52532196f, -0.0929481089f, -0.210795805f, 0.147234216f, 0.90044713f, 0.989892066f, 0.998987675f, 0.999898732f,
-0.432177931f, -0.397976756f, -0.112152621f, 0.115887694f, 0.89605248f, 0.989438653f, 0.998942196f, 0.999894202f,
-0.992335498f, -0.663538277f, -0.0123883775f, 0.0844252855f, 0.891568303f, 0.988975346f, 0.998895705f, 0.999889553f,
-0.640144348f, -0.863296509f, 0.0874991715f, 0.0528784581f, 0.886994898f, 0.988502085f, 0.9988482f, 0.999884784f,
0.300592542f, -0.977442741f, 0.18651247f, 0.0212787576f, 0.882332861f, 0.98801899f, 0.998799741f, 0.999879956f,
0.964965999f, -0.994656444f, 0.2836622f, -0.0103422189f, 0.87758255f, 0.987526f, 0.998750269f, 0.999875009f,
0.742154181f, -0.913230121f, 0.377977669f, -0.0419528559f, 0.872744501f, 0.987023175f, 0.998699784f, 0.999869943f,
-0.162990779f, -0.741239965f, 0.468516916f, -0.0735215396f, 0.86781919f, 0.986510456f, 0.998648286f, 0.999864817f,
-0.918282807f, -0.495741814f, 0.554374516f, -0.105016708f, 0.862807095f, 0.985987842f, 0.998595834f, 0.999859571f,
-0.829309821f, -0.201079622f, 0.634692967f, -0.136406869f, 0.857708693f, 0.985455394f, 0.998542368f, 0.999854207f,
0.0221267566f, 0.113521777f, 0.708669782f, -0.167660639f, 0.852524519f, 0.984913111f, 0.99848789f, 0.999848783f,
0.853220105f, 0.416867077f, 0.775565803f, -0.198746875f, 0.847255111f, 0.984360933f, 0.998432398f, 0.99984318f,
0.899866819f, 0.678870201f, 0.834712923f, -0.22963427f, 0.841901004f, 0.983798921f, 0.998375952f, 0.999837577f,
0.119180135f, 0.873550534f, 0.885519624f, -0.260292053f, 0.836462677f, 0.983227074f, 0.998318493f, 0.999831796f,
-0.771080196f, 0.981602073f, 0.927478492f, -0.290689558f, 0.830940723f, 0.982645452f, 0.998260021f, 0.999825954f,
-0.952412963f, 0.992308319f, 0.960170269f, -0.3207964f, 0.825335622f, 0.982053936f, 0.998200536f, 0.999819994f,
-0.258101642f, 0.904607594f, 0.98326844f, -0.350582451f, 0.819648027f, 0.981452644f, 0.998140097f, 0.999813974f,
0.673507154f, 0.727198064f, 0.996542096f, -0.380017966f, 0.813878477f, 0.980841517f, 0.998078644f, 0.999807835f,
0.985896587f, 0.477671444f, 0.999858618f, -0.409073502f, 0.808027506f, 0.980220556f, 0.998016179f, 0.999801576f
};
__device__ const float ROPE_SIN[64][8] = {
0.0f, 0.0f, 0.0f, 0.0f, 0.0f, 0.0f, 0.0f, 0.0f,
0.841470957f, 0.310983598f, 0.0998334214f, 0.0316175036f, 0.00999983307f, 0.00316227227f, 0.000999999931f, 0.000316227757f,
0.909297407f, 0.591127098f, 0.198669329f, 0.0632033944f, 0.0199986659f, 0.00632451288f, 0.0019999987f, 0.000632455456f,
0.141120002f, 0.812648892f, 0.295520216f, 0.0947260857f, 0.0299954992f, 0.00948669016f, 0.0029999956f, 0.000948683126f,
-0.756802499f, 0.953580737f, 0.389418334f, 0.126154065f, 0.0399893336f, 0.0126487734f, 0.00399998948f, 0.00126491068f,
-0.958924294f, 0.999946535f, 0.47942555f, 0.157455876f, 0.0499791652f, 0.0158107281f, 0.0049999794f, 0.00158113812f,
-0.279415488f, 0.947148204f, 0.564642489f, 0.188600272f, 0.0599640049f, 0.0189725272f, 0.0059999642f, 0.00189736532f,
0.656986594f, 0.800421596f, 0.64421767f, 0.219556093f, 0.0699428469f, 0.0221341345f, 0.00699994294f, 0.00221359241f,
0.989358246f, 0.574317753f, 0.717356086f, 0.250292331f, 0.0799146891f, 0.0252955221f, 0.0079999147f, 0.00252981926f,
0.412118495f, 0.291259229f, 0.783326924f, 0.280778319f, 0.0898785442f, 0.0284566563f, 0.00899987947f, 0.00284604589f,
-0.54402113f, -0.0206835698f, 0.841470957f, 0.310983568f, 0.099833414f, 0.0316175036f, 0.009999834f, 0.00316227227f,
-0.999990225f, -0.33057496f, 0.891207397f, 0.340877861f, 0.1097783f, 0.0347780399f, 0.0109997792f, 0.00347849843f,
-0.536572933f, -0.60768342f, 0.932039082f, 0.370431304f, 0.119712204f, 0.0379382223f, 0.0119997123f, 0.00379472389f,
0.420167029f, -0.824528456f, 0.963558197f, 0.399614304f, 0.129634142f, 0.0410980321f, 0.0129996343f, 0.00411094911f,
0.990607381f, -0.959605396f, 0.985449731f, 0.428397775f, 0.139543116f, 0.0442574248f, 0.0139995432f, 0.00442717411f,
0.650287867f, -0.999518692f, 0.997494996f, 0.456752867f, 0.149438128f, 0.0474163815f, 0.0149994381f, 0.00474339863f,
-0.287903309f, -0.940310359f, 0.999573588f, 0.484651238f, 0.159318209f, 0.0505748577f, 0.015999319f, 0.00505962269f,
-0.961397469f, -0.78785187f, 0.991664827f, 0.512064993f, 0.169182345f, 0.0537328273f, 0.0169991814f, 0.00537584582f,
-0.750987232f, -0.557262897f, 0.973847628f, 0.538966715f, 0.179029569f, 0.0568902642f, 0.0179990288f, 0.00569206895f,
0.149877205f, -0.271410108f, 0.946300089f, 0.565329552f, 0.188858896f, 0.060047131f, 0.0189988576f, 0.00600829115f,
0.912945271f, 0.0413582884f, 0.909297407f, 0.591127038f, 0.198669314f, 0.0632033944f, 0.0199986678f, 0.00632451288f,
0.836655617f, 0.35002476f, 0.863209307f, 0.616333544f, 0.208459899f, 0.0663590282f, 0.0209984574f, 0.00664073415f,
-0.00885130931f, 0.623979926f, 0.808496356f, 0.640923738f, 0.218229622f, 0.0695140064f, 0.0219982266f, 0.00695695449f,
-0.846220434f, 0.836055279f, 0.745705247f, 0.664873064f, 0.227977514f, 0.0726682767f, 0.0229979735f, 0.00727317436f,
-0.905578375f, 0.965219259f, 0.67546314f, 0.688157499f, 0.237702623f, 0.0758218244f, 0.0239976961f, 0.0075893933f,
-0.132351756f, 0.998663187f, 0.598472118f, 0.710753918f, 0.247403964f, 0.0789746121f, 0.0249973964f, 0.00790561177f,
0.76255846f, 0.933070183f, 0.515501261f, 0.732639611f, 0.257080555f, 0.0821266174f, 0.0259970706f, 0.00822182931f,
0.956375957f, 0.774945021f, 0.427379847f, 0.753792703f, 0.266731411f, 0.0852777958f, 0.0269967206f, 0.00853804592f,
0.270905793f, 0.539968967f, 0.334988207f, 0.774192095f, 0.276355654f, 0.0884281173f, 0.0279963426f, 0.0088542616f,
-0.663633883f, 0.251445323f, 0.239249229f, 0.793817401f, 0.28595221f, 0.0915775672f, 0.0289959367f, 0.00917047635f,
-0.988031626f, -0.0620148405f, 0.141120002f, 0.812648892f, 0.295520186f, 0.0947260931f, 0.029995501f, 0.00948669016f,
-0.404037654f, -0.369325012f, 0.0415805206f, 0.830667794f, 0.305058628f, 0.0978736654f, 0.0309950355f, 0.00980290305f,
0.551426709f, -0.640009403f, -0.0583741926f, 0.847856104f, 0.314566553f, 0.101020269f, 0.0319945402f, 0.0101191159f,
0.999911845f, -0.847224355f, -0.157745644f, 0.864196658f, 0.324043006f, 0.10416586f, 0.0329940096f, 0.010435327f,
0.529082716f, -0.97042042f, -0.255541205f, 0.879673064f, 0.333487093f, 0.107310407f, 0.0339934528f, 0.010751537f,
-0.428182662f, -0.997380435f, -0.350783229f, 0.894269884f, 0.342897803f, 0.110453881f, 0.034992855f, 0.0110677453f,
-0.991778851f, -0.925431013f, -0.442520559f, 0.907972515f, 0.352274209f, 0.113596253f, 0.0359922275f, 0.0113839535f,
-0.643538117f, -0.761706948f, -0.529836178f, 0.920767248f, 0.361615449f, 0.116737492f, 0.036991559f, 0.0117001599f,
0.296368569f, -0.522444785f, -0.611857831f, 0.932641268f, 0.370920479f, 0.119877554f, 0.0379908569f, 0.0120163653f,
0.963795364f, -0.231372014f, -0.687766254f, 0.943582714f, 0.380188406f, 0.123016424f, 0.0389901139f, 0.0123325698f,
0.745113134f, 0.0826458037f, -0.756802499f, 0.953580678f, 0.389418334f, 0.126154065f, 0.0399893373f, 0.0126487734f,
-0.158622667f, 0.388467699f, -0.818277061f, 0.962625206f, 0.39860931f, 0.129290432f, 0.0409885161f, 0.0129649751f,
-0.916521549f, 0.655764699f, -0.871575892f, 0.970707119f, 0.407760441f, 0.132425532f, 0.0419876575f, 0.0132811759f,
-0.831774771f, 0.858030677f, -0.916166008f, 0.977818429f, 0.416870773f, 0.135559291f, 0.0429867506f, 0.0135973748f,
0.0177019257f, 0.975206196f, -0.951602101f, 0.983951986f, 0.425939471f, 0.138691694f, 0.0439858064f, 0.0139135728f,
0.850903511f, 0.995670974f, -0.977530122f, 0.989101648f, 0.434965521f, 0.141822711f, 0.0449848175f, 0.0142297689f,
0.901788354f, 0.917395473f, -0.993690968f, 0.993262351f, 0.44394809f, 0.144952312f, 0.0459837839f, 0.0145459641f,
0.123573124f, 0.748142362f, -0.999923289f, 0.996429801f, 0.452886283f, 0.148080453f, 0.0469827019f, 0.0148621574f,
-0.768254638f, 0.504697084f, -0.99616462f, 0.99860096f, 0.461779177f, 0.151207119f, 0.0479815714f, 0.0151783489f,
-0.953752637f, 0.211200655f, -0.982452571f, 0.999773562f, 0.470625877f, 0.15433228f, 0.0489803962f, 0.0154945394f,
-0.262374848f, -0.10324046f, -0.958924294f, 0.999946535f, 0.47942555f, 0.157455891f, 0.0499791689f, 0.0158107281f,
0.670229197f, -0.407444149f, -0.925814748f, 0.99911958f, 0.48817724f, 0.160577938f, 0.0509778969f, 0.0161269177f,
0.986627579f, -0.671240151f, -0.883454502f, 0.997293651f, 0.496880114f, 0.163698375f, 0.051976569f, 0.0164431017f,
0.395925164f, -0.868469954f, -0.832267344f, 0.994470477f, 0.505533338f, 0.166817173f, 0.0529751927f, 0.0167592876f,
-0.558789074f, -0.979574919f, -0.772764444f, 0.990652919f, 0.514135957f, 0.169934288f, 0.0539737605f, 0.0170754679f,
-0.999755144f, -0.993535519f, -0.705540299f, 0.985844791f, 0.522687256f, 0.173049718f, 0.0549722798f, 0.01739165f,
-0.521551013f, -0.908967435f, -0.631266713f, 0.980050862f, 0.531186223f, 0.17616342f, 0.0559707358f, 0.0177078284f,
0.436164767f, -0.734258294f, -0.550685287f, 0.973276973f, 0.539632022f, 0.179275364f, 0.0569691435f, 0.0180240069f,
0.992872655f, -0.486733496f, -0.464602023f, 0.965529919f, 0.548023939f, 0.182385504f, 0.0579674877f, 0.0183401816f,
0.636738002f, -0.190938011f, -0.373876572f, 0.956817448f, 0.55636102f, 0.185493827f, 0.0589657798f, 0.0186563563f,
-0.304810613f, 0.12379095f, -0.279415488f, 0.947148204f, 0.564642429f, 0.188600287f, 0.0599640086f, 0.0189725272f,
-0.966117799f, 0.426245421f, -0.182162598f, 0.936531842f, 0.572867453f, 0.191704854f, 0.0609621815f, 0.0192886982f,
-0.739180684f, 0.686427653f, -0.0830891207f, 0.924979091f, 0.581035137f, 0.194807529f, 0.0619602874f, 0.0196048655f,
0.167355701f, 0.878538549f, 0.0168140903f, 0.912501454f, 0.589144766f, 0.197908238f, 0.0629583374f, 0.0199210308f
};

struct Params { const float* in[41]; float* out; unsigned char* ws; };
enum { I_X = 0, I_C, I_CTX, I_CCTX, I_LNG, I_LNB, I_ADAW, I_ADAB, I_WIN, I_LQ1, I_LK1, I_LQ2, I_LK2, I_SUBLN, I_GW2, I_GGB, I_GNG, I_CONV, I_W2, I_W0, I_A2, I_A0, I_G2, I_KK, I_KA, I_RK,
       I_LNXG, I_LNXB, I_WOUT, I_LN1G, I_LN1B, I_RW, I_RB, I_MWG, I_MBG, I_MWU, I_MBU, I_MWD, I_MBD, I_LN2G, I_LN2B };

#define WSP(T, off) ((T*)(p.ws + (off)))
#define SCRP(T, off) ((T*)(p.ws + WS_SCR + (off)))

__device__ __forceinline__ void conv_tile(const float* __restrict__ src, int ld, int nvalid, int k0, int n0, bf16_t* __restrict__ dst, int rs, int ro, LAS float* tile, int tid) {
    {
        const int k = tid >> 3, n8 = (tid & 7) * 8;
        const float* s = src + (size_t)(k0 + k) * ld + n0 + n8;
        f32x4 a = {0.f, 0.f, 0.f, 0.f}, b = {0.f, 0.f, 0.f, 0.f};
        if (n0 + n8 + 8 <= nvalid) { a = *(const f32x4*)s; b = *(const f32x4*)(s + 4); }
        LAS float* t = tile + k * 65 + n8;
        t[0] = a[0]; t[1] = a[1]; t[2] = a[2]; t[3] = a[3]; t[4] = b[0]; t[5] = b[1]; t[6] = b[2]; t[7] = b[3];
    }
    __syncthreads();
    {
        const int n = tid >> 3, k8 = (tid & 7) * 8;
        const LAS float* t = tile + k8 * 65 + n;
        u32x4 o; o.x = pk2(t[0], t[65]); o.y = pk2(t[130], t[195]); o.z = pk2(t[260], t[325]); o.w = pk2(t[390], t[455]);
        *(u32x4*)(dst + ((size_t)(n0 + n) * rs + ro) * 1024 + k0 + k8) = o;
    }
    __syncthreads();
}
constexpr int JW_IN = 16 * 56, JW_OUT = 256, JW_LAYER = JW_IN + JW_OUT + 32 * 768, JW_TOTAL = 2 * JW_LAYER, J_MOD = 48;
__device__ __forceinline__ void conv_job(const Params& p, int j, LAS float* tile, int tid) {
    asm volatile("" : "+v"(tid));
    const int l = j / JW_LAYER; int r = j % JW_LAYER;
    if (r < JW_IN) { const int kt = r / 56, nt = r % 56;
        conv_tile(p.in[I_WIN] + (size_t)l * 1024 * DIN, DIN, DIN, kt * 64, nt * 64, WSP(bf16_t, WS_WIN) + (size_t)l * DINP * 1024, 1, 0, tile, tid); return; }
    r -= JW_IN;
    if (r < JW_OUT) { const int kt = r >> 4, nt = r & 15;
        conv_tile(p.in[I_WOUT] + (size_t)l * 1024 * 1024, 1024, 1024, kt * 64, nt * 64, WSP(bf16_t, WS_WOUT) + (size_t)l * 1024 * 1024, 1, 0, tile, tid); return; }
    r -= JW_OUT;
    const int e = r / 768, q = r % 768, which = q >> 8, t = q & 255, kt = t >> 4, nt = t & 15;
    const size_t eo = (size_t)(l * 32 + e) * 1024 * 1024;
    if (which == 0) conv_tile(p.in[I_MWG] + eo, 1024, 1024, kt * 64, nt * 64, WSP(bf16_t, WS_WGU) + 2 * eo, 2, 0, tile, tid);
    else if (which == 1) conv_tile(p.in[I_MWU] + eo, 1024, 1024, kt * 64, nt * 64, WSP(bf16_t, WS_WGU) + 2 * eo, 2, 1, tile, tid);
    else conv_tile(p.in[I_MWD] + eo, 1024, 1024, kt * 64, nt * 64, WSP(bf16_t, WS_WDN) + eo, 1, 0, tile, tid);
}
__device__ __forceinline__ void mod_job(const Params& p, int job, LAS float* lds, int tid) {
    asm volatile("" : "+v"(tid));
    const int l = job / 24, c0 = (job % 24) * 256;
    LAS float* sv = lds;
    LAS float* part = lds + 5120;
    for (int i = tid; i < 5120; i += NTHR) { const int s = i >> 10, k = i & 1023; const float cv = s < 4 ? p.in[I_C][s * 1024 + k] : p.in[I_CCTX][k]; sv[i] = siluf_(cv); }
    __syncthreads();
    const int n = tid & 255, kh = tid >> 8;
    const float* w = p.in[I_ADAW] + (size_t)l * 1024 * 6144 + (size_t)(kh * 512) * 6144 + c0 + n;
    float a0 = 0.f, a1 = 0.f, a2 = 0.f, a3 = 0.f, a4 = 0.f;
    const LAS float* s0 = sv + kh * 512;
#pragma unroll 8
    for (int k = 0; k < 512; ++k) { const float wv = w[(size_t)k * 6144];
        a0 += s0[k] * wv; a1 += s0[1024 + k] * wv; a2 += s0[2048 + k] * wv; a3 += s0[3072 + k] * wv; a4 += s0[4096 + k] * wv; }
    part[(kh * 5 + 0) * 256 + n] = a0; part[(kh * 5 + 1) * 256 + n] = a1; part[(kh * 5 + 2) * 256 + n] = a2; part[(kh * 5 + 3) * 256 + n] = a3; part[(kh * 5 + 4) * 256 + n] = a4;
    __syncthreads();
    if (kh == 0) { const float bb = p.in[I_ADAB][l * 6144 + c0 + n]; float* mo = WSP(float, WS_MOD);
#pragma unroll
        for (int s = 0; s < 5; ++s) mo[(size_t)(l * 5 + s) * 6144 + c0 + n] = part[s * 256 + n] + part[(5 + s) * 256 + n] + bb; }
    __syncthreads();
}

__device__ __forceinline__ void ln_in_rows(const Params& p, int gw, int ngw, int lane) {
    float* H = WSP(float, WS_H); bf16_t* XM = WSP(bf16_t, WS_XM); const float* MOD = WSP(float, WS_MOD);
    for (int row = gw; row < NTOK; row += ngw) {
        const float* src = row < NLAT ? p.in[I_X] + (size_t)row * D : p.in[I_CTX] + (size_t)(row - NLAT) * D;
        f32x4 v[4]; float s = 0.f;
#pragma unroll
        for (int j = 0; j < 4; ++j) { v[j] = *(const f32x4*)(src + lane * 4 + 256 * j); s += (v[j][0] + v[j][1]) + (v[j][2] + v[j][3]); }
        const float mean = wave_sum(s) * (1.f / D); float s2 = 0.f;
#pragma unroll
        for (int j = 0; j < 4; ++j) { v[j] = v[j] - mean; s2 += (v[j][0] * v[j][0] + v[j][1] * v[j][1]) + (v[j][2] * v[j][2] + v[j][3] * v[j][3]); }
        const float rstd = rsqrtf(wave_sum(s2) * (1.f / D) + LN_EPS);
        const int sidx = row < NLAT ? (row >> 12) : 4; const float* mod = MOD + (size_t)sidx * 6144;
#pragma unroll
        for (int j = 0; j < 4; ++j) { const int c = lane * 4 + 256 * j;
            const f32x4 g = *(const f32x4*)(p.in[I_LNG] + c), bb = *(const f32x4*)(p.in[I_LNB] + c);
            const f32x4 y = v[j] * rstd * g + bb;
            *(f32x4*)(H + (size_t)row * D + c) = y;
            const f32x4 sh = *(const f32x4*)(mod + c), sc = *(const f32x4*)(mod + 1024 + c);
            const f32x4 xm = y * (sc + 1.f) + sh;
            u32x2 o; o.x = pk2(xm[0], xm[1]); o.y = pk2(xm[2], xm[3]);
            *(u32x2*)(XM + (size_t)row * D + c) = o; }
    }
}

__device__ __forceinline__ void unpack8(const u32x4 u, float (&f)[8]) {
    f[0] = bflo(u.x); f[1] = bfhi(u.x); f[2] = bflo(u.y); f[3] = bfhi(u.y); f[4] = bflo(u.z); f[5] = bfhi(u.z); f[6] = bflo(u.w); f[7] = bfhi(u.w);
}
__device__ __forceinline__ void da_job(const Params& p, int l, int b, int kt, LAS unsigned char* lds, int tid) {
    asm volatile("" : "+v"(tid));
    LAS bf16_t* kvt = (LAS bf16_t*)lds;
    const bf16_t* Z = WSP(bf16_t, WS_Z);
    const bool isctx = kt < 8;
    const int rowb = isctx ? NLAT + b * 256 + kt * 32 : b * 4096 + (kt - 8) * 32;
    for (int i = tid; i < 2048; i += NTHR) { const int r = i >> 6, c16 = i & 63;
        *(LAS u32x4*)(kvt + r * 512 + c16 * 8) = *(const u32x4*)(Z + (size_t)(rowb + r) * DINP + ZK + c16 * 8); }
    __syncthreads();
    const int w = tid >> 6, L = tid & 63, fr = L & 15, fq = L >> 4;
    unsigned char* rec = SCRP(unsigned char, SC_KVREC);
    unsigned* kmax = WSP(unsigned, WS_CTL) + CW_KMAX + l * 32;
    for (int h = 0; h < 4; ++h) {
        u32x4 o;
        if (w < 4) {
            const int m = w >> 1, ks = w & 1, key = ks * 16 + fr;
            float ov[8], pv[8];
            unpack8(*(const LAS u32x4*)(kvt + key * 512 + h * 64 + m * 32 + fq * 8), ov);
            unpack8(*(const LAS u32x4*)(kvt + key * 512 + h * 64 + m * 32 + (fq ^ 1) * 8), pv);
            if (!isctx) {
                const int t = (kt - 8) * 32 + key, pos = (fq >> 1) ? (t & 63) : (t >> 6);
                const float sg = (fq & 1) ? 1.f : -1.f;
#pragma unroll
                for (int i = 0; i < 8; ++i) ov[i] = ov[i] * ROPE_COS[pos][i] + sg * pv[i] * ROPE_SIN[pos][i];
            }
            o.x = pk2(ov[0], ov[1]); o.y = pk2(ov[2], ov[3]); o.z = pk2(ov[4], ov[5]); o.w = pk2(ov[6], ov[7]);
            float rv[8]; unpack8(o, rv); float n2 = 0.f;
#pragma unroll
            for (int i = 0; i < 8; ++i) n2 += rv[i] * rv[i];
            n2 += __shfl_xor(n2, 16); n2 += __shfl_xor(n2, 32);
#pragma unroll
            for (int x = 1; x < 16; x <<= 1) n2 = fmaxf(n2, __shfl_xor(n2, x));
            if (L == 0) atomicMax(kmax + (b * 4 + h) * 2 + m, __builtin_bit_cast(unsigned, n2));
        } else {
            const int et = w - 4; unsigned short vv[8];
#pragma unroll
            for (int i = 0; i < 8; ++i) { const int key = (i < 4) ? fq * 4 + i : 16 + fq * 4 + (i - 4); vv[i] = kvt[key * 512 + 256 + h * 64 + et * 16 + fr]; }
            o.x = vv[0] | ((unsigned)vv[1] << 16); o.y = vv[2] | ((unsigned)vv[3] << 16); o.z = vv[4] | ((unsigned)vv[5] << 16); o.w = vv[6] | ((unsigned)vv[7] << 16);
        }
        *(u32x4*)(rec + ((size_t)((b * 4 + h) * NKT + kt)) * 8192 + w * 1024 + L * 16) = o;
    }
    __syncthreads();
}

__device__ __forceinline__ int chunk_row0(int cid) { return cid < 256 ? (cid >> 6) * 4096 + (cid & 63) * 64 : NLAT + ((cid - 256) >> 2) * 256 + ((cid - 256) & 3) * 64; }

__device__ __forceinline__ void gla_job(const Params& p, int l, int cid, int h, LAS unsigned char* lds, int tid) {
    asm volatile("" : "+v"(tid));
    const int r0 = chunk_row0(cid), w = tid >> 6, lane = tid & 63, fr = lane & 15, fq = lane >> 4;
    const bf16_t* Z = WSP(bf16_t, WS_Z);
    LAS float* gi = (LAS float*)lds;
    LAS float* GT = gi + 2048;
    LAS bf16_t* KDT = (LAS bf16_t*)(GT + 2 * 32 * 65);
    LAS bf16_t* Vt = KDT + 2 * 32 * 72;
    for (int i = tid; i < 2048; i += NTHR) { const int pp = i >> 5, k = i & 31; gi[pp * 32 + k] = bf2f(Z[(size_t)(r0 + pp) * DINP + ZGF + k]); }
    for (int i = tid; i < 4096; i += NTHR) { const int pp = i >> 6, v = i & 63; Vt[v * 72 + pp] = Z[(size_t)(r0 + pp) * DINP + ZGV + h * 64 + v]; }
    __syncthreads();
    const float* gw2 = p.in[I_GW2] + (size_t)l * 2 * 16 * 192; const float* ggb = p.in[I_GGB] + (size_t)l * 2 * 192;
#pragma unroll 1
    for (int j = 0; j < 8; ++j) { const int i = tid + NTHR * j, dir = i >> 11, k = (i >> 6) & 31, pp = i & 63;
        float x = ggb[dir * 192 + h * 32 + k];
#pragma unroll
        for (int jj = 0; jj < 16; ++jj) x += gi[pp * 32 + dir * 16 + jj] * gw2[(dir * 16 + jj) * 192 + h * 32 + k];
        GT[(dir * 32 + k) * 65 + pp] = (fminf(x, 0.f) - log1pf(__expf(-fabsf(x)))) * (1.f / 16.f); }
    __syncthreads();
#pragma unroll 1
    for (int c = 0; c < 8; ++c) { const int col = w * 8 + c, dir = col >> 5, pp = dir ? 63 - lane : lane; float x = GT[col * 65 + pp];
#pragma unroll
        for (int o = 1; o < 64; o <<= 1) { const float y = __shfl_up(x, o); if (lane >= o) x += y; }
        GT[col * 65 + pp] = x; }
    __syncthreads();
    float* GBF = SCRP(float, SC_GBF); float* GBB = SCRP(float, SC_GBB);
    for (int i = tid; i < 4096; i += NTHR) { const int dir = i >> 11, pp = (i >> 5) & 63, k = i & 31; const float bb = GT[(dir * 32 + k) * 65 + pp];
        (dir ? GBB : GBF)[(size_t)(r0 + pp) * 192 + h * 32 + k] = bb;
        const float kk = bf2f(Z[(size_t)(r0 + pp) * DINP + ZGK + h * 32 + k]);
        KDT[(dir * 32 + k) * 72 + pp] = (bf16_t)f2bf(kk * __expf(GT[(dir * 32 + k) * 65 + (dir ? 0 : 63)] - bb)); }
    __syncthreads();
    float* KVC = SCRP(float, SC_KVC); float* DC = SCRP(float, SC_DC);
#pragma unroll
    for (int q = 0; q < 2; ++q) { const int idx = w * 2 + q, dir = idx >> 3, mt = (idx >> 2) & 1, nt = idx & 3;
        f32x4 acc = {0.f, 0.f, 0.f, 0.f};
#pragma unroll
        for (int ks = 0; ks < 2; ++ks) { const bf16x8 a = *(const LAS bf16x8*)(KDT + (dir * 32 + mt * 16 + fr) * 72 + ks * 32 + fq * 8), b = *(const LAS bf16x8*)(Vt + (nt * 16 + fr) * 72 + ks * 32 + fq * 8);
            acc = __builtin_amdgcn_mfma_f32_16x16x32_bf16(a, b, acc, 0, 0, 0); }
        float* dst = KVC + ((size_t)((cid * 6 + h) * 2 + dir)) * 2048;
#pragma unroll
        for (int j = 0; j < 4; ++j) dst[(mt * 16 + fq * 4 + j) * 64 + nt * 16 + fr] = acc[j]; }
    if (tid < 64) { const int dir = tid >> 5, k = tid & 31; DC[((cid * 6 + h) * 2 + dir) * 32 + k] = __expf(GT[(dir * 32 + k) * 65 + (dir ? 0 : 63)]); }
    __syncthreads();
}

constexpr int SGS = 136;
__device__ __forceinline__ void rw_job(const Params& p, int l, int tt, LAS unsigned char* lds, int tid) {
    asm volatile("" : "+v"(tid));
    const int r0 = tt < 512 ? tt * 32 : NLAT + (tt - 512) * 32;
    const int pos = tt < 512 ? (r0 & 4095) : ((r0 - NLAT) & 255), slen = tt < 512 ? 4096 : 256;
    const bool has_prev = pos > 0, has_next = pos + 32 < slen;
    const bf16_t* Z = WSP(bf16_t, WS_Z);
    LAS bf16_t* rkv = (LAS bf16_t*)lds;
    LAS bf16_t* XW = (LAS bf16_t*)(lds + 78336);
    LAS bf16_t* XG = XW + 4 * 32 * 72;
    for (int i = tid; i < 34 * 144; i += NTHR) { const int rr = i / 144, c16 = i % 144; const bool ok = rr == 0 ? has_prev : (rr == 33 ? has_next : true);
        u32x4 v = {0u, 0u, 0u, 0u}; if (ok) v = *(const u32x4*)(Z + (size_t)(r0 - 1 + rr) * DINP + ZRKV + c16 * 8);
        *(LAS u32x4*)(rkv + rr * 1152 + c16 * 8) = v; }
    for (int i = tid; i < 32 * 384; i += NTHR) { const int t = i / 384, c = i % 384; const float v = bf2f(Z[(size_t)(r0 + t) * DINP + ZWF + c]);
        if (c < 128) XW[((c >> 6) * 32 + t) * 72 + (c & 63)] = (bf16_t)f2bf(tanhf(v));
        else if (c < 256) XW[((2 + ((c - 128) >> 6)) * 32 + t) * 72 + (c & 63)] = (bf16_t)f2bf(v);
        else XG[t * SGS + (c - 256)] = (bf16_t)f2bf(sigmoidf_(v)); }
    __syncthreads();
    const int h = tid >> 6, lane = tid & 63, fr = lane & 15, fq = lane >> 4;
    if (h < 6) {
        const float* cw = p.in[I_CONV] + (size_t)l * 3 * 1152;
        const bf16_t* WT = WSP(bf16_t, WS_RWW) + (size_t)l * RWW_LAYER;
        bf16_t* Rg = SCRP(bf16_t, SC_R); bf16_t* KKg = SCRP(bf16_t, SC_KK); bf16_t* Vg = SCRP(bf16_t, SC_V); bf16_t* Gg = SCRP(bf16_t, SC_G); float* BON = SCRP(float, SC_BON);
        bf16_t* BKF = SCRP(bf16_t, SC_BKF); bf16_t* BKB = SCRP(bf16_t, SC_BKB); bf16_t* KMF = SCRP(bf16_t, SC_KMF); bf16_t* KMB = SCRP(bf16_t, SC_KMB);
        float* LWF = SCRP(float, SC_WF); float* LWB = SCRP(float, SC_WB);
#define CONV3(t, off, c, w0, w1, w2) (bf2f(rkv[(t) * 1152 + (off) + (c)]) * (w0) + bf2f(rkv[((t) + 1) * 1152 + (off) + (c)]) * (w1) + bf2f(rkv[((t) + 2) * 1152 + (off) + (c)]) * (w2))
#pragma unroll 1
        for (int mt = 0; mt < 2; ++mt) {
            float kr[4][4], kc[4][4], ss[4] = {0.f, 0.f, 0.f, 0.f};
#pragma unroll
            for (int nt = 0; nt < 4; ++nt) { const int c = h * 64 + nt * 16 + fr;
                const float ck0 = cw[384 + c], ck1 = cw[1152 + 384 + c], ck2 = cw[2304 + 384 + c], kkw = p.in[I_KK][l * 384 + c];
#pragma unroll
                for (int j = 0; j < 4; ++j) { const int t = mt * 16 + fq * 4 + j; kc[nt][j] = CONV3(t, 384, c, ck0, ck1, ck2); kr[nt][j] = kc[nt][j] * kkw; ss[j] += kr[nt][j] * kr[nt][j]; } }
            float invn[4], bon[4] = {0.f, 0.f, 0.f, 0.f};
#pragma unroll
            for (int j = 0; j < 4; ++j) invn[j] = 1.f / fmaxf(sqrtf(red16(ss[j])), 1e-12f);
            bf16x8 ax[4][2], ag[4];
#pragma unroll
            for (int m = 0; m < 4; ++m)
#pragma unroll
                for (int ks = 0; ks < 2; ++ks) ax[m][ks] = *(const LAS bf16x8*)(XW + ((m * 32 + mt * 16 + fr) * 72) + ks * 32 + fq * 8);
#pragma unroll
            for (int ks = 0; ks < 4; ++ks) ag[ks] = *(const LAS bf16x8*)(XG + (mt * 16 + fr) * SGS + ks * 32 + fq * 8);
#pragma unroll 1
            for (int nt = 0; nt < 4; ++nt) { const int c = h * 64 + nt * 16 + fr;
                f32x4 acc[5];
#pragma unroll
                for (int m = 0; m < 5; ++m) acc[m] = (f32x4){0.f, 0.f, 0.f, 0.f};
#pragma unroll
                for (int m = 0; m < 4; ++m)
#pragma unroll
                    for (int ks = 0; ks < 2; ++ks) { const bf16x8 bw = *(const bf16x8*)(WT + (size_t)m * 384 * 64 + (size_t)c * 64 + ks * 32 + fq * 8);
                        acc[m] = __builtin_amdgcn_mfma_f32_16x16x32_bf16(ax[m][ks], bw, acc[m], 0, 0, 0); }
#pragma unroll
                for (int ks = 0; ks < 4; ++ks) { const bf16x8 bw = *(const bf16x8*)(WT + (size_t)4 * 384 * 64 + (size_t)c * 128 + ks * 32 + fq * 8);
                    acc[4] = __builtin_amdgcn_mfma_f32_16x16x32_bf16(ag[ks], bw, acc[4], 0, 0, 0); }
                const float cr0 = cw[c], cr1 = cw[1152 + c], cr2 = cw[2304 + c], cv0 = cw[768 + c], cv1 = cw[1152 + 768 + c], cv2 = cw[2304 + 768 + c];
                const float kaw = p.in[I_KA][l * 384 + c], rkw = p.in[I_RK][l * 384 + c];
                const float w0f = p.in[I_W0][(l * 2) * 384 + c], w0b = p.in[I_W0][(l * 2 + 1) * 384 + c], a0f = p.in[I_A0][(l * 2) * 384 + c], a0b = p.in[I_A0][(l * 2 + 1) * 384 + c];
#pragma unroll
                for (int j = 0; j < 4; ++j) { const int t = mt * 16 + fq * 4 + j; const size_t o = (size_t)(r0 + t) * 384 + c;
                    const float r = CONV3(t, 0, c, cr0, cr1, cr2), v = CONV3(t, 768, c, cv0, cv1, cv2), k = kc[nt][j], kkn = kr[nt][j] * invn[j];
                    const float af = sigmoidf_(a0f + acc[2][j]), ab = sigmoidf_(a0b + acc[3][j]);
                    const float kmf = k * (1.f + (af - 1.f) * kaw), kmb = k * (1.f + (ab - 1.f) * kaw);
                    Rg[o] = (bf16_t)f2bf(r); Vg[o] = (bf16_t)f2bf(v); KKg[o] = (bf16_t)f2bf(kkn);
                    BKF[o] = (bf16_t)f2bf(kkn * af); BKB[o] = (bf16_t)f2bf(kkn * ab); KMF[o] = (bf16_t)f2bf(kmf); KMB[o] = (bf16_t)f2bf(kmb);
                    LWF[o] = -0.6065306597f * sigmoidf_(w0f + acc[0][j]); LWB[o] = -0.6065306597f * sigmoidf_(w0b + acc[1][j]);
                    Gg[o] = (bf16_t)f2bf(acc[4][j]);
                    bon[j] += r * (kmf + kmb) * rkw; } }
#pragma unroll
            for (int j = 0; j < 4; ++j) { const float bs = red16(bon[j]); if (fr == 0) BON[(size_t)(r0 + mt * 16 + fq * 4 + j) * 8 + h] = bs; }
        }
#undef CONV3
    }
    __syncthreads();
}

__device__ __forceinline__ int chain_chunk(int b, int dir, int step) {
    if (step < 4) return 256 + b * 4 + (dir ? 3 - step : step);
    const int cl = step - 4; return b * 64 + (dir ? 63 - cl : cl);
}
__device__ __forceinline__ void g2_job(const Params& p, int job, int tid) {
    asm volatile("" : "+v"(tid));
    const int chain = job >> 2, q = job & 3, b = chain / 12, h = (chain % 12) >> 1, dir = chain & 1, e = q * 512 + tid, k = e >> 6;
    const float* __restrict__ KVC = SCRP(float, SC_KVC); const float* __restrict__ DC = SCRP(float, SC_DC); float* __restrict__ SC = SCRP(float, SC_SC);
    float S = 0.f;
#pragma unroll 1
    for (int s0 = 0; s0 < 68; s0 += 34) {
        float dv[34], kv[34];
#pragma unroll
        for (int u = 0; u < 34; ++u) { const size_t base = (size_t)((chain_chunk(b, dir, s0 + u) * 6 + h) * 2 + dir); dv[u] = DC[base * 32 + k]; kv[u] = KVC[base * 2048 + e]; }
#pragma unroll
        for (int u = 0; u < 34; ++u) { const size_t base = (size_t)((chain_chunk(b, dir, s0 + u) * 6 + h) * 2 + dir); SC[base * 2048 + e] = S; S = S * dv[u] + kv[u]; }
    }
}

__device__ __forceinline__ void scan_job(const Params& p, int chain, int half, LAS unsigned char* lds, int tid) {
    asm volatile("" : "+v"(tid));
    const int b = chain / 12, h = (chain % 12) >> 1, dir = chain & 1;
    const int rl = tid >> 4, kq = tid & 15, vrow = half * 32 + rl, k0 = kq * 4;
    LAS float* buf = (LAS float*)lds;
    const bf16_t* KKg = SCRP(bf16_t, SC_KK); const bf16_t* Rg = SCRP(bf16_t, SC_R); const bf16_t* Vg = SCRP(bf16_t, SC_V);
    const bf16_t* BKg = SCRP(bf16_t, dir ? SC_BKB : SC_BKF); const bf16_t* KMg = SCRP(bf16_t, dir ? SC_KMB : SC_KMF);
    const float* Wg = SCRP(float, dir ? SC_WB : SC_WF); float* Yg = SCRP(float, dir ? SC_YB : SC_YF);
    const int stl = tid >> 4, e4 = (tid & 15) * 4;
    auto blk_row0 = [&](int blk) -> int { const int s = blk * 32;
        if (s < 256) return NLAT + b * 256 + (dir ? 255 - s : s);
        const int t = s - 256; return b * 4096 + (dir ? 4095 - t : t); };
    const int sgn = dir ? -1 : 1;
    u32x2 l_kk, l_bk, l_km, l_r, l_v; f32x4 l_w;
    auto issue = [&](int blk) { const size_t o = (size_t)(blk_row0(blk) + sgn * stl) * 384 + h * 64 + e4;
        l_kk = *(const u32x2*)(KKg + o); l_bk = *(const u32x2*)(BKg + o); l_km = *(const u32x2*)(KMg + o); l_r = *(const u32x2*)(Rg + o); l_v = *(const u32x2*)(Vg + o); l_w = *(const f32x4*)(Wg + o); };
    auto commit = [&](int bi) { LAS float* d = buf + bi * (32 * 384) + stl * 384 + e4;
        *(LAS f32x4*)(d) = (f32x4){bflo(l_kk.x), bfhi(l_kk.x), bflo(l_kk.y), bfhi(l_kk.y)};
        *(LAS f32x4*)(d + 64) = l_w;
        *(LAS f32x4*)(d + 128) = (f32x4){bflo(l_bk.x), bfhi(l_bk.x), bflo(l_bk.y), bfhi(l_bk.y)};
        *(LAS f32x4*)(d + 192) = (f32x4){bflo(l_km.x), bfhi(l_km.x), bflo(l_km.y), bfhi(l_km.y)};
        *(LAS f32x4*)(d + 256) = (f32x4){bflo(l_r.x), bfhi(l_r.x), bflo(l_r.y), bfhi(l_r.y)};
        *(LAS f32x4*)(d + 320) = (f32x4){bflo(l_v.x), bfhi(l_v.x), bflo(l_v.y), bfhi(l_v.y)}; };
    issue(0); commit(0);
    __syncthreads();
    float S0 = 0.f, S1 = 0.f, S2 = 0.f, S3 = 0.f;
#pragma unroll 1
    for (int blk = 0; blk < 136; ++blk) {
        if (blk + 1 < 136) issue(blk + 1);
        const LAS float* cur = buf + (blk & 1) * (32 * 384);
        const int row0 = blk_row0(blk);
#pragma unroll 4
        for (int s = 0; s < 32; ++s) {
            const LAS float* q = cur + s * 384;
            const f32x4 kk = *(const LAS f32x4*)(q + k0), w = *(const LAS f32x4*)(q + 64 + k0), bk = *(const LAS f32x4*)(q + 128 + k0), km = *(const LAS f32x4*)(q + 192 + k0), rr = *(const LAS f32x4*)(q + 256 + k0);
            const float vv = q[320 + vrow];
            float d = (S0 * kk[0] + S1 * kk[1]) + (S2 * kk[2] + S3 * kk[3]);
            d = red16(d);
            const float sa = -d;
            S0 = S0 * w[0] + (sa * bk[0] + vv * km[0]); S1 = S1 * w[1] + (sa * bk[1] + vv * km[1]); S2 = S2 * w[2] + (sa * bk[2] + vv * km[2]); S3 = S3 * w[3] + (sa * bk[3] + vv * km[3]);
            float y = (S0 * rr[0] + S1 * rr[1]) + (S2 * rr[2] + S3 * rr[3]);
            y = red16(y);
            if (kq == 0) Yg[(size_t)(row0 + sgn * s) * 384 + h * 64 + vrow] = y;
        }
        if (blk + 1 < 136) commit((blk + 1) & 1);
        __syncthreads();
    }
}

__device__ __forceinline__ void attn_unit(const Params& p, int l, int b, int h, bool isctx, int qb, LAS unsigned char* lds, int tid) {
    asm volatile("" : "+v"(tid));
    const int w = tid >> 6, L = tid & 63, fr = L & 15, fq = L >> 4;
    const int qrow0 = (isctx ? NLAT + b * 256 : b * 4096) + qb * 128;
    const int nst = isctx ? 4 : 68;
    const unsigned char* rec = SCRP(unsigned char, SC_KVREC) + (size_t)(b * 4 + h) * NKT * 8192;
    const bf16_t* Z = WSP(bf16_t, WS_Z);
    u32x4 ld0 = *(const u32x4*)(rec + tid * 16), ld1 = *(const u32x4*)(rec + 8192 + tid * 16);
    float lam;
    { const float* q1 = p.in[I_LQ1] + l * 32; const float* k1 = p.in[I_LK1] + l * 32; const float* q2 = p.in[I_LQ2] + l * 32; const float* k2 = p.in[I_LK2] + l * 32;
      float s1 = 0.f, s2 = 0.f;
      for (int i = 0; i < 32; ++i) { s1 += q1[i] * k1[i]; s2 += q2[i] * k2[i]; }
      const float lam_init = l == 0 ? 0.2f : 0.35550907f;
      lam = __expf(s1) - __expf(s2) + lam_init; }
    asm volatile("" : "+v"(lam));
    const float one_m_li = l == 0 ? 0.8f : 0.64449093f;
    bf16x8 Qb[2]; f32x4 cinit[2];
    {
        const int row = qrow0 + w * 16 + fr, tpos = qb * 128 + w * 16 + fr;
        const unsigned* kmax = WSP(unsigned, WS_CTL) + CW_KMAX + l * 32 + (b * 4 + h) * 2;
#pragma unroll
        for (int m = 0; m < 2; ++m) {
            float ov[8], pv[8];
            unpack8(*(const u32x4*)(Z + (size_t)row * DINP + ZQ + h * 64 + m * 32 + fq * 8), ov);
            unpack8(*(const u32x4*)(Z + (size_t)row * DINP + ZQ + h * 64 + m * 32 + (fq ^ 1) * 8), pv);
            if (!isctx) {
                const int pos = (fq >> 1) ? (tpos & 63) : (tpos >> 6); const float sg = (fq & 1) ? 1.f : -1.f;
#pragma unroll
                for (int i = 0; i < 8; ++i) ov[i] = ov[i] * ROPE_COS[pos][i] + sg * pv[i] * ROPE_SIN[pos][i];
            }
#pragma unroll
            for (int i = 0; i < 8; ++i) ov[i] *= 0.2550348616f;
            u32x4 o; o.x = pk2(ov[0], ov[1]); o.y = pk2(ov[2], ov[3]); o.z = pk2(ov[4], ov[5]); o.w = pk2(ov[6], ov[7]);
            float rv[8]; unpack8(o, rv); float n2 = 0.f;
#pragma unroll
            for (int i = 0; i < 8; ++i) n2 += rv[i] * rv[i];
            n2 += __shfl_xor(n2, 16); n2 += __shfl_xor(n2, 32);
            const float km = __builtin_bit_cast(float, __hip_atomic_load(kmax + m, __ATOMIC_RELAXED, __HIP_MEMORY_SCOPE_AGENT));
            const float mq = sqrtf(n2) * sqrtf(km);
            Qb[m] = __builtin_bit_cast(bf16x8, o);
            cinit[m] = (f32x4){-mq, -mq, -mq, -mq};
        }
    }
    *(LAS u32x4*)(lds + tid * 16) = ld0; *(LAS u32x4*)(lds + 8192 + tid * 16) = ld1;
    __syncthreads();
    f32x4 O[2][4]; float ls[2] = {0.f, 0.f};
#pragma unroll
    for (int m = 0; m < 2; ++m)
#pragma unroll
        for (int et = 0; et < 4; ++et) O[m][et] = (f32x4){0.f, 0.f, 0.f, 0.f};
#pragma unroll 1
    for (int st = 0; st < nst; ++st) {
        if (st + 1 < nst) { ld0 = *(const u32x4*)(rec + (size_t)(st + 1) * 16384 + tid * 16); ld1 = *(const u32x4*)(rec + (size_t)(st + 1) * 16384 + 8192 + tid * 16); }
        const LAS unsigned char* cur = lds + (st & 1) * 16384;
#pragma unroll
        for (int hf = 0; hf < 2; ++hf) {
            const LAS unsigned char* rp = cur + hf * 8192 + L * 16;
            bf16x8 vb[4];
#pragma unroll
            for (int et = 0; et < 4; ++et) vb[et] = *(const LAS bf16x8*)(rp + (4 + et) * 1024);
#pragma unroll
            for (int m = 0; m < 2; ++m) {
                const bf16x8 ka0 = *(const LAS bf16x8*)(rp + (m * 2) * 1024), ka1 = *(const LAS bf16x8*)(rp + (m * 2 + 1) * 1024);
                const f32x4 s0 = __builtin_amdgcn_mfma_f32_16x16x32_bf16(ka0, Qb[m], cinit[m], 0, 0, 0);
                const f32x4 s1 = __builtin_amdgcn_mfma_f32_16x16x32_bf16(ka1, Qb[m], cinit[m], 0, 0, 0);
                float e[8];
#pragma unroll
                for (int i = 0; i < 4; ++i) { e[i] = __builtin_amdgcn_exp2f(s0[i]); e[4 + i] = __builtin_amdgcn_exp2f(s1[i]); }
                ls[m] += ((e[0] + e[1]) + (e[2] + e[3])) + ((e[4] + e[5]) + (e[6] + e[7]));
                u32x4 pk; pk.x = pg8::cvt_pk_bf16(e[0], e[1]); pk.y = pg8::cvt_pk_bf16(e[2], e[3]); pk.z = pg8::cvt_pk_bf16(e[4], e[5]); pk.w = pg8::cvt_pk_bf16(e[6], e[7]);
                const bf16x8 pa = __builtin_bit_cast(bf16x8, pk);
#pragma unroll
                for (int et = 0; et < 4; ++et) O[m][et] = __builtin_amdgcn_mfma_f32_16x16x32_bf16(pa, vb[et], O[m][et], 0, 0, 0);
            }
        }
        if (st + 1 < nst) { LAS unsigned char* nb = lds + ((st + 1) & 1) * 16384; *(LAS u32x4*)(nb + tid * 16) = ld0; *(LAS u32x4*)(nb + 8192 + tid * 16) = ld1; }
        __syncthreads();
    }
#pragma unroll
    for (int m = 0; m < 2; ++m) { ls[m] += __shfl_xor(ls[m], 16); ls[m] += __shfl_xor(ls[m], 32); }
    const float* sg = p.in[I_SUBLN] + l * 64; bf16_t* CAT = WSP(bf16_t, WS_CAT);
#pragma unroll
    for (int j = 0; j < 4; ++j) {
        const float l0 = __shfl(ls[0], fq * 4 + j), l1 = __shfl(ls[1], fq * 4 + j);
        const float i0 = 1.f / l0, i1 = lam / l1;
        float ov[4], ss = 0.f;
#pragma unroll
        for (int et = 0; et < 4; ++et) { ov[et] = O[0][et][j] * i0 - O[1][et][j] * i1; ss += ov[et] * ov[et]; }
#pragma unroll
        for (int x = 1; x < 16; x <<= 1) ss += __shfl_xor(ss, x);
        const float rs = rsqrtf(ss * (1.f / 64.f) + LN_EPS) * one_m_li;
        const size_t ro = (size_t)(qrow0 + w * 16 + fq * 4 + j) * D + h * 64;
#pragma unroll
        for (int et = 0; et < 4; ++et) CAT[ro + et * 16 + fr] = (bf16_t)f2bf(ov[et] * rs * sg[et * 16 + fr]);
    }
    __syncthreads();
}

constexpr int LS4 = 40;
__device__ __forceinline__ f32x4 mfma_k32(const LAS bf16_t* A, const LAS bf16_t* B, int mt, int nt, int fr, int fq, f32x4 acc) {
    const bf16x8 a = *(const LAS bf16x8*)(A + (mt * 16 + fr) * LS4 + fq * 8), b = *(const LAS bf16x8*)(B + (nt * 16 + fr) * LS4 + fq * 8);
    return __builtin_amdgcn_mfma_f32_16x16x32_bf16(a, b, acc, 0, 0, 0);
}
__device__ __forceinline__ void g3_job(const Params& p, int l, int cid, int h, LAS unsigned char* lds, int tid) {
    asm volatile("" : "+v"(tid));
    const int r0 = chunk_row0(cid), w = tid >> 6, lane = tid & 63, fr = lane & 15, fq = lane >> 4;
    const bf16_t* Z = WSP(bf16_t, WS_Z);
    LAS bf16_t* QF = (LAS bf16_t*)lds;
    LAS bf16_t* KF = QF + 64 * LS4;  LAS bf16_t* QB = KF + 64 * LS4;  LAS bf16_t* KB = QB + 64 * LS4;
    LAS bf16_t* SFt = KB + 64 * LS4; LAS bf16_t* SBt = SFt + 64 * LS4;
    LAS bf16_t* Vt = SBt + 64 * LS4;
    LAS bf16_t* AT = Vt + 64 * 72;
    LAS f32x4* xb = (LAS f32x4*)(AT + 64 * 72);
    const float* GBF = SCRP(float, SC_GBF); const float* GBB = SCRP(float, SC_GBB); const float* SC = SCRP(float, SC_SC);
    for (int i = tid; i < 2048; i += NTHR) { const int pp = i >> 5, k = i & 31; const size_t zr = (size_t)(r0 + pp) * DINP;
        const float q = bf2f(Z[zr + ZGQ + h * 32 + k]) * 0.17677669529f, kk = bf2f(Z[zr + ZGK + h * 32 + k]);
        const float bf = GBF[(size_t)(r0 + pp) * 192 + h * 32 + k], bb = GBB[(size_t)(r0 + pp) * 192 + h * 32 + k];
        QF[pp * LS4 + k] = (bf16_t)f2bf(q * __expf(bf)); KF[pp * LS4 + k] = (bf16_t)f2bf(kk * __expf(-bf)); QB[pp * LS4 + k] = (bf16_t)f2bf(q * __expf(bb)); KB[pp * LS4 + k] = (bf16_t)f2bf(kk * __expf(-bb)); }
    for (int i = tid; i < 4096; i += NTHR) { const int pp = i >> 6, v = i & 63; Vt[v * 72 + pp] = Z[(size_t)(r0 + pp) * DINP + ZGV + h * 64 + v]; }
    for (int i = tid; i < 2048; i += NTHR) { const int k = i >> 6, v = i & 63;
        SFt[v * LS4 + k] = (bf16_t)f2bf(SC[((size_t)((cid * 6 + h) * 2 + 0)) * 2048 + i]); SBt[v * LS4 + k] = (bf16_t)f2bf(SC[((size_t)((cid * 6 + h) * 2 + 1)) * 2048 + i]); }
    __syncthreads();
#pragma unroll
    for (int q = 0; q < 2; ++q) { const int idx = w * 2 + q, mt = idx >> 2, nt = idx & 3;
        f32x4 af = {0.f, 0.f, 0.f, 0.f}, ab = {0.f, 0.f, 0.f, 0.f};
        if (nt <= mt) af = mfma_k32(QF, KF, mt, nt, fr, fq, af);
        if (nt >= mt) ab = mfma_k32(QB, KB, mt, nt, fr, fq, ab);
#pragma unroll
        for (int j = 0; j < 4; ++j) { const int tt = mt * 16 + fq * 4 + j, ss = nt * 16 + fr;
            AT[tt * 72 + ss] = (bf16_t)f2bf((ss <= tt ? af[j] : 0.f) + (ss >= tt ? ab[j] : 0.f)); } }
    __syncthreads();
    const int mt = w & 3;
    f32x4 acc[4];
#pragma unroll
    for (int nt = 0; nt < 4; ++nt) { acc[nt] = (f32x4){0.f, 0.f, 0.f, 0.f};
        if (w < 4) {
#pragma unroll
            for (int ks = 0; ks < 2; ++ks) { const bf16x8 a = *(const LAS bf16x8*)(AT + (mt * 16 + fr) * 72 + ks * 32 + fq * 8), b = *(const LAS bf16x8*)(Vt + (nt * 16 + fr) * 72 + ks * 32 + fq * 8);
                acc[nt] = __builtin_amdgcn_mfma_f32_16x16x32_bf16(a, b, acc[nt], 0, 0, 0); } }
        else { acc[nt] = mfma_k32(QF, SFt, mt, nt, fr, fq, acc[nt]); acc[nt] = mfma_k32(QB, SBt, mt, nt, fr, fq, acc[nt]); xb[(mt * 4 + nt) * 64 + lane] = acc[nt]; } }
    __syncthreads();
    if (w < 4) {
        bf16_t* CAT = WSP(bf16_t, WS_CAT);
#pragma unroll
        for (int nt = 0; nt < 4; ++nt) acc[nt] += xb[(mt * 4 + nt) * 64 + lane];
#pragma unroll
        for (int j = 0; j < 4; ++j) { const int row = r0 + mt * 16 + fq * 4 + j;
            float ss = (acc[0][j] * acc[0][j] + acc[1][j] * acc[1][j]) + (acc[2][j] * acc[2][j] + acc[3][j] * acc[3][j]); ss = red16(ss);
            const float rs = rsqrtf(ss * (1.f / 64.f) + LN_EPS);
#pragma unroll
            for (int nt = 0; nt < 4; ++nt) { const int v = nt * 16 + fr; const float gr = bf2f(Z[(size_t)row * DINP + ZGR + h * 64 + v]);
                CAT[(size_t)row * D + 256 + h * 64 + v] = (bf16_t)f2bf(acc[nt][j] * rs * p.in[I_GNG][l * 64 + v] * siluf_(gr)); } }
    }
    __syncthreads();
}

__device__ __forceinline__ void rw_post(const Params& p, int l, int nrows, int gw, int ngw, int lane) {
    const float* YF = SCRP(float, SC_YF); const float* YB = SCRP(float, SC_YB); const float* BON = SCRP(float, SC_BON);
    const bf16_t* Vg = SCRP(bf16_t, SC_V); const bf16_t* Gg = SCRP(bf16_t, SC_G); bf16_t* CAT = WSP(bf16_t, WS_CAT);
    for (int it = gw; it < nrows * 6; it += ngw) { const int row = it / 6, h = it % 6, c = h * 64 + lane; const size_t o = (size_t)row * 384 + c;
        const float y = YF[o] + YB[o];
        const float mu = wave_sum(y) * (1.f / 64.f); const float dv = y - mu; const float var = wave_sum(dv * dv) * (1.f / 64.f);
        const float yn = dv * rsqrtf(var + RW_GN_EPS) * p.in[I_LNXG][l * 384 + c] + p.in[I_LNXB][l * 384 + c];
        const float outv = (yn + BON[(size_t)row * 8 + h] * bf2f(Vg[o])) * bf2f(Gg[o]);
        CAT[(size_t)row * D + 640 + c] = (bf16_t)f2bf(outv); }
}

__device__ __forceinline__ void ln1_router(const Params& p, int l, int nrows, LAS unsigned char* lds, int tid, int gw, int ngw, int lane, int bx, bool dry = false) {
    LAS float* rwt = (LAS float*)lds;
    const float* rw = p.in[I_RW] + (size_t)l * 1024 * 32;
    for (int i = tid; i < 32768; i += NTHR) rwt[(i >> 5) * 33 + (i & 31)] = rw[i];
    LAS unsigned* lcnt = (LAS unsigned*)(lds + 135168);
    if (tid < 32) lcnt[tid] = 0u;
    __syncthreads();
    float* H = WSP(float, WS_H); bf16_t* XM = WSP(bf16_t, WS_XM); const bf16_t* MIX = WSP(bf16_t, WS_Z); const float* MOD = WSP(float, WS_MOD);
    int* TOPE = WSP(int, WS_TOP); float* TOPG = WSP(float, WS_TOP + TOP_STRIDE); int* TOPR = WSP(int, WS_TOP + 2 * TOP_STRIDE);
    const float* g1p = p.in[I_LN1G] + l * 1024; const float* b1p = p.in[I_LN1B] + l * 1024; const float* rb = p.in[I_RB] + l * 32;
    float alpha = DN_ALPHA; asm volatile("" : "+v"(alpha));
    for (int row = gw; row < nrows; row += ngw) {
        const int sidx = row < NLAT ? (row >> 12) : 4; const float* mod = MOD + (size_t)(l * 5 + sidx) * 6144;
        float y[16]; float s = 0.f;
#pragma unroll
        for (int i = 0; i < 16; ++i) { const int c = lane + 64 * i; y[i] = alpha * H[(size_t)row * D + c] + mod[2048 + c] * bf2f(MIX[(size_t)row * D + c]); s += y[i]; }
        const float mean = wave_sum(s) * (1.f / D); float s2 = 0.f;
#pragma unroll
        for (int i = 0; i < 16; ++i) { y[i] -= mean; s2 += y[i] * y[i]; }
        const float rstd = rsqrtf(wave_sum(s2) * (1.f / D) + LN_EPS);
#pragma unroll
        for (int i = 0; i < 16; ++i) { const int c = lane + 64 * i; const float hn = y[i] * rstd * g1p[c] + b1p[c];
            const float m = hn * (1.f + mod[4096 + c]) + mod[3072 + c];
            if (!dry || m == 123456.789f) { H[(size_t)row * D + c] = hn; XM[(size_t)row * D + c] = (bf16_t)f2bf(m); } y[i] = m; }
        float lg[32];
#pragma unroll
        for (int e = 0; e < 32; ++e) { float a = 0.f;
#pragma unroll
            for (int i = 0; i < 16; ++i) a += y[i] * rwt[(lane + 64 * i) * 33 + e];
            lg[e] = wave_sum(a) + rb[e]; }
        float tv[4]; int ti[4];
#pragma unroll
        for (int k = 0; k < 4; ++k) { float best = -3.0e38f; int bi = 0;
#pragma unroll
            for (int e = 0; e < 32; ++e) { if (lg[e] > best) { best = lg[e]; bi = e; } }
            tv[k] = best; ti[k] = bi;
#pragma unroll
            for (int e = 0; e < 32; ++e) lg[e] = (e == bi) ? -3.0e38f : lg[e]; }
        if (lane == 0 && (!dry || tv[0] == 123456.789f)) {
            const float e1 = __expf(tv[1] - tv[0]), e2 = __expf(tv[2] - tv[0]), e3 = __expf(tv[3] - tv[0]); const float inv = 1.f / (1.f + e1 + e2 + e3);
            const float gg[4] = {inv, e1 * inv, e2 * inv, e3 * inv};
#pragma unroll
            for (int k = 0; k < 4; ++k) { TOPE[row * 4 + k] = ti[k]; TOPG[row * 4 + k] = gg[k]; TOPR[row * 4 + k] = (int)atomicAdd((unsigned*)(lcnt + ti[k]), 1u); }
        }
    }
    __syncthreads();
    if (tid < 32 && !dry) WSP(unsigned, WS_CNTWG)[(size_t)(l * 256 + bx) * 32 + tid] = lcnt[tid];
}

__device__ __forceinline__ int moe_tables(const Params& p, int l, LAS int* tab, LAS int* basew, int G, int tid) {
    const unsigned* cw = WSP(unsigned, WS_CNTWG) + (size_t)l * 256 * 32;
    for (int i = tid; i < G * 32; i += NTHR) basew[i] = (int)cw[i];
    __syncthreads();
    if (tid < 32) { int run = 0; for (int wg = 0; wg < G; ++wg) { const int c = basew[wg * 32 + tid]; basew[wg * 32 + tid] = run; run += c; } tab[32 + tid] = run; }
    __syncthreads();
    if (tid == 0) { int run = 0;
        for (int e = 0; e < 32; ++e) { const int c = tab[32 + e]; tab[e] = run * 256; run += (c + 255) >> 8; tab[64 + e] = run; }
        tab[96] = run; }
    __syncthreads();
    for (int blk = tid; blk < CAP_BLK; blk += NTHR) { int e = 0;
        for (int j = 0; j < 31; ++j) e += (blk >= tab[64 + j]) ? 1 : 0;
        tab[128 + blk] = e; }
    __syncthreads();
    return tab[96];
}

__device__ __forceinline__ void moe_gather(const Params& p, int l, int nrows, LAS int* tab, const LAS int* basew, int gw, int ngw, int lane) {
    const int* TOPE = WSP(int, WS_TOP); const int* TOPR = WSP(int, WS_TOP + 2 * TOP_STRIDE); int* TOPS = WSP(int, WS_TOP + 3 * TOP_STRIDE);
    const bf16_t* XM = WSP(bf16_t, WS_XM); bf16_t* XB = SCRP(bf16_t, SC_XB);
    for (int it = gw; it < nrows * 4; it += ngw) { const int tok = it >> 2, e = TOPE[it], slot = tab[e] + basew[((tok % ngw) >> 3) * 32 + e] + TOPR[it];
        if (lane == 0) TOPS[it] = slot;
        const u32x4* s = (const u32x4*)(XM + (size_t)tok * D); u32x4* d = (u32x4*)(XB + (size_t)slot * D);
        d[lane] = s[lane]; d[64 + lane] = s[64 + lane]; }
    for (int it = gw; it < 32 * 256; it += ngw) { const int e = it >> 8, i = it & 255, c = tab[32 + e], row = tab[e] + c + i, pend = tab[e] + (((c + 255) >> 8) << 8);
        if (row < pend) { u32x4* d = (u32x4*)(XB + (size_t)row * D); d[lane] = (u32x4){0u, 0u, 0u, 0u}; d[64 + lane] = (u32x4){0u, 0u, 0u, 0u}; } }
}

__device__ __forceinline__ void ln2_rows(const Params& p, int l, int nrows, int gw, int ngw, int lane, bool dry = false) {
    float* H = WSP(float, WS_H); bf16_t* XM = WSP(bf16_t, WS_XM); const bf16_t* YB = SCRP(bf16_t, SC_XB); const float* MOD = WSP(float, WS_MOD);
    const float* TOPG = WSP(float, WS_TOP + TOP_STRIDE); const int* TOPS = WSP(int, WS_TOP + 3 * TOP_STRIDE);
    const float* g2p = p.in[I_LN2G] + l * 1024; const float* b2p = p.in[I_LN2B] + l * 1024;
    float alpha = DN_ALPHA; asm volatile("" : "+v"(alpha));
    for (int row = gw; row < nrows; row += ngw) {
        const int sidx = row < NLAT ? (row >> 12) : 4; const float* mod = MOD + (size_t)(l * 5 + sidx) * 6144;
        f32x4 f[4];
#pragma unroll
        for (int j = 0; j < 4; ++j) f[j] = (f32x4){0.f, 0.f, 0.f, 0.f};
#pragma unroll
        for (int k = 0; k < 4; ++k) { const float g = TOPG[row * 4 + k]; const bf16_t* yr = YB + (size_t)TOPS[row * 4 + k] * D;
#pragma unroll
            for (int j = 0; j < 4; ++j) { const u32x2 u = *(const u32x2*)(yr + lane * 4 + 256 * j); f[j] += (f32x4){bflo(u.x), bfhi(u.x), bflo(u.y), bfhi(u.y)} * g; } }
        f32x4 y[4]; float s = 0.f;
#pragma unroll
        for (int j = 0; j < 4; ++j) { const int c = lane * 4 + 256 * j; y[j] = *(const f32x4*)(H + (size_t)row * D + c) * alpha + *(const f32x4*)(mod + 5120 + c) * f[j]; s += (y[j][0] + y[j][1]) + (y[j][2] + y[j][3]); }
        const float mean = wave_sum(s) * (1.f / D); float s2 = 0.f;
#pragma unroll
        for (int j = 0; j < 4; ++j) { y[j] = y[j] - mean; s2 += (y[j][0] * y[j][0] + y[j][1] * y[j][1]) + (y[j][2] * y[j][2] + y[j][3] * y[j][3]); }
        const float rstd = rsqrtf(wave_sum(s2) * (1.f / D) + LN_EPS);
#pragma unroll
        for (int j = 0; j < 4; ++j) { const int c = lane * 4 + 256 * j;
            const f32x4 hn = y[j] * rstd * *(const f32x4*)(g2p + c) + *(const f32x4*)(b2p + c);
            if (dry && hn[0] != 123456.789f) continue;
            if (l == 0) { *(f32x4*)(H + (size_t)row * D + c) = hn;
                const float* mod1 = MOD + (size_t)(5 + sidx) * 6144;
                const f32x4 xm = hn * (*(const f32x4*)(mod1 + 1024 + c) + 1.f) + *(const f32x4*)(mod1 + c);
                u32x2 o; o.x = pk2(xm[0], xm[1]); o.y = pk2(xm[2], xm[3]); *(u32x2*)(XM + (size_t)row * D + c) = o; }
            else *(f32x4*)(p.out + (size_t)row * D + c) = hn; }
    }
}

constexpr int LSB = 72;
constexpr size_t RW_REC = 8192;
__device__ __forceinline__ int kperm_lo(int ks, int fq) { return (2 * ks) * 16 + fq * 4; }
__device__ __forceinline__ f32x4 tile_nt(const LAS bf16_t* A, const LAS bf16_t* B, int mt, int nt, int fr, int fq, f32x4 acc) {
#pragma unroll
    for (int ks = 0; ks < 2; ++ks) {
        const bf16x8 a = *(const LAS bf16x8*)(A + (mt * 16 + fr) * LSB + ks * 32 + fq * 8);
        const bf16x8 b = *(const LAS bf16x8*)(B + (nt * 16 + fr) * LSB + ks * 32 + fq * 8);
        acc = __builtin_amdgcn_mfma_f32_16x16x32_bf16(a, b, acc, 0, 0, 0);
    }
    return acc;
}
__device__ __forceinline__ size_t rwa_goff(int unit, int tid) {
    const int cid = unit / 12, h = (unit % 12) >> 1, dir = unit & 1, t = tid >> 3, k8 = (tid & 7) * 8;
    return (size_t)(chunk_row0(cid) + (dir ? 63 - t : t)) * 384 + h * 64 + k8;
}
__device__ __forceinline__ void rwa_job(const Params& p, int unit, int next_unit, bool first, LAS unsigned char* lds, int tid) {
    asm volatile("" : "+v"(tid));
    const int cid = unit / 12, h = (unit % 12) >> 1, dir = unit & 1;
    const int w = tid >> 6, lane = tid & 63, fr = lane & 15, fq = lane >> 4;
    LAS bf16_t* At = (LAS bf16_t*)lds;            LAS bf16_t* Bt = At + 64 * LSB;   LAS bf16_t* Kt = Bt + 64 * LSB;  LAS bf16_t* Rt = Kt + 64 * LSB;
    LAS bf16_t* BHt = Rt + 64 * LSB;              LAS bf16_t* KHt = BHt + 64 * LSB; LAS bf16_t* Vt = KHt + 64 * LSB;
    LAS float* F0 = (LAS float*)(lds + 64512);
    LAS float* PF = (LAS float*)(lds + 81152);
    LAS bf16_t* AAK = (LAS bf16_t*)(lds + 97536);
    LAS bf16_t* ARB = AAK + 64 * LSB;  LAS bf16_t* ARK = ARB + 64 * LSB;
    LAS bf16_t* TAT = ARK + 64 * LSB;  LAS bf16_t* TPT = TAT + 64 * LSB;
    LAS float* gC = (LAS float*)(lds + 143616);
    LAS float* TD = (LAS float*)(lds + 143872);
    LAS bf16_t* ABH = (LAS bf16_t*)(lds + 147968);
    const int t = tid >> 3, k8 = (tid & 7) * 8;
    const size_t go = rwa_goff(unit, tid);
    if (first) { const float* Wg = SCRP(float, dir ? SC_WB : SC_WF); const f32x4 a = *(const f32x4*)(Wg + go), b = *(const f32x4*)(Wg + go + 4);
        F0[(k8 + 0) * 65 + t] = a[0]; F0[(k8 + 1) * 65 + t] = a[1]; F0[(k8 + 2) * 65 + t] = a[2]; F0[(k8 + 3) * 65 + t] = a[3];
        F0[(k8 + 4) * 65 + t] = b[0]; F0[(k8 + 5) * 65 + t] = b[1]; F0[(k8 + 6) * 65 + t] = b[2]; F0[(k8 + 7) * 65 + t] = b[3]; }
    const u32x4 in_kk = *(const u32x4*)(SCRP(bf16_t, SC_KK) + go), in_bk = *(const u32x4*)(SCRP(bf16_t, dir ? SC_BKB : SC_BKF) + go), in_km = *(const u32x4*)(SCRP(bf16_t, dir ? SC_KMB : SC_KMF) + go);
    const u32x4 in_rr = *(const u32x4*)(SCRP(bf16_t, SC_R) + go), in_vv = *(const u32x4*)(SCRP(bf16_t, SC_V) + go);
    __syncthreads();
#pragma unroll 1
    for (int c = 0; c < 8; ++c) { const int k = w * 8 + c; float x = F0[k * 65 + lane];
#pragma unroll
        for (int o = 1; o < 64; o <<= 1) { const float y = __shfl_up(x, o); if (lane >= o) x += y; }
        F0[k * 65 + lane] = x; }
    __syncthreads();
    {
        float kk[8], bk[8], km[8], rr[8];
        unpack8(in_kk, kk); unpack8(in_bk, bk); unpack8(in_km, km); unpack8(in_rr, rr);
        const u32x4 vraw = in_vv;
        float a_[8], b_[8], k_[8], r_[8];
#pragma unroll
        for (int i = 0; i < 8; ++i) { const float L = F0[(k8 + i) * 65 + t], LC = F0[(k8 + i) * 65 + 63], Lm1 = t > 0 ? F0[(k8 + i) * 65 + t - 1] : 0.f;
            const float eL = __expf(L), eN = __expf(-L), eM = __expf(Lm1), eH = __expf(LC - L);
            a_[i] = -kk[i] * eM; b_[i] = bk[i] * eN; k_[i] = km[i] * eN; r_[i] = rr[i] * eL;
            BHt[(k8 + i) * LSB + t] = (bf16_t)f2bf(bk[i] * eH); KHt[(k8 + i) * LSB + t] = (bf16_t)f2bf(km[i] * eH);
            if (t == 63) gC[k8 + i] = __expf(LC); }
        { u32x4 o; o.x = pk2(a_[0], a_[1]); o.y = pk2(a_[2], a_[3]); o.z = pk2(a_[4], a_[5]); o.w = pk2(a_[6], a_[7]); *(LAS u32x4*)(At + t * LSB + k8) = o; }
        { u32x4 o; o.x = pk2(b_[0], b_[1]); o.y = pk2(b_[2], b_[3]); o.z = pk2(b_[4], b_[5]); o.w = pk2(b_[6], b_[7]); *(LAS u32x4*)(Bt + t * LSB + k8) = o; }
        { u32x4 o; o.x = pk2(k_[0], k_[1]); o.y = pk2(k_[2], k_[3]); o.z = pk2(k_[4], k_[5]); o.w = pk2(k_[6], k_[7]); *(LAS u32x4*)(Kt + t * LSB + k8) = o; }
        { u32x4 o; o.x = pk2(r_[0], r_[1]); o.y = pk2(r_[2], r_[3]); o.z = pk2(r_[4], r_[5]); o.w = pk2(r_[6], r_[7]); *(LAS u32x4*)(Rt + t * LSB + k8) = o; }
        Vt[(k8 + 0) * LSB + t] = (bf16_t)(vraw.x & 0xffffu); Vt[(k8 + 1) * LSB + t] = (bf16_t)(vraw.x >> 16); Vt[(k8 + 2) * LSB + t] = (bf16_t)(vraw.y & 0xffffu); Vt[(k8 + 3) * LSB + t] = (bf16_t)(vraw.y >> 16);
        Vt[(k8 + 4) * LSB + t] = (bf16_t)(vraw.z & 0xffffu); Vt[(k8 + 5) * LSB + t] = (bf16_t)(vraw.z >> 16); Vt[(k8 + 6) * LSB + t] = (bf16_t)(vraw.w & 0xffffu); Vt[(k8 + 7) * LSB + t] = (bf16_t)(vraw.w >> 16);
    }
    __syncthreads();
#pragma unroll 1
    for (int idx = w; idx < 64; idx += 8) { const int pr = idx >> 4, mt = (idx >> 2) & 3, nt = idx & 3;
        f32x4 acc = {0.f, 0.f, 0.f, 0.f};
        if (nt <= mt) acc = tile_nt(pr < 2 ? At : Rt, (pr & 1) ? Kt : Bt, mt, nt, fr, fq, acc);
#pragma unroll
        for (int j = 0; j < 4; ++j) { const int tt = mt * 16 + fq * 4 + j, ss = nt * 16 + fr; const bool keep = pr < 2 ? (ss < tt) : (ss <= tt); const float v = keep ? acc[j] : 0.f;
            if (pr == 0) { F0[tt * 64 + ss] = v; ABH[tt * LSB + ss] = (bf16_t)f2bf(v); } else (pr == 1 ? AAK : (pr == 2 ? ARB : ARK))[tt * LSB + ss] = (bf16_t)f2bf(v); } }
    __syncthreads();
#pragma unroll
    for (int q = 0; q < 2; ++q) { const int idx = w * 2 + q, mt = idx >> 2, nt = idx & 3; f32x4 acc = {0.f, 0.f, 0.f, 0.f};
        acc = tile_nt(AAK, Vt, mt, nt, fr, fq, acc);
#pragma unroll
        for (int j = 0; j < 4; ++j) PF[(mt * 16 + fq * 4 + j) * 64 + nt * 16 + fr] = acc[j]; }
    __syncthreads();
    if (w < 4 && lane < 16) {
        float x[16];
#pragma unroll
        for (int tt = 0; tt < 16; ++tt) { float a0 = (tt == lane) ? 1.f : 0.f;
#pragma unroll
            for (int s2 = 0; s2 < tt; ++s2) a0 += F0[(w * 16 + tt) * 64 + w * 16 + s2] * x[s2];
            x[tt] = a0; TD[(w * 16 + tt) * 16 + lane] = a0; }
    }
    __syncthreads();
    {
        f32x4 X0[4], X[4];
#pragma unroll
        for (int bb = 0; bb < 4; ++bb)
#pragma unroll
            for (int j = 0; j < 4; ++j) { const int tt = bb * 16 + fq * 4 + j; X0[bb][j] = (w < 4) ? bf2f(At[tt * LSB + w * 16 + fr]) : PF[tt * 64 + (w - 4) * 16 + fr]; }
        bf16x8 Tf[4];
#pragma unroll
        for (int bb = 0; bb < 4; ++bb) { const f32x4 tv = *(const LAS f32x4*)(TD + (bb * 16 + fr) * 16 + fq * 4); u32x4 o; o.x = pk2(tv[0], tv[1]); o.y = pk2(tv[2], tv[3]); o.z = 0u; o.w = 0u; Tf[bb] = __builtin_bit_cast(bf16x8, o); }
        const f32x4 zero4 = {0.f, 0.f, 0.f, 0.f};
#pragma unroll
        for (int bb = 0; bb < 4; ++bb) {
            f32x4 rhs = X0[bb];
            if (bb >= 1) {
                const u32x2 a = *(const LAS u32x2*)(ABH + (bb * 16 + fr) * LSB + fq * 4); u32x2 a2 = {0u, 0u};
                if (bb >= 2) a2 = *(const LAS u32x2*)(ABH + (bb * 16 + fr) * LSB + 16 + fq * 4);
                u32x4 af; af.x = a.x; af.y = a.y; af.z = a2.x; af.w = a2.y;
                u32x4 bf; bf.x = pk2(X[0][0], X[0][1]); bf.y = pk2(X[0][2], X[0][3]);
                if (bb >= 2) { bf.z = pk2(X[1][0], X[1][1]); bf.w = pk2(X[1][2], X[1][3]); } else { bf.z = 0u; bf.w = 0u; }
                rhs = __builtin_amdgcn_mfma_f32_16x16x32_bf16(__builtin_bit_cast(bf16x8, af), __builtin_bit_cast(bf16x8, bf), rhs, 0, 0, 0);
            }
            if (bb == 3) {
                const u32x2 a = *(const LAS u32x2*)(ABH + (48 + fr) * LSB + 32 + fq * 4);
                u32x4 af; af.x = a.x; af.y = a.y; af.z = 0u; af.w = 0u;
                u32x4 bf; bf.x = pk2(X[2][0], X[2][1]); bf.y = pk2(X[2][2], X[2][3]); bf.z = 0u; bf.w = 0u;
                rhs = __builtin_amdgcn_mfma_f32_16x16x32_bf16(__builtin_bit_cast(bf16x8, af), __builtin_bit_cast(bf16x8, bf), rhs, 0, 0, 0);
            }
            u32x4 rb; rb.x = pk2(rhs[0], rhs[1]); rb.y = pk2(rhs[2], rhs[3]); rb.z = 0u; rb.w = 0u;
            X[bb] = __builtin_amdgcn_mfma_f32_16x16x32_bf16(Tf[bb], __builtin_bit_cast(bf16x8, rb), zero4, 0, 0, 0);
            LAS bf16_t* dst = ((w < 4) ? TAT : TPT) + ((w & 3) * 16 + fr) * LSB + bb * 16 + fq * 4;
            u32x2 o; o.x = pk2(X[bb][0], X[bb][1]); o.y = pk2(X[bb][2], X[bb][3]); *(LAS u32x2*)dst = o;
        }
    }
    __syncthreads();
    f32x4 nw0 = {0.f, 0.f, 0.f, 0.f}, nw1 = {0.f, 0.f, 0.f, 0.f};
    if (next_unit >= 0) { const float* Wn = SCRP(float, (next_unit & 1) ? SC_WB : SC_WF) + rwa_goff(next_unit, tid); nw0 = *(const f32x4*)Wn; nw1 = *(const f32x4*)(Wn + 4); }
    const size_t u = (size_t)((cid * 6 + h) * 2 + dir);
    LAS bf16_t* SQ = AAK; LAS bf16_t* SM = (LAS bf16_t*)PF; LAS float* SY = F0;
    unsigned char* GREC = p.ws + WS_GREC + u * RW_REC;
#pragma unroll 1
    for (int idx = w; idx < 64; idx += 8) { const int pr = idx >> 4, mt = (idx >> 2) & 3, nt = idx & 3; f32x4 acc = {0.f, 0.f, 0.f, 0.f};
        if (pr == 0) { acc = tile_nt(ARB, TAT, mt, nt, fr, fq, acc);
#pragma unroll
            for (int j = 0; j < 4; ++j) { const int tt = mt * 16 + fq * 4 + j, kk_ = nt * 16 + fr; SQ[tt * LSB + kk_] = (bf16_t)f2bf(acc[j] + bf2f(Rt[tt * LSB + kk_])); } }
        else if (pr == 1) { acc = tile_nt(ARB, TPT, mt, nt, fr, fq, acc); acc = tile_nt(ARK, Vt, mt, nt, fr, fq, acc);
#pragma unroll
            for (int j = 0; j < 4; ++j) SY[(mt * 16 + fq * 4 + j) * 64 + nt * 16 + fr] = acc[j]; }
        else if (pr == 2) { acc = tile_nt(BHt, TAT, mt, nt, fr, fq, acc);
#pragma unroll
            for (int j = 0; j < 4; ++j) { const int k1 = mt * 16 + fq * 4 + j, k2 = nt * 16 + fr; SM[k1 * LSB + k2] = (bf16_t)f2bf(acc[j] + (k1 == k2 ? gC[k1] : 0.f)); } }
        else { acc = tile_nt(BHt, TPT, mt, nt, fr, fq, acc); acc = tile_nt(KHt, Vt, mt, nt, fr, fq, acc);
            u32x2 o; o.x = pk2(acc[0], acc[1]); o.y = pk2(acc[2], acc[3]); *(u32x2*)(GREC + ((mt * 4 + nt) * 64 + lane) * 8) = o; } }
    __syncthreads();
    {
        const int mt = w >> 1, ks = w & 1, row = mt * 16 + fr, rq = dir ? 63 - row : row;
        u32x4 o; { const u32x2 a = *(const LAS u32x2*)(SQ + rq * LSB + kperm_lo(ks, fq)), b = *(const LAS u32x2*)(SQ + rq * LSB + kperm_lo(ks, fq) + 16); o.x = a.x; o.y = a.y; o.z = b.x; o.w = b.y; }
        *(u32x4*)(SCRP(unsigned char, SC_YF) + u * RW_REC + (size_t)(w * 64 + lane) * 16) = o;
        { const u32x2 a = *(const LAS u32x2*)(SM + row * LSB + kperm_lo(ks, fq)), b = *(const LAS u32x2*)(SM + row * LSB + kperm_lo(ks, fq) + 16); o.x = a.x; o.y = a.y; o.z = b.x; o.w = b.y; }
        *(u32x4*)(p.ws + WS_MREC + u * RW_REC + (size_t)(w * 64 + lane) * 16) = o;
#pragma unroll
        for (int q = 0; q < 2; ++q) { const int tl = w * 2 + q, mt2 = tl >> 2, nt2 = tl & 3; float yv[4];
#pragma unroll
            for (int j = 0; j < 4; ++j) { const int to = mt2 * 16 + fq * 4 + j; yv[j] = SY[(dir ? 63 - to : to) * 64 + nt2 * 16 + fr]; }
            u32x2 oy; oy.x = pk2(yv[0], yv[1]); oy.y = pk2(yv[2], yv[3]);
            *(u32x2*)(SCRP(unsigned char, SC_YB) + u * RW_REC + (size_t)(tl * 64 + lane) * 8) = oy; }
    }
    __syncthreads();
    if (next_unit >= 0) {
        F0[(k8 + 0) * 65 + t] = nw0[0]; F0[(k8 + 1) * 65 + t] = nw0[1]; F0[(k8 + 2) * 65 + t] = nw0[2]; F0[(k8 + 3) * 65 + t] = nw0[3];
        F0[(k8 + 4) * 65 + t] = nw1[0]; F0[(k8 + 5) * 65 + t] = nw1[1]; F0[(k8 + 6) * 65 + t] = nw1[2]; F0[(k8 + 7) * 65 + t] = nw1[3]; }
}

__device__ __forceinline__ void rwb_job(const Params& p, int chain, int tid) {
    asm volatile("" : "+v"(tid));
    const int b = chain / 12, h = (chain % 12) >> 1, dir = chain & 1, nt = tid >> 6, lane = tid & 63;
    if (nt >= 4) return;
    f32x4 H[4];
#pragma unroll
    for (int mt = 0; mt < 4; ++mt) H[mt] = (f32x4){0.f, 0.f, 0.f, 0.f};
    bf16x8 Mf[4][2]; u32x2 Gf[4];
    auto load = [&](int step) { const size_t u = (size_t)((chain_chunk(b, dir, step) * 6 + h) * 2 + dir);
        const unsigned char* mr = p.ws + WS_MREC + u * RW_REC; const unsigned char* gr = p.ws + WS_GREC + u * RW_REC;
#pragma unroll
        for (int mt = 0; mt < 4; ++mt) { Mf[mt][0] = *(const bf16x8*)(mr + (size_t)((mt * 2) * 64 + lane) * 16); Mf[mt][1] = *(const bf16x8*)(mr + (size_t)((mt * 2 + 1) * 64 + lane) * 16);
            Gf[mt] = *(const u32x2*)(gr + (size_t)((mt * 4 + nt) * 64 + lane) * 8); } };
    load(0);
#pragma unroll 1
    for (int step = 0; step < 68; ++step) {
        const size_t u = (size_t)((chain_chunk(b, dir, step) * 6 + h) * 2 + dir);
        bf16x8 Bh[2], Bl[2];
#pragma unroll
        for (int ks = 0; ks < 2; ++ks) { const f32x4 x0 = H[2 * ks], x1 = H[2 * ks + 1];
            u32x4 hi; hi.x = pk2(x0[0], x0[1]); hi.y = pk2(x0[2], x0[3]); hi.z = pk2(x1[0], x1[1]); hi.w = pk2(x1[2], x1[3]);
            u32x4 lo; lo.x = pk2(x0[0] - bflo(hi.x), x0[1] - bfhi(hi.x)); lo.y = pk2(x0[2] - bflo(hi.y), x0[3] - bfhi(hi.y)); lo.z = pk2(x1[0] - bflo(hi.z), x1[1] - bfhi(hi.z)); lo.w = pk2(x1[2] - bflo(hi.w), x1[3] - bfhi(hi.w));
            Bh[ks] = __builtin_bit_cast(bf16x8, hi); Bl[ks] = __builtin_bit_cast(bf16x8, lo);
            *(u32x4*)(p.ws + WS_XM + u * RW_REC + (size_t)((ks * 4 + nt) * 64 + lane) * 16) = hi; }
        f32x4 acc[4];
#pragma unroll
        for (int mt = 0; mt < 4; ++mt) { acc[mt] = (f32x4){bflo(Gf[mt].x), bfhi(Gf[mt].x), bflo(Gf[mt].y), bfhi(Gf[mt].y)};
#pragma unroll
            for (int ks = 0; ks < 2; ++ks) { acc[mt] = __builtin_amdgcn_mfma_f32_16x16x32_bf16(Mf[mt][ks], Bh[ks], acc[mt], 0, 0, 0); acc[mt] = __builtin_amdgcn_mfma_f32_16x16x32_bf16(Mf[mt][ks], Bl[ks], acc[mt], 0, 0, 0); } }
        if (step + 1 < 68) load(step + 1);
#pragma unroll
        for (int mt = 0; mt < 4; ++mt) H[mt] = acc[mt];
    }
}

__device__ __forceinline__ void rwc_job(const Params& p, int l, int cid, int h, LAS unsigned char* lds, int tid) {
    asm volatile("" : "+v"(tid));
    const int r0 = chunk_row0(cid), w = tid >> 6, lane = tid & 63, fr = lane & 15, fq = lane >> 4, dirw = w >> 2, mt = w & 3;
    const size_t u = (size_t)((cid * 6 + h) * 2 + dirw);
    const unsigned char* qr = SCRP(unsigned char, SC_YF) + u * RW_REC; const unsigned char* yr = SCRP(unsigned char, SC_YB) + u * RW_REC; const unsigned char* hr = p.ws + WS_XM + u * RW_REC;
    const bf16x8 Q0 = *(const bf16x8*)(qr + (size_t)((mt * 2) * 64 + lane) * 16), Q1 = *(const bf16x8*)(qr + (size_t)((mt * 2 + 1) * 64 + lane) * 16);
    f32x4 acc[4];
#pragma unroll
    for (int nt = 0; nt < 4; ++nt) { const u32x2 y0 = *(const u32x2*)(yr + (size_t)((mt * 4 + nt) * 64 + lane) * 8);
        acc[nt] = (f32x4){bflo(y0.x), bfhi(y0.x), bflo(y0.y), bfhi(y0.y)};
        const bf16x8 B0 = *(const bf16x8*)(hr + (size_t)((0 * 4 + nt) * 64 + lane) * 16), B1 = *(const bf16x8*)(hr + (size_t)((1 * 4 + nt) * 64 + lane) * 16);
        acc[nt] = __builtin_amdgcn_mfma_f32_16x16x32_bf16(Q0, B0, acc[nt], 0, 0, 0); acc[nt] = __builtin_amdgcn_mfma_f32_16x16x32_bf16(Q1, B1, acc[nt], 0, 0, 0); }
    LAS f32x4* xb = (LAS f32x4*)lds;
    if (dirw == 1) {
#pragma unroll
        for (int nt = 0; nt < 4; ++nt) xb[(mt * 4 + nt) * 64 + lane] = acc[nt]; }
    __syncthreads();
    if (dirw == 0) {
        const bf16_t* Vg = SCRP(bf16_t, SC_V); const bf16_t* Gg = SCRP(bf16_t, SC_G); const float* BON = SCRP(float, SC_BON); bf16_t* CAT = WSP(bf16_t, WS_CAT);
#pragma unroll
        for (int nt = 0; nt < 4; ++nt) acc[nt] += xb[(mt * 4 + nt) * 64 + lane];
#pragma unroll
        for (int j = 0; j < 4; ++j) { const int row = r0 + mt * 16 + fq * 4 + j;
            float s = (acc[0][j] + acc[1][j]) + (acc[2][j] + acc[3][j]); s = red16(s); const float mu = s * (1.f / 64.f);
            float d0 = acc[0][j] - mu, d1 = acc[1][j] - mu, d2 = acc[2][j] - mu, d3 = acc[3][j] - mu;
            float v2 = (d0 * d0 + d1 * d1) + (d2 * d2 + d3 * d3); v2 = red16(v2); const float rs = rsqrtf(v2 * (1.f / 64.f) + RW_GN_EPS);
            const float bon = BON[(size_t)row * 8 + h];
            const float dd[4] = {d0, d1, d2, d3};
#pragma unroll
            for (int nt = 0; nt < 4; ++nt) { const int c = h * 64 + nt * 16 + fr; const size_t o = (size_t)row * 384 + c;
                const float yn = dd[nt] * rs * p.in[I_LNXG][l * 384 + c] + p.in[I_LNXB][l * 384 + c];
                CAT[(size_t)row * D + 640 + c] = (bf16_t)f2bf((yn + bon * bf2f(Vg[o])) * bf2f(Gg[o])); } }
    }
    __syncthreads();
}

#ifndef PHM
#define PHM 0x3ffff
#endif
#ifndef REPM
#define REPM 0
#endif
constexpr int LDS_TAB_OFF = 131072;
#define QUEUE_LOOP(head, n_all, BODY) do { const bool ldr_ = (wave_s == 0 && lane_id_() == 0); \
    if (ldr_) qslot[0] = (int)atomicAdd((head), 1u); __syncthreads(); \
    for (int k_ = 0;; ++k_) { const int j = qslot[k_ & 1]; if (j >= (n_all)) break; if (ldr_) qslot[(k_ + 1) & 1] = (int)atomicAdd((head), 1u); BODY; __syncthreads(); } } while (0)
#define GRID_BAR() do { unsigned char* w_ = p_arg.ws; asm volatile("" : "+s"(w_)); XcdBarrier b_; b_.bar = (unsigned*)(w_ + WS_CTL) + CW_BAR; b_.x = xb_xcc_id(); b_.st = ctlw; b_.w = wave_s; xcd_barrier(b_); if (REPM & 64) xcd_barrier(b_); } while (0)
#define PHASE_BEGIN_G() Params p = p_arg; asm volatile("" : "+s"(p.ws));
#define PHASE_BEGIN() Params p = p_arg; asm volatile("" : "+s"(p.ws)); \
    int tid = wave_s * 64 + lane_id_(); asm volatile("" : "+v"(tid)); const int lane = tid & 63, gw = bx * 8 + wave_s; (void)lane; (void)gw; (void)p;

__global__ void __launch_bounds__(NTHR, 2) fwd_kernel(Params p_arg) {
    extern __shared__ __attribute__((aligned(16))) unsigned char lds_raw[];
    LAS unsigned char* lds = (LAS unsigned char*)lds_raw;
    const int G = gridDim.x, bx = blockIdx.x, ngw = G * 8;
    const int wave_s = WAVE_ID_SGPR();
    volatile LAS unsigned* ctlw = (volatile LAS unsigned*)(lds + LDS_CTL_OFF);
    if (wave_s == 0) ctlw[lane_id_()] = 0u;
    __syncthreads();
    { PHASE_BEGIN(); (void)xcd_barrier_post(WSP(unsigned, WS_CTL) + CW_BAR, ctlw, wave_s); }
    volatile LAS int* qslot = (volatile LAS int*)(ctlw + 16);
    LAS int* tab = (LAS int*)(lds + LDS_TAB_OFF);

    for (int rep_ = 0; rep_ < ((REPM & 1) ? 2 : 1); ++rep_)
    { PHASE_BEGIN();
#if PHM & 1
      for (int j = bx; j < J_MOD; j += G) mod_job(p, j, (LAS float*)lds, tid);
#endif
#if PHM & 2
      for (int j = bx; j < JW_TOTAL; j += G) conv_job(p, j, (LAS float*)lds, tid);
#endif
      { bf16_t* wt = WSP(bf16_t, WS_RWW);
        for (int i = bx * NTHR + tid; i < 2 * (int)RWW_LAYER; i += G * NTHR) { const int l = i / (int)RWW_LAYER, r = i % (int)RWW_LAYER; float v;
            if (r < 4 * 384 * 64) { const int m = r / (384 * 64), q = r % (384 * 64), n = q >> 6, k = q & 63;
                v = (m < 2 ? p.in[I_W2] : p.in[I_A2])[((size_t)(l * 2 + (m & 1)) * 64 + k) * 384 + n]; }
            else { const int q = r - 4 * 384 * 64, n = q >> 7, k = q & 127; v = p.in[I_G2][((size_t)l * 128 + k) * 384 + n]; }
            wt[i] = (bf16_t)f2bf(v); } }
      float* bgu = WSP(float, WS_BGU);
      for (int i = bx * NTHR + tid; i < 2 * 32 * 2048; i += G * NTHR) { const int le = i >> 11, c = i & 2047; bgu[i] = (c & 1) ? p.in[I_MBU][le * 1024 + (c >> 1)] : p.in[I_MBG][le * 1024 + (c >> 1)]; } }
    GRID_BAR();
#if PHM & 4
    for (int rep_ = 0; rep_ < ((REPM & 32) ? 2 : 1); ++rep_)
    { PHASE_BEGIN(); ln_in_rows(p, gw, ngw, lane); }
#endif
    GRID_BAR();

#pragma unroll 1
    for (int l = 0; l < 2; ++l) {
        const int nrows = l == 0 ? NTOK : NLAT;
#if PHM & 8
        for (int rep_ = 0; rep_ < ((REPM & 8) ? 2 : 1); ++rep_)
        { PHASE_BEGIN_G();
          pg8::Gemm g{WSP(bf16_t, WS_XM), WSP(bf16_t, WS_WIN) + (size_t)l * DINP * 1024, NTOK, DINP, 1024};
          pg8::StaticOrder S; S.init(NTOK, DINP, 1024, G, bx);
          pg8::EpiBf16 E{WSP(bf16_t, WS_Z), DINP, nullptr, 0};
          pg8::gemm_phase<pg8::EpiBf16, pg8::StaticOrder>(lds, g, S, E, wave_s); }
#endif
        GRID_BAR();
        for (int rep_ = 0; rep_ < ((REPM & 2) ? 2 : 1); ++rep_)
        { PHASE_BEGIN();
          unsigned* head = WSP(unsigned, WS_CTL) + CW_QHEAD + (l * 8 + 0 + 4 * rep_) * 64;
          const int n_rw = 544, n_gla = NCHUNK * 6, n_da = 4 * NKT, n_all = n_rw + n_gla + n_da;
          QUEUE_LOOP(head, n_all, {
              if (j < n_rw) rw_job(p, l, j, lds, tid);
              if (j >= n_rw && j < n_rw + n_gla) { const int q = j - n_rw; gla_job(p, l, q / 6, q % 6, lds, tid); }
              if (j >= n_rw + n_gla) { const int q = j - n_rw - n_gla; da_job(p, l, q / NKT, q % NKT, lds, tid); }
          }); }
        GRID_BAR();
        for (int rep_ = 0; rep_ < ((REPM & 32) ? 2 : 1); ++rep_)
        { PHASE_BEGIN();
          { const int n_u = NCHUNK * 12;
            for (int u = bx; u < n_u; u += G) rwa_job(p, u, (u + G < n_u) ? u + G : -1, u == bx, lds, tid); }
          if (bx >= G - 192) g2_job(p, bx - (G - 192), tid); }
        GRID_BAR();
        for (int rep_ = 0; rep_ < ((REPM & 4) ? 2 : 1); ++rep_)
        { PHASE_BEGIN();
          unsigned* head = WSP(unsigned, WS_CTL) + CW_QHEAD + (l * 8 + 1 + 4 * rep_) * 64;
          const int n_sc = 48, n_att = 512 + (l == 0 ? 32 : 0), n_g3 = (l == 0 ? NCHUNK : 256) * 6, n_all = n_sc + n_att + n_g3;
          QUEUE_LOOP(head, n_all, {
              if (j < n_sc) rwb_job(p, j, tid);
              if (j >= n_sc && j < n_sc + n_att) { const int q = j - n_sc; const bool ic = q >= 512; const int c = q - 512;
                  attn_unit(p, l, ic ? (c >> 3) : (q >> 7), ic ? ((c >> 1) & 3) : ((q >> 5) & 3), ic, ic ? (c & 1) : (q & 31), lds, tid); }
              if (j >= n_sc + n_att) { const int q = j - n_sc - n_att; g3_job(p, l, q / 6, q % 6, lds, tid); }
          }); }
        GRID_BAR();
        for (int rep_ = 0; rep_ < ((REPM & 32) ? 2 : 1); ++rep_)
        { PHASE_BEGIN();
          const int n_all = (l == 0 ? NCHUNK : 256) * 6;
          for (int j = bx; j < n_all; j += G) rwc_job(p, l, j / 6, j % 6, lds, tid); }
        GRID_BAR();
#if PHM & 4096
        for (int rep_ = 0; rep_ < ((REPM & 8) ? 2 : 1); ++rep_)
        { PHASE_BEGIN_G();
          pg8::Gemm g{WSP(bf16_t, WS_CAT), WSP(bf16_t, WS_WOUT) + (size_t)l * 1024 * 1024, nrows, 1024, 1024};
          pg8::StaticOrder S; S.init(nrows, 1024, 1024, G, bx);
          pg8::EpiBf16 E{WSP(bf16_t, WS_Z), 1024, nullptr, 0};
          pg8::gemm_phase<pg8::EpiBf16, pg8::StaticOrder>(lds, g, S, E, wave_s); }
#endif
        GRID_BAR();
#if PHM & 8192
        for (int rep_ = ((REPM & 128) ? 0 : 1); rep_ < 2; ++rep_)
        { PHASE_BEGIN(); ln1_router(p, l, nrows, lds, tid, gw, ngw, lane, bx, rep_ == 0); }
#endif
        GRID_BAR();
        { PHASE_BEGIN();
          moe_tables(p, l, tab, (LAS int*)lds, G, tid);
#if PHM & 16384
          for (int rep_ = 0; rep_ < ((REPM & 32) ? 2 : 1); ++rep_)
          moe_gather(p, l, nrows, tab, (const LAS int*)lds, gw, ngw, lane);
#endif
        }
        GRID_BAR();
#if PHM & 32768
        for (int rep_ = 0; rep_ < ((REPM & 16) ? 2 : 1); ++rep_)
        { PHASE_BEGIN_G();
          const int nblk = tab[96];
          pg8::Gemm g{SCRP(bf16_t, SC_XB), WSP(bf16_t, WS_WGU) + (size_t)l * 32 * 2048 * 1024, nblk * 256, 2048, 1024};
          pg8::GroupOrder<8> S{G, (G % 8 == 0) ? (bx % 8) * (G / 8) + bx / 8 : bx, nblk, tab + 128};
          pg8::EpiSwiglu E{SCRP(bf16_t, SC_ACT), WSP(float, WS_BGU) + (size_t)l * 32 * 2048};
          pg8::gemm_phase<pg8::EpiSwiglu, pg8::GroupOrder<8>>(lds, g, S, E, wave_s); }
#endif
        GRID_BAR();
#if PHM & 65536
        for (int rep_ = 0; rep_ < ((REPM & 16) ? 2 : 1); ++rep_)
        { PHASE_BEGIN_G();
          const int nblk = tab[96];
          pg8::Gemm g{SCRP(bf16_t, SC_ACT), WSP(bf16_t, WS_WDN) + (size_t)l * 32 * 1024 * 1024, nblk * 256, 1024, 1024};
          pg8::GroupOrder<4> S{G, (G % 8 == 0) ? (bx % 8) * (G / 8) + bx / 8 : bx, nblk, tab + 128};
          pg8::EpiBf16 E{SCRP(bf16_t, SC_XB), 1024, p.in[I_MBD] + (size_t)l * 32 * 1024, 1024};
          pg8::gemm_phase<pg8::EpiBf16, pg8::GroupOrder<4>>(lds, g, S, E, wave_s); }
#endif
        GRID_BAR();
#if PHM & 131072
        for (int rep_ = ((REPM & 256) ? 0 : 1); rep_ < 2; ++rep_)
        { PHASE_BEGIN(); ln2_rows(p, l, nrows, gw, ngw, lane, rep_ == 0); }
#endif
        GRID_BAR();
    }
}

extern "C" void kernel_launch(void* const* d_in, const int* in_sizes, int n_in, void* d_out, int out_size, void* d_ws, size_t ws_size, hipStream_t stream) {
    (void)in_sizes; (void)n_in; (void)out_size; (void)ws_size;
    static int grid = 0;
    if (!grid) {
        (void)hipFuncSetAttribute((const void*)fwd_kernel, hipFuncAttributeMaxDynamicSharedMemorySize, LDS_BYTES);
        int dev = 0, cus = 0; (void)hipGetDevice(&dev); (void)hipDeviceGetAttribute(&cus, hipDeviceAttributeMultiprocessorCount, dev);
        grid = cus > 0 && cus < 256 ? cus : 256;
    }
    (void)hipMemsetAsync(d_ws, 0, CTL_BYTES, stream);
    Params p{};
    for (int i = 0; i < 41; ++i) p.in[i] = (const float*)d_in[i];
    p.out = (float*)d_out; p.ws = (unsigned char*)d_ws;
    hipLaunchKernelGGL(fwd_kernel, dim3(grid), dim3(NTHR), LDS_BYTES, stream, p);
}
```

```cpp
#include <hip/hip_runtime.h>
#include <cstdint>
#include <cstdio>

#define LAS __attribute__((address_space(3)))
typedef unsigned short bf16_t;
typedef short bf16x8 __attribute__((ext_vector_type(8)));
typedef float f32x4 __attribute__((ext_vector_type(4)));
typedef float f32x2 __attribute__((ext_vector_type(2)));
typedef unsigned u32x4 __attribute__((ext_vector_type(4)));
typedef unsigned u32x2 __attribute__((ext_vector_type(2)));

constexpr int D = 1024, NB = 4, SEQ = 4096, LCX = 256, NLAT = NB * SEQ, NCX = NB * LCX, NTOK = NLAT + NCX;
constexpr int DIN = 3488, DINP = 3584;
constexpr int NE = 32, FF = 1024;
constexpr int CAP_BLK = 304, CAP = CAP_BLK * 256;
constexpr int NTHR = 512;
constexpr int ZQ = 0, ZK = 256, ZV = 512, ZGQ = 768, ZGK = 960, ZGV = 1152, ZGF = 1536, ZGB = 1552, ZGR = 1568, ZRKV = 1952, ZWF = 3104, ZWB = 3168, ZAF = 3232, ZAB = 3296, ZG = 3360;
constexpr int NKT = 136;
constexpr int NCHUNK = 272;
constexpr float LN_EPS = 1e-5f, RW_GN_EPS = 64e-5f;
constexpr float DN_ALPHA = 1.41421356237f;

constexpr size_t MiB = 1u << 20;
constexpr size_t WS_CTL = 0, CTL_BYTES = 1 * MiB;
constexpr size_t WS_MOD = 1 * MiB;
constexpr size_t WS_TOP = 2 * MiB;
constexpr size_t TOP_STRIDE = (size_t)NTOK * 4 * 4;
constexpr size_t WS_CNTWG = 3 * MiB + 768 * 1024;
constexpr size_t WS_RWW = 3 * MiB + 128 * 1024;
constexpr size_t RWW_LAYER = 4 * 384 * 64 + 384 * 128;
static_assert(WS_TOP + 4 * TOP_STRIDE <= WS_RWW && WS_RWW + 2 * RWW_LAYER * 2 <= WS_CNTWG && WS_CNTWG + 2 * 256 * 32 * 4 <= 4 * MiB, "ws map");
constexpr size_t WS_RTW = 4 * MiB + 512 * 1024;
constexpr size_t WS_BGU = 4 * MiB;
constexpr size_t WS_H = 5 * MiB;
constexpr size_t WS_XM = 73 * MiB;
constexpr size_t WS_CAT = 107 * MiB;
constexpr size_t WS_Z = 141 * MiB;
constexpr size_t WS_WIN = 260 * MiB;
constexpr size_t WS_WOUT = 274 * MiB;
constexpr size_t WS_WGU = 278 * MiB;
constexpr size_t WS_WDN = 534 * MiB;
constexpr size_t WS_SCR = 662 * MiB;
constexpr size_t WS_END = 966 * MiB;
constexpr size_t WS_MREC = 966 * MiB, WS_GREC = 992 * MiB, WS_TOTAL = 1018 * MiB;
static_assert(WS_MREC + (size_t)3264 * 8192 <= WS_GREC && WS_GREC + (size_t)3264 * 8192 <= WS_TOTAL && WS_TOTAL <= 1024 * MiB, "ws map");
static_assert(WS_H + (size_t)NTOK * D * 4 <= WS_XM && WS_XM + (size_t)NTOK * D * 2 <= WS_CAT && WS_CAT + (size_t)NTOK * D * 2 <= WS_Z, "ws map");
static_assert(WS_Z + (size_t)NTOK * DINP * 2 <= WS_WIN && WS_WIN + (size_t)2 * DINP * D * 2 <= WS_WOUT && WS_WOUT + (size_t)2 * D * D * 2 <= WS_WGU, "ws map");
static_assert(WS_WGU + (size_t)2 * 32 * 2048 * 1024 * 2 <= WS_WDN && WS_WDN + (size_t)2 * 32 * 1024 * 1024 * 2 <= WS_SCR, "ws map");
constexpr size_t SC_XB = 0, SC_ACT = (size_t)CAP * D * 2;
static_assert(WS_SCR + 2 * SC_ACT <= WS_END, "ws map");
constexpr size_t SZ_T384B = (size_t)NTOK * 384 * 2, SZ_T384F = (size_t)NTOK * 384 * 4, SZ_T192F = (size_t)NTOK * 192 * 4;
constexpr size_t SC_KVREC = 0;
constexpr size_t SC_GBF = SC_KVREC + (size_t)16 * NKT * 8192;
constexpr size_t SC_GBB = SC_GBF + SZ_T192F;
constexpr size_t SC_KVC = SC_GBB + SZ_T192F;
constexpr size_t SZ_KVC = (size_t)NCHUNK * 6 * 2 * 2048 * 4;
constexpr size_t SC_SC = SC_KVC + SZ_KVC;
constexpr size_t SC_DC = SC_SC + SZ_KVC;
constexpr size_t SC_R = SC_DC + (size_t)NCHUNK * 6 * 2 * 32 * 4;
constexpr size_t SC_KK = SC_R + SZ_T384B, SC_V = SC_KK + SZ_T384B, SC_BKF = SC_V + SZ_T384B, SC_BKB = SC_BKF + SZ_T384B, SC_KMF = SC_BKB + SZ_T384B, SC_KMB = SC_KMF + SZ_T384B, SC_G = SC_KMB + SZ_T384B;
constexpr size_t SC_WF = SC_G + SZ_T384B, SC_WB = SC_WF + SZ_T384F, SC_YF = SC_WB + SZ_T384F, SC_YB = SC_YF + SZ_T384F, SC_BON = SC_YB + SZ_T384F;
constexpr size_t SC_MIX_END = SC_BON + (size_t)NTOK * 8 * 4;
static_assert(WS_SCR + SC_MIX_END <= WS_END, "mixer scratch");
constexpr int CW_BAR = 4096, CW_CNT = 8192, CW_QHEAD = 8448  , CW_KMAX = 16896;
static_assert(CW_BAR + 3456 <= CW_CNT && CW_CNT + 128 <= CW_QHEAD && CW_QHEAD + 16 * 512 <= CW_KMAX && (CW_KMAX + 64) * 4 <= (int)CTL_BYTES, "control words");

constexpr int LDS_BYTES = 163840, LDS_CTL_OFF = LDS_BYTES - 256;

__device__ __forceinline__ int lane_id_() { int r; asm volatile("v_mbcnt_lo_u32_b32 %0, -1, 0\n\tv_mbcnt_hi_u32_b32 %0, -1, %0" : "=v"(r)); return r; }
#define WAVE_ID_SGPR() (__builtin_amdgcn_readfirstlane((int)(threadIdx.x >> 6)))

__device__ __forceinline__ unsigned f2bf(float f) { unsigned u = __builtin_bit_cast(unsigned, f); return (u + 0x7fffu + ((u >> 16) & 1u)) >> 16; }
__device__ __forceinline__ unsigned pk2(float lo, float hi) { return f2bf(lo) | (f2bf(hi) << 16); }
__device__ __forceinline__ float bf2f(bf16_t h) { return __builtin_bit_cast(float, (unsigned)h << 16); }
__device__ __forceinline__ float bflo(unsigned u) { return __builtin_bit_cast(float, u << 16); }
__device__ __forceinline__ float bfhi(unsigned u) { return __builtin_bit_cast(float, u & 0xffff0000u); }
__device__ __forceinline__ float wave_sum(float v) {
#pragma unroll
    for (int o = 1; o < 64; o <<= 1) v += __shfl_xor(v, o);
    return v;
}
__device__ __forceinline__ float sigmoidf_(float x) { return 1.f / (1.f + __expf(-x)); }
__device__ __forceinline__ float siluf_(float x) { return x / (1.f + __expf(-x)); }
template <int CTRL> __device__ __forceinline__ float dpp_f(float v) {
    return __builtin_bit_cast(float, __builtin_amdgcn_update_dpp(0, __builtin_bit_cast(int, v), CTRL, 0xF, 0xF, true));
}
__device__ __forceinline__ float red16(float v) {
    v += dpp_f<0xB1>(v);
    v += dpp_f<0x4E>(v);
    v += dpp_f<0x141>(v);
    v += dpp_f<0x140>(v);
    return v;
}

namespace pg8 {
constexpr int BM = 256, BK = 64, HALF = 128, HTB = HALF * BK * 2, STAGE_BYTES = 8 * HTB, NXCD = 8, WGM = 8;
__host__ __device__ __forceinline__ int lds_byte(int r, int c) { const int st = (r >> 4) * 2 + (c >> 5), rr = r & 15, cc = c & 31, ob = rr * 64 + cc * 2; return st * 1024 + (ob ^ (((ob >> 9) & 1) << 5)); }
__host__ __device__ __forceinline__ void stage_rc(int b, int& R, int& C) { const int st = b / 1024, sb = b % 1024, swz = sb ^ (((sb >> 9) & 1) << 5); R = (st >> 1) * 16 + swz / 64; C = (st & 1) * 32 + (swz % 64) / 2; }
__host__ __device__ __forceinline__ int perm32(int rho) { const int n = rho >> 4, i = rho & 15; return 8 * (i >> 2) + 4 * n + (i & 3); }

struct Unit { int pm, pn, e; size_t boff; };
struct Gemm { const bf16_t* A; const bf16_t* Bt; int M, N, K; };

struct StaticOrder {
    int nM, nN, nwg, G, c; size_t tstep;
    __device__ void init(int M, int N, int K, int G_, int c_) { nM = M / BM; nN = N / BM; nwg = nM * nN; G = G_; c = c_; tstep = (size_t)BM * K * 2; }
    __device__ bool next(int i, Unit& u) const {
        const long L = (long)i * G + c; if (L >= nwg) return false;
        int wgid = (int)L; { const int q = nwg / NXCD, r = nwg % NXCD, xcd = wgid % NXCD, off = wgid / NXCD; wgid = (xcd < r ? xcd * (q + 1) : r * (q + 1) + (xcd - r) * q) + off; }
        const int nig = WGM * nN, gid = wgid / nig, fm = gid * WGM, gsz = (nM - fm) < WGM ? (nM - fm) : WGM;
        u.pm = fm + ((wgid % nig) % gsz); u.pn = (wgid % nig) / gsz; u.e = 0; u.boff = (size_t)u.pn * tstep; return true;
    }
};
template <int NPN> struct GroupOrder {
    int G, c, nblk; const LAS int* blk2e;
    __device__ __forceinline__ bool next(int i, Unit& u) const {
        const int L = i * G + c; if (L >= nblk * NPN) return false;
        const int blk = L / NPN; u.pn = L % NPN; u.pm = blk;
        const int e = blk2e[blk];
        u.e = e; u.boff = (size_t)(e * NPN + u.pn) * ((size_t)256 * 1024 * 2); return true;
    }
};

typedef __bf16 bf16x2_t __attribute__((ext_vector_type(2)));
__device__ __forceinline__ unsigned cvt_pk_bf16(float lo, float hi) { const f32x2 v = {lo, hi}; const bf16x2_t b = __builtin_convertvector(v, bf16x2_t); return __builtin_bit_cast(unsigned, b); }

struct EpiBf16 {
    bf16_t* O; int ldc; const float* bias; int bias_estride;
    __device__ __forceinline__ void operator()(const f32x4 (&acc)[2][2][4][2], const Unit& u, int wr, int wc, int fr, int fq) const {
        const int row0 = u.pm * BM + wr * 64 + fr; const int col0 = u.pn * BM + wc * 32 + 8 * fq;
        f32x4 bv[2][2];
#pragma unroll
        for (int bj = 0; bj < 2; ++bj)
#pragma unroll
            for (int n = 0; n < 2; ++n) bv[bj][n] = bias ? *(const f32x4*)(bias + (size_t)u.e * bias_estride + col0 + bj * HALF + 4 * n) : (f32x4){0.f, 0.f, 0.f, 0.f};
#pragma unroll
        for (int ai = 0; ai < 2; ++ai)
#pragma unroll
            for (int m = 0; m < 4; ++m) { bf16_t* rowp = O + (size_t)(row0 + ai * HALF + m * 16) * ldc + col0;
#pragma unroll
                for (int bj = 0; bj < 2; ++bj) { const f32x4 v0 = acc[ai][bj][m][0] + bv[bj][0], v1 = acc[ai][bj][m][1] + bv[bj][1];
                    u32x4 w; w.x = cvt_pk_bf16(v0[0], v0[1]); w.y = cvt_pk_bf16(v0[2], v0[3]); w.z = cvt_pk_bf16(v1[0], v1[1]); w.w = cvt_pk_bf16(v1[2], v1[3]);
                    *(u32x4*)(rowp + bj * HALF) = w; } }
    }
};
struct EpiSwiglu {
    bf16_t* O; const float* bias;
    __device__ __forceinline__ static float act(float g, float u) {
        g = fminf(g, 7.f); u = fminf(fmaxf(u, -7.f), 7.f);
        return (u + 1.f) * g / (1.f + __expf(-1.702f * g));
    }
    __device__ __forceinline__ void operator()(const f32x4 (&acc)[2][2][4][2], const Unit& u, int wr, int wc, int fr, int fq) const {
        const int row0 = u.pm * BM + wr * 64 + fr; const int col0 = u.pn * BM + wc * 32 + 8 * fq;
        f32x4 bv[2][2];
#pragma unroll
        for (int bj = 0; bj < 2; ++bj)
#pragma unroll
            for (int n = 0; n < 2; ++n) bv[bj][n] = *(const f32x4*)(bias + (size_t)u.e * 2048 + col0 + bj * HALF + 4 * n);
#pragma unroll
        for (int ai = 0; ai < 2; ++ai)
#pragma unroll
            for (int m = 0; m < 4; ++m) { bf16_t* rowp = O + (size_t)(row0 + ai * HALF + m * 16) * 1024 + (col0 >> 1);
#pragma unroll
                for (int bj = 0; bj < 2; ++bj) { const f32x4 v0 = acc[ai][bj][m][0] + bv[bj][0], v1 = acc[ai][bj][m][1] + bv[bj][1];
                    u32x2 w; w.x = cvt_pk_bf16(act(v0[0], v0[1]), act(v0[2], v0[3])); w.y = cvt_pk_bf16(act(v1[0], v1[1]), act(v1[2], v1[3]));
                    *(u32x2*)(rowp + bj * (HALF / 2)) = w; } }
    }
};

template <class Epi, class Sched>
__device__ __forceinline__ void gemm_phase(LAS unsigned char* lds, const Gemm g, const Sched& S, const Epi& E, const int wave_s) {
    int tid = wave_s * 64 + lane_id_(); asm volatile("" : "+v"(tid));
    const int wid = __builtin_amdgcn_readfirstlane(tid >> 6), lane = tid & 63, wr = wid >> 2, wc = wid & 3, fr = lane & 15, fq = lane >> 4;
    const int K = g.K, nt = K / BK;
    unsigned voffA[2], voffB[2];
#pragma unroll
    for (int i = 0; i < 2; ++i) { int R, C; stage_rc(tid * 16 + i * 8192, R, C); const int Rb = (R & ~31) + perm32(R & 31);
        voffA[i] = (unsigned)(R * K + C) * 2u; voffB[i] = (unsigned)(Rb * K + C) * 2u; }
    const size_t kstep = (size_t)(BK * 2);
    const size_t hstep = (size_t)HALF * K * 2;
    const size_t tstep = 2 * hstep;
    const unsigned ldsw = (unsigned)wid * 1024u;
    const int aoff = lds_byte(wr * 64 + fr, fq * 8), boff = lds_byte(wc * 32 + fr, fq * 8);
#define PG8_SA(b, h) (((b) * 2 + (h)) * HTB)
#define PG8_SB(b, h) ((4 + (b) * 2 + (h)) * HTB)
#define PG8_STAGE(bufoff, gbase, voff) do { _Pragma("unroll") for (int _i = 0; _i < 2; ++_i) \
        __builtin_amdgcn_global_load_lds((const unsigned*)((const char*)(gbase) + (voff)[_i]), (LAS unsigned*)(lds + (bufoff) + ldsw + _i * 8192), 16, 0, 0); } while (0)
#define PG8_LDA(dst, b, h) do { _Pragma("unroll") for (int m = 0; m < 4; ++m) _Pragma("unroll") for (int k = 0; k < 2; ++k) dst[m][k] = *(const LAS bf16x8*)(lds + PG8_SA(b, h) + aoff + m * 2048 + k * 1024); } while (0)
#define PG8_LDB(dst, b, h) do { _Pragma("unroll") for (int n = 0; n < 2; ++n) _Pragma("unroll") for (int k = 0; k < 2; ++k) dst[n][k] = *(const LAS bf16x8*)(lds + PG8_SB(b, h) + boff + n * 2048 + k * 1024); } while (0)
#define PG8_MMA(ai, bj, At, Bt) do { __builtin_amdgcn_s_setprio(1); _Pragma("unroll") for (int m = 0; m < 4; ++m) _Pragma("unroll") for (int n = 0; n < 2; ++n) _Pragma("unroll") for (int k = 0; k < 2; ++k) \
        acc[ai][bj][m][n] = __builtin_amdgcn_mfma_f32_16x16x32_bf16(Bt[n][k], At[m][k], acc[ai][bj][m][n], 0, 0, 0); __builtin_amdgcn_s_setprio(0); } while (0)
#define PG8_WAIT_V(n) asm volatile("s_waitcnt vmcnt(" #n ")" ::: "memory")
#define PG8_WAIT_L(n) asm volatile("s_waitcnt lgkmcnt(" #n ")" ::: "memory")
#define PG8_BAR __builtin_amdgcn_s_barrier()
#define PG8_SCHED __builtin_amdgcn_sched_barrier(0)
    Unit cur, nxt; int ui = 0;
    if (!S.next(0, cur)) return;
    f32x4 acc[2][2][4][2];
#pragma unroll
    for (int a = 0; a < 2; ++a)
#pragma unroll
        for (int b = 0; b < 2; ++b)
#pragma unroll
            for (int m = 0; m < 4; ++m)
#pragma unroll
                for (int n = 0; n < 2; ++n) acc[a][b][m][n] = (f32x4){0.f, 0.f, 0.f, 0.f};
    bf16x8 At[4][2], B0[2][2], B1[2][2];
    const char* cA = (const char*)g.A + (size_t)cur.pm * tstep; const char* cB = (const char*)g.Bt + cur.boff;
    PG8_STAGE(PG8_SB(0, 0), cB, voffB); PG8_STAGE(PG8_SB(0, 1), cB + hstep, voffB); PG8_STAGE(PG8_SA(0, 0), cA, voffA); PG8_STAGE(PG8_SA(0, 1), cA + hstep, voffA);
    if (wr == 1) PG8_BAR;
    PG8_WAIT_V(2); PG8_BAR;
    PG8_STAGE(PG8_SB(1, 0), cB + kstep, voffB); PG8_STAGE(PG8_SA(1, 0), cA + kstep, voffA); PG8_STAGE(PG8_SB(1, 1), cB + hstep + kstep, voffB);
    PG8_WAIT_V(6); PG8_BAR;
    for (;;) {
        const bool has_next = S.next(ui + 1, nxt);
        const char* nA = has_next ? (const char*)g.A + (size_t)nxt.pm * tstep : cA; const char* nB = has_next ? (const char*)g.Bt + nxt.boff : cB;
        for (int t = 0; t < nt; t += 2) {
            const bool last = (t == nt - 2);
            const char* a1 = cA + (size_t)(t + 1) * kstep;
            const char* a2 = last ? nA : cA + (size_t)(t + 2) * kstep; const char* b2 = last ? nB : cB + (size_t)(t + 2) * kstep;
            const char* a3 = a2 + kstep; const char* b3 = b2 + kstep;
            PG8_LDB(B0, 0, 0); PG8_LDB(B1, 0, 1); PG8_SCHED; PG8_LDA(At, 0, 0); PG8_STAGE(PG8_SA(1, 1), a1 + hstep, voffA);
            PG8_WAIT_V(8); PG8_WAIT_L(0); PG8_BAR; PG8_MMA(0, 0, At, B0); PG8_MMA(0, 1, At, B1); PG8_BAR; PG8_SCHED;
            PG8_LDA(At, 0, 1); PG8_STAGE(PG8_SB(0, 0), b2, voffB); PG8_STAGE(PG8_SB(0, 1), b2 + hstep, voffB); PG8_STAGE(PG8_SA(0, 0), a2, voffA);
            PG8_WAIT_V(8); PG8_WAIT_L(0); PG8_BAR; PG8_MMA(1, 0, At, B0); PG8_MMA(1, 1, At, B1); PG8_BAR; PG8_SCHED;
            PG8_LDB(B0, 1, 0); PG8_LDB(B1, 1, 1); PG8_SCHED; PG8_LDA(At, 1, 0); PG8_STAGE(PG8_SA(0, 1), a2 + hstep, voffA);
            PG8_WAIT_V(8); PG8_WAIT_L(0); PG8_BAR; PG8_MMA(0, 0, At, B0); PG8_MMA(0, 1, At, B1); PG8_BAR; PG8_SCHED;
            PG8_LDA(At, 1, 1); PG8_STAGE(PG8_SB(1, 0), b3, voffB); PG8_STAGE(PG8_SB(1, 1), b3 + hstep, voffB); PG8_STAGE(PG8_SA(1, 0), a3, voffA);
            PG8_WAIT_V(8); PG8_WAIT_L(0); PG8_BAR; PG8_MMA(1, 0, At, B0); PG8_MMA(1, 1, At, B1); PG8_BAR; PG8_SCHED;
        }
        if (wr == 0) PG8_BAR;
        { int tz = wave_s * 64 + lane_id_(); asm volatile("" : "+v"(tz)); const int l2 = tz & 63; E(acc, cur, wave_s >> 2, wave_s & 3, l2 & 15, l2 >> 4); }
        if (!has_next) break;
#pragma unroll
        for (int a = 0; a < 2; ++a)
#pragma unroll
            for (int b = 0; b < 2; ++b)
#pragma unroll
                for (int m = 0; m < 4; ++m)
#pragma unroll
                    for (int n = 0; n < 2; ++n) acc[a][b][m][n] = (f32x4){0.f, 0.f, 0.f, 0.f};
        cur = nxt; cA = nA; cB = nB; ++ui;
        if (wr == 1) PG8_BAR;
    }
    PG8_WAIT_V(0);
    PG8_BAR;
#undef PG8_SA
#undef PG8_SB
#undef PG8_STAGE
#undef PG8_LDA
#undef PG8_LDB
#undef PG8_MMA
#undef PG8_WAIT_V
#undef PG8_WAIT_L
#undef PG8_BAR
#undef PG8_SCHED
}
}
#define XB_TMO      128
#define XB_XCNT(j)  (256  + 64 * (j))
#define XB_XSUB(j)  (1280 + 64 * (j))
#define XB_XGEN(j)  (2304 + 64 * (j))
#define XB_TOP      3328
#define XB_TOPGEN   3392
#define XCD_BAR_WORDS 3456
#define XB_SPIN_CAP (1u << 18)

__device__ __forceinline__ unsigned xb_ld(unsigned* p)              { return __hip_atomic_load(p, __ATOMIC_RELAXED, __HIP_MEMORY_SCOPE_AGENT); }
__device__ __forceinline__ unsigned xb_add(unsigned* p, unsigned v) { return __hip_atomic_fetch_add(p, v, __ATOMIC_RELAXED, __HIP_MEMORY_SCOPE_AGENT); }
__device__ __forceinline__ unsigned xb_xcc_id() { return (unsigned)__builtin_amdgcn_s_getreg((3 << 11) | 20) & 0xFu; }
#define XB_SPIN(cond, bar) do { unsigned _sp = 0; while (cond) { __builtin_amdgcn_s_sleep(1); \
    if ((++_sp & 255u) == 0u) { if (xb_ld(&(bar)[XB_TMO])) break; if (_sp > XB_SPIN_CAP) { atomicAdd(&(bar)[XB_TMO], 1u); break; } } } } while (0)

struct XcdBarrier {
    unsigned* bar; unsigned x; int w;
    volatile LAS unsigned* st;
};

__device__ __forceinline__ XcdBarrier xcd_barrier_post(unsigned* bar, volatile LAS unsigned* st, int wave_s) {
    XcdBarrier b; b.bar = bar; b.x = xb_xcc_id(); b.st = st; b.w = wave_s;
    if (wave_s == 0 && lane_id_() == 0) (void)xb_add(&bar[XB_XCNT(b.x)], 1u);
    return b;
}
__device__ __forceinline__ void xcd_barrier_complete(unsigned* bar, unsigned x, unsigned& nloc, unsigned& nx) {
    const unsigned G = gridDim.x * gridDim.y * gridDim.z;
    unsigned sum, cnt, mine, sp = 0u;
    for (;;) {
        sum = 0u; cnt = 0u; mine = 0u;
#pragma unroll
        for (unsigned j = 0; j < 16; ++j) { const unsigned c = xb_ld(&bar[XB_XCNT(j)]); sum += c; cnt += (c > 0u) ? 1u : 0u; mine = (j == x) ? c : mine; }
        if (sum == G) break;
        __builtin_amdgcn_s_sleep(1);
        if ((++sp & 255u) == 0u) { if (xb_ld(&bar[XB_TMO])) break; if (sp > XB_SPIN_CAP) { atomicAdd(&bar[XB_TMO], 1u); break; } }
    }
    nloc = mine > 0u ? mine : 1u; nx = cnt > 0u ? cnt : 1u;
}

__device__ __forceinline__ void xcd_barrier(const XcdBarrier& b) {
    asm volatile("s_waitcnt vmcnt(0)" ::: "memory");
    __syncthreads();
    if (b.w == 0 && lane_id_() == 0) {
        unsigned* bar = b.bar;
        __builtin_amdgcn_s_waitcnt(0);
        unsigned nloc = b.st[0], nx = b.st[1];
        if (nloc == 0u) { xcd_barrier_complete(bar, b.x, nloc, nx); b.st[0] = nloc; b.st[1] = nx; }
        const unsigned old = xb_add(&bar[XB_XSUB(b.x)], 1u);
        const unsigned gen = old / nloc;
        if (old + 1u == (gen + 1u) * nloc) {
            __builtin_amdgcn_fence(__ATOMIC_RELEASE, "agent");
            asm volatile("s_waitcnt vmcnt(0)" ::: "memory");
            const unsigned og = xb_add(&bar[XB_TOP], 1u);
            const unsigned tg = og / nx;
            if (og + 1u == (tg + 1u) * nx) xb_add(&bar[XB_TOPGEN], 1u);
            else XB_SPIN(xb_ld(&bar[XB_TOPGEN]) == tg, bar);
            __builtin_amdgcn_fence(__ATOMIC_ACQUIRE, "agent");
            xb_add(&bar[XB_XGEN(b.x)], 1u);
            asm volatile("s_waitcnt vmcnt(0)" ::: "memory");
        } else {
            XB_SPIN(xb_ld(&bar[XB_XGEN(b.x)]) == gen, bar);
            __builtin_amdgcn_fence(__ATOMIC_ACQUIRE, "agent");
            asm volatile("s_waitcnt vmcnt(0)" ::: "memory");
        }
    }
    __syncthreads();
}

__device__ const float ROPE_COS[64][8] = {
1.0f, 1.0f, 1.0f, 1.0f, 1.0f, 1.0f, 1.0f, 1.0f,
0.540302277f, 0.950415254f, 0.995004177f, 0.999500036f, 0.999949992f, 0.999994993f, 0.999999523f, 0.99999994f,
-0.416146845f, 0.806578398f, 0.980066597f, 0.998000681f, 0.999800026f, 0.999979973f, 0.999997973f, 0.999999821f,
-0.989992499f, 0.582753658f, 0.955336511f, 0.995503366f, 0.999550045f, 0.999954998f, 0.99999553f, 0.999999523f,
-0.653643608f, 0.301137477f, 0.921060979f, 0.992010653f, 0.999200106f, 0.999920011f, 0.999992013f, 0.999999225f,
0.2836622f, -0.0103423381f, 0.87758255f, 0.987526f, 0.998750269f, 0.999875009f, 0.999987483f, 0.999998748f,
0.960170269f, -0.3207964f, 0.825335622f, 0.982053936f, 0.998200536f, 0.999819994f, 0.999981999f, 0.999998212f,
0.753902256f, -0.599437475f, 0.764842212f, 0.975599885f, 0.997551024f, 0.999755025f, 0.999975502f, 0.999997556f,
-0.145500034f, -0.818632424f, 0.696706712f, 0.968170285f, 0.996801734f, 0.999680042f, 0.999967992f, 0.999996781f,
-0.91113025f, -0.956644177f, 0.621609926f, 0.959772646f, 0.995952725f, 0.999595046f, 0.999959528f, 0.999995947f,
-0.839071512f, -0.999786079f, 0.540302277f, 0.950415313f, 0.995004177f, 0.999500036f, 0.999949992f, 0.999994993f,
0.00442569796f, -0.943779767f, 0.453596085f, 0.940107584f, 0.993956089f, 0.999395072f, 0.999939501f, 0.99999392f,
0.843853951f, -0.79417938f, 0.362357706f, 0.92885989f, 0.99280864f, 0.999280095f, 0.999927998f, 0.999992788f,
0.907446802f, -0.565820515f, 0.267498761f, 0.916683376f, 0.99156189f, 0.999155104f, 0.999915481f, 0.999991536f,
0.136737213f, -0.28134948f, 0.16996716f, 0.903590262f, 0.990216017f, 0.999020159f, 0.99990201f, 0.999990225f,
-0.759687901f, 0.0310223512f, 0.070737198f, 0.889593601f, 0.988771081f, 0.998875201f, 0.999887526f, 0.999988735f,
-0.957659483f, 0.340318173f, -0.0291995462f, 0.87470746f, 0.987227261f, 0.998720288f, 0.999872029f, 0.999987185f,
-0.275163352f, 0.615864813f, -0.128844544f, 0.858946681f, 0.985584795f, 0.998555362f, 0.999855518f, 0.999985576f,
0.660316706f, 0.830336154f, -0.227202162f, 0.842327058f, 0.983843684f, 0.998380423f, 0.999837995f, 0.999983788f,
0.988704622f, 0.962463796f, -0.323289543f, 0.824865162f, 0.982004225f, 0.998195529f, 0.999819517f, 0.99998194f,
0.408082068f, 0.999144375f, -0.416146845f, 0.806578457f, 0.980066597f, 0.998000681f, 0.999800026f, 0.999979973f,
-0.547729254f, 0.936740458f, -0.504846215f, 0.787485182f, 0.97803092f, 0.99779582f, 0.999779522f, 0.999977946f,
-0.99996084f, 0.781440377f, -0.588501155f, 0.767604589f, 0.975897431f, 0.997581005f, 0.999758005f, 0.999975801f,
-0.53283304f, 0.548645258f, -0.666275978f, 0.746956408f, 0.97366637f, 0.997356176f, 0.999735534f, 0.999973536f,
0.424179018f, 0.261441678f, -0.737393796f, 0.725561321f, 0.971337974f, 0.997121394f, 0.99971199f, 0.999971211f,
0.991202831f, -0.0516893305f, -0.801143587f, 0.703440726f, 0.968912423f, 0.996876657f, 0.999687493f, 0.999968767f,
0.64691931f, -0.359694332f, -0.856888831f, 0.680616796f, 0.966389954f, 0.996621907f, 0.999662042f, 0.999966204f,
-0.292138815f, -0.632028639f, -0.904072165f, 0.6571123f, 0.963770926f, 0.996357203f, 0.999635518f, 0.999963522f,
-0.962605894f, -0.841684937f, -0.942222297f, 0.632950664f, 0.961055458f, 0.996082544f, 0.99960804f, 0.99996078f,
-0.748057544f, -0.967871487f, -0.970958173f, 0.608156204f, 0.958243906f, 0.995797932f, 0.999579549f, 0.999957979f,
0.154251456f, -0.998075247f, -0.989992499f, 0.582753658f, 0.955336511f, 0.995503366f, 0.999550045f, 0.999954998f,
0.914742351f, -0.929300308f, -0.999135137f, 0.556768358f, 0.95233357f, 0.995198846f, 0.999519527f, 0.999951959f,
0.83422339f, -0.768367112f, -0.998294771f, 0.53022635f, 0.949235439f, 0.994884372f, 0.999488056f, 0.9999488f,
-0.0132767474f, -0.531235278f, -0.987479806f, 0.503154159f, 0.946042359f, 0.994559944f, 0.999455571f, 0.999945521f,
-0.848570287f, -0.241421118f, -0.966798186f, 0.475578904f, 0.942754686f, 0.994225562f, 0.999422073f, 0.999942183f,
-0.903692186f, 0.0723346695f, -0.93645668f, 0.447528064f, 0.939372718f, 0.993881226f, 0.999387562f, 0.999938726f,
-0.127963692f, 0.378916174f, -0.896758378f, 0.419029742f, 0.935896814f, 0.993526995f, 0.999352098f, 0.99993521f,
0.765414059f, 0.647921681f, -0.848100007f, 0.39011243f, 0.93232733f, 0.993162811f, 0.99931556f, 0.999931574f,
0.955073655f, 0.852673113f, -0.790967762f, 0.360805035f, 0.928664625f, 0.992788672f, 0.999278069f, 0.999927819f,
0.266642928f, 0.972865343f, -0.72593224f, 0.331136853f, 0.924909055f, 0.99240464f, 0.999239624f, 0.999923944f,
-0.666938066f, 0.996578991f, -0.653643608f, 0.301137596f, 0.921060979f, 0.992010653f, 0.999200106f, 0.999920011f,
-0.987339258f, 0.921462357f, -0.574824035f, 0.270837069f, 0.917120814f, 0.991606772f, 0.999159634f, 0.999915957f,
-0.399985313f, 0.754965365f, -0.490260571f, 0.240265876f, 0.913088918f, 0.991192937f, 0.999118149f, 0.999911785f,
0.555113316f, 0.513598442f, -0.400799006f, 0.209454417f, 0.908965766f, 0.990769207f, 0.999075651f, 0.999907553f,
0.999843299f, 0.221298173f, -0.307332784f, 0.178433523f, 0.904751658f, 0.990335584f, 0.99903214f, 0.999903202f,
0.52532196f, -0.0929481089f, -0.210795805f, 0.147234216f, 0.90044713f, 0.989892066f, 0.998987675f, 0.999898732f,
-0.432177931f, -0.397976756f, -0.112152621f, 0.115887694f, 0.89605248f, 0.989438653f, 0.998942196f, 0.999894202f,
-0.992335498f, -0.663538277f, -0.0123883775f, 0.0844252855f, 0.891568303f, 0.988975346f, 0.998895705f, 0.999889553f,
-0.640144348f, -0.863296509f, 0.0874991715f, 0.0528784581f, 0.886994898f, 0.988502085f, 0.9988482f, 0.999884784f,
0.300592542f, -0.977442741f, 0.18651247f, 0.0212787576f, 0.882332861f, 0.98801899f, 0.998799741f, 0.999879956f,
0.964965999f, -0.994656444f, 0.2836622f, -0.0103422189f, 0.87758255f, 0.987526f, 0.998750269f, 0.999875009f,
0.742154181f, -0.913230121f, 0.377977669f, -0.0419528559f, 0.872744501f, 0.987023175f, 0.998699784f, 0.999869943f,
-0.162990779f, -0.741239965f, 0.468516916f, -0.0735215396f, 0.86781919f, 0.986510456f, 0.998648286f, 0.999864817f,
-0.918282807f, -0.495741814f, 0.554374516f, -0.105016708f, 0.862807095f, 0.985987842f, 0.998595834f, 0.999859571f,
-0.829309821f, -0.201079622f, 0.634692967f, -0.136406869f, 0.857708693f, 0.985455394f, 0.998542368f, 0.999854207f,
0.0221267566f, 0.113521777f, 0.708669782f, -0.167660639f, 0.852524519f, 0.984913111f, 0.99848789f, 0.999848783f,
0.853220105f, 0.416867077f, 0.775565803f, -0.198746875f, 0.847255111f, 0.984360933f, 0.998432398f, 0.99984318f,
0.899866819f, 0.678870201f, 0.834712923f, -0.22963427f, 0.841901004f, 0.983798921f, 0.998375952f, 0.999837577f,
0.119180135f, 0.873550534f, 0.885519624f, -0.260292053f, 0.836462677f, 0.983227074f, 0.998318493f, 0.999831796f,
-0.771080196f, 0.981602073f, 0.927478492f, -0.290689558f, 0.830940723f, 0.982645452f, 0.998260021f, 0.999825954f,
-0.952412963f, 0.992308319f, 0.960170269f, -0.3207964f, 0.825335622f, 0.982053936f, 0.998200536f, 0.999819994f,
-0.258101642f, 0.904607594f, 0.98326844f, -0.350582451f, 0.819648027f, 0.981452644f, 0.998140097f, 0.999813974f,
0.673507154f, 0.727198064f, 0.996542096f, -0.380017966f, 0.813878477f, 0.980841517f, 0.998078644f, 0.999807835f,
0.985896587f, 0.477671444f, 0.999858618f, -0.409073502f, 0.808027506f, 0.980220556f, 0.998016179f, 0.999801576f
};
__device__ const float ROPE_SIN[64][8] = {
0.0f, 0.0f, 0.0f, 0.0f, 0.0f, 0.0f, 0.0f, 0.0f,
0.841470957f, 0.310983598f, 0.0998334214f, 0.0316175036f, 0.00999983307f, 0.00316227227f, 0.000999999931f, 0.000316227757f,
0.909297407f, 0.591127098f, 0.198669329f, 0.0632033944f, 0.0199986659f, 0.00632451288f, 0.0019999987f, 0.000632455456f,
0.141120002f, 0.812648892f, 0.295520216f, 0.0947260857f, 0.0299954992f, 0.00948669016f, 0.0029999956f, 0.000948683126f,
-0.756802499f, 0.953580737f, 0.389418334f, 0.126154065f, 0.0399893336f, 0.0126487734f, 0.00399998948f, 0.00126491068f,
-0.958924294f, 0.999946535f, 0.47942555f, 0.157455876f, 0.0499791652f, 0.0158107281f, 0.0049999794f, 0.00158113812f,
-0.279415488f, 0.947148204f, 0.564642489f, 0.188600272f, 0.0599640049f, 0.0189725272f, 0.0059999642f, 0.00189736532f,
0.656986594f, 0.800421596f, 0.64421767f, 0.219556093f, 0.0699428469f, 0.0221341345f, 0.00699994294f, 0.00221359241f,
0.989358246f, 0.574317753f, 0.717356086f, 0.250292331f, 0.0799146891f, 0.0252955221f, 0.0079999147f, 0.00252981926f,
0.412118495f, 0.291259229f, 0.783326924f, 0.280778319f, 0.0898785442f, 0.0284566563f, 0.00899987947f, 0.00284604589f,
-0.54402113f, -0.0206835698f, 0.841470957f, 0.310983568f, 0.099833414f, 0.0316175036f, 0.009999834f, 0.00316227227f,
-0.999990225f, -0.33057496f, 0.891207397f, 0.340877861f, 0.1097783f, 0.0347780399f, 0.0109997792f, 0.00347849843f,
-0.536572933f, -0.60768342f, 0.932039082f, 0.370431304f, 0.119712204f, 0.0379382223f, 0.0119997123f, 0.00379472389f,
0.420167029f, -0.824528456f, 0.963558197f, 0.399614304f, 0.129634142f, 0.0410980321f, 0.0129996343f, 0.00411094911f,
0.990607381f, -0.959605396f, 0.985449731f, 0.428397775f, 0.139543116f, 0.0442574248f, 0.0139995432f, 0.00442717411f,
0.650287867f, -0.999518692f, 0.997494996f, 0.456752867f, 0.149438128f, 0.0474163815f, 0.0149994381f, 0.00474339863f,
-0.287903309f, -0.940310359f, 0.999573588f, 0.484651238f, 0.159318209f, 0.0505748577f, 0.015999319f, 0.00505962269f,
-0.961397469f, -0.78785187f, 0.991664827f, 0.512064993f, 0.169182345f, 0.0537328273f, 0.0169991814f, 0.00537584582f,
-0.750987232f, -0.557262897f, 0.973847628f, 0.538966715f, 0.179029569f, 0.0568902642f, 0.0179990288f, 0.00569206895f,
0.149877205f, -0.271410108f, 0.946300089f, 0.565329552f, 0.188858896f, 0.060047131f, 0.0189988576f, 0.00600829115f,
0.912945271f, 0.0413582884f, 0.909297407f, 0.591127038f, 0.198669314f, 0.0632033944f, 0.0199986678f, 0.00632451288f,
0.836655617f, 0.35002476f, 0.863209307f, 0.616333544f, 0.208459899f, 0.0663590282f, 0.0209984574f, 0.00664073415f,
-0.00885130931f, 0.623979926f, 0.808496356f, 0.640923738f, 0.218229622f, 0.0695140064f, 0.0219982266f, 0.00695695449f,
-0.846220434f, 0.836055279f, 0.745705247f, 0.664873064f, 0.227977514f, 0.0726682767f, 0.0229979735f, 0.00727317436f,
-0.905578375f, 0.965219259f, 0.67546314f, 0.688157499f, 0.237702623f, 0.0758218244f, 0.0239976961f, 0.0075893933f,
-0.132351756f, 0.998663187f, 0.598472118f, 0.710753918f, 0.247403964f, 0.0789746121f, 0.0249973964f, 0.00790561177f,
0.76255846f, 0.933070183f, 0.515501261f, 0.732639611f, 0.257080555f, 0.0821266174f, 0.0259970706f, 0.00822182931f,
0.956375957f, 0.774945021f, 0.427379847f, 0.753792703f, 0.266731411f, 0.0852777958f, 0.0269967206f, 0.00853804592f,
0.270905793f, 0.539968967f, 0.334988207f, 0.774192095f, 0.276355654f, 0.0884281173f, 0.0279963426f, 0.0088542616f,
-0.663633883f, 0.251445323f, 0.239249229f, 0.793817401f, 0.28595221f, 0.0915775672f, 0.0289959367f, 0.00917047635f,
-0.988031626f, -0.0620148405f, 0.141120002f, 0.812648892f, 0.295520186f, 0.0947260931f, 0.029995501f, 0.00948669016f,
-0.404037654f, -0.369325012f, 0.0415805206f, 0.830667794f, 0.305058628f, 0.0978736654f, 0.0309950355f, 0.00980290305f,
0.551426709f, -0.640009403f, -0.0583741926f, 0.847856104f, 0.314566553f, 0.101020269f, 0.0319945402f, 0.0101191159f,
0.999911845f, -0.847224355f, -0.157745644f, 0.864196658f, 0.324043006f, 0.10416586f, 0.0329940096f, 0.010435327f,
0.529082716f, -0.97042042f, -0.255541205f, 0.879673064f, 0.333487093f, 0.107310407f, 0.0339934528f, 0.010751537f,
-0.428182662f, -0.997380435f, -0.350783229f, 0.894269884f, 0.342897803f, 0.110453881f, 0.034992855f, 0.0110677453f,
-0.991778851f, -0.925431013f, -0.442520559f, 0.907972515f, 0.352274209f, 0.113596253f, 0.0359922275f, 0.0113839535f,
-0.643538117f, -0.761706948f, -0.529836178f, 0.920767248f, 0.361615449f, 0.116737492f, 0.036991559f, 0.0117001599f,
0.296368569f, -0.522444785f, -0.611857831f, 0.932641268f, 0.370920479f, 0.119877554f, 0.0379908569f, 0.0120163653f,
0.963795364f, -0.231372014f, -0.687766254f, 0.943582714f, 0.380188406f, 0.123016424f, 0.0389901139f, 0.0123325698f,
0.745113134f, 0.0826458037f, -0.756802499f, 0.953580678f, 0.389418334f, 0.126154065f, 0.0399893373f, 0.0126487734f,
-0.158622667f, 0.388467699f, -0.818277061f, 0.962625206f, 0.39860931f, 0.129290432f, 0.0409885161f, 0.0129649751f,
-0.916521549f, 0.655764699f, -0.871575892f, 0.970707119f, 0.407760441f, 0.132425532f, 0.0419876575f, 0.0132811759f,
-0.831774771f, 0.858030677f, -0.916166008f, 0.977818429f, 0.416870773f, 0.135559291f, 0.0429867506f, 0.0135973748f,
0.0177019257f, 0.975206196f, -0.951602101f, 0.983951986f, 0.425939471f, 0.138691694f, 0.0439858064f, 0.0139135728f,
0.850903511f, 0.995670974f, -0.977530122f, 0.989101648f, 0.434965521f, 0.141822711f, 0.0449848175f, 0.0142297689f,
0.901788354f, 0.917395473f, -0.993690968f, 0.993262351f, 0.44394809f, 0.144952312f, 0.0459837839f, 0.0145459641f,
0.123573124f, 0.748142362f, -0.999923289f, 0.996429801f, 0.452886283f, 0.148080453f, 0.0469827019f, 0.0148621574f,
-0.768254638f, 0.504697084f, -0.99616462f, 0.99860096f, 0.461779177f, 0.151207119f, 0.0479815714f, 0.0151783489f,
-0.953752637f, 0.211200655f, -0.982452571f, 0.999773562f, 0.470625877f, 0.15433228f, 0.0489803962f, 0.0154945394f,
-0.262374848f, -0.10324046f, -0.958924294f, 0.999946535f, 0.47942555f, 0.157455891f, 0.0499791689f, 0.0158107281f,
0.670229197f, -0.407444149f, -0.925814748f, 0.99911958f, 0.48817724f, 0.160577938f, 0.0509778969f, 0.0161269177f,
0.986627579f, -0.671240151f, -0.883454502f, 0.997293651f, 0.496880114f, 0.163698375f, 0.051976569f, 0.0164431017f,
0.395925164f, -0.868469954f, -0.832267344f, 0.994470477f, 0.505533338f, 0.166817173f, 0.0529751927f, 0.0167592876f,
-0.558789074f, -0.979574919f, -0.772764444f, 0.990652919f, 0.514135957f, 0.169934288f, 0.0539737605f, 0.0170754679f,
-0.999755144f, -0.993535519f, -0.705540299f, 0.985844791f, 0.522687256f, 0.173049718f, 0.0549722798f, 0.01739165f,
-0.521551013f, -0.908967435f, -0.631266713f, 0.980050862f, 0.531186223f, 0.17616342f, 0.0559707358f, 0.0177078284f,
0.436164767f, -0.734258294f, -0.550685287f, 0.973276973f, 0.539632022f, 0.179275364f, 0.0569691435f, 0.0180240069f,
0.992872655f, -0.486733496f, -0.464602023f, 0.965529919f, 0.548023939f, 0.182385504f, 0.0579674877f, 0.0183401816f,
0.636738002f, -0.190938011f, -0.373876572f, 0.956817448f, 0.55636102f, 0.185493827f, 0.0589657798f, 0.0186563563f,
-0.304810613f, 0.12379095f, -0.279415488f, 0.947148204f, 0.564642429f, 0.188600287f, 0.0599640086f, 0.0189725272f,
-0.966117799f, 0.426245421f, -0.182162598f, 0.936531842f, 0.572867453f, 0.191704854f, 0.0609621815f, 0.0192886982f,
-0.739180684f, 0.686427653f, -0.0830891207f, 0.924979091f, 0.581035137f, 0.194807529f, 0.0619602874f, 0.0196048655f,
0.167355701f, 0.878538549f, 0.0168140903f, 0.912501454f, 0.589144766f, 0.197908238f, 0.0629583374f, 0.0199210308f
};

struct Params { const float* in[41]; float* out; unsigned char* ws; };
enum { I_X = 0, I_C, I_CTX, I_CCTX, I_LNG, I_LNB, I_ADAW, I_ADAB, I_WIN, I_LQ1, I_LK1, I_LQ2, I_LK2, I_SUBLN, I_GW2, I_GGB, I_GNG, I_CONV, I_W2, I_W0, I_A2, I_A0, I_G2, I_KK, I_KA, I_RK,
       I_LNXG, I_LNXB, I_WOUT, I_LN1G, I_LN1B, I_RW, I_RB, I_MWG, I_MBG, I_MWU, I_MBU, I_MWD, I_MBD, I_LN2G, I_LN2B };

#define WSP(T, off) ((T*)(p.ws + (off)))
#define SCRP(T, off) ((T*)(p.ws + WS_SCR + (off)))

__device__ __forceinline__ void conv_tile(const float* __restrict__ src, int ld, int nvalid, int k0, int n0, bf16_t* __restrict__ dst, int rs, int ro, LAS float* tile, int tid) {
    {
        const int k = tid >> 3, n8 = (tid & 7) * 8;
        const float* s = src + (size_t)(k0 + k) * ld + n0 + n8;
        f32x4 a[4], b[4];
#pragma unroll
        for (int q = 0; q < 4; ++q) { a[q] = (f32x4){0.f, 0.f, 0.f, 0.f}; b[q] = a[q];
            if (n0 + q * 64 + n8 + 8 <= nvalid) { a[q] = *(const f32x4*)(s + q * 64); b[q] = *(const f32x4*)(s + q * 64 + 4); } }
#pragma unroll
        for (int q = 0; q < 4; ++q) { LAS float* t = tile + k * 261 + q * 65 + n8;
            t[0] = a[q][0]; t[1] = a[q][1]; t[2] = a[q][2]; t[3] = a[q][3]; t[4] = b[q][0]; t[5] = b[q][1]; t[6] = b[q][2]; t[7] = b[q][3]; }
    }
    __syncthreads();
    {
        const int n = tid >> 3, k8 = (tid & 7) * 8;
#pragma unroll
        for (int q = 0; q < 4; ++q) { const LAS float* t = tile + k8 * 261 + q * 65 + n;
            u32x4 o; o.x = pk2(t[0], t[261]); o.y = pk2(t[522], t[783]); o.z = pk2(t[1044], t[1305]); o.w = pk2(t[1566], t[1827]);
            *(u32x4*)(dst + ((size_t)(n0 + q * 64 + n) * rs + ro) * 1024 + k0 + k8) = o; }
    }
    __syncthreads();
}
constexpr int JW_IN = 16 * 14, JW_OUT = 64, JW_LAYER = JW_IN + JW_OUT + 32 * 192, JW_TOTAL = 2 * JW_LAYER, J_MOD = 48;
__device__ __forceinline__ void conv_job(const Params& p, int j, LAS float* tile, int tid) {
    asm volatile("" : "+v"(tid));
    const int l = j / JW_LAYER; int r = j % JW_LAYER;
    if (r < JW_IN) { const int kt = r / 14, nt = r % 14;
        conv_tile(p.in[I_WIN] + (size_t)l * 1024 * DIN, DIN, DIN, kt * 64, nt * 256, WSP(bf16_t, WS_WIN) + (size_t)l * DINP * 1024, 1, 0, tile, tid); return; }
    r -= JW_IN;
    if (r < JW_OUT) { const int kt = r >> 2, nt = r & 3;
        conv_tile(p.in[I_WOUT] + (size_t)l * 1024 * 1024, 1024, 1024, kt * 64, nt * 256, WSP(bf16_t, WS_WOUT) + (size_t)l * 1024 * 1024, 1, 0, tile, tid); return; }
    r -= JW_OUT;
    const int e = r / 192, q = r % 192, which = q >> 6, t = q & 63, kt = t >> 2, nt = t & 3;
    const size_t eo = (size_t)(l * 32 + e) * 1024 * 1024;
    if (which == 0) conv_tile(p.in[I_MWG] + eo, 1024, 1024, kt * 64, nt * 256, WSP(bf16_t, WS_WGU) + 2 * eo, 2, 0, tile, tid);
    else if (which == 1) conv_tile(p.in[I_MWU] + eo, 1024, 1024, kt * 64, nt * 256, WSP(bf16_t, WS_WGU) + 2 * eo, 2, 1, tile, tid);
    else conv_tile(p.in[I_MWD] + eo, 1024, 1024, kt * 64, nt * 256, WSP(bf16_t, WS_WDN) + eo, 1, 0, tile, tid);
}
__device__ __forceinline__ void mod_job(const Params& p, int job, LAS float* lds, int tid) {
    asm volatile("" : "+v"(tid));
    const int l = job / 24, c0 = (job % 24) * 256;
    LAS float* sv = lds;
    LAS float* part = lds + 5120;
    for (int i = tid; i < 5120; i += NTHR) { const int s = i >> 10, k = i & 1023; const float cv = s < 4 ? p.in[I_C][s * 1024 + k] : p.in[I_CCTX][k]; sv[i] = siluf_(cv); }
    __syncthreads();
    const int n = tid & 255, kh = tid >> 8;
    const float* w = p.in[I_ADAW] + (size_t)l * 1024 * 6144 + (size_t)(kh * 512) * 6144 + c0 + n;
    float a0 = 0.f, a1 = 0.f, a2 = 0.f, a3 = 0.f, a4 = 0.f;
    const LAS float* s0 = sv + kh * 512;
#pragma unroll 8
    for (int k = 0; k < 512; ++k) { const float wv = w[(size_t)k * 6144];
        a0 += s0[k] * wv; a1 += s0[1024 + k] * wv; a2 += s0[2048 + k] * wv; a3 += s0[3072 + k] * wv; a4 += s0[4096 + k] * wv; }
    part[(kh * 5 + 0) * 256 + n] = a0; part[(kh * 5 + 1) * 256 + n] = a1; part[(kh * 5 + 2) * 256 + n] = a2; part[(kh * 5 + 3) * 256 + n] = a3; part[(kh * 5 + 4) * 256 + n] = a4;
    __syncthreads();
    if (kh == 0) { const float bb = p.in[I_ADAB][l * 6144 + c0 + n]; float* mo = WSP(float, WS_MOD);
#pragma unroll
        for (int s = 0; s < 5; ++s) mo[(size_t)(l * 5 + s) * 6144 + c0 + n] = part[s * 256 + n] + part[(5 + s) * 256 + n] + bb; }
    __syncthreads();
}

__device__ __forceinline__ void ln_in_rows(const Params& p, int gw, int ngw, int lane) {
    float* H = WSP(float, WS_H); bf16_t* XM = WSP(bf16_t, WS_XM); const float* MOD = WSP(float, WS_MOD);
    for (int row = gw; row < NTOK; row += ngw) {
        const float* src = row < NLAT ? p.in[I_X] + (size_t)row * D : p.in[I_CTX] + (size_t)(row - NLAT) * D;
        f32x4 v[4]; float s = 0.f;
#pragma unroll
        for (int j = 0; j < 4; ++j) { v[j] = *(const f32x4*)(src + lane * 4 + 256 * j); s += (v[j][0] + v[j][1]) + (v[j][2] + v[j][3]); }
        const float mean = wave_sum(s) * (1.f / D); float s2 = 0.f;
#pragma unroll
        for (int j = 0; j < 4; ++j) { v[j] = v[j] - mean; s2 += (v[j][0] * v[j][0] + v[j][1] * v[j][1]) + (v[j][2] * v[j][2] + v[j][3] * v[j][3]); }
        const float rstd = rsqrtf(wave_sum(s2) * (1.f / D) + LN_EPS);
        const int sidx = row < NLAT ? (row >> 12) : 4; const float* mod = MOD + (size_t)sidx * 6144;
#pragma unroll
        for (int j = 0; j < 4; ++j) { const int c = lane * 4 + 256 * j;
            const f32x4 g = *(const f32x4*)(p.in[I_LNG] + c), bb = *(const f32x4*)(p.in[I_LNB] + c);
            const f32x4 y = v[j] * rstd * g + bb;
            *(f32x4*)(H + (size_t)row * D + c) = y;
            const f32x4 sh = *(const f32x4*)(mod + c), sc = *(const f32x4*)(mod + 1024 + c);
            const f32x4 xm = y * (sc + 1.f) + sh;
            u32x2 o; o.x = pk2(xm[0], xm[1]); o.y = pk2(xm[2], xm[3]);
            *(u32x2*)(XM + (size_t)row * D + c) = o; }
    }
}

__device__ __forceinline__ void unpack8(const u32x4 u, float (&f)[8]) {
    f[0] = bflo(u.x); f[1] = bfhi(u.x); f[2] = bflo(u.y); f[3] = bfhi(u.y); f[4] = bflo(u.z); f[5] = bfhi(u.z); f[6] = bflo(u.w); f[7] = bfhi(u.w);
}
__device__ __forceinline__ void da_job(const Params& p, int l, int b, int kt, LAS unsigned char* lds, int tid) {
    asm volatile("" : "+v"(tid));
    LAS bf16_t* kvt = (LAS bf16_t*)lds;
    const bf16_t* Z = WSP(bf16_t, WS_Z);
    const bool isctx = kt < 8;
    const int rowb = isctx ? NLAT + b * 256 + kt * 32 : b * 4096 + (kt - 8) * 32;
    for (int i = tid; i < 2048; i += NTHR) { const int r = i >> 6, c16 = i & 63;
        *(LAS u32x4*)(kvt + r * 512 + c16 * 8) = *(const u32x4*)(Z + (size_t)(rowb + r) * DINP + ZK + c16 * 8); }
    __syncthreads();
    const int w = tid >> 6, L = tid & 63, fr = L & 15, fq = L >> 4;
    unsigned char* rec = SCRP(unsigned char, SC_KVREC);
    unsigned* kmax = WSP(unsigned, WS_CTL) + CW_KMAX + l * 32;
    for (int h = 0; h < 4; ++h) {
        u32x4 o;
        if (w < 4) {
            const int m = w >> 1, ks = w & 1, key = ks * 16 + fr;
            float ov[8], pv[8];
            unpack8(*(const LAS u32x4*)(kvt + key * 512 + h * 64 + m * 32 + fq * 8), ov);
            unpack8(*(const LAS u32x4*)(kvt + key * 512 + h * 64 + m * 32 + (fq ^ 1) * 8), pv);
            if (!isctx) {
                const int t = (kt - 8) * 32 + key, pos = (fq >> 1) ? (t & 63) : (t >> 6);
                const float sg = (fq & 1) ? 1.f : -1.f;
#pragma unroll
                for (int i = 0; i < 8; ++i) ov[i] = ov[i] * ROPE_COS[pos][i] + sg * pv[i] * ROPE_SIN[pos][i];
            }
            o.x = pk2(ov[0], ov[1]); o.y = pk2(ov[2], ov[3]); o.z = pk2(ov[4], ov[5]); o.w = pk2(ov[6], ov[7]);
            float rv[8]; unpack8(o, rv); float n2 = 0.f;
#pragma unroll
            for (int i = 0; i < 8; ++i) n2 += rv[i] * rv[i];
            n2 += __shfl_xor(n2, 16); n2 += __shfl_xor(n2, 32);
#pragma unroll
            for (int x = 1; x < 16; x <<= 1) n2 = fmaxf(n2, __shfl_xor(n2, x));
            if (L == 0) { unsigned* kp = kmax + (b * 4 + h) * 2 + m; const unsigned nb = __builtin_bit_cast(unsigned, n2);
                if (nb > __hip_atomic_load(kp, __ATOMIC_RELAXED, __HIP_MEMORY_SCOPE_AGENT)) atomicMax(kp, nb); }
        } else {
            const int et = w - 4; unsigned short vv[8];
#pragma unroll
            for (int i = 0; i < 8; ++i) { const int key = (i < 4) ? fq * 4 + i : 16 + fq * 4 + (i - 4); vv[i] = kvt[key * 512 + 256 + h * 64 + et * 16 + fr]; }
            o.x = vv[0] | ((unsigned)vv[1] << 16); o.y = vv[2] | ((unsigned)vv[3] << 16); o.z = vv[4] | ((unsigned)vv[5] << 16); o.w = vv[6] | ((unsigned)vv[7] << 16);
        }
        *(u32x4*)(rec + ((size_t)((b * 4 + h) * NKT + kt)) * 8192 + w * 1024 + L * 16) = o;
    }
    __syncthreads();
}

__device__ __forceinline__ int chunk_row0(int cid) { return cid < 256 ? (cid >> 6) * 4096 + (cid & 63) * 64 : NLAT + ((cid - 256) >> 2) * 256 + ((cid - 256) & 3) * 64; }

constexpr int GLA_HL = 43264;
__device__ __forceinline__ void gla_job(const Params& p, int l, int cid, int hb, LAS unsigned char* lds, int tid) {
    asm volatile("" : "+v"(tid));
    const int r0 = chunk_row0(cid), w = tid >> 6, lane = tid & 63, fr = lane & 15, fq = lane >> 4;
    const bf16_t* Z = WSP(bf16_t, WS_Z);
#define GLA_PTRS(hh) LAS float* gi = (LAS float*)(lds + (hh) * GLA_HL); LAS float* GT = gi + 2048; LAS bf16_t* KDT = (LAS bf16_t*)(GT + 2 * 32 * 65); LAS bf16_t* Vt = KDT + 2 * 32 * 72; (void)gi; (void)GT; (void)KDT; (void)Vt;
#pragma unroll 1
    for (int hh = 0; hh < 3; ++hh) { const int h = hb + hh; GLA_PTRS(hh)
        if (tid < 256) { const int pp = tid >> 2, k8 = (tid & 3) * 8; float v[8]; unpack8(*(const u32x4*)(Z + (size_t)(r0 + pp) * DINP + ZGF + k8), v);
            *(LAS f32x4*)(gi + pp * 32 + k8) = (f32x4){v[0], v[1], v[2], v[3]}; *(LAS f32x4*)(gi + pp * 32 + k8 + 4) = (f32x4){v[4], v[5], v[6], v[7]}; }
        { const int pp = tid >> 3, v8 = (tid & 7) * 8; const u32x4 u = *(const u32x4*)(Z + (size_t)(r0 + pp) * DINP + ZGV + h * 64 + v8);
          Vt[(v8 + 0) * 72 + pp] = (bf16_t)(u.x & 0xffffu); Vt[(v8 + 1) * 72 + pp] = (bf16_t)(u.x >> 16); Vt[(v8 + 2) * 72 + pp] = (bf16_t)(u.y & 0xffffu); Vt[(v8 + 3) * 72 + pp] = (bf16_t)(u.y >> 16);
          Vt[(v8 + 4) * 72 + pp] = (bf16_t)(u.z & 0xffffu); Vt[(v8 + 5) * 72 + pp] = (bf16_t)(u.z >> 16); Vt[(v8 + 6) * 72 + pp] = (bf16_t)(u.w & 0xffffu); Vt[(v8 + 7) * 72 + pp] = (bf16_t)(u.w >> 16); } }
    LAS float* gwl = (LAS float*)(lds + 3 * GLA_HL);
    for (int i = tid; i < 2 * 17 * 96; i += NTHR) { const int dir = i / (17 * 96), r = (i / 96) % 17, c = i % 96;
        gwl[i] = r < 16 ? p.in[I_GW2][((size_t)(l * 2 + dir) * 16 + r) * 192 + hb * 32 + c] : p.in[I_GGB][(size_t)(l * 2 + dir) * 192 + hb * 32 + c]; }
    __syncthreads();
#pragma unroll 1
    for (int hh = 0; hh < 3; ++hh) { GLA_PTRS(hh)
#pragma unroll 1
        for (int j = 0; j < 8; ++j) { const int i = tid + NTHR * j, dir = i >> 11, k = (i >> 6) & 31, pp = i & 63;
            float x = gwl[(dir * 17 + 16) * 96 + hh * 32 + k];
#pragma unroll
            for (int jj = 0; jj < 16; ++jj) x += gi[pp * 32 + dir * 16 + jj] * gwl[(dir * 17 + jj) * 96 + hh * 32 + k];
            GT[(dir * 32 + k) * 65 + pp] = (fminf(x, 0.f) - log1pf(__expf(-fabsf(x)))) * (1.f / 16.f); } }
    __syncthreads();
#pragma unroll 1
    for (int hh = 0; hh < 3; ++hh) { GLA_PTRS(hh)
#pragma unroll
        for (int c = 0; c < 8; ++c) { const int col = w * 8 + c, dir = col >> 5, pp = dir ? 63 - lane : lane; float x = GT[col * 65 + pp];
#pragma unroll
            for (int o = 1; o < 64; o <<= 1) { const float y = __shfl_up(x, o); if (lane >= o) x += y; }
            GT[col * 65 + pp] = x; } }
    __syncthreads();
    float* GBF = SCRP(float, SC_GBF); float* GBB = SCRP(float, SC_GBB);
#pragma unroll 1
    for (int hh = 0; hh < 3; ++hh) { const int h = hb + hh; GLA_PTRS(hh)
        for (int i = tid; i < 4096; i += NTHR) { const int dir = i >> 11, pp = (i >> 5) & 63, k = i & 31; const float bb = GT[(dir * 32 + k) * 65 + pp];
            (dir ? GBB : GBF)[(size_t)(r0 + pp) * 192 + h * 32 + k] = bb;
            const float kk = bf2f(Z[(size_t)(r0 + pp) * DINP + ZGK + h * 32 + k]);
            KDT[(dir * 32 + k) * 72 + pp] = (bf16_t)f2bf(kk * __expf(GT[(dir * 32 + k) * 65 + (dir ? 0 : 63)] - bb)); } }
    __syncthreads();
    float* KVC = SCRP(float, SC_KVC); float* DC = SCRP(float, SC_DC);
#pragma unroll 1
    for (int hh = 0; hh < 3; ++hh) { const int h = hb + hh; GLA_PTRS(hh)
#pragma unroll
        for (int q = 0; q < 2; ++q) { const int idx = w * 2 + q, dir = idx >> 3, mt = (idx >> 2) & 1, nt = idx & 3;
            f32x4 acc = {0.f, 0.f, 0.f, 0.f};
#pragma unroll
            for (int ks = 0; ks < 2; ++ks) { const bf16x8 a = *(const LAS bf16x8*)(KDT + (dir * 32 + mt * 16 + fr) * 72 + ks * 32 + fq * 8), b = *(const LAS bf16x8*)(Vt + (nt * 16 + fr) * 72 + ks * 32 + fq * 8);
                acc = __builtin_amdgcn_mfma_f32_16x16x32_bf16(a, b, acc, 0, 0, 0); }
            float* dst = KVC + ((size_t)((cid * 6 + h) * 2 + dir)) * 2048;
#pragma unroll
            for (int j = 0; j < 4; ++j) dst[(mt * 16 + fq * 4 + j) * 64 + nt * 16 + fr] = acc[j]; }
        if (tid < 64) { const int dir = tid >> 5, k = tid & 31; DC[((cid * 6 + h) * 2 + dir) * 32 + k] = __expf(GT[(dir * 32 + k) * 65 + (dir ? 0 : 63)]); } }
#undef GLA_PTRS
    __syncthreads();
}

constexpr int SGS = 136;
__device__ __forceinline__ void rw_job(const Params& p, int l, int tt, LAS unsigned char* lds, int tid) {
    asm volatile("" : "+v"(tid));
    const int r0 = tt < 512 ? tt * 32 : NLAT + (tt - 512) * 32;
    const int pos = tt < 512 ? (r0 & 4095) : ((r0 - NLAT) & 255), slen = tt < 512 ? 4096 : 256;
    const bool has_prev = pos > 0, has_next = pos + 32 < slen;
    const bf16_t* Z = WSP(bf16_t, WS_Z);
    LAS bf16_t* rkv = (LAS bf16_t*)lds;
    LAS bf16_t* XW = (LAS bf16_t*)(lds + 78336);
    LAS bf16_t* XG = XW + 4 * 32 * 72;
    for (int i = tid; i < 34 * 144; i += NTHR) { const int rr = i / 144, c16 = i % 144; const bool ok = rr == 0 ? has_prev : (rr == 33 ? has_next : true);
        u32x4 v = {0u, 0u, 0u, 0u}; if (ok) v = *(const u32x4*)(Z + (size_t)(r0 - 1 + rr) * DINP + ZRKV + c16 * 8);
        *(LAS u32x4*)(rkv + rr * 1152 + c16 * 8) = v; }
    for (int i = tid; i < 32 * 48; i += NTHR) { const int t = i / 48, c = (i % 48) * 8; float v[8]; unpack8(*(const u32x4*)(Z + (size_t)(r0 + t) * DINP + ZWF + c), v);
        if (c < 128) {
#pragma unroll
            for (int q = 0; q < 8; ++q) v[q] = tanhf(v[q]); }
        else if (c >= 256) {
#pragma unroll
            for (int q = 0; q < 8; ++q) v[q] = sigmoidf_(v[q]); }
        u32x4 o; o.x = pk2(v[0], v[1]); o.y = pk2(v[2], v[3]); o.z = pk2(v[4], v[5]); o.w = pk2(v[6], v[7]);
        if (c < 256) *(LAS u32x4*)(XW + ((c >> 6) * 32 + t) * 72 + (c & 63)) = o; else *(LAS u32x4*)(XG + t * SGS + (c - 256)) = o; }
    __syncthreads();
    LAS float* PRM = (LAS float*)(XG + 32 * SGS);
    for (int i = tid; i < 16 * 384; i += NTHR) { const int r = i / 384, c = i % 384; float v;
        if (r < 9) v = p.in[I_CONV][(size_t)l * 3 * 1152 + (r % 3) * 1152 + (r / 3) * 384 + c];
        else if (r == 9) v = p.in[I_KK][l * 384 + c]; else if (r == 10) v = p.in[I_KA][l * 384 + c]; else if (r == 11) v = p.in[I_RK][l * 384 + c];
        else if (r < 14) v = p.in[I_W0][(l * 2 + (r - 12)) * 384 + c]; else v = p.in[I_A0][(l * 2 + (r - 14)) * 384 + c];
        PRM[i] = v; }
    __syncthreads();
    const int h = tid >> 6, lane = tid & 63, fr = lane & 15, fq = lane >> 4;
    if (h < 6) {
        const bf16_t* WT = WSP(bf16_t, WS_RWW) + (size_t)l * RWW_LAYER;
        bf16_t* Rg = SCRP(bf16_t, SC_R); bf16_t* KKg = SCRP(bf16_t, SC_KK); bf16_t* Vg = SCRP(bf16_t, SC_V); bf16_t* Gg = SCRP(bf16_t, SC_G); float* BON = SCRP(float, SC_BON);
        bf16_t* BKF = SCRP(bf16_t, SC_BKF); bf16_t* BKB = SCRP(bf16_t, SC_BKB); bf16_t* KMF = SCRP(bf16_t, SC_KMF); bf16_t* KMB = SCRP(bf16_t, SC_KMB);
        float* LWF = SCRP(float, SC_WF); float* LWB = SCRP(float, SC_WB);
#define CONV3(t, off, c, w0, w1, w2) (bf2f(rkv[(t) * 1152 + (off) + (c)]) * (w0) + bf2f(rkv[((t) + 1) * 1152 + (off) + (c)]) * (w1) + bf2f(rkv[((t) + 2) * 1152 + (off) + (c)]) * (w2))
        LAS float* invl = PRM + 16 * 384 + h * 64;
#pragma unroll
        for (int mt = 0; mt < 2; ++mt) { float ss[4] = {0.f, 0.f, 0.f, 0.f};
#pragma unroll
            for (int nt = 0; nt < 4; ++nt) { const int c = h * 64 + nt * 16 + fr; const float ck0 = PRM[3 * 384 + c], ck1 = PRM[4 * 384 + c], ck2 = PRM[5 * 384 + c], kkw = PRM[9 * 384 + c];
#pragma unroll
                for (int j = 0; j < 4; ++j) { const int t = mt * 16 + fq * 4 + j; const float kr = CONV3(t, 384, c, ck0, ck1, ck2) * kkw; ss[j] += kr * kr; } }
#pragma unroll
            for (int j = 0; j < 4; ++j) { const float iv = 1.f / fmaxf(sqrtf(red16(ss[j])), 1e-12f); if (fr == 0) { invl[mt * 16 + fq * 4 + j] = iv; invl[32 + mt * 16 + fq * 4 + j] = 0.f; } } }
#pragma unroll 1
        for (int np = 0; np < 2; ++np) {
            bf16x8 bw[2][4][2], bg[2][4];
#pragma unroll
            for (int q = 0; q < 2; ++q) { const int c = h * 64 + (np * 2 + q) * 16 + fr;
#pragma unroll
                for (int m = 0; m < 4; ++m)
#pragma unroll
                    for (int ks = 0; ks < 2; ++ks) bw[q][m][ks] = *(const bf16x8*)(WT + (size_t)m * 384 * 64 + (size_t)c * 64 + ks * 32 + fq * 8);
#pragma unroll
                for (int ks = 0; ks < 4; ++ks) bg[q][ks] = *(const bf16x8*)(WT + (size_t)4 * 384 * 64 + (size_t)c * 128 + ks * 32 + fq * 8); }
#pragma unroll 1
            for (int mt = 0; mt < 2; ++mt) {
                bf16x8 ax[4][2], ag[4];
#pragma unroll
                for (int m = 0; m < 4; ++m)
#pragma unroll
                    for (int ks = 0; ks < 2; ++ks) ax[m][ks] = *(const LAS bf16x8*)(XW + ((m * 32 + mt * 16 + fr) * 72) + ks * 32 + fq * 8);
#pragma unroll
                for (int ks = 0; ks < 4; ++ks) ag[ks] = *(const LAS bf16x8*)(XG + (mt * 16 + fr) * SGS + ks * 32 + fq * 8);
#pragma unroll
                for (int q = 0; q < 2; ++q) { const int c = h * 64 + (np * 2 + q) * 16 + fr;
                    f32x4 acc[5];
#pragma unroll
                    for (int m = 0; m < 5; ++m) acc[m] = (f32x4){0.f, 0.f, 0.f, 0.f};
#pragma unroll
                    for (int m = 0; m < 4; ++m)
#pragma unroll
                        for (int ks = 0; ks < 2; ++ks) acc[m] = __builtin_amdgcn_mfma_f32_16x16x32_bf16(ax[m][ks], bw[q][m][ks], acc[m], 0, 0, 0);
#pragma unroll
                    for (int ks = 0; ks < 4; ++ks) acc[4] = __builtin_amdgcn_mfma_f32_16x16x32_bf16(ag[ks], bg[q][ks], acc[4], 0, 0, 0);
                    const float cr0 = PRM[c], cr1 = PRM[384 + c], cr2 = PRM[768 + c], ck0 = PRM[3 * 384 + c], ck1 = PRM[4 * 384 + c], ck2 = PRM[5 * 384 + c], cv0 = PRM[6 * 384 + c], cv1 = PRM[7 * 384 + c], cv2 = PRM[8 * 384 + c];
                    const float kkw = PRM[9 * 384 + c], kaw = PRM[10 * 384 + c], rkw = PRM[11 * 384 + c], w0f = PRM[12 * 384 + c], w0b = PRM[13 * 384 + c], a0f = PRM[14 * 384 + c], a0b = PRM[15 * 384 + c];
#pragma unroll
                    for (int j = 0; j < 4; ++j) { const int t = mt * 16 + fq * 4 + j; const size_t o = (size_t)(r0 + t) * 384 + c;
                        const float r = CONV3(t, 0, c, cr0, cr1, cr2), v = CONV3(t, 768, c, cv0, cv1, cv2), k = CONV3(t, 384, c, ck0, ck1, ck2), kkn = k * kkw * invl[t];
                        const float af = sigmoidf_(a0f + acc[2][j]), ab = sigmoidf_(a0b + acc[3][j]);
                        const float kmf = k * (1.f + (af - 1.f) * kaw), kmb = k * (1.f + (ab - 1.f) * kaw);
                        Rg[o] = (bf16_t)f2bf(r); Vg[o] = (bf16_t)f2bf(v); KKg[o] = (bf16_t)f2bf(kkn);
                        BKF[o] = (bf16_t)f2bf(kkn * af); BKB[o] = (bf16_t)f2bf(kkn * ab); KMF[o] = (bf16_t)f2bf(kmf); KMB[o] = (bf16_t)f2bf(kmb);
                        LWF[o] = -0.6065306597f * sigmoidf_(w0f + acc[0][j]); LWB[o] = -0.6065306597f * sigmoidf_(w0b + acc[1][j]);
                        Gg[o] = (bf16_t)f2bf(acc[4][j]);
                        const float bv = red16(r * (kmf + kmb) * rkw); if (fr == 0) invl[32 + t] += bv; } }
            }
        }
        if (lane < 32) BON[(size_t)(r0 + lane) * 8 + h] = invl[32 + lane];
#undef CONV3
    }
    __syncthreads();
}

__device__ __forceinline__ int chain_chunk(int b, int dir, int step) {
    if (step < 4) return 256 + b * 4 + (dir ? 3 - step : step);
    const int cl = step - 4; return b * 64 + (dir ? 63 - cl : cl);
}
__device__ __forceinline__ void g2_job(const Params& p, int job, int tid) {
    asm volatile("" : "+v"(tid));
    const int chain = job >> 2, q = job & 3, b = chain / 12, h = (chain % 12) >> 1, dir = chain & 1, e = q * 512 + tid, k = e >> 6;
    const float* __restrict__ KVC = SCRP(float, SC_KVC); const float* __restrict__ DC = SCRP(float, SC_DC); float* __restrict__ SC = SCRP(float, SC_SC);
    float S = 0.f;
#pragma unroll 1
    for (int s0 = 0; s0 < 68; s0 += 34) {
        float dv[34], kv[34];
#pragma unroll
        for (int u = 0; u < 34; ++u) { const size_t base = (size_t)((chain_chunk(b, dir, s0 + u) * 6 + h) * 2 + dir); dv[u] = DC[base * 32 + k]; kv[u] = KVC[base * 2048 + e]; }
#pragma unroll
        for (int u = 0; u < 34; ++u) { const size_t base = (size_t)((chain_chunk(b, dir, s0 + u) * 6 + h) * 2 + dir); SC[base * 2048 + e] = S; S = S * dv[u] + kv[u]; }
    }
}

__device__ __forceinline__ void scan_job(const Params& p, int chain, int half, LAS unsigned char* lds, int tid) {
    asm volatile("" : "+v"(tid));
    const int b = chain / 12, h = (chain % 12) >> 1, dir = chain & 1;
    const int rl = tid >> 4, kq = tid & 15, vrow = half * 32 + rl, k0 = kq * 4;
    LAS float* buf = (LAS float*)lds;
    const bf16_t* KKg = SCRP(bf16_t, SC_KK); const bf16_t* Rg = SCRP(bf16_t, SC_R); const bf16_t* Vg = SCRP(bf16_t, SC_V);
    const bf16_t* BKg = SCRP(bf16_t, dir ? SC_BKB : SC_BKF); const bf16_t* KMg = SCRP(bf16_t, dir ? SC_KMB : SC_KMF);
    const float* Wg = SCRP(float, dir ? SC_WB : SC_WF); float* Yg = SCRP(float, dir ? SC_YB : SC_YF);
    const int stl = tid >> 4, e4 = (tid & 15) * 4;
    auto blk_row0 = [&](int blk) -> int { const int s = blk * 32;
        if (s < 256) return NLAT + b * 256 + (dir ? 255 - s : s);
        const int t = s - 256; return b * 4096 + (dir ? 4095 - t : t); };
    const int sgn = dir ? -1 : 1;
    u32x2 l_kk, l_bk, l_km, l_r, l_v; f32x4 l_w;
    auto issue = [&](int blk) { const size_t o = (size_t)(blk_row0(blk) + sgn * stl) * 384 + h * 64 + e4;
        l_kk = *(const u32x2*)(KKg + o); l_bk = *(const u32x2*)(BKg + o); l_km = *(const u32x2*)(KMg + o); l_r = *(const u32x2*)(Rg + o); l_v = *(const u32x2*)(Vg + o); l_w = *(const f32x4*)(Wg + o); };
    auto commit = [&](int bi) { LAS float* d = buf + bi * (32 * 384) + stl * 384 + e4;
        *(LAS f32x4*)(d) = (f32x4){bflo(l_kk.x), bfhi(l_kk.x), bflo(l_kk.y), bfhi(l_kk.y)};
        *(LAS f32x4*)(d + 64) = l_w;
        *(LAS f32x4*)(d + 128) = (f32x4){bflo(l_bk.x), bfhi(l_bk.x), bflo(l_bk.y), bfhi(l_bk.y)};
        *(LAS f32x4*)(d + 192) = (f32x4){bflo(l_km.x), bfhi(l_km.x), bflo(l_km.y), bfhi(l_km.y)};
        *(LAS f32x4*)(d + 256) = (f32x4){bflo(l_r.x), bfhi(l_r.x), bflo(l_r.y), bfhi(l_r.y)};
        *(LAS f32x4*)(d + 320) = (f32x4){bflo(l_v.x), bfhi(l_v.x), bflo(l_v.y), bfhi(l_v.y)}; };
    issue(0); commit(0);
    __syncthreads();
    float S0 = 0.f, S1 = 0.f, S2 = 0.f, S3 = 0.f;
#pragma unroll 1
    for (int blk = 0; blk < 136; ++blk) {
        if (blk + 1 < 136) issue(blk + 1);
        const LAS float* cur = buf + (blk & 1) * (32 * 384);
        const int row0 = blk_row0(blk);
#pragma unroll 4
        for (int s = 0; s < 32; ++s) {
            const LAS float* q = cur + s * 384;
            const f32x4 kk = *(const LAS f32x4*)(q + k0), w = *(const LAS f32x4*)(q + 64 + k0), bk = *(const LAS f32x4*)(q + 128 + k0), km = *(const LAS f32x4*)(q + 192 + k0), rr = *(const LAS f32x4*)(q + 256 + k0);
            const float vv = q[320 + vrow];
            float d = (S0 * kk[0] + S1 * kk[1]) + (S2 * kk[2] + S3 * kk[3]);
            d = red16(d);
            const float sa = -d;
            S0 = S0 * w[0] + (sa * bk[0] + vv * km[0]); S1 = S1 * w[1] + (sa * bk[1] + vv * km[1]); S2 = S2 * w[2] + (sa * bk[2] + vv * km[2]); S3 = S3 * w[3] + (sa * bk[3] + vv * km[3]);
            float y = (S0 * rr[0] + S1 * rr[1]) + (S2 * rr[2] + S3 * rr[3]);
            y = red16(y);
            if (kq == 0) Yg[(size_t)(row0 + sgn * s) * 384 + h * 64 + vrow] = y;
        }
        if (blk + 1 < 136) commit((blk + 1) & 1);
        __syncthreads();
    }
}

__device__ __forceinline__ void attn_unit(const Params& p, int l, int b, int h, bool isctx, int qb, LAS unsigned char* lds, int tid) {
    asm volatile("" : "+v"(tid));
    const int w = tid >> 6, L = tid & 63, fr = L & 15, fq = L >> 4;
    const int qrow0 = (isctx ? NLAT + b * 256 : b * 4096) + qb * 256;
    const int nst = isctx ? 2 : 34;
    const unsigned char* rec = SCRP(unsigned char, SC_KVREC) + (size_t)(b * 4 + h) * NKT * 8192;
    const bf16_t* Z = WSP(bf16_t, WS_Z);
    u32x4 ld[4];
#pragma unroll
    for (int q = 0; q < 4; ++q) ld[q] = *(const u32x4*)(rec + q * 8192 + tid * 16);
    float lam;
    { const float* q1 = p.in[I_LQ1] + l * 32; const float* k1 = p.in[I_LK1] + l * 32; const float* q2 = p.in[I_LQ2] + l * 32; const float* k2 = p.in[I_LK2] + l * 32;
      float s1 = 0.f, s2 = 0.f;
      for (int i = 0; i < 32; ++i) { s1 += q1[i] * k1[i]; s2 += q2[i] * k2[i]; }
      const float lam_init = l == 0 ? 0.2f : 0.35550907f;
      lam = __expf(s1) - __expf(s2) + lam_init; }
    asm volatile("" : "+v"(lam));
    const float one_m_li = l == 0 ? 0.8f : 0.64449093f;
    bf16x8 Qb[2][2]; f32x4 cinit[2][2];
    {
        const unsigned* kmax = WSP(unsigned, WS_CTL) + CW_KMAX + l * 32 + (b * 4 + h) * 2;
#pragma unroll
        for (int sub = 0; sub < 2; ++sub) {
            const int row = qrow0 + w * 32 + sub * 16 + fr, tpos = qb * 256 + w * 32 + sub * 16 + fr;
#pragma unroll
            for (int m = 0; m < 2; ++m) {
                float ov[8], pv[8];
                unpack8(*(const u32x4*)(Z + (size_t)row * DINP + ZQ + h * 64 + m * 32 + fq * 8), ov);
                unpack8(*(const u32x4*)(Z + (size_t)row * DINP + ZQ + h * 64 + m * 32 + (fq ^ 1) * 8), pv);
                if (!isctx) {
                    const int pos = (fq >> 1) ? (tpos & 63) : (tpos >> 6); const float sg = (fq & 1) ? 1.f : -1.f;
#pragma unroll
                    for (int i = 0; i < 8; ++i) ov[i] = ov[i] * ROPE_COS[pos][i] + sg * pv[i] * ROPE_SIN[pos][i];
                }
#pragma unroll
                for (int i = 0; i < 8; ++i) ov[i] *= 0.2550348616f;
                u32x4 o; o.x = pk2(ov[0], ov[1]); o.y = pk2(ov[2], ov[3]); o.z = pk2(ov[4], ov[5]); o.w = pk2(ov[6], ov[7]);
                float rv[8]; unpack8(o, rv); float n2 = 0.f;
#pragma unroll
                for (int i = 0; i < 8; ++i) n2 += rv[i] * rv[i];
                n2 += __shfl_xor(n2, 16); n2 += __shfl_xor(n2, 32);
                const float km = __builtin_bit_cast(float, __hip_atomic_load(kmax + m, __ATOMIC_RELAXED, __HIP_MEMORY_SCOPE_AGENT));
                const float mq = sqrtf(n2) * sqrtf(km);
                Qb[sub][m] = __builtin_bit_cast(bf16x8, o);
                cinit[sub][m] = (f32x4){-mq, -mq, -mq, -mq};
            }
        }
    }
#pragma unroll
    for (int q = 0; q < 4; ++q) *(LAS u32x4*)(lds + q * 8192 + tid * 16) = ld[q];
    __syncthreads();
    f32x4 O[2][2][4], Ls[2][2];
#pragma unroll
    for (int sub = 0; sub < 2; ++sub)
#pragma unroll
        for (int m = 0; m < 2; ++m) { Ls[sub][m] = (f32x4){0.f, 0.f, 0.f, 0.f};
#pragma unroll
            for (int et = 0; et < 4; ++et) O[sub][m][et] = (f32x4){0.f, 0.f, 0.f, 0.f}; }
    const bf16x8 ones = __builtin_bit_cast(bf16x8, (u32x4){0x3f803f80u, 0x3f803f80u, 0x3f803f80u, 0x3f803f80u});
#pragma unroll 1
    for (int st = 0; st < nst; ++st) {
        if (st + 1 < nst) {
#pragma unroll
            for (int q = 0; q < 4; ++q) ld[q] = *(const u32x4*)(rec + (size_t)(st + 1) * 32768 + q * 8192 + tid * 16); }
        const LAS unsigned char* cur = lds + (st & 1) * 32768;
#pragma unroll
        for (int hf = 0; hf < 4; ++hf) {
            const LAS unsigned char* rp = cur + hf * 8192 + L * 16;
            bf16x8 vb[4];
#pragma unroll
            for (int et = 0; et < 4; ++et) vb[et] = *(const LAS bf16x8*)(rp + (4 + et) * 1024);
#pragma unroll
            for (int m = 0; m < 2; ++m) {
                const bf16x8 ka0 = *(const LAS bf16x8*)(rp + (m * 2) * 1024), ka1 = *(const LAS bf16x8*)(rp + (m * 2 + 1) * 1024);
#pragma unroll
                for (int sub = 0; sub < 2; ++sub) {
                    const f32x4 s0 = __builtin_amdgcn_mfma_f32_16x16x32_bf16(ka0, Qb[sub][m], cinit[sub][m], 0, 0, 0);
                    const f32x4 s1 = __builtin_amdgcn_mfma_f32_16x16x32_bf16(ka1, Qb[sub][m], cinit[sub][m], 0, 0, 0);
                    float e[8];
#pragma unroll
                    for (int i = 0; i < 4; ++i) { e[i] = __builtin_amdgcn_exp2f(s0[i]); e[4 + i] = __builtin_amdgcn_exp2f(s1[i]); }
                    u32x4 pk; pk.x = pg8::cvt_pk_bf16(e[0], e[1]); pk.y = pg8::cvt_pk_bf16(e[2], e[3]); pk.z = pg8::cvt_pk_bf16(e[4], e[5]); pk.w = pg8::cvt_pk_bf16(e[6], e[7]);
                    const bf16x8 pa = __builtin_bit_cast(bf16x8, pk);
                    Ls[sub][m] = __builtin_amdgcn_mfma_f32_16x16x32_bf16(pa, ones, Ls[sub][m], 0, 0, 0);
#pragma unroll
                    for (int et = 0; et < 4; ++et) O[sub][m][et] = __builtin_amdgcn_mfma_f32_16x16x32_bf16(pa, vb[et], O[sub][m][et], 0, 0, 0);
                }
            }
        }
        if (st + 1 < nst) { LAS unsigned char* nb = lds + ((st + 1) & 1) * 32768;
#pragma unroll
            for (int q = 0; q < 4; ++q) *(LAS u32x4*)(nb + q * 8192 + tid * 16) = ld[q]; }
        __syncthreads();
    }
    const float* sg = p.in[I_SUBLN] + l * 64; bf16_t* CAT = WSP(bf16_t, WS_CAT);
#pragma unroll
    for (int sub = 0; sub < 2; ++sub)
#pragma unroll
        for (int j = 0; j < 4; ++j) {
            const float i0 = 1.f / Ls[sub][0][j], i1 = lam / Ls[sub][1][j];
            float ov[4], ss = 0.f;
#pragma unroll
            for (int et = 0; et < 4; ++et) { ov[et] = O[sub][0][et][j] * i0 - O[sub][1][et][j] * i1; ss += ov[et] * ov[et]; }
#pragma unroll
            for (int x = 1; x < 16; x <<= 1) ss += __shfl_xor(ss, x);
            const float rs = rsqrtf(ss * (1.f / 64.f) + LN_EPS) * one_m_li;
            const size_t ro = (size_t)(qrow0 + w * 32 + sub * 16 + fq * 4 + j) * D + h * 64;
#pragma unroll
            for (int et = 0; et < 4; ++et) CAT[ro + et * 16 + fr] = (bf16_t)f2bf(ov[et] * rs * sg[et * 16 + fr]);
        }
    __syncthreads();
}

constexpr int LS4 = 40;
__device__ __forceinline__ f32x4 mfma_k32(const LAS bf16_t* A, const LAS bf16_t* B, int mt, int nt, int fr, int fq, f32x4 acc) {
    const bf16x8 a = *(const LAS bf16x8*)(A + (mt * 16 + fr) * LS4 + fq * 8), b = *(const LAS bf16x8*)(B + (nt * 16 + fr) * LS4 + fq * 8);
    return __builtin_amdgcn_mfma_f32_16x16x32_bf16(a, b, acc, 0, 0, 0);
}
__device__ __forceinline__ void g3_job(const Params& p, int l, int cid, int h, LAS unsigned char* lds, int tid) {
    asm volatile("" : "+v"(tid));
    const int r0 = chunk_row0(cid), w = tid >> 6, lane = tid & 63, fr = lane & 15, fq = lane >> 4;
    const bf16_t* Z = WSP(bf16_t, WS_Z);
    LAS bf16_t* QF = (LAS bf16_t*)lds;
    LAS bf16_t* KF = QF + 64 * LS4;  LAS bf16_t* QB = KF + 64 * LS4;  LAS bf16_t* KB = QB + 64 * LS4;
    LAS bf16_t* SFt = KB + 64 * LS4; LAS bf16_t* SBt = SFt + 64 * LS4;
    LAS bf16_t* Vt = SBt + 64 * LS4;
    LAS bf16_t* AT = Vt + 64 * 72;
    LAS f32x4* xb = (LAS f32x4*)(AT + 64 * 72);
    const float* GBF = SCRP(float, SC_GBF); const float* GBB = SCRP(float, SC_GBB); const float* SC = SCRP(float, SC_SC);
    for (int i = tid; i < 2048; i += NTHR) { const int pp = i >> 5, k = i & 31; const size_t zr = (size_t)(r0 + pp) * DINP;
        const float q = bf2f(Z[zr + ZGQ + h * 32 + k]) * 0.17677669529f, kk = bf2f(Z[zr + ZGK + h * 32 + k]);
        const float bf = GBF[(size_t)(r0 + pp) * 192 + h * 32 + k], bb = GBB[(size_t)(r0 + pp) * 192 + h * 32 + k];
        QF[pp * LS4 + k] = (bf16_t)f2bf(q * __expf(bf)); KF[pp * LS4 + k] = (bf16_t)f2bf(kk * __expf(-bf)); QB[pp * LS4 + k] = (bf16_t)f2bf(q * __expf(bb)); KB[pp * LS4 + k] = (bf16_t)f2bf(kk * __expf(-bb)); }
    { const int pp = tid >> 3, v8 = (tid & 7) * 8; const u32x4 u = *(const u32x4*)(Z + (size_t)(r0 + pp) * DINP + ZGV + h * 64 + v8);
      Vt[(v8 + 0) * 72 + pp] = (bf16_t)(u.x & 0xffffu); Vt[(v8 + 1) * 72 + pp] = (bf16_t)(u.x >> 16); Vt[(v8 + 2) * 72 + pp] = (bf16_t)(u.y & 0xffffu); Vt[(v8 + 3) * 72 + pp] = (bf16_t)(u.y >> 16);
      Vt[(v8 + 4) * 72 + pp] = (bf16_t)(u.z & 0xffffu); Vt[(v8 + 5) * 72 + pp] = (bf16_t)(u.z >> 16); Vt[(v8 + 6) * 72 + pp] = (bf16_t)(u.w & 0xffffu); Vt[(v8 + 7) * 72 + pp] = (bf16_t)(u.w >> 16); }
    for (int i = tid; i < 2048; i += NTHR) { const int k = i >> 6, v = i & 63;
        SFt[v * LS4 + k] = (bf16_t)f2bf(SC[((size_t)((cid * 6 + h) * 2 + 0)) * 2048 + i]); SBt[v * LS4 + k] = (bf16_t)f2bf(SC[((size_t)((cid * 6 + h) * 2 + 1)) * 2048 + i]); }
    __syncthreads();
#pragma unroll
    for (int q = 0; q < 2; ++q) { const int idx = w * 2 + q, mt = idx >> 2, nt = idx & 3;
        f32x4 af = {0.f, 0.f, 0.f, 0.f}, ab = {0.f, 0.f, 0.f, 0.f};
        if (nt <= mt) af = mfma_k32(QF, KF, mt, nt, fr, fq, af);
        if (nt >= mt) ab = mfma_k32(QB, KB, mt, nt, fr, fq, ab);
#pragma unroll
        for (int j = 0; j < 4; ++j) { const int tt = mt * 16 + fq * 4 + j, ss = nt * 16 + fr;
            AT[tt * 72 + ss] = (bf16_t)f2bf((ss <= tt ? af[j] : 0.f) + (ss >= tt ? ab[j] : 0.f)); } }
    __syncthreads();
    const int mt = w & 3;
    f32x4 acc[4];
#pragma unroll
    for (int nt = 0; nt < 4; ++nt) { acc[nt] = (f32x4){0.f, 0.f, 0.f, 0.f};
        if (w < 4) {
#pragma unroll
            for (int ks = 0; ks < 2; ++ks) { const bf16x8 a = *(const LAS bf16x8*)(AT + (mt * 16 + fr) * 72 + ks * 32 + fq * 8), b = *(const LAS bf16x8*)(Vt + (nt * 16 + fr) * 72 + ks * 32 + fq * 8);
                acc[nt] = __builtin_amdgcn_mfma_f32_16x16x32_bf16(a, b, acc[nt], 0, 0, 0); } }
        else { acc[nt] = mfma_k32(QF, SFt, mt, nt, fr, fq, acc[nt]); acc[nt] = mfma_k32(QB, SBt, mt, nt, fr, fq, acc[nt]); xb[(mt * 4 + nt) * 64 + lane] = acc[nt]; } }
    __syncthreads();
    if (w < 4) {
        bf16_t* CAT = WSP(bf16_t, WS_CAT);
#pragma unroll
        for (int nt = 0; nt < 4; ++nt) acc[nt] += xb[(mt * 4 + nt) * 64 + lane];
#pragma unroll
        for (int j = 0; j < 4; ++j) { const int row = r0 + mt * 16 + fq * 4 + j;
            float ss = (acc[0][j] * acc[0][j] + acc[1][j] * acc[1][j]) + (acc[2][j] * acc[2][j] + acc[3][j] * acc[3][j]); ss = red16(ss);
            const float rs = rsqrtf(ss * (1.f / 64.f) + LN_EPS);
#pragma unroll
            for (int nt = 0; nt < 4; ++nt) { const int v = nt * 16 + fr; const float gr = bf2f(Z[(size_t)row * DINP + ZGR + h * 64 + v]);
                CAT[(size_t)row * D + 256 + h * 64 + v] = (bf16_t)f2bf(acc[nt][j] * rs * p.in[I_GNG][l * 64 + v] * siluf_(gr)); } }
    }
    __syncthreads();
}

__device__ __forceinline__ void rw_post(const Params& p, int l, int nrows, int gw, int ngw, int lane) {
    const float* YF = SCRP(float, SC_YF); const float* YB = SCRP(float, SC_YB); const float* BON = SCRP(float, SC_BON);
    const bf16_t* Vg = SCRP(bf16_t, SC_V); const bf16_t* Gg = SCRP(bf16_t, SC_G); bf16_t* CAT = WSP(bf16_t, WS_CAT);
    for (int it = gw; it < nrows * 6; it += ngw) { const int row = it / 6, h = it % 6, c = h * 64 + lane; const size_t o = (size_t)row * 384 + c;
        const float y = YF[o] + YB[o];
        const float mu = wave_sum(y) * (1.f / 64.f); const float dv = y - mu; const float var = wave_sum(dv * dv) * (1.f / 64.f);
        const float yn = dv * rsqrtf(var + RW_GN_EPS) * p.in[I_LNXG][l * 384 + c] + p.in[I_LNXB][l * 384 + c];
        const float outv = (yn + BON[(size_t)row * 8 + h] * bf2f(Vg[o])) * bf2f(Gg[o]);
        CAT[(size_t)row * D + 640 + c] = (bf16_t)f2bf(outv); }
}

constexpr int RA_S = 1032;
__device__ __forceinline__ void ln1_router(const Params& p, int l, int nrows, LAS unsigned char* lds, int tid, int G, int bx, bool dry = false) {
    asm volatile("" : "+v"(tid));
    const int w = tid >> 6, lane = tid & 63, fr = lane & 15, fq = lane >> 4;
    LAS bf16_t* AH = (LAS bf16_t*)lds;
    LAS bf16_t* AL = AH + 16 * RA_S;
    LAS float* part = (LAS float*)(AL + 16 * RA_S);
    LAS float* lgs = part + 8 * 16 * 32;
    LAS unsigned* lcnt = (LAS unsigned*)(lgs + 16 * 32);
    if (tid < 32) lcnt[tid] = 0u;
    float* H = WSP(float, WS_H); bf16_t* XM = WSP(bf16_t, WS_XM); const bf16_t* MIX = WSP(bf16_t, WS_Z); const float* MOD = WSP(float, WS_MOD);
    int* TOPE = WSP(int, WS_TOP); float* TOPG = WSP(float, WS_TOP + TOP_STRIDE); int* TOPR = WSP(int, WS_TOP + 2 * TOP_STRIDE);
    const float* g1p = p.in[I_LN1G] + l * 1024; const float* b1p = p.in[I_LN1B] + l * 1024; const float* rb = p.in[I_RB] + l * 32;
    const bf16_t* RT = WSP(bf16_t, WS_RTW) + (size_t)l * 2 * 32 * 1024;
    bf16x8 bh[4][2], bl[4][2];
#pragma unroll
    for (int ks = 0; ks < 4; ++ks)
#pragma unroll
        for (int nt = 0; nt < 2; ++nt) { const size_t o = (size_t)(nt * 16 + fr) * 1024 + (w * 4 + ks) * 32 + fq * 8; bh[ks][nt] = *(const bf16x8*)(RT + o); bl[ks][nt] = *(const bf16x8*)(RT + 32 * 1024 + o); }
    float alpha = DN_ALPHA; asm volatile("" : "+v"(alpha));
    __syncthreads();
    const int ngroups = nrows >> 4;
    for (int g = bx; g < ngroups; g += G) {
        f32x4 y[2][4]; float s[2] = {0.f, 0.f};
#pragma unroll
        for (int r = 0; r < 2; ++r) { const int row = g * 16 + r * 8 + w; const int sidx = row < NLAT ? (row >> 12) : 4; const float* mod = MOD + (size_t)(l * 5 + sidx) * 6144;
#pragma unroll
            for (int j = 0; j < 4; ++j) { const int c = lane * 4 + 256 * j; const u32x2 mx = *(const u32x2*)(MIX + (size_t)row * D + c);
                y[r][j] = *(const f32x4*)(H + (size_t)row * D + c) * alpha + *(const f32x4*)(mod + 2048 + c) * (f32x4){bflo(mx.x), bfhi(mx.x), bflo(mx.y), bfhi(mx.y)};
                s[r] += (y[r][j][0] + y[r][j][1]) + (y[r][j][2] + y[r][j][3]); } }
#pragma unroll
        for (int r = 0; r < 2; ++r) { const int row = g * 16 + r * 8 + w; const int sidx = row < NLAT ? (row >> 12) : 4; const float* mod = MOD + (size_t)(l * 5 + sidx) * 6144;
            const float mean = wave_sum(s[r]) * (1.f / D); float s2 = 0.f;
#pragma unroll
            for (int j = 0; j < 4; ++j) { y[r][j] = y[r][j] - mean; s2 += (y[r][j][0] * y[r][j][0] + y[r][j][1] * y[r][j][1]) + (y[r][j][2] * y[r][j][2] + y[r][j][3] * y[r][j][3]); }
            const float rstd = rsqrtf(wave_sum(s2) * (1.f / D) + LN_EPS);
#pragma unroll
            for (int j = 0; j < 4; ++j) { const int c = lane * 4 + 256 * j;
                const f32x4 hn = y[r][j] * rstd * *(const f32x4*)(g1p + c) + *(const f32x4*)(b1p + c);
                const f32x4 m = hn * (*(const f32x4*)(mod + 4096 + c) + 1.f) + *(const f32x4*)(mod + 3072 + c);
                if (!dry || m[0] == 123456.789f) { *(f32x4*)(H + (size_t)row * D + c) = hn; u32x2 o; o.x = pk2(m[0], m[1]); o.y = pk2(m[2], m[3]); *(u32x2*)(XM + (size_t)row * D + c) = o; }
                u32x2 hi; hi.x = pk2(m[0], m[1]); hi.y = pk2(m[2], m[3]);
                u32x2 lo; lo.x = pk2(m[0] - bflo(hi.x), m[1] - bfhi(hi.x)); lo.y = pk2(m[2] - bflo(hi.y), m[3] - bfhi(hi.y));
                *(LAS u32x2*)(AH + (r * 8 + w) * RA_S + c) = hi; *(LAS u32x2*)(AL + (r * 8 + w) * RA_S + c) = lo; } }
        __syncthreads();
        {
            f32x4 acc[2] = {{0.f, 0.f, 0.f, 0.f}, {0.f, 0.f, 0.f, 0.f}};
#pragma unroll
            for (int ks = 0; ks < 4; ++ks) { const int ko = fr * RA_S + (w * 4 + ks) * 32 + fq * 8;
                const bf16x8 ah = *(const LAS bf16x8*)(AH + ko), al = *(const LAS bf16x8*)(AL + ko);
#pragma unroll
                for (int nt = 0; nt < 2; ++nt) { acc[nt] = __builtin_amdgcn_mfma_f32_16x16x32_bf16(ah, bh[ks][nt], acc[nt], 0, 0, 0);
                    acc[nt] = __builtin_amdgcn_mfma_f32_16x16x32_bf16(al, bh[ks][nt], acc[nt], 0, 0, 0); acc[nt] = __builtin_amdgcn_mfma_f32_16x16x32_bf16(ah, bl[ks][nt], acc[nt], 0, 0, 0); } }
#pragma unroll
            for (int nt = 0; nt < 2; ++nt)
#pragma unroll
                for (int j = 0; j < 4; ++j) part[(w * 16 + fq * 4 + j) * 32 + nt * 16 + fr] = acc[nt][j];
        }
        __syncthreads();
        { const int rr = lane >> 5, e = lane & 31, rl = rr * 8 + w; float a = rb[e];
#pragma unroll
          for (int ww = 0; ww < 8; ++ww) a += part[(ww * 16 + rl) * 32 + e];
          lgs[rl * 32 + e] = a; }
#pragma unroll
        for (int r = 0; r < 2; ++r) { const int row = g * 16 + r * 8 + w;
            float lg[32];
#pragma unroll
            for (int e4 = 0; e4 < 8; ++e4) { const f32x4 v = *(const LAS f32x4*)(lgs + (r * 8 + w) * 32 + e4 * 4); lg[e4 * 4] = v[0]; lg[e4 * 4 + 1] = v[1]; lg[e4 * 4 + 2] = v[2]; lg[e4 * 4 + 3] = v[3]; }
            float tv[4]; int ti[4];
#pragma unroll
            for (int k = 0; k < 4; ++k) { float best = -3.0e38f; int bi = 0;
#pragma unroll
                for (int e = 0; e < 32; ++e) { if (lg[e] > best) { best = lg[e]; bi = e; } }
                tv[k] = best; ti[k] = bi;
#pragma unroll
                for (int e = 0; e < 32; ++e) lg[e] = (e == bi) ? -3.0e38f : lg[e]; }
            if (lane == 0 && (!dry || tv[0] == 123456.789f)) {
                const float e1 = __expf(tv[1] - tv[0]), e2 = __expf(tv[2] - tv[0]), e3 = __expf(tv[3] - tv[0]); const float inv = 1.f / (1.f + e1 + e2 + e3);
                const float gg[4] = {inv, e1 * inv, e2 * inv, e3 * inv};
#pragma unroll
                for (int k = 0; k < 4; ++k) { TOPE[row * 4 + k] = ti[k]; TOPG[row * 4 + k] = gg[k]; TOPR[row * 4 + k] = (int)atomicAdd((unsigned*)(lcnt + ti[k]), 1u); }
            } }
        __syncthreads();
    }
    __syncthreads();
    if (tid < 32 && !dry) WSP(unsigned, WS_CNTWG)[(size_t)(l * 256 + bx) * 32 + tid] = lcnt[tid];
}

__device__ __forceinline__ int moe_tables(const Params& p, int l, LAS int* tab, LAS int* basew, int G, int tid) {
    const unsigned* cw = WSP(unsigned, WS_CNTWG) + (size_t)l * 256 * 32;
    for (int i = tid; i < G * 32; i += NTHR) basew[i] = (int)cw[i];
    __syncthreads();
    if (tid < 32) { int run = 0; for (int wg = 0; wg < G; ++wg) { const int c = basew[wg * 32 + tid]; basew[wg * 32 + tid] = run; run += c; } tab[32 + tid] = run; }
    __syncthreads();
    if (tid == 0) { int run = 0;
        for (int e = 0; e < 32; ++e) { const int c = tab[32 + e]; tab[e] = run * 256; run += (c + 255) >> 8; tab[64 + e] = run; }
        tab[96] = run; }
    __syncthreads();
    for (int blk = tid; blk < CAP_BLK; blk += NTHR) { int e = 0;
        for (int j = 0; j < 31; ++j) e += (blk >= tab[64 + j]) ? 1 : 0;
        tab[128 + blk] = e; }
    __syncthreads();
    return tab[96];
}

__device__ __forceinline__ void moe_gather(const Params& p, int l, int nrows, LAS int* tab, const LAS int* basew, int gw, int ngw, int lane) {
    const int* TOPE = WSP(int, WS_TOP); const int* TOPR = WSP(int, WS_TOP + 2 * TOP_STRIDE); int* TOPS = WSP(int, WS_TOP + 3 * TOP_STRIDE);
    const bf16_t* XM = WSP(bf16_t, WS_XM); bf16_t* XB = SCRP(bf16_t, SC_XB);
    for (int it = gw; it < nrows * 4; it += ngw) { const int tok = it >> 2, e = TOPE[it], slot = tab[e] + basew[((tok >> 4) % (ngw >> 3)) * 32 + e] + TOPR[it];
        if (lane == 0) TOPS[it] = slot;
        const u32x4* s = (const u32x4*)(XM + (size_t)tok * D); u32x4* d = (u32x4*)(XB + (size_t)slot * D);
        d[lane] = s[lane]; d[64 + lane] = s[64 + lane]; }
}

__device__ __forceinline__ void ln2_rows(const Params& p, int l, int nrows, int gw, int ngw, int lane, bool dry = false) {
    float* H = WSP(float, WS_H); bf16_t* XM = WSP(bf16_t, WS_XM); const bf16_t* YB = SCRP(bf16_t, SC_XB); const float* MOD = WSP(float, WS_MOD);
    const float* TOPG = WSP(float, WS_TOP + TOP_STRIDE); const int* TOPS = WSP(int, WS_TOP + 3 * TOP_STRIDE);
    const float* g2p = p.in[I_LN2G] + l * 1024; const float* b2p = p.in[I_LN2B] + l * 1024;
    float alpha = DN_ALPHA; asm volatile("" : "+v"(alpha));
    for (int row0 = gw * 2; row0 < nrows; row0 += ngw * 2) {
        f32x4 f[2][4], y[2][4]; float s[2] = {0.f, 0.f};
        int slot[2][4]; float gt[2][4];
#pragma unroll
        for (int r = 0; r < 2; ++r)
#pragma unroll
            for (int k = 0; k < 4; ++k) { slot[r][k] = TOPS[(row0 + r) * 4 + k]; gt[r][k] = TOPG[(row0 + r) * 4 + k]; }
#pragma unroll
        for (int r = 0; r < 2; ++r) {
#pragma unroll
            for (int j = 0; j < 4; ++j) f[r][j] = (f32x4){0.f, 0.f, 0.f, 0.f};
#pragma unroll
            for (int k = 0; k < 4; ++k) { const bf16_t* yr = YB + (size_t)slot[r][k] * D;
#pragma unroll
                for (int j = 0; j < 4; ++j) { const u32x2 u = *(const u32x2*)(yr + lane * 4 + 256 * j); f[r][j] += (f32x4){bflo(u.x), bfhi(u.x), bflo(u.y), bfhi(u.y)} * gt[r][k]; } } }
#pragma unroll
        for (int r = 0; r < 2; ++r) { const int row = row0 + r; const int sidx = row < NLAT ? (row >> 12) : 4; const float* mod = MOD + (size_t)(l * 5 + sidx) * 6144;
#pragma unroll
            for (int j = 0; j < 4; ++j) { const int c = lane * 4 + 256 * j; y[r][j] = *(const f32x4*)(H + (size_t)row * D + c) * alpha + *(const f32x4*)(mod + 5120 + c) * f[r][j]; s[r] += (y[r][j][0] + y[r][j][1]) + (y[r][j][2] + y[r][j][3]); } }
#pragma unroll
        for (int r = 0; r < 2; ++r) { const int row = row0 + r; const int sidx = row < NLAT ? (row >> 12) : 4;
            const float mean = wave_sum(s[r]) * (1.f / D); float s2 = 0.f;
#pragma unroll
            for (int j = 0; j < 4; ++j) { y[r][j] = y[r][j] - mean; s2 += (y[r][j][0] * y[r][j][0] + y[r][j][1] * y[r][j][1]) + (y[r][j][2] * y[r][j][2] + y[r][j][3] * y[r][j][3]); }
            const float rstd = rsqrtf(wave_sum(s2) * (1.f / D) + LN_EPS);
#pragma unroll
            for (int j = 0; j < 4; ++j) { const int c = lane * 4 + 256 * j;
                const f32x4 hn = y[r][j] * rstd * *(const f32x4*)(g2p + c) + *(const f32x4*)(b2p + c);
                if (dry && hn[0] != 123456.789f) continue;
                if (l == 0) { *(f32x4*)(H + (size_t)row * D + c) = hn;
                    const float* mod1 = MOD + (size_t)(5 + sidx) * 6144;
                    const f32x4 xm = hn * (*(const f32x4*)(mod1 + 1024 + c) + 1.f) + *(const f32x4*)(mod1 + c);
                    u32x2 o; o.x = pk2(xm[0], xm[1]); o.y = pk2(xm[2], xm[3]); *(u32x2*)(XM + (size_t)row * D + c) = o; }
                else *(f32x4*)(p.out + (size_t)row * D + c) = hn; } }
    }
}

constexpr int LSB = 72;
constexpr size_t RW_REC = 8192;
__device__ __forceinline__ int kperm_lo(int ks, int fq) { return (2 * ks) * 16 + fq * 4; }
__device__ __forceinline__ f32x4 tile_nt(const LAS bf16_t* A, const LAS bf16_t* B, int mt, int nt, int fr, int fq, f32x4 acc) {
#pragma unroll
    for (int ks = 0; ks < 2; ++ks) {
        const bf16x8 a = *(const LAS bf16x8*)(A + (mt * 16 + fr) * LSB + ks * 32 + fq * 8);
        const bf16x8 b = *(const LAS bf16x8*)(B + (nt * 16 + fr) * LSB + ks * 32 + fq * 8);
        acc = __builtin_amdgcn_mfma_f32_16x16x32_bf16(a, b, acc, 0, 0, 0);
    }
    return acc;
}
__device__ __forceinline__ size_t rwa_goff(int unit, int tid) {
    const int cid = unit / 12, h = (unit % 12) >> 1, dir = unit & 1, t = tid >> 3, k8 = (tid & 7) * 8;
    return (size_t)(chunk_row0(cid) + (dir ? 63 - t : t)) * 384 + h * 64 + k8;
}
__device__ __forceinline__ void rwa_job(const Params& p, int unit, int next_unit, bool first, LAS unsigned char* lds, int tid) {
    asm volatile("" : "+v"(tid));
    const int cid = unit / 12, h = (unit % 12) >> 1, dir = unit & 1;
    const int w = tid >> 6, lane = tid & 63, fr = lane & 15, fq = lane >> 4;
    LAS bf16_t* At = (LAS bf16_t*)lds;            LAS bf16_t* Bt = At + 64 * LSB;   LAS bf16_t* Kt = Bt + 64 * LSB;  LAS bf16_t* Rt = Kt + 64 * LSB;
    LAS bf16_t* BHt = Rt + 64 * LSB;              LAS bf16_t* KHt = BHt + 64 * LSB; LAS bf16_t* Vt = KHt + 64 * LSB;
    LAS float* F0 = (LAS float*)(lds + 64512);
    LAS float* PF = (LAS float*)(lds + 81152);
    LAS bf16_t* AAK = (LAS bf16_t*)(lds + 97536);
    LAS bf16_t* ARB = AAK + 64 * LSB;  LAS bf16_t* ARK = ARB + 64 * LSB;
    LAS bf16_t* TAT = ARK + 64 * LSB;  LAS bf16_t* TPT = TAT + 64 * LSB;
    LAS float* gC = (LAS float*)(lds + 143616);
    LAS float* TD = (LAS float*)(lds + 143872);
    LAS bf16_t* ABH = (LAS bf16_t*)(lds + 147968);
    const int t = tid >> 3, k8 = (tid & 7) * 8;
    const size_t go = rwa_goff(unit, tid);
    if (first) { const float* Wg = SCRP(float, dir ? SC_WB : SC_WF); const f32x4 a = *(const f32x4*)(Wg + go), b = *(const f32x4*)(Wg + go + 4);
        F0[(k8 + 0) * 65 + t] = a[0]; F0[(k8 + 1) * 65 + t] = a[1]; F0[(k8 + 2) * 65 + t] = a[2]; F0[(k8 + 3) * 65 + t] = a[3];
        F0[(k8 + 4) * 65 + t] = b[0]; F0[(k8 + 5) * 65 + t] = b[1]; F0[(k8 + 6) * 65 + t] = b[2]; F0[(k8 + 7) * 65 + t] = b[3]; }
    const u32x4 in_kk = *(const u32x4*)(SCRP(bf16_t, SC_KK) + go), in_bk = *(const u32x4*)(SCRP(bf16_t, dir ? SC_BKB : SC_BKF) + go), in_km = *(const u32x4*)(SCRP(bf16_t, dir ? SC_KMB : SC_KMF) + go);
    const u32x4 in_rr = *(const u32x4*)(SCRP(bf16_t, SC_R) + go), in_vv = *(const u32x4*)(SCRP(bf16_t, SC_V) + go);
    __syncthreads();
#pragma unroll
    for (int c = 0; c < 8; ++c) { const int k = w * 8 + c; float x = F0[k * 65 + lane];
#pragma unroll
        for (int o = 1; o < 64; o <<= 1) { const float y = __shfl_up(x, o); if (lane >= o) x += y; }
        F0[k * 65 + lane] = x; }
    __syncthreads();
    {
        float kk[8], bk[8], km[8], rr[8];
        unpack8(in_kk, kk); unpack8(in_bk, bk); unpack8(in_km, km); unpack8(in_rr, rr);
        const u32x4 vraw = in_vv;
        float a_[8], b_[8], k_[8], r_[8];
#pragma unroll
        for (int i = 0; i < 8; ++i) { const float L = F0[(k8 + i) * 65 + t], LC = F0[(k8 + i) * 65 + 63], Lm1 = t > 0 ? F0[(k8 + i) * 65 + t - 1] : 0.f;
            const float eL = __expf(L), eN = __expf(-L), eM = __expf(Lm1), eH = __expf(LC - L);
            a_[i] = -kk[i] * eM; b_[i] = bk[i] * eN; k_[i] = km[i] * eN; r_[i] = rr[i] * eL;
            BHt[(k8 + i) * LSB + t] = (bf16_t)f2bf(bk[i] * eH); KHt[(k8 + i) * LSB + t] = (bf16_t)f2bf(km[i] * eH);
            if (t == 63) gC[k8 + i] = __expf(LC); }
        { u32x4 o; o.x = pk2(a_[0], a_[1]); o.y = pk2(a_[2], a_[3]); o.z = pk2(a_[4], a_[5]); o.w = pk2(a_[6], a_[7]); *(LAS u32x4*)(At + t * LSB + k8) = o; }
        { u32x4 o; o.x = pk2(b_[0], b_[1]); o.y = pk2(b_[2], b_[3]); o.z = pk2(b_[4], b_[5]); o.w = pk2(b_[6], b_[7]); *(LAS u32x4*)(Bt + t * LSB + k8) = o; }
        { u32x4 o; o.x = pk2(k_[0], k_[1]); o.y = pk2(k_[2], k_[3]); o.z = pk2(k_[4], k_[5]); o.w = pk2(k_[6], k_[7]); *(LAS u32x4*)(Kt + t * LSB + k8) = o; }
        { u32x4 o; o.x = pk2(r_[0], r_[1]); o.y = pk2(r_[2], r_[3]); o.z = pk2(r_[4], r_[5]); o.w = pk2(r_[6], r_[7]); *(LAS u32x4*)(Rt + t * LSB + k8) = o; }
        Vt[(k8 + 0) * LSB + t] = (bf16_t)(vraw.x & 0xffffu); Vt[(k8 + 1) * LSB + t] = (bf16_t)(vraw.x >> 16); Vt[(k8 + 2) * LSB + t] = (bf16_t)(vraw.y & 0xffffu); Vt[(k8 + 3) * LSB + t] = (bf16_t)(vraw.y >> 16);
        Vt[(k8 + 4) * LSB + t] = (bf16_t)(vraw.z & 0xffffu); Vt[(k8 + 5) * LSB + t] = (bf16_t)(vraw.z >> 16); Vt[(k8 + 6) * LSB + t] = (bf16_t)(vraw.w & 0xffffu); Vt[(k8 + 7) * LSB + t] = (bf16_t)(vraw.w >> 16);
    }
    __syncthreads();
#pragma unroll 1
    for (int idx = w; idx < 64; idx += 8) { const int pr = idx >> 4, mt = (idx >> 2) & 3, nt = idx & 3;
        f32x4 acc = {0.f, 0.f, 0.f, 0.f};
        if (nt <= mt) acc = tile_nt(pr < 2 ? At : Rt, (pr & 1) ? Kt : Bt, mt, nt, fr, fq, acc);
#pragma unroll
        for (int j = 0; j < 4; ++j) { const int tt = mt * 16 + fq * 4 + j, ss = nt * 16 + fr; const bool keep = pr < 2 ? (ss < tt) : (ss <= tt); const float v = keep ? acc[j] : 0.f;
            if (pr == 0) { F0[tt * 64 + ss] = v; ABH[tt * LSB + ss] = (bf16_t)f2bf(v); } else (pr == 1 ? AAK : (pr == 2 ? ARB : ARK))[tt * LSB + ss] = (bf16_t)f2bf(v); } }
    __syncthreads();
#pragma unroll
    for (int q = 0; q < 2; ++q) { const int idx = w * 2 + q, mt = idx >> 2, nt = idx & 3; f32x4 acc = {0.f, 0.f, 0.f, 0.f};
        acc = tile_nt(AAK, Vt, mt, nt, fr, fq, acc);
#pragma unroll
        for (int j = 0; j < 4; ++j) PF[(mt * 16 + fq * 4 + j) * 64 + nt * 16 + fr] = acc[j]; }
    __syncthreads();
    if (w < 4 && lane < 16) {
        float x[16];
#pragma unroll
        for (int tt = 0; tt < 16; ++tt) { float a0 = (tt == lane) ? 1.f : 0.f;
#pragma unroll
            for (int s2 = 0; s2 < tt; ++s2) a0 += F0[(w * 16 + tt) * 64 + w * 16 + s2] * x[s2];
            x[tt] = a0; TD[(w * 16 + tt) * 16 + lane] = a0; }
    }
    __syncthreads();
    {
        f32x4 X0[4], X[4];
#pragma unroll
        for (int bb = 0; bb < 4; ++bb)
#pragma unroll
            for (int j = 0; j < 4; ++j) { const int tt = bb * 16 + fq * 4 + j; X0[bb][j] = (w < 4) ? bf2f(At[tt * LSB + w * 16 + fr]) : PF[tt * 64 + (w - 4) * 16 + fr]; }
        bf16x8 Tf[4];
#pragma unroll
        for (int bb = 0; bb < 4; ++bb) { const f32x4 tv = *(const LAS f32x4*)(TD + (bb * 16 + fr) * 16 + fq * 4); u32x4 o; o.x = pk2(tv[0], tv[1]); o.y = pk2(tv[2], tv[3]); o.z = 0u; o.w = 0u; Tf[bb] = __builtin_bit_cast(bf16x8, o); }
        const f32x4 zero4 = {0.f, 0.f, 0.f, 0.f};
#pragma unroll
        for (int bb = 0; bb < 4; ++bb) {
            f32x4 rhs = X0[bb];
            if (bb >= 1) {
                const u32x2 a = *(const LAS u32x2*)(ABH + (bb * 16 + fr) * LSB + fq * 4); u32x2 a2 = {0u, 0u};
                if (bb >= 2) a2 = *(const LAS u32x2*)(ABH + (bb * 16 + fr) * LSB + 16 + fq * 4);
                u32x4 af; af.x = a.x; af.y = a.y; af.z = a2.x; af.w = a2.y;
                u32x4 bf; bf.x = pk2(X[0][0], X[0][1]); bf.y = pk2(X[0][2], X[0][3]);
                if (bb >= 2) { bf.z = pk2(X[1][0], X[1][1]); bf.w = pk2(X[1][2], X[1][3]); } else { bf.z = 0u; bf.w = 0u; }
                rhs = __builtin_amdgcn_mfma_f32_16x16x32_bf16(__builtin_bit_cast(bf16x8, af), __builtin_bit_cast(bf16x8, bf), rhs, 0, 0, 0);
            }
            if (bb == 3) {
                const u32x2 a = *(const LAS u32x2*)(ABH + (48 + fr) * LSB + 32 + fq * 4);
                u32x4 af; af.x = a.x; af.y = a.y; af.z = 0u; af.w = 0u;
                u32x4 bf; bf.x = pk2(X[2][0], X[2][1]); bf.y = pk2(X[2][2], X[2][3]); bf.z = 0u; bf.w = 0u;
                rhs = __builtin_amdgcn_mfma_f32_16x16x32_bf16(__builtin_bit_cast(bf16x8, af), __builtin_bit_cast(bf16x8, bf), rhs, 0, 0, 0);
            }
            u32x4 rb; rb.x = pk2(rhs[0], rhs[1]); rb.y = pk2(rhs[2], rhs[3]); rb.z = 0u; rb.w = 0u;
            X[bb] = __builtin_amdgcn_mfma_f32_16x16x32_bf16(Tf[bb], __builtin_bit_cast(bf16x8, rb), zero4, 0, 0, 0);
            LAS bf16_t* dst = ((w < 4) ? TAT : TPT) + ((w & 3) * 16 + fr) * LSB + bb * 16 + fq * 4;
            u32x2 o; o.x = pk2(X[bb][0], X[bb][1]); o.y = pk2(X[bb][2], X[bb][3]); *(LAS u32x2*)dst = o;
        }
    }
    __syncthreads();
    f32x4 nw0 = {0.f, 0.f, 0.f, 0.f}, nw1 = {0.f, 0.f, 0.f, 0.f};
    if (next_unit >= 0) { const float* Wn = SCRP(float, (next_unit & 1) ? SC_WB : SC_WF) + rwa_goff(next_unit, tid); nw0 = *(const f32x4*)Wn; nw1 = *(const f32x4*)(Wn + 4); }
    const size_t u = (size_t)((cid * 6 + h) * 2 + dir);
    LAS bf16_t* SQ = AAK; LAS bf16_t* SM = (LAS bf16_t*)PF; LAS float* SY = F0;
    unsigned char* GREC = p.ws + WS_GREC + u * RW_REC;
#pragma unroll 1
    for (int idx = w; idx < 64; idx += 8) { const int pr = idx >> 4, mt = (idx >> 2) & 3, nt = idx & 3; f32x4 acc = {0.f, 0.f, 0.f, 0.f};
        if (pr == 0) { acc = tile_nt(ARB, TAT, mt, nt, fr, fq, acc);
#pragma unroll
            for (int j = 0; j < 4; ++j) { const int tt = mt * 16 + fq * 4 + j, kk_ = nt * 16 + fr; SQ[tt * LSB + kk_] = (bf16_t)f2bf(acc[j] + bf2f(Rt[tt * LSB + kk_])); } }
        else if (pr == 1) { acc = tile_nt(ARB, TPT, mt, nt, fr, fq, acc); acc = tile_nt(ARK, Vt, mt, nt, fr, fq, acc);
#pragma unroll
            for (int j = 0; j < 4; ++j) SY[(mt * 16 + fq * 4 + j) * 64 + nt * 16 + fr] = acc[j]; }
        else if (pr == 2) { acc = tile_nt(BHt, TAT, mt, nt, fr, fq, acc);
#pragma unroll
            for (int j = 0; j < 4; ++j) { const int k1 = mt * 16 + fq * 4 + j, k2 = nt * 16 + fr; SM[k1 * LSB + k2] = (bf16_t)f2bf(acc[j] + (k1 == k2 ? gC[k1] : 0.f)); } }
        else { acc = tile_nt(BHt, TPT, mt, nt, fr, fq, acc); acc = tile_nt(KHt, Vt, mt, nt, fr, fq, acc);
            u32x2 o; o.x = pk2(acc[0], acc[1]); o.y = pk2(acc[2], acc[3]); *(u32x2*)(GREC + ((mt * 4 + nt) * 64 + lane) * 8) = o; } }
    __syncthreads();
    {
        const int mt = w >> 1, ks = w & 1, row = mt * 16 + fr, rq = dir ? 63 - row : row;
        u32x4 o; { const u32x2 a = *(const LAS u32x2*)(SQ + rq * LSB + kperm_lo(ks, fq)), b = *(const LAS u32x2*)(SQ + rq * LSB + kperm_lo(ks, fq) + 16); o.x = a.x; o.y = a.y; o.z = b.x; o.w = b.y; }
        *(u32x4*)(SCRP(unsigned char, SC_YF) + u * RW_REC + (size_t)(w * 64 + lane) * 16) = o;
        { const u32x2 a = *(const LAS u32x2*)(SM + row * LSB + kperm_lo(ks, fq)), b = *(const LAS u32x2*)(SM + row * LSB + kperm_lo(ks, fq) + 16); o.x = a.x; o.y = a.y; o.z = b.x; o.w = b.y; }
        *(u32x4*)(p.ws + WS_MREC + u * RW_REC + (size_t)(w * 64 + lane) * 16) = o;
#pragma unroll
        for (int q = 0; q < 2; ++q) { const int tl = w * 2 + q, mt2 = tl >> 2, nt2 = tl & 3; float yv[4];
#pragma unroll
            for (int j = 0; j < 4; ++j) { const int to = mt2 * 16 + fq * 4 + j; yv[j] = SY[(dir ? 63 - to : to) * 64 + nt2 * 16 + fr]; }
            u32x2 oy; oy.x = pk2(yv[0], yv[1]); oy.y = pk2(yv[2], yv[3]);
            *(u32x2*)(SCRP(unsigned char, SC_YB) + u * RW_REC + (size_t)(tl * 64 + lane) * 8) = oy; }
    }
    __syncthreads();
    if (next_unit >= 0) {
        F0[(k8 + 0) * 65 + t] = nw0[0]; F0[(k8 + 1) * 65 + t] = nw0[1]; F0[(k8 + 2) * 65 + t] = nw0[2]; F0[(k8 + 3) * 65 + t] = nw0[3];
        F0[(k8 + 4) * 65 + t] = nw1[0]; F0[(k8 + 5) * 65 + t] = nw1[1]; F0[(k8 + 6) * 65 + t] = nw1[2]; F0[(k8 + 7) * 65 + t] = nw1[3]; }
}

__device__ __forceinline__ void rwb_job(const Params& p, int chain, int tid) {
    asm volatile("" : "+v"(tid));
    const int b = chain / 12, h = (chain % 12) >> 1, dir = chain & 1, nt = tid >> 6, lane = tid & 63;
    if (nt >= 4) return;
    f32x4 H[4];
#pragma unroll
    for (int mt = 0; mt < 4; ++mt) H[mt] = (f32x4){0.f, 0.f, 0.f, 0.f};
    bf16x8 Mf[4][2]; u32x2 Gf[4];
    auto load = [&](int step) { const size_t u = (size_t)((chain_chunk(b, dir, step) * 6 + h) * 2 + dir);
        const unsigned char* mr = p.ws + WS_MREC + u * RW_REC; const unsigned char* gr = p.ws + WS_GREC + u * RW_REC;
#pragma unroll
        for (int mt = 0; mt < 4; ++mt) { Mf[mt][0] = *(const bf16x8*)(mr + (size_t)((mt * 2) * 64 + lane) * 16); Mf[mt][1] = *(const bf16x8*)(mr + (size_t)((mt * 2 + 1) * 64 + lane) * 16);
            Gf[mt] = *(const u32x2*)(gr + (size_t)((mt * 4 + nt) * 64 + lane) * 8); } };
    load(0);
#pragma unroll 1
    for (int step = 0; step < 68; ++step) {
        const size_t u = (size_t)((chain_chunk(b, dir, step) * 6 + h) * 2 + dir);
        bf16x8 Bh[2], Bl[2];
#pragma unroll
        for (int ks = 0; ks < 2; ++ks) { const f32x4 x0 = H[2 * ks], x1 = H[2 * ks + 1];
            u32x4 hi; hi.x = pk2(x0[0], x0[1]); hi.y = pk2(x0[2], x0[3]); hi.z = pk2(x1[0], x1[1]); hi.w = pk2(x1[2], x1[3]);
            u32x4 lo; lo.x = pk2(x0[0] - bflo(hi.x), x0[1] - bfhi(hi.x)); lo.y = pk2(x0[2] - bflo(hi.y), x0[3] - bfhi(hi.y)); lo.z = pk2(x1[0] - bflo(hi.z), x1[1] - bfhi(hi.z)); lo.w = pk2(x1[2] - bflo(hi.w), x1[3] - bfhi(hi.w));
            Bh[ks] = __builtin_bit_cast(bf16x8, hi); Bl[ks] = __builtin_bit_cast(bf16x8, lo);
            *(u32x4*)(p.ws + WS_XM + u * RW_REC + (size_t)((ks * 4 + nt) * 64 + lane) * 16) = hi; }
        f32x4 acc[4];
#pragma unroll
        for (int mt = 0; mt < 4; ++mt) { acc[mt] = (f32x4){bflo(Gf[mt].x), bfhi(Gf[mt].x), bflo(Gf[mt].y), bfhi(Gf[mt].y)};
#pragma unroll
            for (int ks = 0; ks < 2; ++ks) { acc[mt] = __builtin_amdgcn_mfma_f32_16x16x32_bf16(Mf[mt][ks], Bh[ks], acc[mt], 0, 0, 0); acc[mt] = __builtin_amdgcn_mfma_f32_16x16x32_bf16(Mf[mt][ks], Bl[ks], acc[mt], 0, 0, 0); } }
        if (step + 1 < 68) load(step + 1);
#pragma unroll
        for (int mt = 0; mt < 4; ++mt) H[mt] = acc[mt];
    }
}

__device__ __forceinline__ void rwc_job(const Params& p, int l, int cid, int h, LAS unsigned char* lds, int tid) {
    asm volatile("" : "+v"(tid));
    const int r0 = chunk_row0(cid), w = tid >> 6, lane = tid & 63, fr = lane & 15, fq = lane >> 4, dirw = w >> 2, mt = w & 3;
    const size_t u = (size_t)((cid * 6 + h) * 2 + dirw);
    const unsigned char* qr = SCRP(unsigned char, SC_YF) + u * RW_REC; const unsigned char* yr = SCRP(unsigned char, SC_YB) + u * RW_REC; const unsigned char* hr = p.ws + WS_XM + u * RW_REC;
    const bf16x8 Q0 = *(const bf16x8*)(qr + (size_t)((mt * 2) * 64 + lane) * 16), Q1 = *(const bf16x8*)(qr + (size_t)((mt * 2 + 1) * 64 + lane) * 16);
    f32x4 acc[4];
#pragma unroll
    for (int nt = 0; nt < 4; ++nt) { const u32x2 y0 = *(const u32x2*)(yr + (size_t)((mt * 4 + nt) * 64 + lane) * 8);
        acc[nt] = (f32x4){bflo(y0.x), bfhi(y0.x), bflo(y0.y), bfhi(y0.y)};
        const bf16x8 B0 = *(const bf16x8*)(hr + (size_t)((0 * 4 + nt) * 64 + lane) * 16), B1 = *(const bf16x8*)(hr + (size_t)((1 * 4 + nt) * 64 + lane) * 16);
        acc[nt] = __builtin_amdgcn_mfma_f32_16x16x32_bf16(Q0, B0, acc[nt], 0, 0, 0); acc[nt] = __builtin_amdgcn_mfma_f32_16x16x32_bf16(Q1, B1, acc[nt], 0, 0, 0); }
    LAS f32x4* xb = (LAS f32x4*)lds;
    if (dirw == 1) {
#pragma unroll
        for (int nt = 0; nt < 4; ++nt) xb[(mt * 4 + nt) * 64 + lane] = acc[nt]; }
    __syncthreads();
    if (dirw == 0) {
        const bf16_t* Vg = SCRP(bf16_t, SC_V); const bf16_t* Gg = SCRP(bf16_t, SC_G); const float* BON = SCRP(float, SC_BON); bf16_t* CAT = WSP(bf16_t, WS_CAT);
#pragma unroll
        for (int nt = 0; nt < 4; ++nt) acc[nt] += xb[(mt * 4 + nt) * 64 + lane];
#pragma unroll
        for (int j = 0; j < 4; ++j) { const int row = r0 + mt * 16 + fq * 4 + j;
            float s = (acc[0][j] + acc[1][j]) + (acc[2][j] + acc[3][j]); s = red16(s); const float mu = s * (1.f / 64.f);
            float d0 = acc[0][j] - mu, d1 = acc[1][j] - mu, d2 = acc[2][j] - mu, d3 = acc[3][j] - mu;
            float v2 = (d0 * d0 + d1 * d1) + (d2 * d2 + d3 * d3); v2 = red16(v2); const float rs = rsqrtf(v2 * (1.f / 64.f) + RW_GN_EPS);
            const float bon = BON[(size_t)row * 8 + h];
            const float dd[4] = {d0, d1, d2, d3};
#pragma unroll
            for (int nt = 0; nt < 4; ++nt) { const int c = h * 64 + nt * 16 + fr; const size_t o = (size_t)row * 384 + c;
                const float yn = dd[nt] * rs * p.in[I_LNXG][l * 384 + c] + p.in[I_LNXB][l * 384 + c];
                CAT[(size_t)row * D + 640 + c] = (bf16_t)f2bf((yn + bon * bf2f(Vg[o])) * bf2f(Gg[o])); } }
    }
    __syncthreads();
}

#ifndef PHM
#define PHM 0x3ffff
#endif
#ifndef REPM
#define REPM 0
#endif
#ifndef TPH
#define TPH -1
#endif
#define T_BEGIN(id) do { if (TPH == (id)) tph_t0 = __builtin_amdgcn_s_memrealtime(); } while (0)
#define T_END(id) do { if (TPH == (id)) tph_acc += __builtin_amdgcn_s_memrealtime() - tph_t0; } while (0)
constexpr int LDS_TAB_OFF = 131072;
__device__ __forceinline__ int q_fetch(unsigned* head, int n_all, int& shard, int& left) {
    while (left > 0) { const int c = (int)atomicAdd(head + shard * 64, 1u); const int j = c * 8 + shard; if (j < n_all) return j; shard = (shard + 1) & 7; --left; }
    return n_all;
}
#define QUEUE_LOOP(head, n_all, BODY) do { const bool ldr_ = (wave_s == 0 && lane_id_() == 0); int qs_ = (int)(xb_xcc_id() & 7u), ql_ = 8; \
    if (ldr_) qslot[0] = q_fetch((head), (n_all), qs_, ql_); __syncthreads(); \
    for (int k_ = 0;; ++k_) { const int j = qslot[k_ & 1]; if (j >= (n_all)) break; if (ldr_) qslot[(k_ + 1) & 1] = q_fetch((head), (n_all), qs_, ql_); BODY; __syncthreads(); } } while (0)
#define GRID_BAR() do { unsigned char* w_ = p_arg.ws; asm volatile("" : "+s"(w_)); XcdBarrier b_; b_.bar = (unsigned*)(w_ + WS_CTL) + CW_BAR; b_.x = xb_xcc_id(); b_.st = ctlw; b_.w = wave_s; xcd_barrier(b_); if (REPM & 64) xcd_barrier(b_); } while (0)
#define PHASE_BEGIN_G() Params p = p_arg; asm volatile("" : "+s"(p.ws));
#define PHASE_BEGIN() Params p = p_arg; asm volatile("" : "+s"(p.ws)); \
    int tid = wave_s * 64 + lane_id_(); asm volatile("" : "+v"(tid)); const int lane = tid & 63, gw = bx * 8 + wave_s; (void)lane; (void)gw; (void)p;

__global__ void __launch_bounds__(NTHR, 2) fwd_kernel(Params p_arg) {
    extern __shared__ __attribute__((aligned(16))) unsigned char lds_raw[];
    LAS unsigned char* lds = (LAS unsigned char*)lds_raw;
    const int G = gridDim.x, bx = blockIdx.x, ngw = G * 8;
    const int wave_s = WAVE_ID_SGPR();
    unsigned long long tph_t0 = 0ull, tph_acc = 0ull; (void)tph_t0; (void)tph_acc;
    volatile LAS unsigned* ctlw = (volatile LAS unsigned*)(lds + LDS_CTL_OFF);
    if (wave_s == 0) ctlw[lane_id_()] = 0u;
    __syncthreads();
    { PHASE_BEGIN(); (void)xcd_barrier_post(WSP(unsigned, WS_CTL) + CW_BAR, ctlw, wave_s); }
    volatile LAS int* qslot = (volatile LAS int*)(ctlw + 16);
    LAS int* tab = (LAS int*)(lds + LDS_TAB_OFF);

    T_BEGIN(0);
    for (int rep_ = 0; rep_ < ((REPM & 1) ? 2 : 1); ++rep_)
    { PHASE_BEGIN();
#if PHM & 1
      for (int j = bx; j < J_MOD; j += G) mod_job(p, j, (LAS float*)lds, tid);
#endif
#if PHM & 2
      for (int j = bx; j < JW_TOTAL; j += G) conv_job(p, j, (LAS float*)lds, tid);
#endif
      { bf16_t* wt = WSP(bf16_t, WS_RWW);
        for (int i = bx * NTHR + tid; i < 2 * (int)RWW_LAYER; i += G * NTHR) { const int l = i / (int)RWW_LAYER, r = i % (int)RWW_LAYER; float v;
            if (r < 4 * 384 * 64) { const int m = r / (384 * 64), q = r % (384 * 64), n = q >> 6, k = q & 63;
                v = (m < 2 ? p.in[I_W2] : p.in[I_A2])[((size_t)(l * 2 + (m & 1)) * 64 + k) * 384 + n]; }
            else { const int q = r - 4 * 384 * 64, n = q >> 7, k = q & 127; v = p.in[I_G2][((size_t)l * 128 + k) * 384 + n]; }
            wt[i] = (bf16_t)f2bf(v); } }
      { bf16_t* rt = WSP(bf16_t, WS_RTW);
        for (int i = bx * NTHR + tid; i < 2 * 32 * 1024; i += G * NTHR) { const int l = i >> 15, e = (i >> 10) & 31, k = i & 1023; const float v = p.in[I_RW][((size_t)l * 1024 + k) * 32 + e];
            const unsigned hi = f2bf(v); rt[(size_t)l * 65536 + e * 1024 + k] = (bf16_t)hi; rt[(size_t)l * 65536 + 32768 + e * 1024 + k] = (bf16_t)f2bf(v - __builtin_bit_cast(float, hi << 16)); } }
      float* bgu = WSP(float, WS_BGU);
      for (int i = bx * NTHR + tid; i < 2 * 32 * 2048; i += G * NTHR) { const int le = i >> 11, c = i & 2047; bgu[i] = (c & 1) ? p.in[I_MBU][le * 1024 + (c >> 1)] : p.in[I_MBG][le * 1024 + (c >> 1)]; } }
    GRID_BAR(); T_END(0);
    T_BEGIN(1);
#if PHM & 4
    for (int rep_ = 0; rep_ < ((REPM & 32) ? 2 : 1); ++rep_)
    { PHASE_BEGIN(); ln_in_rows(p, gw, ngw, lane); }
#endif
    GRID_BAR(); T_END(1);

#pragma unroll 1
    for (int l = 0; l < 2; ++l) {
        const int nrows = l == 0 ? NTOK : NLAT;
        T_BEGIN(2);
#if PHM & 8
        for (int rep_ = 0; rep_ < ((REPM & 8) ? 2 : 1); ++rep_)
        { PHASE_BEGIN_G();
          pg8::Gemm g{WSP(bf16_t, WS_XM), WSP(bf16_t, WS_WIN) + (size_t)l * DINP * 1024, NTOK, DINP, 1024};
          pg8::StaticOrder S; S.init(NTOK, DINP, 1024, G, bx);
          pg8::EpiBf16 E{WSP(bf16_t, WS_Z), DINP, nullptr, 0};
          pg8::gemm_phase<pg8::EpiBf16, pg8::StaticOrder>(lds, g, S, E, wave_s); }
#endif
        GRID_BAR(); T_END(2);
        T_BEGIN(3);
        for (int rep_ = 0; rep_ < ((REPM & 2) ? 2 : 1); ++rep_)
        { PHASE_BEGIN();
          unsigned* head = WSP(unsigned, WS_CTL) + CW_QHEAD + (l * 8 + 0 + 4 * rep_) * 512;
          const int n_rw1 = 544, n_rw = n_rw1 * ((REPM & 2048) ? 2 : 1), n_gla1 = NCHUNK * 2, n_gla = n_gla1 * ((REPM & 4096) ? 2 : 1), n_da1 = 4 * NKT, n_da = n_da1 * ((REPM & 8192) ? 2 : 1), n_all = n_rw + n_gla + n_da;
          QUEUE_LOOP(head, n_all, {
              if (j < n_rw) { T_BEGIN(20); rw_job(p, l, j % n_rw1, lds, tid); T_END(20); }
              if (j >= n_rw && j < n_rw + n_gla) { const int q = (j - n_rw) % n_gla1; T_BEGIN(21); gla_job(p, l, q >> 1, (q & 1) * 3, lds, tid); T_END(21); }
              if (j >= n_rw + n_gla) { const int q = (j - n_rw - n_gla) % n_da1; T_BEGIN(22); da_job(p, l, q / NKT, q % NKT, lds, tid); T_END(22); }
          }); }
        GRID_BAR(); T_END(3);
        T_BEGIN(4);
        for (int rep_ = 0; rep_ < ((REPM & 32) ? 2 : 1); ++rep_)
        { PHASE_BEGIN();
          { const int n_u = NCHUNK * 12;
            for (int u = bx; u < n_u; u += G) rwa_job(p, u, (u + G < n_u) ? u + G : -1, u == bx, lds, tid); }
          if (bx >= G - 192) g2_job(p, bx - (G - 192), tid); }
        GRID_BAR(); T_END(4);
        T_BEGIN(5);
        for (int rep_ = 0; rep_ < ((REPM & 4) ? 2 : 1); ++rep_)
        { PHASE_BEGIN();
          unsigned* head = WSP(unsigned, WS_CTL) + CW_QHEAD + (l * 8 + 1 + 4 * rep_) * 512;
          const int n_sc = 48, n_att1 = 256 + (l == 0 ? 16 : 0), n_att = n_att1 * ((REPM & 512) ? 2 : 1), n_g31 = (l == 0 ? NCHUNK : 256) * 6, n_g3 = n_g31 * ((REPM & 1024) ? 2 : 1), n_all = n_sc + n_att + n_g3;
          QUEUE_LOOP(head, n_all, {
              if (j < n_sc) rwb_job(p, j, tid);
              if (j >= n_sc && j < n_sc + n_att) { const int q = (j - n_sc) % n_att1; const bool ic = q >= 256; const int c = q - 256;
                  attn_unit(p, l, ic ? (c >> 2) : (q >> 6), ic ? (c & 3) : ((q >> 4) & 3), ic, ic ? 0 : (q & 15), lds, tid); }
              if (j >= n_sc + n_att) { const int q = (j - n_sc - n_att) % n_g31; g3_job(p, l, q / 6, q % 6, lds, tid); }
          }); }
        GRID_BAR(); T_END(5);
        T_BEGIN(6);
        for (int rep_ = 0; rep_ < ((REPM & 32) ? 2 : 1); ++rep_)
        { PHASE_BEGIN();
          const int n_all = (l == 0 ? NCHUNK : 256) * 6;
          for (int j = bx; j < n_all; j += G) rwc_job(p, l, j / 6, j % 6, lds, tid); }
        GRID_BAR(); T_END(6);
        T_BEGIN(7);
#if PHM & 4096
        for (int rep_ = 0; rep_ < ((REPM & 8) ? 2 : 1); ++rep_)
        { PHASE_BEGIN_G();
          pg8::Gemm g{WSP(bf16_t, WS_CAT), WSP(bf16_t, WS_WOUT) + (size_t)l * 1024 * 1024, nrows, 1024, 1024};
          pg8::StaticOrder S; S.init(nrows, 1024, 1024, G, bx);
          pg8::EpiBf16 E{WSP(bf16_t, WS_Z), 1024, nullptr, 0};
          pg8::gemm_phase<pg8::EpiBf16, pg8::StaticOrder>(lds, g, S, E, wave_s); }
#endif
        GRID_BAR(); T_END(7);
        T_BEGIN(8);
#if PHM & 8192
        for (int rep_ = ((REPM & 128) ? 0 : 1); rep_ < 2; ++rep_)
        { PHASE_BEGIN(); ln1_router(p, l, nrows, lds, tid, G, bx, rep_ == 0); }
#endif
        GRID_BAR(); T_END(8);
        T_BEGIN(9);
        { PHASE_BEGIN();
          moe_tables(p, l, tab, (LAS int*)lds, G, tid);
#if PHM & 16384
          for (int rep_ = 0; rep_ < ((REPM & 32) ? 2 : 1); ++rep_)
          moe_gather(p, l, nrows, tab, (const LAS int*)lds, gw, ngw, lane);
#endif
        }
        GRID_BAR(); T_END(9);
        T_BEGIN(10);
#if PHM & 32768
        for (int rep_ = 0; rep_ < ((REPM & 16) ? 2 : 1); ++rep_)
        { PHASE_BEGIN_G();
          const int nblk = tab[96];
          pg8::Gemm g{SCRP(bf16_t, SC_XB), WSP(bf16_t, WS_WGU) + (size_t)l * 32 * 2048 * 1024, nblk * 256, 2048, 1024};
          pg8::GroupOrder<8> S{G, (G % 8 == 0) ? (bx % 8) * (G / 8) + bx / 8 : bx, nblk, tab + 128};
          pg8::EpiSwiglu E{SCRP(bf16_t, SC_ACT), WSP(float, WS_BGU) + (size_t)l * 32 * 2048};
          pg8::gemm_phase<pg8::EpiSwiglu, pg8::GroupOrder<8>>(lds, g, S, E, wave_s); }
#endif
        GRID_BAR(); T_END(10);
        T_BEGIN(11);
#if PHM & 65536
        for (int rep_ = 0; rep_ < ((REPM & 16) ? 2 : 1); ++rep_)
        { PHASE_BEGIN_G();
          const int nblk = tab[96];
          pg8::Gemm g{SCRP(bf16_t, SC_ACT), WSP(bf16_t, WS_WDN) + (size_t)l * 32 * 1024 * 1024, nblk * 256, 1024, 1024};
          pg8::GroupOrder<4> S{G, (G % 8 == 0) ? (bx % 8) * (G / 8) + bx / 8 : bx, nblk, tab + 128};
          pg8::EpiBf16 E{SCRP(bf16_t, SC_XB), 1024, p.in[I_MBD] + (size_t)l * 32 * 1024, 1024};
          pg8::gemm_phase<pg8::EpiBf16, pg8::GroupOrder<4>>(lds, g, S, E, wave_s); }
#endif
        GRID_BAR(); T_END(11);
        T_BEGIN(12);
#if PHM & 131072
        for (int rep_ = ((REPM & 256) ? 0 : 1); rep_ < 2; ++rep_)
        { PHASE_BEGIN(); ln2_rows(p, l, nrows, gw, ngw, lane, rep_ == 0); }
#endif
        GRID_BAR(); T_END(12);
    }
    if (TPH >= 0 && bx == 0 && wave_s == 0 && lane_id_() == 0) { Params p = p_arg; p.out[0] += (float)tph_acc * 1e-4f; }
}

extern "C" void kernel_launch(void* const* d_in, const int* in_sizes, int n_in, void* d_out, int out_size, void* d_ws, size_t ws_size, hipStream_t stream) {
    (void)in_sizes; (void)n_in; (void)out_size; (void)ws_size;
    static int grid = 0;
    if (!grid) {
        (void)hipFuncSetAttribute((const void*)fwd_kernel, hipFuncAttributeMaxDynamicSharedMemorySize, LDS_BYTES);
        int dev = 0, cus = 0; (void)hipGetDevice(&dev); (void)hipDeviceGetAttribute(&cus, hipDeviceAttributeMultiprocessorCount, dev);
        grid = cus > 0 && cus < 256 ? cus : 256;
    }
    (void)hipMemsetAsync(d_ws, 0, CTL_BYTES, stream);
    Params p{};
    for (int i = 0; i < 41; ++i) p.in[i] = (const float*)d_in[i];
    p.out = (float*)d_out; p.ws = (unsigned char*)d_ws;
    hipLaunchKernelGGL(fwd_kernel, dim3(grid), dim3(NTHR), LDS_BYTES, stream, p);
}
```

```cpp
#include <hip/hip_runtime.h>
#include <cstdint>
#include <cstdio>

#define LAS __attribute__((address_space(3)))
typedef unsigned short bf16_t;
typedef short bf16x8 __attribute__((ext_vector_type(8)));
typedef float f32x4 __attribute__((ext_vector_type(4)));
typedef float f32x2 __attribute__((ext_vector_type(2)));
typedef unsigned u32x4 __attribute__((ext_vector_type(4)));
typedef unsigned u32x2 __attribute__((ext_vector_type(2)));

constexpr int D = 1024, NB = 4, SEQ = 4096, LCX = 256, NLAT = NB * SEQ, NCX = NB * LCX, NTOK = NLAT + NCX;
constexpr int DIN = 3488, DINP = 3584;
constexpr int NE = 32, FF = 1024;
constexpr int CAP_BLK = 304, CAP = CAP_BLK * 256;
constexpr int NTHR = 512;
constexpr int ZQ = 0, ZK = 256, ZV = 512, ZGQ = 768, ZGK = 960, ZGV = 1152, ZGF = 1536, ZGB = 1552, ZGR = 1568, ZRKV = 1952, ZWF = 3104, ZWB = 3168, ZAF = 3232, ZAB = 3296, ZG = 3360;
constexpr int NKT = 136;
constexpr int NCHUNK = 272;
constexpr float LN_EPS = 1e-5f, RW_GN_EPS = 64e-5f;
constexpr float DN_ALPHA = 1.41421356237f;

constexpr size_t MiB = 1u << 20;
constexpr size_t WS_CTL = 0, CTL_BYTES = 1 * MiB;
constexpr size_t WS_MOD = 1 * MiB;
constexpr size_t WS_TOP = 2 * MiB;
constexpr size_t TOP_STRIDE = (size_t)NTOK * 4 * 4;
constexpr size_t WS_CNTWG = 3 * MiB + 768 * 1024;
constexpr size_t WS_RWW = 3 * MiB + 128 * 1024;
constexpr size_t RWW_LAYER = 4 * 384 * 64 + 384 * 128;
static_assert(WS_TOP + 4 * TOP_STRIDE <= WS_RWW && WS_RWW + 2 * RWW_LAYER * 2 <= WS_CNTWG && WS_CNTWG + 2 * 256 * 32 * 4 <= 4 * MiB, "ws map");
constexpr size_t WS_RTW = 4 * MiB + 512 * 1024;
constexpr size_t WS_BGU = 4 * MiB;
constexpr size_t WS_H = 5 * MiB;
constexpr size_t WS_XM = 73 * MiB;
constexpr size_t WS_CAT = 107 * MiB;
constexpr size_t WS_Z = 141 * MiB;
constexpr size_t WS_WIN = 260 * MiB;
constexpr size_t WS_WOUT = 274 * MiB;
constexpr size_t WS_WGU = 278 * MiB;
constexpr size_t WS_WDN = 534 * MiB;
constexpr size_t WS_SCR = 662 * MiB;
constexpr size_t WS_END = 966 * MiB;
constexpr size_t WS_MREC = 966 * MiB, WS_GREC = 992 * MiB, WS_TOTAL = 1018 * MiB;
static_assert(WS_MREC + (size_t)3264 * 8192 <= WS_GREC && WS_GREC + (size_t)3264 * 8192 <= WS_TOTAL && WS_TOTAL <= 1024 * MiB, "ws map");
static_assert(WS_H + (size_t)NTOK * D * 4 <= WS_XM && WS_XM + (size_t)NTOK * D * 2 <= WS_CAT && WS_CAT + (size_t)NTOK * D * 2 <= WS_Z, "ws map");
static_assert(WS_Z + (size_t)NTOK * DINP * 2 <= WS_WIN && WS_WIN + (size_t)2 * DINP * D * 2 <= WS_WOUT && WS_WOUT + (size_t)2 * D * D * 2 <= WS_WGU, "ws map");
static_assert(WS_WGU + (size_t)2 * 32 * 2048 * 1024 * 2 <= WS_WDN && WS_WDN + (size_t)2 * 32 * 1024 * 1024 * 2 <= WS_SCR, "ws map");
constexpr size_t SC_XB = 0, SC_ACT = (size_t)CAP * D * 2;
static_assert(WS_SCR + 2 * SC_ACT <= WS_END, "ws map");
constexpr size_t SZ_T384B = (size_t)NTOK * 384 * 2, SZ_T384F = (size_t)NTOK * 384 * 4, SZ_T192F = (size_t)NTOK * 192 * 4;
constexpr size_t SC_KVREC = 0;
constexpr size_t SC_GBF = SC_KVREC + (size_t)16 * NKT * 8192;
constexpr size_t SC_GBB = SC_GBF + SZ_T192F;
constexpr size_t SC_KVC = SC_GBB + SZ_T192F;
constexpr size_t SZ_KVC = (size_t)NCHUNK * 6 * 2 * 2048 * 4;
constexpr size_t SC_SC = SC_KVC + SZ_KVC;
constexpr size_t SC_DC = SC_SC + SZ_KVC;
constexpr size_t SC_R = SC_DC + (size_t)NCHUNK * 6 * 2 * 32 * 4;
constexpr size_t SC_KK = SC_R + SZ_T384B, SC_V = SC_KK + SZ_T384B, SC_BKF = SC_V + SZ_T384B, SC_BKB = SC_BKF + SZ_T384B, SC_KMF = SC_BKB + SZ_T384B, SC_KMB = SC_KMF + SZ_T384B, SC_G = SC_KMB + SZ_T384B;
constexpr size_t SC_WF = SC_G + SZ_T384B, SC_WB = SC_WF + SZ_T384F, SC_YF = SC_WB + SZ_T384F, SC_YB = SC_YF + SZ_T384F, SC_BON = SC_YB + SZ_T384F;
constexpr size_t SC_MIX_END = SC_BON + (size_t)NTOK * 8 * 4;
static_assert(WS_SCR + SC_MIX_END <= WS_END, "mixer scratch");
constexpr int CW_BAR = 4096, CW_CNT = 8192, CW_QHEAD = 8448  , CW_KMAX = 16896;
static_assert(CW_BAR + 3456 <= CW_CNT && CW_CNT + 128 <= CW_QHEAD && CW_QHEAD + 16 * 512 <= CW_KMAX && (CW_KMAX + 64) * 4 <= (int)CTL_BYTES, "control words");

constexpr int LDS_BYTES = 163840, LDS_CTL_OFF = LDS_BYTES - 256;

__device__ __forceinline__ int lane_id_() { int r; asm volatile("v_mbcnt_lo_u32_b32 %0, -1, 0\n\tv_mbcnt_hi_u32_b32 %0, -1, %0" : "=v"(r)); return r; }
#define WAVE_ID_SGPR() (__builtin_amdgcn_readfirstlane((int)(threadIdx.x >> 6)))

__device__ __forceinline__ unsigned f2bf(float f) { unsigned u = __builtin_bit_cast(unsigned, f); return (u + 0x7fffu + ((u >> 16) & 1u)) >> 16; }
__device__ __forceinline__ unsigned pk2(float lo, float hi) { return f2bf(lo) | (f2bf(hi) << 16); }
__device__ __forceinline__ float bf2f(bf16_t h) { return __builtin_bit_cast(float, (unsigned)h << 16); }
__device__ __forceinline__ float bflo(unsigned u) { return __builtin_bit_cast(float, u << 16); }
__device__ __forceinline__ float bfhi(unsigned u) { return __builtin_bit_cast(float, u & 0xffff0000u); }
__device__ __forceinline__ float wave_sum(float v) {
#pragma unroll
    for (int o = 1; o < 64; o <<= 1) v += __shfl_xor(v, o);
    return v;
}
__device__ __forceinline__ float sigmoidf_(float x) { return __builtin_amdgcn_rcpf(1.f + __expf(-x)); }
__device__ __forceinline__ float siluf_(float x) { return x * __builtin_amdgcn_rcpf(1.f + __expf(-x)); }
__device__ __forceinline__ float tanhf_(float x) { return 1.f - 2.f * __builtin_amdgcn_rcpf(1.f + __expf(2.f * x)); }
template <int CTRL> __device__ __forceinline__ float dpp_f(float v) {
    return __builtin_bit_cast(float, __builtin_amdgcn_update_dpp(0, __builtin_bit_cast(int, v), CTRL, 0xF, 0xF, true));
}
__device__ __forceinline__ float red16(float v) {
    v += dpp_f<0xB1>(v);
    v += dpp_f<0x4E>(v);
    v += dpp_f<0x141>(v);
    v += dpp_f<0x140>(v);
    return v;
}

namespace pg8 {
constexpr int BM = 256, BK = 64, HALF = 128, HTB = HALF * BK * 2, STAGE_BYTES = 8 * HTB, NXCD = 8, WGM = 8;
__host__ __device__ __forceinline__ int lds_byte(int r, int c) { const int st = (r >> 4) * 2 + (c >> 5), rr = r & 15, cc = c & 31, ob = rr * 64 + cc * 2; return st * 1024 + (ob ^ (((ob >> 9) & 1) << 5)); }
__host__ __device__ __forceinline__ void stage_rc(int b, int& R, int& C) { const int st = b / 1024, sb = b % 1024, swz = sb ^ (((sb >> 9) & 1) << 5); R = (st >> 1) * 16 + swz / 64; C = (st & 1) * 32 + (swz % 64) / 2; }
__host__ __device__ __forceinline__ int perm32(int rho) { const int n = rho >> 4, i = rho & 15; return 8 * (i >> 2) + 4 * n + (i & 3); }

struct Unit { int pm, pn, e; size_t boff; };
struct Gemm { const bf16_t* A; const bf16_t* Bt; int M, N, K; };

struct StaticOrder {
    int nM, nN, nwg, G, c; size_t tstep;
    __device__ void init(int M, int N, int K, int G_, int c_) { nM = M / BM; nN = N / BM; nwg = nM * nN; G = G_; c = c_; tstep = (size_t)BM * K * 2; }
    __device__ bool next(int i, Unit& u) const {
        const long L = (long)i * G + c; if (L >= nwg) return false;
        int wgid = (int)L; { const int q = nwg / NXCD, r = nwg % NXCD, xcd = wgid % NXCD, off = wgid / NXCD; wgid = (xcd < r ? xcd * (q + 1) : r * (q + 1) + (xcd - r) * q) + off; }
        const int nig = WGM * nN, gid = wgid / nig, fm = gid * WGM, gsz = (nM - fm) < WGM ? (nM - fm) : WGM;
        u.pm = fm + ((wgid % nig) % gsz); u.pn = (wgid % nig) / gsz; u.e = 0; u.boff = (size_t)u.pn * tstep; return true;
    }
};
template <int NPN> struct GroupOrder {
    int G, c, nblk; const LAS int* blk2e;
    __device__ __forceinline__ bool next(int i, Unit& u) const {
        const int L = i * G + c; if (L >= nblk * NPN) return false;
        const int blk = L / NPN; u.pn = L % NPN; u.pm = blk;
        const int e = blk2e[blk];
        u.e = e; u.boff = (size_t)(e * NPN + u.pn) * ((size_t)256 * 1024 * 2); return true;
    }
};

typedef __bf16 bf16x2_t __attribute__((ext_vector_type(2)));
__device__ __forceinline__ unsigned cvt_pk_bf16(float lo, float hi) { const f32x2 v = {lo, hi}; const bf16x2_t b = __builtin_convertvector(v, bf16x2_t); return __builtin_bit_cast(unsigned, b); }

struct EpiBf16 {
    bf16_t* O; int ldc; const float* bias; int bias_estride;
    __device__ __forceinline__ void operator()(const f32x4 (&acc)[2][2][4][2], const Unit& u, int wr, int wc, int fr, int fq) const {
        const int row0 = u.pm * BM + wr * 64 + fr; const int col0 = u.pn * BM + wc * 32 + 8 * fq;
        f32x4 bv[2][2];
#pragma unroll
        for (int bj = 0; bj < 2; ++bj)
#pragma unroll
            for (int n = 0; n < 2; ++n) bv[bj][n] = bias ? *(const f32x4*)(bias + (size_t)u.e * bias_estride + col0 + bj * HALF + 4 * n) : (f32x4){0.f, 0.f, 0.f, 0.f};
#pragma unroll
        for (int ai = 0; ai < 2; ++ai)
#pragma unroll
            for (int m = 0; m < 4; ++m) { bf16_t* rowp = O + (size_t)(row0 + ai * HALF + m * 16) * ldc + col0;
#pragma unroll
                for (int bj = 0; bj < 2; ++bj) { const f32x4 v0 = acc[ai][bj][m][0] + bv[bj][0], v1 = acc[ai][bj][m][1] + bv[bj][1];
                    u32x4 w; w.x = cvt_pk_bf16(v0[0], v0[1]); w.y = cvt_pk_bf16(v0[2], v0[3]); w.z = cvt_pk_bf16(v1[0], v1[1]); w.w = cvt_pk_bf16(v1[2], v1[3]);
                    *(u32x4*)(rowp + bj * HALF) = w; } }
    }
};
struct EpiSwiglu {
    bf16_t* O; const float* bias;
    __device__ __forceinline__ static float act(float g, float u) {
        g = fminf(g, 7.f); u = fminf(fmaxf(u, -7.f), 7.f);
        return (u + 1.f) * g * __builtin_amdgcn_rcpf(1.f + __expf(-1.702f * g));
    }
    __device__ __forceinline__ void operator()(const f32x4 (&acc)[2][2][4][2], const Unit& u, int wr, int wc, int fr, int fq) const {
        const int row0 = u.pm * BM + wr * 64 + fr; const int col0 = u.pn * BM + wc * 32 + 8 * fq;
        f32x4 bv[2][2];
#pragma unroll
        for (int bj = 0; bj < 2; ++bj)
#pragma unroll
            for (int n = 0; n < 2; ++n) bv[bj][n] = *(const f32x4*)(bias + (size_t)u.e * 2048 + col0 + bj * HALF + 4 * n);
#pragma unroll
        for (int ai = 0; ai < 2; ++ai)
#pragma unroll
            for (int m = 0; m < 4; ++m) { bf16_t* rowp = O + (size_t)(row0 + ai * HALF + m * 16) * 1024 + (col0 >> 1);
#pragma unroll
                for (int bj = 0; bj < 2; ++bj) { const f32x4 v0 = acc[ai][bj][m][0] + bv[bj][0], v1 = acc[ai][bj][m][1] + bv[bj][1];
                    u32x2 w; w.x = cvt_pk_bf16(act(v0[0], v0[1]), act(v0[2], v0[3])); w.y = cvt_pk_bf16(act(v1[0], v1[1]), act(v1[2], v1[3]));
                    *(u32x2*)(rowp + bj * (HALF / 2)) = w; } }
    }
};

template <class Epi, class Sched>
__device__ __forceinline__ void gemm_phase(LAS unsigned char* lds, const Gemm g, const Sched& S, const Epi& E, const int wave_s) {
    int tid = wave_s * 64 + lane_id_(); asm volatile("" : "+v"(tid));
    const int wid = __builtin_amdgcn_readfirstlane(tid >> 6), lane = tid & 63, wr = wid >> 2, wc = wid & 3, fr = lane & 15, fq = lane >> 4;
    const int K = g.K, nt = K / BK;
    unsigned voffA[2], voffB[2];
#pragma unroll
    for (int i = 0; i < 2; ++i) { int R, C; stage_rc(tid * 16 + i * 8192, R, C); const int Rb = (R & ~31) + perm32(R & 31);
        voffA[i] = (unsigned)(R * K + C) * 2u; voffB[i] = (unsigned)(Rb * K + C) * 2u; }
    const size_t kstep = (size_t)(BK * 2);
    const size_t hstep = (size_t)HALF * K * 2;
    const size_t tstep = 2 * hstep;
    const unsigned ldsw = (unsigned)wid * 1024u;
    const int aoff = lds_byte(wr * 64 + fr, fq * 8), boff = lds_byte(wc * 32 + fr, fq * 8);
#define PG8_SA(b, h) (((b) * 2 + (h)) * HTB)
#define PG8_SB(b, h) ((4 + (b) * 2 + (h)) * HTB)
#define PG8_STAGE(bufoff, gbase, voff) do { _Pragma("unroll") for (int _i = 0; _i < 2; ++_i) \
        __builtin_amdgcn_global_load_lds((const unsigned*)((const char*)(gbase) + (voff)[_i]), (LAS unsigned*)(lds + (bufoff) + ldsw + _i * 8192), 16, 0, 0); } while (0)
#define PG8_LDA(dst, b, h) do { _Pragma("unroll") for (int m = 0; m < 4; ++m) _Pragma("unroll") for (int k = 0; k < 2; ++k) dst[m][k] = *(const LAS bf16x8*)(lds + PG8_SA(b, h) + aoff + m * 2048 + k * 1024); } while (0)
#define PG8_LDB(dst, b, h) do { _Pragma("unroll") for (int n = 0; n < 2; ++n) _Pragma("unroll") for (int k = 0; k < 2; ++k) dst[n][k] = *(const LAS bf16x8*)(lds + PG8_SB(b, h) + boff + n * 2048 + k * 1024); } while (0)
#define PG8_MMA(ai, bj, At, Bt) do { __builtin_amdgcn_s_setprio(1); _Pragma("unroll") for (int m = 0; m < 4; ++m) _Pragma("unroll") for (int n = 0; n < 2; ++n) _Pragma("unroll") for (int k = 0; k < 2; ++k) \
        acc[ai][bj][m][n] = __builtin_amdgcn_mfma_f32_16x16x32_bf16(Bt[n][k], At[m][k], acc[ai][bj][m][n], 0, 0, 0); __builtin_amdgcn_s_setprio(0); } while (0)
#define PG8_WAIT_V(n) asm volatile("s_waitcnt vmcnt(" #n ")" ::: "memory")
#define PG8_WAIT_L(n) asm volatile("s_waitcnt lgkmcnt(" #n ")" ::: "memory")
#define PG8_BAR __builtin_amdgcn_s_barrier()
#define PG8_SCHED __builtin_amdgcn_sched_barrier(0)
    Unit cur, nxt; int ui = 0;
    if (!S.next(0, cur)) return;
    f32x4 acc[2][2][4][2];
#pragma unroll
    for (int a = 0; a < 2; ++a)
#pragma unroll
        for (int b = 0; b < 2; ++b)
#pragma unroll
            for (int m = 0; m < 4; ++m)
#pragma unroll
                for (int n = 0; n < 2; ++n) acc[a][b][m][n] = (f32x4){0.f, 0.f, 0.f, 0.f};
    bf16x8 At[4][2], B0[2][2], B1[2][2];
    const char* cA = (const char*)g.A + (size_t)cur.pm * tstep; const char* cB = (const char*)g.Bt + cur.boff;
    PG8_STAGE(PG8_SB(0, 0), cB, voffB); PG8_STAGE(PG8_SB(0, 1), cB + hstep, voffB); PG8_STAGE(PG8_SA(0, 0), cA, voffA); PG8_STAGE(PG8_SA(0, 1), cA + hstep, voffA);
    if (wr == 1) PG8_BAR;
    PG8_WAIT_V(2); PG8_BAR;
    PG8_STAGE(PG8_SB(1, 0), cB + kstep, voffB); PG8_STAGE(PG8_SA(1, 0), cA + kstep, voffA); PG8_STAGE(PG8_SB(1, 1), cB + hstep + kstep, voffB);
    PG8_WAIT_V(6); PG8_BAR;
    for (;;) {
        const bool has_next = S.next(ui + 1, nxt);
        const char* nA = has_next ? (const char*)g.A + (size_t)nxt.pm * tstep : cA; const char* nB = has_next ? (const char*)g.Bt + nxt.boff : cB;
        for (int t = 0; t < nt; t += 2) {
            const bool last = (t == nt - 2);
            const char* a1 = cA + (size_t)(t + 1) * kstep;
            const char* a2 = last ? nA : cA + (size_t)(t + 2) * kstep; const char* b2 = last ? nB : cB + (size_t)(t + 2) * kstep;
            const char* a3 = a2 + kstep; const char* b3 = b2 + kstep;
            PG8_LDB(B0, 0, 0); PG8_LDB(B1, 0, 1); PG8_SCHED; PG8_LDA(At, 0, 0); PG8_STAGE(PG8_SA(1, 1), a1 + hstep, voffA);
            PG8_WAIT_V(8); PG8_WAIT_L(0); PG8_BAR; PG8_MMA(0, 0, At, B0); PG8_MMA(0, 1, At, B1); PG8_BAR; PG8_SCHED;
            PG8_LDA(At, 0, 1); PG8_STAGE(PG8_SB(0, 0), b2, voffB); PG8_STAGE(PG8_SB(0, 1), b2 + hstep, voffB); PG8_STAGE(PG8_SA(0, 0), a2, voffA);
            PG8_WAIT_V(8); PG8_WAIT_L(0); PG8_BAR; PG8_MMA(1, 0, At, B0); PG8_MMA(1, 1, At, B1); PG8_BAR; PG8_SCHED;
            PG8_LDB(B0, 1, 0); PG8_LDB(B1, 1, 1); PG8_SCHED; PG8_LDA(At, 1, 0); PG8_STAGE(PG8_SA(0, 1), a2 + hstep, voffA);
            PG8_WAIT_V(8); PG8_WAIT_L(0); PG8_BAR; PG8_MMA(0, 0, At, B0); PG8_MMA(0, 1, At, B1); PG8_BAR; PG8_SCHED;
            PG8_LDA(At, 1, 1); PG8_STAGE(PG8_SB(1, 0), b3, voffB); PG8_STAGE(PG8_SB(1, 1), b3 + hstep, voffB); PG8_STAGE(PG8_SA(1, 0), a3, voffA);
            PG8_WAIT_V(8); PG8_WAIT_L(0); PG8_BAR; PG8_MMA(1, 0, At, B0); PG8_MMA(1, 1, At, B1); PG8_BAR; PG8_SCHED;
        }
        if (wr == 0) PG8_BAR;
        { int tz = wave_s * 64 + lane_id_(); asm volatile("" : "+v"(tz)); const int l2 = tz & 63; E(acc, cur, wave_s >> 2, wave_s & 3, l2 & 15, l2 >> 4); }
        if (!has_next) break;
#pragma unroll
        for (int a = 0; a < 2; ++a)
#pragma unroll
            for (int b = 0; b < 2; ++b)
#pragma unroll
                for (int m = 0; m < 4; ++m)
#pragma unroll
                    for (int n = 0; n < 2; ++n) acc[a][b][m][n] = (f32x4){0.f, 0.f, 0.f, 0.f};
        cur = nxt; cA = nA; cB = nB; ++ui;
        if (wr == 1) PG8_BAR;
    }
    PG8_WAIT_V(0);
    PG8_BAR;
#undef PG8_SA
#undef PG8_SB
#undef PG8_STAGE
#undef PG8_LDA
#undef PG8_LDB
#undef PG8_MMA
#undef PG8_WAIT_V
#undef PG8_WAIT_L
#undef PG8_BAR
#undef PG8_SCHED
}
}
#define XB_TMO      128
#define XB_XCNT(j)  (256  + 64 * (j))
#define XB_XSUB(j)  (1280 + 64 * (j))
#define XB_XGEN(j)  (2304 + 64 * (j))
#define XB_TOP      3328
#define XB_TOPGEN   3392
#define XCD_BAR_WORDS 3456
#define XB_SPIN_CAP (1u << 18)

__device__ __forceinline__ unsigned xb_ld(unsigned* p)              { return __hip_atomic_load(p, __ATOMIC_RELAXED, __HIP_MEMORY_SCOPE_AGENT); }
__device__ __forceinline__ unsigned xb_add(unsigned* p, unsigned v) { return __hip_atomic_fetch_add(p, v, __ATOMIC_RELAXED, __HIP_MEMORY_SCOPE_AGENT); }
__device__ __forceinline__ unsigned xb_xcc_id() { return (unsigned)__builtin_amdgcn_s_getreg((3 << 11) | 20) & 0xFu; }
#define XB_SPIN(cond, bar) do { unsigned _sp = 0; while (cond) { __builtin_amdgcn_s_sleep(1); \
    if ((++_sp & 255u) == 0u) { if (xb_ld(&(bar)[XB_TMO])) break; if (_sp > XB_SPIN_CAP) { atomicAdd(&(bar)[XB_TMO], 1u); break; } } } } while (0)

struct XcdBarrier {
    unsigned* bar; unsigned x; int w;
    volatile LAS unsigned* st;
};

__device__ __forceinline__ XcdBarrier xcd_barrier_post(unsigned* bar, volatile LAS unsigned* st, int wave_s) {
    XcdBarrier b; b.bar = bar; b.x = xb_xcc_id(); b.st = st; b.w = wave_s;
    if (wave_s == 0 && lane_id_() == 0) (void)xb_add(&bar[XB_XCNT(b.x)], 1u);
    return b;
}
__device__ __forceinline__ void xcd_barrier_complete(unsigned* bar, unsigned x, unsigned& nloc, unsigned& nx) {
    const unsigned G = gridDim.x * gridDim.y * gridDim.z;
    unsigned sum, cnt, mine, sp = 0u;
    for (;;) {
        sum = 0u; cnt = 0u; mine = 0u;
#pragma unroll
        for (unsigned j = 0; j < 16; ++j) { const unsigned c = xb_ld(&bar[XB_XCNT(j)]); sum += c; cnt += (c > 0u) ? 1u : 0u; mine = (j == x) ? c : mine; }
        if (sum == G) break;
        __builtin_amdgcn_s_sleep(1);
        if ((++sp & 255u) == 0u) { if (xb_ld(&bar[XB_TMO])) break; if (sp > XB_SPIN_CAP) { atomicAdd(&bar[XB_TMO], 1u); break; } }
    }
    nloc = mine > 0u ? mine : 1u; nx = cnt > 0u ? cnt : 1u;
}

__device__ __forceinline__ void xcd_barrier(const XcdBarrier& b) {
    asm volatile("s_waitcnt vmcnt(0)" ::: "memory");
    __syncthreads();
    if (b.w == 0 && lane_id_() == 0) {
        unsigned* bar = b.bar;
        __builtin_amdgcn_s_waitcnt(0);
        unsigned nloc = b.st[0], nx = b.st[1];
        if (nloc == 0u) { xcd_barrier_complete(bar, b.x, nloc, nx); b.st[0] = nloc; b.st[1] = nx; }
        const unsigned old = xb_add(&bar[XB_XSUB(b.x)], 1u);
        const unsigned gen = old / nloc;
        if (old + 1u == (gen + 1u) * nloc) {
            __builtin_amdgcn_fence(__ATOMIC_RELEASE, "agent");
            asm volatile("s_waitcnt vmcnt(0)" ::: "memory");
            const unsigned og = xb_add(&bar[XB_TOP], 1u);
            const unsigned tg = og / nx;
            if (og + 1u == (tg + 1u) * nx) xb_add(&bar[XB_TOPGEN], 1u);
            else XB_SPIN(xb_ld(&bar[XB_TOPGEN]) == tg, bar);
            __builtin_amdgcn_fence(__ATOMIC_ACQUIRE, "agent");
            xb_add(&bar[XB_XGEN(b.x)], 1u);
            asm volatile("s_waitcnt vmcnt(0)" ::: "memory");
        } else {
            XB_SPIN(xb_ld(&bar[XB_XGEN(b.x)]) == gen, bar);
            __builtin_amdgcn_fence(__ATOMIC_ACQUIRE, "agent");
            asm volatile("s_waitcnt vmcnt(0)" ::: "memory");
        }
    }
    __syncthreads();
}

__device__ const float ROPE_COS[64][8] = {
1.0f, 1.0f, 1.0f, 1.0f, 1.0f, 1.0f, 1.0f, 1.0f,
0.540302277f, 0.950415254f, 0.995004177f, 0.999500036f, 0.999949992f, 0.999994993f, 0.999999523f, 0.99999994f,
-0.416146845f, 0.806578398f, 0.980066597f, 0.998000681f, 0.999800026f, 0.999979973f, 0.999997973f, 0.999999821f,
-0.989992499f, 0.582753658f, 0.955336511f, 0.995503366f, 0.999550045f, 0.999954998f, 0.99999553f, 0.999999523f,
-0.653643608f, 0.301137477f, 0.921060979f, 0.992010653f, 0.999200106f, 0.999920011f, 0.999992013f, 0.999999225f,
0.2836622f, -0.0103423381f, 0.87758255f, 0.987526f, 0.998750269f, 0.999875009f, 0.999987483f, 0.999998748f,
0.960170269f, -0.3207964f, 0.825335622f, 0.982053936f, 0.998200536f, 0.999819994f, 0.999981999f, 0.999998212f,
0.753902256f, -0.599437475f, 0.764842212f, 0.975599885f, 0.997551024f, 0.999755025f, 0.999975502f, 0.999997556f,
-0.145500034f, -0.818632424f, 0.696706712f, 0.968170285f, 0.996801734f, 0.999680042f, 0.999967992f, 0.999996781f,
-0.91113025f, -0.956644177f, 0.621609926f, 0.959772646f, 0.995952725f, 0.999595046f, 0.999959528f, 0.999995947f,
-0.839071512f, -0.999786079f, 0.540302277f, 0.950415313f, 0.995004177f, 0.999500036f, 0.999949992f, 0.999994993f,
0.00442569796f, -0.943779767f, 0.453596085f, 0.940107584f, 0.993956089f, 0.999395072f, 0.999939501f, 0.99999392f,
0.843853951f, -0.79417938f, 0.362357706f, 0.92885989f, 0.99280864f, 0.999280095f, 0.999927998f, 0.999992788f,
0.907446802f, -0.565820515f, 0.267498761f, 0.916683376f, 0.99156189f, 0.999155104f, 0.999915481f, 0.999991536f,
0.136737213f, -0.28134948f, 0.16996716f, 0.903590262f, 0.990216017f, 0.999020159f, 0.99990201f, 0.999990225f,
-0.759687901f, 0.0310223512f, 0.070737198f, 0.889593601f, 0.988771081f, 0.998875201f, 0.999887526f, 0.999988735f,
-0.957659483f, 0.340318173f, -0.0291995462f, 0.87470746f, 0.987227261f, 0.998720288f, 0.999872029f, 0.999987185f,
-0.275163352f, 0.615864813f, -0.128844544f, 0.858946681f, 0.985584795f, 0.998555362f, 0.999855518f, 0.999985576f,
0.660316706f, 0.830336154f, -0.227202162f, 0.842327058f, 0.983843684f, 0.998380423f, 0.999837995f, 0.999983788f,
0.988704622f, 0.962463796f, -0.323289543f, 0.824865162f, 0.982004225f, 0.998195529f, 0.999819517f, 0.99998194f,
0.408082068f, 0.999144375f, -0.416146845f, 0.806578457f, 0.980066597f, 0.998000681f, 0.999800026f, 0.999979973f,
-0.547729254f, 0.936740458f, -0.504846215f, 0.787485182f, 0.97803092f, 0.99779582f, 0.999779522f, 0.999977946f,
-0.99996084f, 0.781440377f, -0.588501155f, 0.767604589f, 0.975897431f, 0.997581005f, 0.999758005f, 0.999975801f,
-0.53283304f, 0.548645258f, -0.666275978f, 0.746956408f, 0.97366637f, 0.997356176f, 0.999735534f, 0.999973536f,
0.424179018f, 0.261441678f, -0.737393796f, 0.725561321f, 0.971337974f, 0.997121394f, 0.99971199f, 0.999971211f,
0.991202831f, -0.0516893305f, -0.801143587f, 0.703440726f, 0.968912423f, 0.996876657f, 0.999687493f, 0.999968767f,
0.64691931f, -0.359694332f, -0.856888831f, 0.680616796f, 0.966389954f, 0.996621907f, 0.999662042f, 0.999966204f,
-0.292138815f, -0.632028639f, -0.904072165f, 0.6571123f, 0.963770926f, 0.996357203f, 0.999635518f, 0.999963522f,
-0.962605894f, -0.841684937f, -0.942222297f, 0.632950664f, 0.961055458f, 0.996082544f, 0.99960804f, 0.99996078f,
-0.748057544f, -0.967871487f, -0.970958173f, 0.608156204f, 0.958243906f, 0.995797932f, 0.999579549f, 0.999957979f,
0.154251456f, -0.998075247f, -0.989992499f, 0.582753658f, 0.955336511f, 0.995503366f, 0.999550045f, 0.999954998f,
0.914742351f, -0.929300308f, -0.999135137f, 0.556768358f, 0.95233357f, 0.995198846f, 0.999519527f, 0.999951959f,
0.83422339f, -0.768367112f, -0.998294771f, 0.53022635f, 0.949235439f, 0.994884372f, 0.999488056f, 0.9999488f,
-0.0132767474f, -0.531235278f, -0.987479806f, 0.503154159f, 0.946042359f, 0.994559944f, 0.999455571f, 0.999945521f,
-0.848570287f, -0.241421118f, -0.966798186f, 0.475578904f, 0.942754686f, 0.994225562f, 0.999422073f, 0.999942183f,
-0.903692186f, 0.0723346695f, -0.93645668f, 0.447528064f, 0.939372718f, 0.993881226f, 0.999387562f, 0.999938726f,
-0.127963692f, 0.378916174f, -0.896758378f, 0.419029742f, 0.935896814f, 0.993526995f, 0.999352098f, 0.99993521f,
0.765414059f, 0.647921681f, -0.848100007f, 0.39011243f, 0.93232733f, 0.993162811f, 0.99931556f, 0.999931574f,
0.955073655f, 0.852673113f, -0.790967762f, 0.360805035f, 0.928664625f, 0.992788672f, 0.999278069f, 0.999927819f,
0.266642928f, 0.972865343f, -0.72593224f, 0.331136853f, 0.924909055f, 0.99240464f, 0.999239624f, 0.999923944f,
-0.666938066f, 0.996578991f, -0.653643608f, 0.301137596f, 0.921060979f, 0.992010653f, 0.999200106f, 0.999920011f,
-0.987339258f, 0.921462357f, -0.574824035f, 0.270837069f, 0.917120814f, 0.991606772f, 0.999159634f, 0.999915957f,
-0.399985313f, 0.754965365f, -0.490260571f, 0.240265876f, 0.913088918f, 0.991192937f, 0.999118149f, 0.999911785f,
0.555113316f, 0.513598442f, -0.400799006f, 0.209454417f, 0.908965766f, 0.990769207f, 0.999075651f, 0.999907553f,
0.999843299f, 0.221298173f, -0.307332784f, 0.178433523f, 0.904751658f, 0.990335584f, 0.99903214f, 0.999903202f,
0.52532196f, -0.0929481089f, -0.210795805f, 0.147234216f, 0.90044713f, 0.989892066f, 0.998987675f, 0.999898732f,
-0.432177931f, -0.397976756f, -0.112152621f, 0.115887694f, 0.89605248f, 0.989438653f, 0.998942196f, 0.999894202f,
-0.992335498f, -0.663538277f, -0.0123883775f, 0.0844252855f, 0.891568303f, 0.988975346f, 0.998895705f, 0.999889553f,
-0.640144348f, -0.863296509f, 0.0874991715f, 0.0528784581f, 0.886994898f, 0.988502085f, 0.9988482f, 0.999884784f,
0.300592542f, -0.977442741f, 0.18651247f, 0.0212787576f, 0.882332861f, 0.98801899f, 0.998799741f, 0.999879956f,
0.964965999f, -0.994656444f, 0.2836622f, -0.0103422189f, 0.87758255f, 0.987526f, 0.998750269f, 0.999875009f,
0.742154181f, -0.913230121f, 0.377977669f, -0.0419528559f, 0.872744501f, 0.987023175f, 0.998699784f, 0.999869943f,
-0.162990779f, -0.741239965f, 0.468516916f, -0.0735215396f, 0.86781919f, 0.986510456f, 0.998648286f, 0.999864817f,
-0.918282807f, -0.495741814f, 0.554374516f, -0.105016708f, 0.862807095f, 0.985987842f, 0.998595834f, 0.999859571f,
-0.829309821f, -0.201079622f, 0.634692967f, -0.136406869f, 0.857708693f, 0.985455394f, 0.998542368f, 0.999854207f,
0.0221267566f, 0.113521777f, 0.708669782f, -0.167660639f, 0.852524519f, 0.984913111f, 0.99848789f, 0.999848783f,
0.853220105f, 0.416867077f, 0.775565803f, -0.198746875f, 0.847255111f, 0.984360933f, 0.998432398f, 0.99984318f,
0.899866819f, 0.678870201f, 0.834712923f, -0.22963427f, 0.841901004f, 0.983798921f, 0.998375952f, 0.999837577f,
0.119180135f, 0.873550534f, 0.885519624f, -0.260292053f, 0.836462677f, 0.983227074f, 0.998318493f, 0.999831796f,
-0.771080196f, 0.981602073f, 0.927478492f, -0.290689558f, 0.830940723f, 0.982645452f, 0.998260021f, 0.999825954f,
-0.952412963f, 0.992308319f, 0.960170269f, -0.3207964f, 0.825335622f, 0.982053936f, 0.998200536f, 0.999819994f,
-0.258101642f, 0.904607594f, 0.98326844f, -0.350582451f, 0.819648027f, 0.981452644f, 0.998140097f, 0.999813974f,
0.673507154f, 0.727198064f, 0.996542096f, -0.380017966f, 0.813878477f, 0.980841517f, 0.998078644f, 0.999807835f,
0.985896587f, 0.477671444f, 0.999858618f, -0.409073502f, 0.808027506f, 0.980220556f, 0.998016179f, 0.999801576f
};
__device__ const float ROPE_SIN[64][8] = {
0.0f, 0.0f, 0.0f, 0.0f, 0.0f, 0.0f, 0.0f, 0.0f,
0.841470957f, 0.310983598f, 0.0998334214f, 0.0316175036f, 0.00999983307f, 0.00316227227f, 0.000999999931f, 0.000316227757f,
0.909297407f, 0.591127098f, 0.198669329f, 0.0632033944f, 0.0199986659f, 0.00632451288f, 0.0019999987f, 0.000632455456f,
0.141120002f, 0.812648892f, 0.295520216f, 0.0947260857f, 0.0299954992f, 0.00948669016f, 0.0029999956f, 0.000948683126f,
-0.756802499f, 0.953580737f, 0.389418334f, 0.126154065f, 0.0399893336f, 0.0126487734f, 0.00399998948f, 0.00126491068f,
-0.958924294f, 0.999946535f, 0.47942555f, 0.157455876f, 0.0499791652f, 0.0158107281f, 0.0049999794f, 0.00158113812f,
-0.279415488f, 0.947148204f, 0.564642489f, 0.188600272f, 0.0599640049f, 0.0189725272f, 0.0059999642f, 0.00189736532f,
0.656986594f, 0.800421596f, 0.64421767f, 0.219556093f, 0.0699428469f, 0.0221341345f, 0.00699994294f, 0.00221359241f,
0.989358246f, 0.574317753f, 0.717356086f, 0.250292331f, 0.0799146891f, 0.0252955221f, 0.0079999147f, 0.00252981926f,
0.412118495f, 0.291259229f, 0.783326924f, 0.280778319f, 0.0898785442f, 0.0284566563f, 0.00899987947f, 0.00284604589f,
-0.54402113f, -0.0206835698f, 0.841470957f, 0.310983568f, 0.099833414f, 0.0316175036f, 0.009999834f, 0.00316227227f,
-0.999990225f, -0.33057496f, 0.891207397f, 0.340877861f, 0.1097783f, 0.0347780399f, 0.0109997792f, 0.00347849843f,
-0.536572933f, -0.60768342f, 0.932039082f, 0.370431304f, 0.119712204f, 0.0379382223f, 0.0119997123f, 0.00379472389f,
0.420167029f, -0.824528456f, 0.963558197f, 0.399614304f, 0.129634142f, 0.0410980321f, 0.0129996343f, 0.00411094911f,
0.990607381f, -0.959605396f, 0.985449731f, 0.428397775f, 0.139543116f, 0.0442574248f, 0.0139995432f, 0.00442717411f,
0.650287867f, -0.999518692f, 0.997494996f, 0.456752867f, 0.149438128f, 0.0474163815f, 0.0149994381f, 0.00474339863f,
-0.287903309f, -0.940310359f, 0.999573588f, 0.484651238f, 0.159318209f, 0.0505748577f, 0.015999319f, 0.00505962269f,
-0.961397469f, -0.78785187f, 0.991664827f, 0.512064993f, 0.169182345f, 0.0537328273f, 0.0169991814f, 0.00537584582f,
-0.750987232f, -0.557262897f, 0.973847628f, 0.538966715f, 0.179029569f, 0.0568902642f, 0.0179990288f, 0.00569206895f,
0.149877205f, -0.271410108f, 0.946300089f, 0.565329552f, 0.188858896f, 0.060047131f, 0.0189988576f, 0.00600829115f,
0.912945271f, 0.0413582884f, 0.909297407f, 0.591127038f, 0.198669314f, 0.0632033944f, 0.0199986678f, 0.00632451288f,
0.836655617f, 0.35002476f, 0.863209307f, 0.616333544f, 0.208459899f, 0.0663590282f, 0.0209984574f, 0.00664073415f,
-0.00885130931f, 0.623979926f, 0.808496356f, 0.640923738f, 0.218229622f, 0.0695140064f, 0.0219982266f, 0.00695695449f,
-0.846220434f, 0.836055279f, 0.745705247f, 0.664873064f, 0.227977514f, 0.0726682767f, 0.0229979735f, 0.00727317436f,
-0.905578375f, 0.965219259f, 0.67546314f, 0.688157499f, 0.237702623f, 0.0758218244f, 0.0239976961f, 0.0075893933f,
-0.132351756f, 0.998663187f, 0.598472118f, 0.710753918f, 0.247403964f, 0.0789746121f, 0.0249973964f, 0.00790561177f,
0.76255846f, 0.933070183f, 0.515501261f, 0.732639611f, 0.257080555f, 0.0821266174f, 0.0259970706f, 0.00822182931f,
0.956375957f, 0.774945021f, 0.427379847f, 0.753792703f, 0.266731411f, 0.0852777958f, 0.0269967206f, 0.00853804592f,
0.270905793f, 0.539968967f, 0.334988207f, 0.774192095f, 0.276355654f, 0.0884281173f, 0.0279963426f, 0.0088542616f,
-0.663633883f, 0.251445323f, 0.239249229f, 0.793817401f, 0.28595221f, 0.0915775672f, 0.0289959367f, 0.00917047635f,
-0.988031626f, -0.0620148405f, 0.141120002f, 0.812648892f, 0.295520186f, 0.0947260931f, 0.029995501f, 0.00948669016f,
-0.404037654f, -0.369325012f, 0.0415805206f, 0.830667794f, 0.305058628f, 0.0978736654f, 0.0309950355f, 0.00980290305f,
0.551426709f, -0.640009403f, -0.0583741926f, 0.847856104f, 0.314566553f, 0.101020269f, 0.0319945402f, 0.0101191159f,
0.999911845f, -0.847224355f, -0.157745644f, 0.864196658f, 0.324043006f, 0.10416586f, 0.0329940096f, 0.010435327f,
0.529082716f, -0.97042042f, -0.255541205f, 0.879673064f, 0.333487093f, 0.107310407f, 0.0339934528f, 0.010751537f,
-0.428182662f, -0.997380435f, -0.350783229f, 0.894269884f, 0.342897803f, 0.110453881f, 0.034992855f, 0.0110677453f,
-0.991778851f, -0.925431013f, -0.442520559f, 0.907972515f, 0.352274209f, 0.113596253f, 0.0359922275f, 0.0113839535f,
-0.643538117f, -0.761706948f, -0.529836178f, 0.920767248f, 0.361615449f, 0.116737492f, 0.036991559f, 0.0117001599f,
0.296368569f, -0.522444785f, -0.611857831f, 0.932641268f, 0.370920479f, 0.119877554f, 0.0379908569f, 0.0120163653f,
0.963795364f, -0.231372014f, -0.687766254f, 0.943582714f, 0.380188406f, 0.123016424f, 0.0389901139f, 0.0123325698f,
0.745113134f, 0.0826458037f, -0.756802499f, 0.953580678f, 0.389418334f, 0.126154065f, 0.0399893373f, 0.0126487734f,
-0.158622667f, 0.388467699f, -0.818277061f, 0.962625206f, 0.39860931f, 0.129290432f, 0.0409885161f, 0.0129649751f,
-0.916521549f, 0.655764699f, -0.871575892f, 0.970707119f, 0.407760441f, 0.132425532f, 0.0419876575f, 0.0132811759f,
-0.831774771f, 0.858030677f, -0.916166008f, 0.977818429f, 0.416870773f, 0.135559291f, 0.0429867506f, 0.0135973748f,
0.0177019257f, 0.975206196f, -0.951602101f, 0.983951986f, 0.425939471f, 0.138691694f, 0.0439858064f, 0.0139135728f,
0.850903511f, 0.995670974f, -0.977530122f, 0.989101648f, 0.434965521f, 0.141822711f, 0.0449848175f, 0.0142297689f,
0.901788354f, 0.917395473f, -0.993690968f, 0.993262351f, 0.44394809f, 0.144952312f, 0.0459837839f, 0.0145459641f,
0.123573124f, 0.748142362f, -0.999923289f, 0.996429801f, 0.452886283f, 0.148080453f, 0.0469827019f, 0.0148621574f,
-0.768254638f, 0.504697084f, -0.99616462f, 0.99860096f, 0.461779177f, 0.151207119f, 0.0479815714f, 0.0151783489f,
-0.953752637f, 0.211200655f, -0.982452571f, 0.999773562f, 0.470625877f, 0.15433228f, 0.0489803962f, 0.0154945394f,
-0.262374848f, -0.10324046f, -0.958924294f, 0.999946535f, 0.47942555f, 0.157455891f, 0.0499791689f, 0.0158107281f,
0.670229197f, -0.407444149f, -0.925814748f, 0.99911958f, 0.48817724f, 0.160577938f, 0.0509778969f, 0.0161269177f,
0.986627579f, -0.671240151f, -0.883454502f, 0.997293651f, 0.496880114f, 0.163698375f, 0.051976569f, 0.0164431017f,
0.395925164f, -0.868469954f, -0.832267344f, 0.994470477f, 0.505533338f, 0.166817173f, 0.0529751927f, 0.0167592876f,
-0.558789074f, -0.979574919f, -0.772764444f, 0.990652919f, 0.514135957f, 0.169934288f, 0.0539737605f, 0.0170754679f,
-0.999755144f, -0.993535519f, -0.705540299f, 0.985844791f, 0.522687256f, 0.173049718f, 0.0549722798f, 0.01739165f,
-0.521551013f, -0.908967435f, -0.631266713f, 0.980050862f, 0.531186223f, 0.17616342f, 0.0559707358f, 0.0177078284f,
0.436164767f, -0.734258294f, -0.550685287f, 0.973276973f, 0.539632022f, 0.179275364f, 0.0569691435f, 0.0180240069f,
0.992872655f, -0.486733496f, -0.464602023f, 0.965529919f, 0.548023939f, 0.182385504f, 0.0579674877f, 0.0183401816f,
0.636738002f, -0.190938011f, -0.373876572f, 0.956817448f, 0.55636102f, 0.185493827f, 0.0589657798f, 0.0186563563f,
-0.304810613f, 0.12379095f, -0.279415488f, 0.947148204f, 0.564642429f, 0.188600287f, 0.0599640086f, 0.0189725272f,
-0.966117799f, 0.426245421f, -0.182162598f, 0.936531842f, 0.572867453f, 0.191704854f, 0.0609621815f, 0.0192886982f,
-0.739180684f, 0.686427653f, -0.0830891207f, 0.924979091f, 0.581035137f, 0.194807529f, 0.0619602874f, 0.0196048655f,
0.167355701f, 0.878538549f, 0.0168140903f, 0.912501454f, 0.589144766f, 0.197908238f, 0.0629583374f, 0.0199210308f
};

struct Params { const float* in[41]; float* out; unsigned char* ws; };
enum { I_X = 0, I_C, I_CTX, I_CCTX, I_LNG, I_LNB, I_ADAW, I_ADAB, I_WIN, I_LQ1, I_LK1, I_LQ2, I_LK2, I_SUBLN, I_GW2, I_GGB, I_GNG, I_CONV, I_W2, I_W0, I_A2, I_A0, I_G2, I_KK, I_KA, I_RK,
       I_LNXG, I_LNXB, I_WOUT, I_LN1G, I_LN1B, I_RW, I_RB, I_MWG, I_MBG, I_MWU, I_MBU, I_MWD, I_MBD, I_LN2G, I_LN2B };

#define WSP(T, off) ((T*)(p.ws + (off)))
#define SCRP(T, off) ((T*)(p.ws + WS_SCR + (off)))

__device__ __forceinline__ void conv_tile(const float* __restrict__ src, int ld, int nvalid, int k0, int n0, bf16_t* __restrict__ dst, int rs, int ro, LAS float* tile, int tid) {
    {
        const int k = tid >> 3, n8 = (tid & 7) * 8;
        const float* s = src + (size_t)(k0 + k) * ld + n0 + n8;
        f32x4 a[4], b[4];
#pragma unroll
        for (int q = 0; q < 4; ++q) { a[q] = (f32x4){0.f, 0.f, 0.f, 0.f}; b[q] = a[q];
            if (n0 + q * 64 + n8 + 8 <= nvalid) { a[q] = *(const f32x4*)(s + q * 64); b[q] = *(const f32x4*)(s + q * 64 + 4); } }
#pragma unroll
        for (int q = 0; q < 4; ++q) { LAS float* t = tile + k * 261 + q * 65 + n8;
            t[0] = a[q][0]; t[1] = a[q][1]; t[2] = a[q][2]; t[3] = a[q][3]; t[4] = b[q][0]; t[5] = b[q][1]; t[6] = b[q][2]; t[7] = b[q][3]; }
    }
    __syncthreads();
    {
        const int n = tid >> 3, k8 = (tid & 7) * 8;
#pragma unroll
        for (int q = 0; q < 4; ++q) { const LAS float* t = tile + k8 * 261 + q * 65 + n;
            u32x4 o; o.x = pk2(t[0], t[261]); o.y = pk2(t[522], t[783]); o.z = pk2(t[1044], t[1305]); o.w = pk2(t[1566], t[1827]);
            *(u32x4*)(dst + ((size_t)(n0 + q * 64 + n) * rs + ro) * 1024 + k0 + k8) = o; }
    }
    __syncthreads();
}
constexpr int JW_IN = 16 * 14, JW_OUT = 64, JW_LAYER = JW_IN + JW_OUT + 32 * 192, JW_TOTAL = 2 * JW_LAYER, J_MOD = 48;
__device__ __forceinline__ void conv_job(const Params& p, int j, LAS float* tile, int tid) {
    asm volatile("" : "+v"(tid));
    const int l = j / JW_LAYER; int r = j % JW_LAYER;
    if (r < JW_IN) { const int kt = r / 14, nt = r % 14;
        conv_tile(p.in[I_WIN] + (size_t)l * 1024 * DIN, DIN, DIN, kt * 64, nt * 256, WSP(bf16_t, WS_WIN) + (size_t)l * DINP * 1024, 1, 0, tile, tid); return; }
    r -= JW_IN;
    if (r < JW_OUT) { const int kt = r >> 2, nt = r & 3;
        conv_tile(p.in[I_WOUT] + (size_t)l * 1024 * 1024, 1024, 1024, kt * 64, nt * 256, WSP(bf16_t, WS_WOUT) + (size_t)l * 1024 * 1024, 1, 0, tile, tid); return; }
    r -= JW_OUT;
    const int e = r / 192, q = r % 192, which = q >> 6, t = q & 63, kt = t >> 2, nt = t & 3;
    const size_t eo = (size_t)(l * 32 + e) * 1024 * 1024;
    if (which == 0) conv_tile(p.in[I_MWG] + eo, 1024, 1024, kt * 64, nt * 256, WSP(bf16_t, WS_WGU) + 2 * eo, 2, 0, tile, tid);
    else if (which == 1) conv_tile(p.in[I_MWU] + eo, 1024, 1024, kt * 64, nt * 256, WSP(bf16_t, WS_WGU) + 2 * eo, 2, 1, tile, tid);
    else conv_tile(p.in[I_MWD] + eo, 1024, 1024, kt * 64, nt * 256, WSP(bf16_t, WS_WDN) + eo, 1, 0, tile, tid);
}
__device__ __forceinline__ void mod_job(const Params& p, int job, LAS float* lds, int tid) {
    asm volatile("" : "+v"(tid));
    const int l = job / 24, c0 = (job % 24) * 256;
    LAS float* sv = lds;
    LAS float* part = lds + 5120;
    for (int i = tid; i < 5120; i += NTHR) { const int s = i >> 10, k = i & 1023; const float cv = s < 4 ? p.in[I_C][s * 1024 + k] : p.in[I_CCTX][k]; sv[i] = siluf_(cv); }
    __syncthreads();
    const int n = tid & 255, kh = tid >> 8;
    const float* w = p.in[I_ADAW] + (size_t)l * 1024 * 6144 + (size_t)(kh * 512) * 6144 + c0 + n;
    float a0 = 0.f, a1 = 0.f, a2 = 0.f, a3 = 0.f, a4 = 0.f;
    const LAS float* s0 = sv + kh * 512;
#pragma unroll 8
    for (int k = 0; k < 512; ++k) { const float wv = w[(size_t)k * 6144];
        a0 += s0[k] * wv; a1 += s0[1024 + k] * wv; a2 += s0[2048 + k] * wv; a3 += s0[3072 + k] * wv; a4 += s0[4096 + k] * wv; }
    part[(kh * 5 + 0) * 256 + n] = a0; part[(kh * 5 + 1) * 256 + n] = a1; part[(kh * 5 + 2) * 256 + n] = a2; part[(kh * 5 + 3) * 256 + n] = a3; part[(kh * 5 + 4) * 256 + n] = a4;
    __syncthreads();
    if (kh == 0) { const float bb = p.in[I_ADAB][l * 6144 + c0 + n]; float* mo = WSP(float, WS_MOD);
#pragma unroll
        for (int s = 0; s < 5; ++s) mo[(size_t)(l * 5 + s) * 6144 + c0 + n] = part[s * 256 + n] + part[(5 + s) * 256 + n] + bb; }
    __syncthreads();
}

__device__ __forceinline__ void ln_in_rows(const Params& p, int gw, int ngw, int lane) {
    float* H = WSP(float, WS_H); bf16_t* XM = WSP(bf16_t, WS_XM); const float* MOD = WSP(float, WS_MOD);
    for (int row = gw; row < NTOK; row += ngw) {
        const float* src = row < NLAT ? p.in[I_X] + (size_t)row * D : p.in[I_CTX] + (size_t)(row - NLAT) * D;
        f32x4 v[4]; float s = 0.f;
#pragma unroll
        for (int j = 0; j < 4; ++j) { v[j] = *(const f32x4*)(src + lane * 4 + 256 * j); s += (v[j][0] + v[j][1]) + (v[j][2] + v[j][3]); }
        const float mean = wave_sum(s) * (1.f / D); float s2 = 0.f;
#pragma unroll
        for (int j = 0; j < 4; ++j) { v[j] = v[j] - mean; s2 += (v[j][0] * v[j][0] + v[j][1] * v[j][1]) + (v[j][2] * v[j][2] + v[j][3] * v[j][3]); }
        const float rstd = rsqrtf(wave_sum(s2) * (1.f / D) + LN_EPS);
        const int sidx = row < NLAT ? (row >> 12) : 4; const float* mod = MOD + (size_t)sidx * 6144;
#pragma unroll
        for (int j = 0; j < 4; ++j) { const int c = lane * 4 + 256 * j;
            const f32x4 g = *(const f32x4*)(p.in[I_LNG] + c), bb = *(const f32x4*)(p.in[I_LNB] + c);
            const f32x4 y = v[j] * rstd * g + bb;
            *(f32x4*)(H + (size_t)row * D + c) = y;
            const f32x4 sh = *(const f32x4*)(mod + c), sc = *(const f32x4*)(mod + 1024 + c);
            const f32x4 xm = y * (sc + 1.f) + sh;
            u32x2 o; o.x = pk2(xm[0], xm[1]); o.y = pk2(xm[2], xm[3]);
            *(u32x2*)(XM + (size_t)row * D + c) = o; }
    }
}

__device__ __forceinline__ void unpack8(const u32x4 u, float (&f)[8]) {
    f[0] = bflo(u.x); f[1] = bfhi(u.x); f[2] = bflo(u.y); f[3] = bfhi(u.y); f[4] = bflo(u.z); f[5] = bfhi(u.z); f[6] = bflo(u.w); f[7] = bfhi(u.w);
}
__device__ __forceinline__ void da_job(const Params& p, int l, int b, int kt, LAS unsigned char* lds, int tid) {
    asm volatile("" : "+v"(tid));
    LAS bf16_t* kvt = (LAS bf16_t*)lds;
    const bf16_t* Z = WSP(bf16_t, WS_Z);
    const bool isctx = kt < 8;
    const int rowb = isctx ? NLAT + b * 256 + kt * 32 : b * 4096 + (kt - 8) * 32;
    for (int i = tid; i < 2048; i += NTHR) { const int r = i >> 6, c16 = i & 63;
        *(LAS u32x4*)(kvt + r * 512 + c16 * 8) = *(const u32x4*)(Z + (size_t)(rowb + r) * DINP + ZK + c16 * 8); }
    __syncthreads();
    const int w = tid >> 6, L = tid & 63, fr = L & 15, fq = L >> 4;
    unsigned char* rec = SCRP(unsigned char, SC_KVREC);
    unsigned* kmax = WSP(unsigned, WS_CTL) + CW_KMAX + l * 32;
    for (int h = 0; h < 4; ++h) {
        u32x4 o;
        if (w < 4) {
            const int m = w >> 1, ks = w & 1, key = ks * 16 + fr;
            float ov[8], pv[8];
            unpack8(*(const LAS u32x4*)(kvt + key * 512 + h * 64 + m * 32 + fq * 8), ov);
            unpack8(*(const LAS u32x4*)(kvt + key * 512 + h * 64 + m * 32 + (fq ^ 1) * 8), pv);
            if (!isctx) {
                const int t = (kt - 8) * 32 + key, pos = (fq >> 1) ? (t & 63) : (t >> 6);
                const float sg = (fq & 1) ? 1.f : -1.f;
#pragma unroll
                for (int i = 0; i < 8; ++i) ov[i] = ov[i] * ROPE_COS[pos][i] + sg * pv[i] * ROPE_SIN[pos][i];
            }
            o.x = pk2(ov[0], ov[1]); o.y = pk2(ov[2], ov[3]); o.z = pk2(ov[4], ov[5]); o.w = pk2(ov[6], ov[7]);
            float rv[8]; unpack8(o, rv); float n2 = 0.f;
#pragma unroll
            for (int i = 0; i < 8; ++i) n2 += rv[i] * rv[i];
            n2 += __shfl_xor(n2, 16); n2 += __shfl_xor(n2, 32);
#pragma unroll
            for (int x = 1; x < 16; x <<= 1) n2 = fmaxf(n2, __shfl_xor(n2, x));
            if (L == 0) { unsigned* kp = kmax + (b * 4 + h) * 2 + m; const unsigned nb = __builtin_bit_cast(unsigned, n2);
                if (nb > __hip_atomic_load(kp, __ATOMIC_RELAXED, __HIP_MEMORY_SCOPE_AGENT)) atomicMax(kp, nb); }
        } else {
            const int et = w - 4; unsigned short vv[8];
#pragma unroll
            for (int i = 0; i < 8; ++i) { const int key = (i < 4) ? fq * 4 + i : 16 + fq * 4 + (i - 4); vv[i] = kvt[key * 512 + 256 + h * 64 + et * 16 + fr]; }
            o.x = vv[0] | ((unsigned)vv[1] << 16); o.y = vv[2] | ((unsigned)vv[3] << 16); o.z = vv[4] | ((unsigned)vv[5] << 16); o.w = vv[6] | ((unsigned)vv[7] << 16);
        }
        *(u32x4*)(rec + ((size_t)((b * 4 + h) * NKT + kt)) * 8192 + w * 1024 + L * 16) = o;
    }
    __syncthreads();
}

__device__ __forceinline__ int chunk_row0(int cid) { return cid < 256 ? (cid >> 6) * 4096 + (cid & 63) * 64 : NLAT + ((cid - 256) >> 2) * 256 + ((cid - 256) & 3) * 64; }

constexpr int GLA_HL = 43264;
__device__ __forceinline__ void gla_job(const Params& p, int l, int cid, int hb, LAS unsigned char* lds, int tid) {
    asm volatile("" : "+v"(tid));
    const int r0 = chunk_row0(cid), w = tid >> 6, lane = tid & 63, fr = lane & 15, fq = lane >> 4;
    const bf16_t* Z = WSP(bf16_t, WS_Z);
#define GLA_PTRS(hh) LAS float* gi = (LAS float*)(lds + (hh) * GLA_HL); LAS float* GT = gi + 2048; LAS bf16_t* KDT = (LAS bf16_t*)(GT + 2 * 32 * 65); LAS bf16_t* Vt = KDT + 2 * 32 * 72; (void)gi; (void)GT; (void)KDT; (void)Vt;
#pragma unroll 1
    for (int hh = 0; hh < 3; ++hh) { const int h = hb + hh; GLA_PTRS(hh)
        if (tid < 256) { const int pp = tid >> 2, k8 = (tid & 3) * 8; float v[8]; unpack8(*(const u32x4*)(Z + (size_t)(r0 + pp) * DINP + ZGF + k8), v);
            *(LAS f32x4*)(gi + pp * 32 + k8) = (f32x4){v[0], v[1], v[2], v[3]}; *(LAS f32x4*)(gi + pp * 32 + k8 + 4) = (f32x4){v[4], v[5], v[6], v[7]}; }
        { const int pp = tid >> 3, v8 = (tid & 7) * 8; const u32x4 u = *(const u32x4*)(Z + (size_t)(r0 + pp) * DINP + ZGV + h * 64 + v8);
          Vt[(v8 + 0) * 72 + pp] = (bf16_t)(u.x & 0xffffu); Vt[(v8 + 1) * 72 + pp] = (bf16_t)(u.x >> 16); Vt[(v8 + 2) * 72 + pp] = (bf16_t)(u.y & 0xffffu); Vt[(v8 + 3) * 72 + pp] = (bf16_t)(u.y >> 16);
          Vt[(v8 + 4) * 72 + pp] = (bf16_t)(u.z & 0xffffu); Vt[(v8 + 5) * 72 + pp] = (bf16_t)(u.z >> 16); Vt[(v8 + 6) * 72 + pp] = (bf16_t)(u.w & 0xffffu); Vt[(v8 + 7) * 72 + pp] = (bf16_t)(u.w >> 16); } }
    LAS float* gwl = (LAS float*)(lds + 3 * GLA_HL);
    for (int i = tid; i < 2 * 17 * 96; i += NTHR) { const int dir = i / (17 * 96), r = (i / 96) % 17, c = i % 96;
        gwl[i] = r < 16 ? p.in[I_GW2][((size_t)(l * 2 + dir) * 16 + r) * 192 + hb * 32 + c] : p.in[I_GGB][(size_t)(l * 2 + dir) * 192 + hb * 32 + c]; }
    __syncthreads();
#pragma unroll 1
    for (int hh = 0; hh < 3; ++hh) { GLA_PTRS(hh)
#pragma unroll 1
        for (int j = 0; j < 8; ++j) { const int i = tid + NTHR * j, dir = i >> 11, k = (i >> 6) & 31, pp = i & 63;
            float x = gwl[(dir * 17 + 16) * 96 + hh * 32 + k];
#pragma unroll
            for (int jj = 0; jj < 16; ++jj) x += gi[pp * 32 + dir * 16 + jj] * gwl[(dir * 17 + jj) * 96 + hh * 32 + k];
            GT[(dir * 32 + k) * 65 + pp] = (fminf(x, 0.f) - __logf(1.f + __expf(-fabsf(x)))) * (1.f / 16.f); } }
    __syncthreads();
#pragma unroll 1
    for (int hh = 0; hh < 3; ++hh) { GLA_PTRS(hh)
#pragma unroll
        for (int c = 0; c < 8; ++c) { const int col = w * 8 + c, dir = col >> 5, pp = dir ? 63 - lane : lane; float x = GT[col * 65 + pp];
#pragma unroll
            for (int o = 1; o < 64; o <<= 1) { const float y = __shfl_up(x, o); if (lane >= o) x += y; }
            GT[col * 65 + pp] = x; } }
    __syncthreads();
    float* GBF = SCRP(float, SC_GBF); float* GBB = SCRP(float, SC_GBB);
#pragma unroll 1
    for (int hh = 0; hh < 3; ++hh) { const int h = hb + hh; GLA_PTRS(hh)
        for (int i = tid; i < 4096; i += NTHR) { const int dir = i >> 11, pp = (i >> 5) & 63, k = i & 31; const float bb = GT[(dir * 32 + k) * 65 + pp];
            (dir ? GBB : GBF)[(size_t)(r0 + pp) * 192 + h * 32 + k] = bb;
            const float kk = bf2f(Z[(size_t)(r0 + pp) * DINP + ZGK + h * 32 + k]);
            KDT[(dir * 32 + k) * 72 + pp] = (bf16_t)f2bf(kk * __expf(GT[(dir * 32 + k) * 65 + (dir ? 0 : 63)] - bb)); } }
    __syncthreads();
    float* KVC = SCRP(float, SC_KVC); float* DC = SCRP(float, SC_DC);
#pragma unroll 1
    for (int hh = 0; hh < 3; ++hh) { const int h = hb + hh; GLA_PTRS(hh)
#pragma unroll
        for (int q = 0; q < 2; ++q) { const int idx = w * 2 + q, dir = idx >> 3, mt = (idx >> 2) & 1, nt = idx & 3;
            f32x4 acc = {0.f, 0.f, 0.f, 0.f};
#pragma unroll
            for (int ks = 0; ks < 2; ++ks) { const bf16x8 a = *(const LAS bf16x8*)(KDT + (dir * 32 + mt * 16 + fr) * 72 + ks * 32 + fq * 8), b = *(const LAS bf16x8*)(Vt + (nt * 16 + fr) * 72 + ks * 32 + fq * 8);
                acc = __builtin_amdgcn_mfma_f32_16x16x32_bf16(a, b, acc, 0, 0, 0); }
            float* dst = KVC + ((size_t)((cid * 6 + h) * 2 + dir)) * 2048;
#pragma unroll
            for (int j = 0; j < 4; ++j) dst[(mt * 16 + fq * 4 + j) * 64 + nt * 16 + fr] = acc[j]; }
        if (tid < 64) { const int dir = tid >> 5, k = tid & 31; DC[((cid * 6 + h) * 2 + dir) * 32 + k] = __expf(GT[(dir * 32 + k) * 65 + (dir ? 0 : 63)]); } }
#undef GLA_PTRS
    __syncthreads();
}

constexpr int SGS = 136;
#ifndef TPH
#define TPH -1
#endif
#define TB2_(id) do { if (TPH == (id)) tph_t0 = __builtin_amdgcn_s_memrealtime(); } while (0)
#define TE2_(id) do { if (TPH == (id)) tph_acc += __builtin_amdgcn_s_memrealtime() - tph_t0; } while (0)
__device__ __forceinline__ void rw_job(const Params& p, int l, int tt, LAS unsigned char* lds, int tid, unsigned long long& tph_t0, unsigned long long& tph_acc) {
    asm volatile("" : "+v"(tid));
    const int r0 = tt < 512 ? tt * 32 : NLAT + (tt - 512) * 32;
    const int pos = tt < 512 ? (r0 & 4095) : ((r0 - NLAT) & 255), slen = tt < 512 ? 4096 : 256;
    const bool has_prev = pos > 0, has_next = pos + 32 < slen;
    TB2_(40);
    const bf16_t* Z = WSP(bf16_t, WS_Z);
    LAS bf16_t* rkv = (LAS bf16_t*)lds;
    LAS bf16_t* XW = (LAS bf16_t*)(lds + 78336);
    LAS bf16_t* XG = XW + 4 * 32 * 72;
    for (int i = tid; i < 34 * 144; i += NTHR) { const int rr = i / 144, c16 = i % 144; const bool ok = rr == 0 ? has_prev : (rr == 33 ? has_next : true);
        u32x4 v = {0u, 0u, 0u, 0u}; if (ok) v = *(const u32x4*)(Z + (size_t)(r0 - 1 + rr) * DINP + ZRKV + c16 * 8);
        *(LAS u32x4*)(rkv + rr * 1152 + c16 * 8) = v; }
    for (int i = tid; i < 32 * 48; i += NTHR) { const int t = i / 48, c = (i % 48) * 8; float v[8]; unpack8(*(const u32x4*)(Z + (size_t)(r0 + t) * DINP + ZWF + c), v);
        if (c < 128) {
#pragma unroll
            for (int q = 0; q < 8; ++q) v[q] = tanhf_(v[q]); }
        else if (c >= 256) {
#pragma unroll
            for (int q = 0; q < 8; ++q) v[q] = sigmoidf_(v[q]); }
        u32x4 o; o.x = pk2(v[0], v[1]); o.y = pk2(v[2], v[3]); o.z = pk2(v[4], v[5]); o.w = pk2(v[6], v[7]);
        if (c < 256) *(LAS u32x4*)(XW + ((c >> 6) * 32 + t) * 72 + (c & 63)) = o; else *(LAS u32x4*)(XG + t * SGS + (c - 256)) = o; }
    __syncthreads(); TE2_(40); TB2_(41);
    LAS float* PRM = (LAS float*)(XG + 32 * SGS);
    for (int i = tid; i < 16 * 384; i += NTHR) { const int r = i / 384, c = i % 384; float v;
        if (r < 9) v = p.in[I_CONV][(size_t)l * 3 * 1152 + (r % 3) * 1152 + (r / 3) * 384 + c];
        else if (r == 9) v = p.in[I_KK][l * 384 + c]; else if (r == 10) v = p.in[I_KA][l * 384 + c]; else if (r == 11) v = p.in[I_RK][l * 384 + c];
        else if (r < 14) v = p.in[I_W0][(l * 2 + (r - 12)) * 384 + c]; else v = p.in[I_A0][(l * 2 + (r - 14)) * 384 + c];
        PRM[i] = v; }
    __syncthreads(); TE2_(41); TB2_(42);
    const int h = tid >> 6, lane = tid & 63, fr = lane & 15, fq = lane >> 4;
    if (h < 6) {
        const bf16_t* WT = WSP(bf16_t, WS_RWW) + (size_t)l * RWW_LAYER;
        bf16_t* Rg = SCRP(bf16_t, SC_R); bf16_t* KKg = SCRP(bf16_t, SC_KK); bf16_t* Vg = SCRP(bf16_t, SC_V); bf16_t* Gg = SCRP(bf16_t, SC_G); float* BON = SCRP(float, SC_BON);
        bf16_t* BKF = SCRP(bf16_t, SC_BKF); bf16_t* BKB = SCRP(bf16_t, SC_BKB); bf16_t* KMF = SCRP(bf16_t, SC_KMF); bf16_t* KMB = SCRP(bf16_t, SC_KMB);
        float* LWF = SCRP(float, SC_WF); float* LWB = SCRP(float, SC_WB);
#define CONV3(t, off, c, w0, w1, w2) (bf2f(rkv[(t) * 1152 + (off) + (c)]) * (w0) + bf2f(rkv[((t) + 1) * 1152 + (off) + (c)]) * (w1) + bf2f(rkv[((t) + 2) * 1152 + (off) + (c)]) * (w2))
        LAS float* invl = PRM + 16 * 384 + h * 64;
#pragma unroll
        for (int mt = 0; mt < 2; ++mt) { float ss[4] = {0.f, 0.f, 0.f, 0.f};
#pragma unroll
            for (int nt = 0; nt < 4; ++nt) { const int c = h * 64 + nt * 16 + fr; const float ck0 = PRM[3 * 384 + c], ck1 = PRM[4 * 384 + c], ck2 = PRM[5 * 384 + c], kkw = PRM[9 * 384 + c];
#pragma unroll
                for (int j = 0; j < 4; ++j) { const int t = mt * 16 + fq * 4 + j; const float kr = CONV3(t, 384, c, ck0, ck1, ck2) * kkw; ss[j] += kr * kr; } }
#pragma unroll
            for (int j = 0; j < 4; ++j) { const float iv = 1.f / fmaxf(sqrtf(red16(ss[j])), 1e-12f); if (fr == 0) { invl[mt * 16 + fq * 4 + j] = iv; invl[32 + mt * 16 + fq * 4 + j] = 0.f; } } }
        TE2_(42); TB2_(43);
#pragma unroll 1
        for (int np = 0; np < 2; ++np) {
            bf16x8 bw[2][4][2], bg[2][4];
#pragma unroll
            for (int q = 0; q < 2; ++q) { const int c = h * 64 + (np * 2 + q) * 16 + fr;
#pragma unroll
                for (int m = 0; m < 4; ++m)
#pragma unroll
                    for (int ks = 0; ks < 2; ++ks) bw[q][m][ks] = *(const bf16x8*)(WT + (size_t)m * 384 * 64 + (size_t)c * 64 + ks * 32 + fq * 8);
#pragma unroll
                for (int ks = 0; ks < 4; ++ks) bg[q][ks] = *(const bf16x8*)(WT + (size_t)4 * 384 * 64 + (size_t)c * 128 + ks * 32 + fq * 8); }
#pragma unroll 1
            for (int mt = 0; mt < 2; ++mt) {
                bf16x8 ax[4][2], ag[4];
#pragma unroll
                for (int m = 0; m < 4; ++m)
#pragma unroll
                    for (int ks = 0; ks < 2; ++ks) ax[m][ks] = *(const LAS bf16x8*)(XW + ((m * 32 + mt * 16 + fr) * 72) + ks * 32 + fq * 8);
#pragma unroll
                for (int ks = 0; ks < 4; ++ks) ag[ks] = *(const LAS bf16x8*)(XG + (mt * 16 + fr) * SGS + ks * 32 + fq * 8);
#pragma unroll
                for (int q = 0; q < 2; ++q) { const int c = h * 64 + (np * 2 + q) * 16 + fr;
                    f32x4 acc[5];
#pragma unroll
                    for (int m = 0; m < 5; ++m) acc[m] = (f32x4){0.f, 0.f, 0.f, 0.f};
#pragma unroll
                    for (int m = 0; m < 4; ++m)
#pragma unroll
                        for (int ks = 0; ks < 2; ++ks) acc[m] = __builtin_amdgcn_mfma_f32_16x16x32_bf16(ax[m][ks], bw[q][m][ks], acc[m], 0, 0, 0);
#pragma unroll
                    for (int ks = 0; ks < 4; ++ks) acc[4] = __builtin_amdgcn_mfma_f32_16x16x32_bf16(ag[ks], bg[q][ks], acc[4], 0, 0, 0);
                    const float cr0 = PRM[c], cr1 = PRM[384 + c], cr2 = PRM[768 + c], ck0 = PRM[3 * 384 + c], ck1 = PRM[4 * 384 + c], ck2 = PRM[5 * 384 + c], cv0 = PRM[6 * 384 + c], cv1 = PRM[7 * 384 + c], cv2 = PRM[8 * 384 + c];
                    const float kkw = PRM[9 * 384 + c], kaw = PRM[10 * 384 + c], rkw = PRM[11 * 384 + c], w0f = PRM[12 * 384 + c], w0b = PRM[13 * 384 + c], a0f = PRM[14 * 384 + c], a0b = PRM[15 * 384 + c];
#pragma unroll
                    for (int j = 0; j < 4; ++j) { const int t = mt * 16 + fq * 4 + j; const size_t o = (size_t)(r0 + t) * 384 + c;
                        const float r = CONV3(t, 0, c, cr0, cr1, cr2), v = CONV3(t, 768, c, cv0, cv1, cv2), k = CONV3(t, 384, c, ck0, ck1, ck2), kkn = k * kkw * invl[t];
                        const float af = sigmoidf_(a0f + acc[2][j]), ab = sigmoidf_(a0b + acc[3][j]);
                        const float kmf = k * (1.f + (af - 1.f) * kaw), kmb = k * (1.f + (ab - 1.f) * kaw);
                        Rg[o] = (bf16_t)f2bf(r); Vg[o] = (bf16_t)f2bf(v); KKg[o] = (bf16_t)f2bf(kkn);
                        BKF[o] = (bf16_t)f2bf(kkn * af); BKB[o] = (bf16_t)f2bf(kkn * ab); KMF[o] = (bf16_t)f2bf(kmf); KMB[o] = (bf16_t)f2bf(kmb);
                        LWF[o] = -0.6065306597f * sigmoidf_(w0f + acc[0][j]); LWB[o] = -0.6065306597f * sigmoidf_(w0b + acc[1][j]);
                        Gg[o] = (bf16_t)f2bf(acc[4][j]);
                        const float bv = red16(r * (kmf + kmb) * rkw); if (fr == 0) invl[32 + t] += bv; } }
            }
        }
        if (lane < 32) BON[(size_t)(r0 + lane) * 8 + h] = invl[32 + lane];
#undef CONV3
    }
    __syncthreads(); TE2_(43);
}

__device__ __forceinline__ int chain_chunk(int b, int dir, int step) {
    if (step < 4) return 256 + b * 4 + (dir ? 3 - step : step);
    const int cl = step - 4; return b * 64 + (dir ? 63 - cl : cl);
}
__device__ __forceinline__ void g2_job(const Params& p, int job, int tid) {
    asm volatile("" : "+v"(tid));
    const int chain = job >> 2, q = job & 3, b = chain / 12, h = (chain % 12) >> 1, dir = chain & 1, e = q * 512 + tid, k = e >> 6;
    const float* __restrict__ KVC = SCRP(float, SC_KVC); const float* __restrict__ DC = SCRP(float, SC_DC); float* __restrict__ SC = SCRP(float, SC_SC);
    float S = 0.f;
#pragma unroll 1
    for (int s0 = 0; s0 < 68; s0 += 34) {
        float dv[34], kv[34];
#pragma unroll
        for (int u = 0; u < 34; ++u) { const size_t base = (size_t)((chain_chunk(b, dir, s0 + u) * 6 + h) * 2 + dir); dv[u] = DC[base * 32 + k]; kv[u] = KVC[base * 2048 + e]; }
#pragma unroll
        for (int u = 0; u < 34; ++u) { const size_t base = (size_t)((chain_chunk(b, dir, s0 + u) * 6 + h) * 2 + dir); SC[base * 2048 + e] = S; S = S * dv[u] + kv[u]; }
    }
}

__device__ __forceinline__ void attn_unit(const Params& p, int l, int b, int h, bool isctx, int qb, LAS unsigned char* lds, int tid) {
    asm volatile("" : "+v"(tid));
    const int w = tid >> 6, L = tid & 63, fr = L & 15, fq = L >> 4;
    const int qrow0 = (isctx ? NLAT + b * 256 : b * 4096) + qb * 256;
    const int nst = isctx ? 2 : 34;
    const unsigned char* rec = SCRP(unsigned char, SC_KVREC) + (size_t)(b * 4 + h) * NKT * 8192;
    const bf16_t* Z = WSP(bf16_t, WS_Z);
    u32x4 ld[4];
#pragma unroll
    for (int q = 0; q < 4; ++q) ld[q] = *(const u32x4*)(rec + q * 8192 + tid * 16);
    float lam;
    { const float* q1 = p.in[I_LQ1] + l * 32; const float* k1 = p.in[I_LK1] + l * 32; const float* q2 = p.in[I_LQ2] + l * 32; const float* k2 = p.in[I_LK2] + l * 32;
      float s1 = 0.f, s2 = 0.f;
      for (int i = 0; i < 32; ++i) { s1 += q1[i] * k1[i]; s2 += q2[i] * k2[i]; }
      const float lam_init = l == 0 ? 0.2f : 0.35550907f;
      lam = __expf(s1) - __expf(s2) + lam_init; }
    asm volatile("" : "+v"(lam));
    const float one_m_li = l == 0 ? 0.8f : 0.64449093f;
    bf16x8 Qb[2][2]; f32x4 cinit[2][2];
    {
        const unsigned* kmax = WSP(unsigned, WS_CTL) + CW_KMAX + l * 32 + (b * 4 + h) * 2;
#pragma unroll
        for (int sub = 0; sub < 2; ++sub) {
            const int row = qrow0 + w * 32 + sub * 16 + fr, tpos = qb * 256 + w * 32 + sub * 16 + fr;
#pragma unroll
            for (int m = 0; m < 2; ++m) {
                float ov[8], pv[8];
                unpack8(*(const u32x4*)(Z + (size_t)row * DINP + ZQ + h * 64 + m * 32 + fq * 8), ov);
                unpack8(*(const u32x4*)(Z + (size_t)row * DINP + ZQ + h * 64 + m * 32 + (fq ^ 1) * 8), pv);
                if (!isctx) {
                    const int pos = (fq >> 1) ? (tpos & 63) : (tpos >> 6); const float sg = (fq & 1) ? 1.f : -1.f;
#pragma unroll
                    for (int i = 0; i < 8; ++i) ov[i] = ov[i] * ROPE_COS[pos][i] + sg * pv[i] * ROPE_SIN[pos][i];
                }
#pragma unroll
                for (int i = 0; i < 8; ++i) ov[i] *= 0.2550348616f;
                u32x4 o; o.x = pk2(ov[0], ov[1]); o.y = pk2(ov[2], ov[3]); o.z = pk2(ov[4], ov[5]); o.w = pk2(ov[6], ov[7]);
                float rv[8]; unpack8(o, rv); float n2 = 0.f;
#pragma unroll
                for (int i = 0; i < 8; ++i) n2 += rv[i] * rv[i];
                n2 += __shfl_xor(n2, 16); n2 += __shfl_xor(n2, 32);
                const float km = __builtin_bit_cast(float, __hip_atomic_load(kmax + m, __ATOMIC_RELAXED, __HIP_MEMORY_SCOPE_AGENT));
                const float mq = sqrtf(n2) * sqrtf(km);
                Qb[sub][m] = __builtin_bit_cast(bf16x8, o);
                cinit[sub][m] = (f32x4){-mq, -mq, -mq, -mq};
            }
        }
    }
#pragma unroll
    for (int q = 0; q < 4; ++q) *(LAS u32x4*)(lds + q * 8192 + tid * 16) = ld[q];
    __syncthreads();
    f32x4 O[2][2][4], Ls[2][2];
#pragma unroll
    for (int sub = 0; sub < 2; ++sub)
#pragma unroll
        for (int m = 0; m < 2; ++m) { Ls[sub][m] = (f32x4){0.f, 0.f, 0.f, 0.f};
#pragma unroll
            for (int et = 0; et < 4; ++et) O[sub][m][et] = (f32x4){0.f, 0.f, 0.f, 0.f}; }
    const bf16x8 ones = __builtin_bit_cast(bf16x8, (u32x4){0x3f803f80u, 0x3f803f80u, 0x3f803f80u, 0x3f803f80u});
#pragma unroll 1
    for (int st = 0; st < nst; ++st) {
        if (st + 1 < nst) {
#pragma unroll
            for (int q = 0; q < 4; ++q) ld[q] = *(const u32x4*)(rec + (size_t)(st + 1) * 32768 + q * 8192 + tid * 16); }
        const LAS unsigned char* cur = lds + (st & 1) * 32768;
#pragma unroll
        for (int hf = 0; hf < 4; ++hf) {
            const LAS unsigned char* rp = cur + hf * 8192 + L * 16;
            bf16x8 vb[4];
#pragma unroll
            for (int et = 0; et < 4; ++et) vb[et] = *(const LAS bf16x8*)(rp + (4 + et) * 1024);
#pragma unroll
            for (int m = 0; m < 2; ++m) {
                const bf16x8 ka0 = *(const LAS bf16x8*)(rp + (m * 2) * 1024), ka1 = *(const LAS bf16x8*)(rp + (m * 2 + 1) * 1024);
#pragma unroll
                for (int sub = 0; sub < 2; ++sub) {
                    const f32x4 s0 = __builtin_amdgcn_mfma_f32_16x16x32_bf16(ka0, Qb[sub][m], cinit[sub][m], 0, 0, 0);
                    const f32x4 s1 = __builtin_amdgcn_mfma_f32_16x16x32_bf16(ka1, Qb[sub][m], cinit[sub][m], 0, 0, 0);
                    float e[8];
#pragma unroll
                    for (int i = 0; i < 4; ++i) { e[i] = __builtin_amdgcn_exp2f(s0[i]); e[4 + i] = __builtin_amdgcn_exp2f(s1[i]); }
                    u32x4 pk; pk.x = pg8::cvt_pk_bf16(e[0], e[1]); pk.y = pg8::cvt_pk_bf16(e[2], e[3]); pk.z = pg8::cvt_pk_bf16(e[4], e[5]); pk.w = pg8::cvt_pk_bf16(e[6], e[7]);
                    const bf16x8 pa = __builtin_bit_cast(bf16x8, pk);
                    Ls[sub][m] = __builtin_amdgcn_mfma_f32_16x16x32_bf16(pa, ones, Ls[sub][m], 0, 0, 0);
#pragma unroll
                    for (int et = 0; et < 4; ++et) O[sub][m][et] = __builtin_amdgcn_mfma_f32_16x16x32_bf16(pa, vb[et], O[sub][m][et], 0, 0, 0);
                }
            }
        }
        if (st + 1 < nst) { LAS unsigned char* nb = lds + ((st + 1) & 1) * 32768;
#pragma unroll
            for (int q = 0; q < 4; ++q) *(LAS u32x4*)(nb + q * 8192 + tid * 16) = ld[q]; }
        __syncthreads();
    }
    const float* sg = p.in[I_SUBLN] + l * 64; bf16_t* CAT = WSP(bf16_t, WS_CAT);
#pragma unroll
    for (int sub = 0; sub < 2; ++sub)
#pragma unroll
        for (int j = 0; j < 4; ++j) {
            const float i0 = __builtin_amdgcn_rcpf(Ls[sub][0][j]), i1 = lam * __builtin_amdgcn_rcpf(Ls[sub][1][j]);
            float ov[4], ss = 0.f;
#pragma unroll
            for (int et = 0; et < 4; ++et) { ov[et] = O[sub][0][et][j] * i0 - O[sub][1][et][j] * i1; ss += ov[et] * ov[et]; }
#pragma unroll
            for (int x = 1; x < 16; x <<= 1) ss += __shfl_xor(ss, x);
            const float rs = rsqrtf(ss * (1.f / 64.f) + LN_EPS) * one_m_li;
            const size_t ro = (size_t)(qrow0 + w * 32 + sub * 16 + fq * 4 + j) * D + h * 64;
#pragma unroll
            for (int et = 0; et < 4; ++et) CAT[ro + et * 16 + fr] = (bf16_t)f2bf(ov[et] * rs * sg[et * 16 + fr]);
        }
    __syncthreads();
}

constexpr int LS4 = 40;
__device__ __forceinline__ f32x4 mfma_k32(const LAS bf16_t* A, const LAS bf16_t* B, int mt, int nt, int fr, int fq, f32x4 acc) {
    const bf16x8 a = *(const LAS bf16x8*)(A + (mt * 16 + fr) * LS4 + fq * 8), b = *(const LAS bf16x8*)(B + (nt * 16 + fr) * LS4 + fq * 8);
    return __builtin_amdgcn_mfma_f32_16x16x32_bf16(a, b, acc, 0, 0, 0);
}
constexpr int G3_HL = 65536;
__device__ __forceinline__ void g3_job(const Params& p, int l, int cid, int hb, LAS unsigned char* lds, int tid) {
    asm volatile("" : "+v"(tid));
    const int r0 = chunk_row0(cid), w = tid >> 6, lane = tid & 63, fr = lane & 15, fq = lane >> 4;
    const bf16_t* Z = WSP(bf16_t, WS_Z);
#define G3_PTRS(hh) LAS bf16_t* QF = (LAS bf16_t*)(lds + (hh) * G3_HL); LAS bf16_t* KF = QF + 64 * LS4; LAS bf16_t* QB = KF + 64 * LS4; LAS bf16_t* KB = QB + 64 * LS4; \
    LAS bf16_t* SFt = KB + 64 * LS4; LAS bf16_t* SBt = SFt + 64 * LS4; LAS bf16_t* Vt = SBt + 64 * LS4; LAS bf16_t* AT = Vt + 64 * 72; LAS f32x4* xb = (LAS f32x4*)(AT + 64 * 72); \
    (void)QF; (void)KF; (void)QB; (void)KB; (void)SFt; (void)SBt; (void)Vt; (void)AT; (void)xb;
    const float* GBF = SCRP(float, SC_GBF); const float* GBB = SCRP(float, SC_GBB); const float* SC = SCRP(float, SC_SC);
#pragma unroll
    for (int hh = 0; hh < 2; ++hh) { const int h = hb + hh; G3_PTRS(hh)
        { const int pp = tid >> 3, k4 = (tid & 7) * 4; const size_t zr = (size_t)(r0 + pp) * DINP;
          const u32x2 qu = *(const u32x2*)(Z + zr + ZGQ + h * 32 + k4), ku = *(const u32x2*)(Z + zr + ZGK + h * 32 + k4);
          const f32x4 bf = *(const f32x4*)(GBF + (size_t)(r0 + pp) * 192 + h * 32 + k4), bb = *(const f32x4*)(GBB + (size_t)(r0 + pp) * 192 + h * 32 + k4);
          const float q[4] = {bflo(qu.x) * 0.17677669529f, bfhi(qu.x) * 0.17677669529f, bflo(qu.y) * 0.17677669529f, bfhi(qu.y) * 0.17677669529f}, kk[4] = {bflo(ku.x), bfhi(ku.x), bflo(ku.y), bfhi(ku.y)};
          u32x2 o;
          o.x = pk2(q[0] * __expf(bf[0]), q[1] * __expf(bf[1])); o.y = pk2(q[2] * __expf(bf[2]), q[3] * __expf(bf[3])); *(LAS u32x2*)(QF + pp * LS4 + k4) = o;
          o.x = pk2(kk[0] * __expf(-bf[0]), kk[1] * __expf(-bf[1])); o.y = pk2(kk[2] * __expf(-bf[2]), kk[3] * __expf(-bf[3])); *(LAS u32x2*)(KF + pp * LS4 + k4) = o;
          o.x = pk2(q[0] * __expf(bb[0]), q[1] * __expf(bb[1])); o.y = pk2(q[2] * __expf(bb[2]), q[3] * __expf(bb[3])); *(LAS u32x2*)(QB + pp * LS4 + k4) = o;
          o.x = pk2(kk[0] * __expf(-bb[0]), kk[1] * __expf(-bb[1])); o.y = pk2(kk[2] * __expf(-bb[2]), kk[3] * __expf(-bb[3])); *(LAS u32x2*)(KB + pp * LS4 + k4) = o; }
        { const int pp = tid >> 3, v8 = (tid & 7) * 8; const u32x4 u = *(const u32x4*)(Z + (size_t)(r0 + pp) * DINP + ZGV + h * 64 + v8);
          Vt[(v8 + 0) * 72 + pp] = (bf16_t)(u.x & 0xffffu); Vt[(v8 + 1) * 72 + pp] = (bf16_t)(u.x >> 16); Vt[(v8 + 2) * 72 + pp] = (bf16_t)(u.y & 0xffffu); Vt[(v8 + 3) * 72 + pp] = (bf16_t)(u.y >> 16);
          Vt[(v8 + 4) * 72 + pp] = (bf16_t)(u.z & 0xffffu); Vt[(v8 + 5) * 72 + pp] = (bf16_t)(u.z >> 16); Vt[(v8 + 6) * 72 + pp] = (bf16_t)(u.w & 0xffffu); Vt[(v8 + 7) * 72 + pp] = (bf16_t)(u.w >> 16); }
        { const int k = tid >> 4, v4 = (tid & 15) * 4;
          const f32x4 sf = *(const f32x4*)(SC + ((size_t)((cid * 6 + h) * 2 + 0)) * 2048 + k * 64 + v4), sb = *(const f32x4*)(SC + ((size_t)((cid * 6 + h) * 2 + 1)) * 2048 + k * 64 + v4);
#pragma unroll
          for (int q = 0; q < 4; ++q) { SFt[(v4 + q) * LS4 + k] = (bf16_t)f2bf(sf[q]); SBt[(v4 + q) * LS4 + k] = (bf16_t)f2bf(sb[q]); } } }
    __syncthreads();
#pragma unroll
    for (int hh = 0; hh < 2; ++hh) { G3_PTRS(hh)
#pragma unroll
        for (int q = 0; q < 2; ++q) { const int idx = w * 2 + q, mt = idx >> 2, nt = idx & 3;
            f32x4 af = {0.f, 0.f, 0.f, 0.f}, ab = {0.f, 0.f, 0.f, 0.f};
            if (nt <= mt) af = mfma_k32(QF, KF, mt, nt, fr, fq, af);
            if (nt >= mt) ab = mfma_k32(QB, KB, mt, nt, fr, fq, ab);
#pragma unroll
            for (int j = 0; j < 4; ++j) { const int tt = mt * 16 + fq * 4 + j, ss = nt * 16 + fr;
                AT[tt * 72 + ss] = (bf16_t)f2bf((ss <= tt ? af[j] : 0.f) + (ss >= tt ? ab[j] : 0.f)); } } }
    __syncthreads();
    const int mt = w & 3;
    f32x4 acc[2][4];
#pragma unroll
    for (int hh = 0; hh < 2; ++hh) { G3_PTRS(hh)
#pragma unroll
        for (int nt = 0; nt < 4; ++nt) { acc[hh][nt] = (f32x4){0.f, 0.f, 0.f, 0.f};
            if (w < 4) {
#pragma unroll
                for (int ks = 0; ks < 2; ++ks) { const bf16x8 a = *(const LAS bf16x8*)(AT + (mt * 16 + fr) * 72 + ks * 32 + fq * 8), b = *(const LAS bf16x8*)(Vt + (nt * 16 + fr) * 72 + ks * 32 + fq * 8);
                    acc[hh][nt] = __builtin_amdgcn_mfma_f32_16x16x32_bf16(a, b, acc[hh][nt], 0, 0, 0); } }
            else { acc[hh][nt] = mfma_k32(QF, SFt, mt, nt, fr, fq, acc[hh][nt]); acc[hh][nt] = mfma_k32(QB, SBt, mt, nt, fr, fq, acc[hh][nt]); xb[(mt * 4 + nt) * 64 + lane] = acc[hh][nt]; } } }
    __syncthreads();
    if (w < 4) {
        bf16_t* CAT = WSP(bf16_t, WS_CAT);
#pragma unroll
        for (int hh = 0; hh < 2; ++hh) { const int h = hb + hh; G3_PTRS(hh)
#pragma unroll
            for (int nt = 0; nt < 4; ++nt) acc[hh][nt] += xb[(mt * 4 + nt) * 64 + lane];
#pragma unroll
            for (int j = 0; j < 4; ++j) { const int row = r0 + mt * 16 + fq * 4 + j;
                float ss = (acc[hh][0][j] * acc[hh][0][j] + acc[hh][1][j] * acc[hh][1][j]) + (acc[hh][2][j] * acc[hh][2][j] + acc[hh][3][j] * acc[hh][3][j]); ss = red16(ss);
                const float rs = rsqrtf(ss * (1.f / 64.f) + LN_EPS);
#pragma unroll
                for (int nt = 0; nt < 4; ++nt) { const int v = nt * 16 + fr; const float gr = bf2f(Z[(size_t)row * DINP + ZGR + h * 64 + v]);
                    CAT[(size_t)row * D + 256 + h * 64 + v] = (bf16_t)f2bf(acc[hh][nt][j] * rs * p.in[I_GNG][l * 64 + v] * siluf_(gr)); } } }
    }
#undef G3_PTRS
    __syncthreads();
}

constexpr int RA_S = 1032;
__device__ __forceinline__ void ln1_router(const Params& p, int l, int nrows, LAS unsigned char* lds, int tid, int G, int bx, bool dry = false) {
    asm volatile("" : "+v"(tid));
    const int w = tid >> 6, lane = tid & 63, fr = lane & 15, fq = lane >> 4;
    LAS bf16_t* AH = (LAS bf16_t*)lds;
    LAS bf16_t* AL = AH + 16 * RA_S;
    LAS float* part = (LAS float*)(AL + 16 * RA_S);
    LAS float* lgs = part + 8 * 16 * 32;
    LAS unsigned* lcnt = (LAS unsigned*)(lgs + 16 * 32);
    if (tid < 32) lcnt[tid] = 0u;
    float* H = WSP(float, WS_H); bf16_t* XM = WSP(bf16_t, WS_XM); const bf16_t* MIX = WSP(bf16_t, WS_Z); const float* MOD = WSP(float, WS_MOD);
    int* TOPE = WSP(int, WS_TOP); float* TOPG = WSP(float, WS_TOP + TOP_STRIDE); int* TOPR = WSP(int, WS_TOP + 2 * TOP_STRIDE);
    const float* g1p = p.in[I_LN1G] + l * 1024; const float* b1p = p.in[I_LN1B] + l * 1024; const float* rb = p.in[I_RB] + l * 32;
    const bf16_t* RT = WSP(bf16_t, WS_RTW) + (size_t)l * 2 * 32 * 1024;
    bf16x8 bh[4][2], bl[4][2];
#pragma unroll
    for (int ks = 0; ks < 4; ++ks)
#pragma unroll
        for (int nt = 0; nt < 2; ++nt) { const size_t o = (size_t)(nt * 16 + fr) * 1024 + (w * 4 + ks) * 32 + fq * 8; bh[ks][nt] = *(const bf16x8*)(RT + o); bl[ks][nt] = *(const bf16x8*)(RT + 32 * 1024 + o); }
    float alpha = DN_ALPHA; asm volatile("" : "+v"(alpha));
    __syncthreads();
    const int ngroups = nrows >> 4;
    for (int g = bx; g < ngroups; g += G) {
        f32x4 y[2][4]; float s[2] = {0.f, 0.f};
#pragma unroll
        for (int r = 0; r < 2; ++r) { const int row = g * 16 + r * 8 + w; const int sidx = row < NLAT ? (row >> 12) : 4; const float* mod = MOD + (size_t)(l * 5 + sidx) * 6144;
#pragma unroll
            for (int j = 0; j < 4; ++j) { const int c = lane * 4 + 256 * j; const u32x2 mx = *(const u32x2*)(MIX + (size_t)row * D + c);
                y[r][j] = *(const f32x4*)(H + (size_t)row * D + c) * alpha + *(const f32x4*)(mod + 2048 + c) * (f32x4){bflo(mx.x), bfhi(mx.x), bflo(mx.y), bfhi(mx.y)};
                s[r] += (y[r][j][0] + y[r][j][1]) + (y[r][j][2] + y[r][j][3]); } }
#pragma unroll
        for (int r = 0; r < 2; ++r) { const int row = g * 16 + r * 8 + w; const int sidx = row < NLAT ? (row >> 12) : 4; const float* mod = MOD + (size_t)(l * 5 + sidx) * 6144;
            const float mean = wave_sum(s[r]) * (1.f / D); float s2 = 0.f;
#pragma unroll
            for (int j = 0; j < 4; ++j) { y[r][j] = y[r][j] - mean; s2 += (y[r][j][0] * y[r][j][0] + y[r][j][1] * y[r][j][1]) + (y[r][j][2] * y[r][j][2] + y[r][j][3] * y[r][j][3]); }
            const float rstd = rsqrtf(wave_sum(s2) * (1.f / D) + LN_EPS);
#pragma unroll
            for (int j = 0; j < 4; ++j) { const int c = lane * 4 + 256 * j;
                const f32x4 hn = y[r][j] * rstd * *(const f32x4*)(g1p + c) + *(const f32x4*)(b1p + c);
                const f32x4 m = hn * (*(const f32x4*)(mod + 4096 + c) + 1.f) + *(const f32x4*)(mod + 3072 + c);
                if (!dry || m[0] == 123456.789f) { *(f32x4*)(H + (size_t)row * D + c) = hn; u32x2 o; o.x = pk2(m[0], m[1]); o.y = pk2(m[2], m[3]); *(u32x2*)(XM + (size_t)row * D + c) = o; }
                u32x2 hi; hi.x = pk2(m[0], m[1]); hi.y = pk2(m[2], m[3]);
                u32x2 lo; lo.x = pk2(m[0] - bflo(hi.x), m[1] - bfhi(hi.x)); lo.y = pk2(m[2] - bflo(hi.y), m[3] - bfhi(hi.y));
                *(LAS u32x2*)(AH + (r * 8 + w) * RA_S + c) = hi; *(LAS u32x2*)(AL + (r * 8 + w) * RA_S + c) = lo; } }
        __syncthreads();
        {
            f32x4 acc[2] = {{0.f, 0.f, 0.f, 0.f}, {0.f, 0.f, 0.f, 0.f}};
#pragma unroll
            for (int ks = 0; ks < 4; ++ks) { const int ko = fr * RA_S + (w * 4 + ks) * 32 + fq * 8;
                const bf16x8 ah = *(const LAS bf16x8*)(AH + ko), al = *(const LAS bf16x8*)(AL + ko);
#pragma unroll
                for (int nt = 0; nt < 2; ++nt) { acc[nt] = __builtin_amdgcn_mfma_f32_16x16x32_bf16(ah, bh[ks][nt], acc[nt], 0, 0, 0);
                    acc[nt] = __builtin_amdgcn_mfma_f32_16x16x32_bf16(al, bh[ks][nt], acc[nt], 0, 0, 0); acc[nt] = __builtin_amdgcn_mfma_f32_16x16x32_bf16(ah, bl[ks][nt], acc[nt], 0, 0, 0); } }
#pragma unroll
            for (int nt = 0; nt < 2; ++nt)
#pragma unroll
                for (int j = 0; j < 4; ++j) part[(w * 16 + fq * 4 + j) * 32 + nt * 16 + fr] = acc[nt][j];
        }
        __syncthreads();
        { const int rr = lane >> 5, e = lane & 31, rl = rr * 8 + w; float a = rb[e];
#pragma unroll
          for (int ww = 0; ww < 8; ++ww) a += part[(ww * 16 + rl) * 32 + e];
          lgs[rl * 32 + e] = a; }
#pragma unroll
        for (int r = 0; r < 2; ++r) { const int row = g * 16 + r * 8 + w;
            float lg[32];
#pragma unroll
            for (int e4 = 0; e4 < 8; ++e4) { const f32x4 v = *(const LAS f32x4*)(lgs + (r * 8 + w) * 32 + e4 * 4); lg[e4 * 4] = v[0]; lg[e4 * 4 + 1] = v[1]; lg[e4 * 4 + 2] = v[2]; lg[e4 * 4 + 3] = v[3]; }
            float tv[4]; int ti[4];
#pragma unroll
            for (int k = 0; k < 4; ++k) { float best = -3.0e38f; int bi = 0;
#pragma unroll
                for (int e = 0; e < 32; ++e) { if (lg[e] > best) { best = lg[e]; bi = e; } }
                tv[k] = best; ti[k] = bi;
#pragma unroll
                for (int e = 0; e < 32; ++e) lg[e] = (e == bi) ? -3.0e38f : lg[e]; }
            if (lane == 0 && (!dry || tv[0] == 123456.789f)) {
                const float e1 = __expf(tv[1] - tv[0]), e2 = __expf(tv[2] - tv[0]), e3 = __expf(tv[3] - tv[0]); const float inv = 1.f / (1.f + e1 + e2 + e3);
                const float gg[4] = {inv, e1 * inv, e2 * inv, e3 * inv};
#pragma unroll
                for (int k = 0; k < 4; ++k) { TOPE[row * 4 + k] = ti[k]; TOPG[row * 4 + k] = gg[k]; TOPR[row * 4 + k] = (int)atomicAdd((unsigned*)(lcnt + ti[k]), 1u); }
            } }
        __syncthreads();
    }
    __syncthreads();
    if (tid < 32 && !dry) WSP(unsigned, WS_CNTWG)[(size_t)(l * 256 + bx) * 32 + tid] = lcnt[tid];
}

__device__ __forceinline__ int moe_tables(const Params& p, int l, LAS int* tab, LAS int* basew, int G, int tid) {
    const unsigned* cw = WSP(unsigned, WS_CNTWG) + (size_t)l * 256 * 32;
    for (int i = tid; i < G * 32; i += NTHR) basew[i] = (int)cw[i];
    __syncthreads();
    if (tid < 32) { int run = 0; for (int wg = 0; wg < G; ++wg) { const int c = basew[wg * 32 + tid]; basew[wg * 32 + tid] = run; run += c; } tab[32 + tid] = run; }
    __syncthreads();
    if (tid == 0) { int run = 0;
        for (int e = 0; e < 32; ++e) { const int c = tab[32 + e]; tab[e] = run * 256; run += (c + 255) >> 8; tab[64 + e] = run; }
        tab[96] = run; }
    __syncthreads();
    for (int blk = tid; blk < CAP_BLK; blk += NTHR) { int e = 0;
        for (int j = 0; j < 31; ++j) e += (blk >= tab[64 + j]) ? 1 : 0;
        tab[128 + blk] = e; }
    __syncthreads();
    return tab[96];
}

__device__ __forceinline__ void moe_gather(const Params& p, int l, int nrows, LAS int* tab, const LAS int* basew, int gw, int ngw, int lane) {
    const int* TOPE = WSP(int, WS_TOP); const int* TOPR = WSP(int, WS_TOP + 2 * TOP_STRIDE); int* TOPS = WSP(int, WS_TOP + 3 * TOP_STRIDE);
    const bf16_t* XM = WSP(bf16_t, WS_XM); bf16_t* XB = SCRP(bf16_t, SC_XB);
    for (int tok = gw; tok < nrows; tok += ngw) {
        const u32x4 e4 = *(const u32x4*)(TOPE + tok * 4), r4 = *(const u32x4*)(TOPR + tok * 4);
        const int wgp = ((tok >> 4) % (ngw >> 3)) * 32;
        u32x4 sl; sl.x = tab[e4.x] + basew[wgp + e4.x] + r4.x; sl.y = tab[e4.y] + basew[wgp + e4.y] + r4.y; sl.z = tab[e4.z] + basew[wgp + e4.z] + r4.z; sl.w = tab[e4.w] + basew[wgp + e4.w] + r4.w;
        if (lane == 0) *(u32x4*)(TOPS + tok * 4) = sl;
        const u32x4* s = (const u32x4*)(XM + (size_t)tok * D); const u32x4 a = s[lane], b2 = s[64 + lane];
        u32x4* d0 = (u32x4*)(XB + (size_t)sl.x * D); u32x4* d1 = (u32x4*)(XB + (size_t)sl.y * D); u32x4* d2 = (u32x4*)(XB + (size_t)sl.z * D); u32x4* d3 = (u32x4*)(XB + (size_t)sl.w * D);
        d0[lane] = a; d0[64 + lane] = b2; d1[lane] = a; d1[64 + lane] = b2; d2[lane] = a; d2[64 + lane] = b2; d3[lane] = a; d3[64 + lane] = b2; }
}

constexpr int NR2 = 2;
__device__ __forceinline__ void ln2_rows(const Params& p, int l, int nrows, int gw, int ngw, int lane, bool dry = false) {
    float* H = WSP(float, WS_H); bf16_t* XM = WSP(bf16_t, WS_XM); const bf16_t* YB = SCRP(bf16_t, SC_XB); const float* MOD = WSP(float, WS_MOD);
    const float* TOPG = WSP(float, WS_TOP + TOP_STRIDE); const int* TOPS = WSP(int, WS_TOP + 3 * TOP_STRIDE);
    const float* g2p = p.in[I_LN2G] + l * 1024; const float* b2p = p.in[I_LN2B] + l * 1024;
    float alpha = DN_ALPHA; asm volatile("" : "+v"(alpha));
    for (int row0 = gw * NR2; row0 < nrows; row0 += ngw * NR2) {
        f32x4 y[NR2][4]; float s[NR2];
        int slot[NR2][4]; float gt[NR2][4];
#pragma unroll
        for (int r = 0; r < NR2; ++r)
#pragma unroll
            for (int k = 0; k < 4; ++k) { slot[r][k] = TOPS[(row0 + r) * 4 + k]; gt[r][k] = TOPG[(row0 + r) * 4 + k]; }
#pragma unroll
        for (int r = 0; r < NR2; ++r) { const int row = row0 + r;
#pragma unroll
            for (int j = 0; j < 4; ++j) y[r][j] = *(const f32x4*)(H + (size_t)row * D + lane * 4 + 256 * j) * alpha; }
#pragma unroll
        for (int r = 0; r < NR2; ++r) { const int row = row0 + r; const int sidx = row < NLAT ? (row >> 12) : 4; const float* mod = MOD + (size_t)(l * 5 + sidx) * 6144;
#pragma unroll
            for (int k = 0; k < 4; ++k) { const bf16_t* yr = YB + (size_t)slot[r][k] * D;
#pragma unroll
                for (int j = 0; j < 4; ++j) { const int c = lane * 4 + 256 * j; const u32x2 u = *(const u32x2*)(yr + c);
                    y[r][j] += *(const f32x4*)(mod + 5120 + c) * gt[r][k] * (f32x4){bflo(u.x), bfhi(u.x), bflo(u.y), bfhi(u.y)}; } }
            s[r] = 0.f;
#pragma unroll
            for (int j = 0; j < 4; ++j) s[r] += (y[r][j][0] + y[r][j][1]) + (y[r][j][2] + y[r][j][3]); }
#pragma unroll
        for (int r = 0; r < NR2; ++r) { const int row = row0 + r; const int sidx = row < NLAT ? (row >> 12) : 4;
            const float mean = wave_sum(s[r]) * (1.f / D); float s2 = 0.f;
#pragma unroll
            for (int j = 0; j < 4; ++j) { y[r][j] = y[r][j] - mean; s2 += (y[r][j][0] * y[r][j][0] + y[r][j][1] * y[r][j][1]) + (y[r][j][2] * y[r][j][2] + y[r][j][3] * y[r][j][3]); }
            const float rstd = rsqrtf(wave_sum(s2) * (1.f / D) + LN_EPS);
#pragma unroll
            for (int j = 0; j < 4; ++j) { const int c = lane * 4 + 256 * j;
                const f32x4 hn = y[r][j] * rstd * *(const f32x4*)(g2p + c) + *(const f32x4*)(b2p + c);
                if (dry && hn[0] != 123456.789f) continue;
                if (l == 0) { *(f32x4*)(H + (size_t)row * D + c) = hn;
                    const float* mod1 = MOD + (size_t)(5 + sidx) * 6144;
                    const f32x4 xm = hn * (*(const f32x4*)(mod1 + 1024 + c) + 1.f) + *(const f32x4*)(mod1 + c);
                    u32x2 o; o.x = pk2(xm[0], xm[1]); o.y = pk2(xm[2], xm[3]); *(u32x2*)(XM + (size_t)row * D + c) = o; }
                else *(f32x4*)(p.out + (size_t)row * D + c) = hn; } }
    }
}

constexpr int LSB = 72;
constexpr size_t RW_REC = 8192;
__device__ __forceinline__ int kperm_lo(int ks, int fq) { return (2 * ks) * 16 + fq * 4; }
__device__ __forceinline__ f32x4 tile_nt(const LAS bf16_t* A, const LAS bf16_t* B, int mt, int nt, int fr, int fq, f32x4 acc) {
#pragma unroll
    for (int ks = 0; ks < 2; ++ks) {
        const bf16x8 a = *(const LAS bf16x8*)(A + (mt * 16 + fr) * LSB + ks * 32 + fq * 8);
        const bf16x8 b = *(const LAS bf16x8*)(B + (nt * 16 + fr) * LSB + ks * 32 + fq * 8);
        acc = __builtin_amdgcn_mfma_f32_16x16x32_bf16(a, b, acc, 0, 0, 0);
    }
    return acc;
}
__device__ __forceinline__ size_t rwa_goff(int unit, int tid) {
    const int cid = unit / 12, h = (unit % 12) >> 1, dir = unit & 1, t = tid >> 3, k8 = (tid & 7) * 8;
    return (size_t)(chunk_row0(cid) + (dir ? 63 - t : t)) * 384 + h * 64 + k8;
}
#ifndef TPH
#define TPH -1
#endif
#define TB_(id) do { if (TPH == (id)) tph_t0 = __builtin_amdgcn_s_memrealtime(); } while (0)
#define TE_(id) do { if (TPH == (id)) tph_acc += __builtin_amdgcn_s_memrealtime() - tph_t0; } while (0)
__device__ __forceinline__ void rwa_job(const Params& p, int unit, int next_unit, bool first, LAS unsigned char* lds, int tid, unsigned long long& tph_t0, unsigned long long& tph_acc) {
    asm volatile("" : "+v"(tid));
    const int cid = unit / 12, h = (unit % 12) >> 1, dir = unit & 1;
    const int w = tid >> 6, lane = tid & 63, fr = lane & 15, fq = lane >> 4;
    LAS bf16_t* At = (LAS bf16_t*)lds;            LAS bf16_t* Bt = At + 64 * LSB;   LAS bf16_t* Kt = Bt + 64 * LSB;  LAS bf16_t* Rt = Kt + 64 * LSB;
    LAS bf16_t* BHt = Rt + 64 * LSB;              LAS bf16_t* KHt = BHt + 64 * LSB; LAS bf16_t* Vt = KHt + 64 * LSB;
    LAS float* F0 = (LAS float*)(lds + 64512);
    LAS float* PF = (LAS float*)(lds + 81152);
    LAS bf16_t* AAK = (LAS bf16_t*)(lds + 97536);
    LAS bf16_t* ARB = AAK + 64 * LSB;  LAS bf16_t* ARK = ARB + 64 * LSB;
    LAS bf16_t* TAT = ARK + 64 * LSB;  LAS bf16_t* TPT = TAT + 64 * LSB;
    LAS float* gC = (LAS float*)(lds + 143616);
    LAS float* TD = (LAS float*)(lds + 143872);
    LAS bf16_t* ABH = (LAS bf16_t*)(lds + 147968);
    TB_(30);
    const int t = tid >> 3, k8 = (tid & 7) * 8;
    const size_t go = rwa_goff(unit, tid);
    if (first) { const float* Wg = SCRP(float, dir ? SC_WB : SC_WF); const f32x4 a = *(const f32x4*)(Wg + go), b = *(const f32x4*)(Wg + go + 4);
        F0[(k8 + 0) * 65 + t] = a[0]; F0[(k8 + 1) * 65 + t] = a[1]; F0[(k8 + 2) * 65 + t] = a[2]; F0[(k8 + 3) * 65 + t] = a[3];
        F0[(k8 + 4) * 65 + t] = b[0]; F0[(k8 + 5) * 65 + t] = b[1]; F0[(k8 + 6) * 65 + t] = b[2]; F0[(k8 + 7) * 65 + t] = b[3]; }
    const u32x4 in_kk = *(const u32x4*)(SCRP(bf16_t, SC_KK) + go), in_bk = *(const u32x4*)(SCRP(bf16_t, dir ? SC_BKB : SC_BKF) + go), in_km = *(const u32x4*)(SCRP(bf16_t, dir ? SC_KMB : SC_KMF) + go);
    const u32x4 in_rr = *(const u32x4*)(SCRP(bf16_t, SC_R) + go), in_vv = *(const u32x4*)(SCRP(bf16_t, SC_V) + go);
    __syncthreads();
#pragma unroll
    for (int c = 0; c < 8; ++c) { const int k = w * 8 + c; float x = F0[k * 65 + lane];
#pragma unroll
        for (int o = 1; o < 64; o <<= 1) { const float y = __shfl_up(x, o); if (lane >= o) x += y; }
        F0[k * 65 + lane] = x; }
    __syncthreads();
    {
        float kk[8], bk[8], km[8], rr[8];
        unpack8(in_kk, kk); unpack8(in_bk, bk); unpack8(in_km, km); unpack8(in_rr, rr);
        const u32x4 vraw = in_vv;
        float a_[8], b_[8], k_[8], r_[8];
#pragma unroll
        for (int i = 0; i < 8; ++i) { const float L = F0[(k8 + i) * 65 + t], LC = F0[(k8 + i) * 65 + 63], Lm1 = t > 0 ? F0[(k8 + i) * 65 + t - 1] : 0.f;
            const float eL = __expf(L), eN = __expf(-L), eM = __expf(Lm1), eH = __expf(LC - L);
            a_[i] = -kk[i] * eM; b_[i] = bk[i] * eN; k_[i] = km[i] * eN; r_[i] = rr[i] * eL;
            BHt[(k8 + i) * LSB + t] = (bf16_t)f2bf(bk[i] * eH); KHt[(k8 + i) * LSB + t] = (bf16_t)f2bf(km[i] * eH);
            if (t == 63) gC[k8 + i] = __expf(LC); }
        { u32x4 o; o.x = pk2(a_[0], a_[1]); o.y = pk2(a_[2], a_[3]); o.z = pk2(a_[4], a_[5]); o.w = pk2(a_[6], a_[7]); *(LAS u32x4*)(At + t * LSB + k8) = o; }
        { u32x4 o; o.x = pk2(b_[0], b_[1]); o.y = pk2(b_[2], b_[3]); o.z = pk2(b_[4], b_[5]); o.w = pk2(b_[6], b_[7]); *(LAS u32x4*)(Bt + t * LSB + k8) = o; }
        { u32x4 o; o.x = pk2(k_[0], k_[1]); o.y = pk2(k_[2], k_[3]); o.z = pk2(k_[4], k_[5]); o.w = pk2(k_[6], k_[7]); *(LAS u32x4*)(Kt + t * LSB + k8) = o; }
        { u32x4 o; o.x = pk2(r_[0], r_[1]); o.y = pk2(r_[2], r_[3]); o.z = pk2(r_[4], r_[5]); o.w = pk2(r_[6], r_[7]); *(LAS u32x4*)(Rt + t * LSB + k8) = o; }
        Vt[(k8 + 0) * LSB + t] = (bf16_t)(vraw.x & 0xffffu); Vt[(k8 + 1) * LSB + t] = (bf16_t)(vraw.x >> 16); Vt[(k8 + 2) * LSB + t] = (bf16_t)(vraw.y & 0xffffu); Vt[(k8 + 3) * LSB + t] = (bf16_t)(vraw.y >> 16);
        Vt[(k8 + 4) * LSB + t] = (bf16_t)(vraw.z & 0xffffu); Vt[(k8 + 5) * LSB + t] = (bf16_t)(vraw.z >> 16); Vt[(k8 + 6) * LSB + t] = (bf16_t)(vraw.w & 0xffffu); Vt[(k8 + 7) * LSB + t] = (bf16_t)(vraw.w >> 16);
    }
    __syncthreads(); TE_(30); TB_(31);
#pragma unroll
    for (int i8 = 0; i8 < 8; ++i8) { const int pr = i8 >> 1, mt = (w >> 2) + 2 * (i8 & 1), nt = w & 3;
        f32x4 acc = {0.f, 0.f, 0.f, 0.f};
        if (nt <= mt) acc = tile_nt(pr < 2 ? At : Rt, (pr & 1) ? Kt : Bt, mt, nt, fr, fq, acc);
#pragma unroll
        for (int j = 0; j < 4; ++j) { const int tt = mt * 16 + fq * 4 + j, ss = nt * 16 + fr; const bool keep = pr < 2 ? (ss < tt) : (ss <= tt); const float v = keep ? acc[j] : 0.f;
            if (pr == 0) { F0[tt * 64 + ss] = v; ABH[tt * LSB + ss] = (bf16_t)f2bf(v); } else (pr == 1 ? AAK : (pr == 2 ? ARB : ARK))[tt * LSB + ss] = (bf16_t)f2bf(v); } }
    __syncthreads();
#pragma unroll
    for (int q = 0; q < 2; ++q) { const int idx = w * 2 + q, mt = idx >> 2, nt = idx & 3; f32x4 acc = {0.f, 0.f, 0.f, 0.f};
        acc = tile_nt(AAK, Vt, mt, nt, fr, fq, acc);
#pragma unroll
        for (int j = 0; j < 4; ++j) PF[(mt * 16 + fq * 4 + j) * 64 + nt * 16 + fr] = acc[j]; }
    __syncthreads(); TE_(31); TB_(32);
    if (w < 4 && lane < 16) {
        float x[16];
#pragma unroll
        for (int tt = 0; tt < 16; ++tt) { float a0 = (tt == lane) ? 1.f : 0.f;
#pragma unroll
            for (int s2 = 0; s2 < tt; ++s2) a0 += F0[(w * 16 + tt) * 64 + w * 16 + s2] * x[s2];
            x[tt] = a0; TD[(w * 16 + tt) * 16 + lane] = a0; }
    }
    __syncthreads();
    {
        f32x4 X0[4], X[4];
#pragma unroll
        for (int bb = 0; bb < 4; ++bb)
#pragma unroll
            for (int j = 0; j < 4; ++j) { const int tt = bb * 16 + fq * 4 + j; X0[bb][j] = (w < 4) ? bf2f(At[tt * LSB + w * 16 + fr]) : PF[tt * 64 + (w - 4) * 16 + fr]; }
        bf16x8 Tf[4];
#pragma unroll
        for (int bb = 0; bb < 4; ++bb) { const f32x4 tv = *(const LAS f32x4*)(TD + (bb * 16 + fr) * 16 + fq * 4); u32x4 o; o.x = pk2(tv[0], tv[1]); o.y = pk2(tv[2], tv[3]); o.z = 0u; o.w = 0u; Tf[bb] = __builtin_bit_cast(bf16x8, o); }
        const f32x4 zero4 = {0.f, 0.f, 0.f, 0.f};
#pragma unroll
        for (int bb = 0; bb < 4; ++bb) {
            f32x4 rhs = X0[bb];
            if (bb >= 1) {
                const u32x2 a = *(const LAS u32x2*)(ABH + (bb * 16 + fr) * LSB + fq * 4); u32x2 a2 = {0u, 0u};
                if (bb >= 2) a2 = *(const LAS u32x2*)(ABH + (bb * 16 + fr) * LSB + 16 + fq * 4);
                u32x4 af; af.x = a.x; af.y = a.y; af.z = a2.x; af.w = a2.y;
                u32x4 bf; bf.x = pk2(X[0][0], X[0][1]); bf.y = pk2(X[0][2], X[0][3]);
                if (bb >= 2) { bf.z = pk2(X[1][0], X[1][1]); bf.w = pk2(X[1][2], X[1][3]); } else { bf.z = 0u; bf.w = 0u; }
                rhs = __builtin_amdgcn_mfma_f32_16x16x32_bf16(__builtin_bit_cast(bf16x8, af), __builtin_bit_cast(bf16x8, bf), rhs, 0, 0, 0);
            }
            if (bb == 3) {
                const u32x2 a = *(const LAS u32x2*)(ABH + (48 + fr) * LSB + 32 + fq * 4);
                u32x4 af; af.x = a.x; af.y = a.y; af.z = 0u; af.w = 0u;
                u32x4 bf; bf.x = pk2(X[2][0], X[2][1]); bf.y = pk2(X[2][2], X[2][3]); bf.z = 0u; bf.w = 0u;
                rhs = __builtin_amdgcn_mfma_f32_16x16x32_bf16(__builtin_bit_cast(bf16x8, af), __builtin_bit_cast(bf16x8, bf), rhs, 0, 0, 0);
            }
            u32x4 rb; rb.x = pk2(rhs[0], rhs[1]); rb.y = pk2(rhs[2], rhs[3]); rb.z = 0u; rb.w = 0u;
            X[bb] = __builtin_amdgcn_mfma_f32_16x16x32_bf16(Tf[bb], __builtin_bit_cast(bf16x8, rb), zero4, 0, 0, 0);
            LAS bf16_t* dst = ((w < 4) ? TAT : TPT) + ((w & 3) * 16 + fr) * LSB + bb * 16 + fq * 4;
            u32x2 o; o.x = pk2(X[bb][0], X[bb][1]); o.y = pk2(X[bb][2], X[bb][3]); *(LAS u32x2*)dst = o;
        }
    }
    __syncthreads();
    TE_(32); TB_(33);
    f32x4 nw0 = {0.f, 0.f, 0.f, 0.f}, nw1 = {0.f, 0.f, 0.f, 0.f};
    if (next_unit >= 0) { const float* Wn = SCRP(float, (next_unit & 1) ? SC_WB : SC_WF) + rwa_goff(next_unit, tid); nw0 = *(const f32x4*)Wn; nw1 = *(const f32x4*)(Wn + 4); }
    const size_t u = (size_t)((cid * 6 + h) * 2 + dir);
    LAS bf16_t* SQ = AAK; LAS bf16_t* SM = (LAS bf16_t*)PF; LAS float* SY = F0;
    unsigned char* GREC = p.ws + WS_GREC + u * RW_REC;
#pragma unroll
    for (int i8 = 0; i8 < 8; ++i8) { const int pr = i8 >> 1, mt = (w >> 2) + 2 * (i8 & 1), nt = w & 3; f32x4 acc = {0.f, 0.f, 0.f, 0.f};
        if (pr == 0) { acc = tile_nt(ARB, TAT, mt, nt, fr, fq, acc);
#pragma unroll
            for (int j = 0; j < 4; ++j) { const int tt = mt * 16 + fq * 4 + j, kk_ = nt * 16 + fr; SQ[tt * LSB + kk_] = (bf16_t)f2bf(acc[j] + bf2f(Rt[tt * LSB + kk_])); } }
        else if (pr == 1) { acc = tile_nt(ARB, TPT, mt, nt, fr, fq, acc); acc = tile_nt(ARK, Vt, mt, nt, fr, fq, acc);
#pragma unroll
            for (int j = 0; j < 4; ++j) SY[(mt * 16 + fq * 4 + j) * 64 + nt * 16 + fr] = acc[j]; }
        else if (pr == 2) { acc = tile_nt(BHt, TAT, mt, nt, fr, fq, acc);
#pragma unroll
            for (int j = 0; j < 4; ++j) { const int k1 = mt * 16 + fq * 4 + j, k2 = nt * 16 + fr; SM[k1 * LSB + k2] = (bf16_t)f2bf(acc[j] + (k1 == k2 ? gC[k1] : 0.f)); } }
        else { acc = tile_nt(BHt, TPT, mt, nt, fr, fq, acc); acc = tile_nt(KHt, Vt, mt, nt, fr, fq, acc);
            u32x2 o; o.x = pk2(acc[0], acc[1]); o.y = pk2(acc[2], acc[3]); *(u32x2*)(GREC + ((mt * 4 + nt) * 64 + lane) * 8) = o; } }
    __syncthreads();
    {
        const int mt = w >> 1, ks = w & 1, row = mt * 16 + fr, rq = dir ? 63 - row : row;
        u32x4 o; { const u32x2 a = *(const LAS u32x2*)(SQ + rq * LSB + kperm_lo(ks, fq)), b = *(const LAS u32x2*)(SQ + rq * LSB + kperm_lo(ks, fq) + 16); o.x = a.x; o.y = a.y; o.z = b.x; o.w = b.y; }
        *(u32x4*)(SCRP(unsigned char, SC_YF) + u * RW_REC + (size_t)(w * 64 + lane) * 16) = o;
        { const u32x2 a = *(const LAS u32x2*)(SM + row * LSB + kperm_lo(ks, fq)), b = *(const LAS u32x2*)(SM + row * LSB + kperm_lo(ks, fq) + 16); o.x = a.x; o.y = a.y; o.z = b.x; o.w = b.y; }
        *(u32x4*)(p.ws + WS_MREC + u * RW_REC + (size_t)(w * 64 + lane) * 16) = o;
#pragma unroll
        for (int q = 0; q < 2; ++q) { const int tl = w * 2 + q, mt2 = tl >> 2, nt2 = tl & 3; float yv[4];
#pragma unroll
            for (int j = 0; j < 4; ++j) { const int to = mt2 * 16 + fq * 4 + j; yv[j] = SY[(dir ? 63 - to : to) * 64 + nt2 * 16 + fr]; }
            u32x2 oy; oy.x = pk2(yv[0], yv[1]); oy.y = pk2(yv[2], yv[3]);
            *(u32x2*)(SCRP(unsigned char, SC_YB) + u * RW_REC + (size_t)(tl * 64 + lane) * 8) = oy; }
    }
    __syncthreads(); TE_(33);
    if (next_unit >= 0) {
        F0[(k8 + 0) * 65 + t] = nw0[0]; F0[(k8 + 1) * 65 + t] = nw0[1]; F0[(k8 + 2) * 65 + t] = nw0[2]; F0[(k8 + 3) * 65 + t] = nw0[3];
        F0[(k8 + 4) * 65 + t] = nw1[0]; F0[(k8 + 5) * 65 + t] = nw1[1]; F0[(k8 + 6) * 65 + t] = nw1[2]; F0[(k8 + 7) * 65 + t] = nw1[3]; }
}

__device__ __forceinline__ void rwb_job(const Params& p, int chain, int tid) {
    asm volatile("" : "+v"(tid));
    const int b = chain / 12, h = (chain % 12) >> 1, dir = chain & 1, nt = tid >> 6, lane = tid & 63;
    if (nt >= 4) return;
    f32x4 H[4];
#pragma unroll
    for (int mt = 0; mt < 4; ++mt) H[mt] = (f32x4){0.f, 0.f, 0.f, 0.f};
    bf16x8 Mf[4][2]; u32x2 Gf[4];
    auto load = [&](int step) { const size_t u = (size_t)((chain_chunk(b, dir, step) * 6 + h) * 2 + dir);
        const unsigned char* mr = p.ws + WS_MREC + u * RW_REC; const unsigned char* gr = p.ws + WS_GREC + u * RW_REC;
#pragma unroll
        for (int mt = 0; mt < 4; ++mt) { Mf[mt][0] = *(const bf16x8*)(mr + (size_t)((mt * 2) * 64 + lane) * 16); Mf[mt][1] = *(const bf16x8*)(mr + (size_t)((mt * 2 + 1) * 64 + lane) * 16);
            Gf[mt] = *(const u32x2*)(gr + (size_t)((mt * 4 + nt) * 64 + lane) * 8); } };
    load(0);
#pragma unroll 1
    for (int step = 0; step < 68; ++step) {
        const size_t u = (size_t)((chain_chunk(b, dir, step) * 6 + h) * 2 + dir);
        bf16x8 Bh[2], Bl[2];
#pragma unroll
        for (int ks = 0; ks < 2; ++ks) { const f32x4 x0 = H[2 * ks], x1 = H[2 * ks + 1];
            u32x4 hi; hi.x = pk2(x0[0], x0[1]); hi.y = pk2(x0[2], x0[3]); hi.z = pk2(x1[0], x1[1]); hi.w = pk2(x1[2], x1[3]);
            u32x4 lo; lo.x = pk2(x0[0] - bflo(hi.x), x0[1] - bfhi(hi.x)); lo.y = pk2(x0[2] - bflo(hi.y), x0[3] - bfhi(hi.y)); lo.z = pk2(x1[0] - bflo(hi.z), x1[1] - bfhi(hi.z)); lo.w = pk2(x1[2] - bflo(hi.w), x1[3] - bfhi(hi.w));
            Bh[ks] = __builtin_bit_cast(bf16x8, hi); Bl[ks] = __builtin_bit_cast(bf16x8, lo);
            *(u32x4*)(p.ws + WS_XM + u * RW_REC + (size_t)((ks * 4 + nt) * 64 + lane) * 16) = hi; }
        f32x4 acc[4];
#pragma unroll
        for (int mt = 0; mt < 4; ++mt) { acc[mt] = (f32x4){bflo(Gf[mt].x), bfhi(Gf[mt].x), bflo(Gf[mt].y), bfhi(Gf[mt].y)};
#pragma unroll
            for (int ks = 0; ks < 2; ++ks) { acc[mt] = __builtin_amdgcn_mfma_f32_16x16x32_bf16(Mf[mt][ks], Bh[ks], acc[mt], 0, 0, 0); acc[mt] = __builtin_amdgcn_mfma_f32_16x16x32_bf16(Mf[mt][ks], Bl[ks], acc[mt], 0, 0, 0); } }
        if (step + 1 < 68) load(step + 1);
#pragma unroll
        for (int mt = 0; mt < 4; ++mt) H[mt] = acc[mt];
    }
}

__device__ __forceinline__ void rwc_job(const Params& p, int l, int cid, int hb, LAS unsigned char* lds, int tid) {
    asm volatile("" : "+v"(tid));
    const int r0 = chunk_row0(cid), w = tid >> 6, lane = tid & 63, fr = lane & 15, fq = lane >> 4, dirw = w >> 2, mt = w & 3;
    f32x4 acc[3][4];
#pragma unroll
    for (int hh = 0; hh < 3; ++hh) { const int h = hb + hh;
        const size_t u = (size_t)((cid * 6 + h) * 2 + dirw);
        const unsigned char* qr = SCRP(unsigned char, SC_YF) + u * RW_REC; const unsigned char* yr = SCRP(unsigned char, SC_YB) + u * RW_REC; const unsigned char* hr = p.ws + WS_XM + u * RW_REC;
        const bf16x8 Q0 = *(const bf16x8*)(qr + (size_t)((mt * 2) * 64 + lane) * 16), Q1 = *(const bf16x8*)(qr + (size_t)((mt * 2 + 1) * 64 + lane) * 16);
#pragma unroll
        for (int nt = 0; nt < 4; ++nt) { const u32x2 y0 = *(const u32x2*)(yr + (size_t)((mt * 4 + nt) * 64 + lane) * 8);
            acc[hh][nt] = (f32x4){bflo(y0.x), bfhi(y0.x), bflo(y0.y), bfhi(y0.y)};
            const bf16x8 B0 = *(const bf16x8*)(hr + (size_t)((0 * 4 + nt) * 64 + lane) * 16), B1 = *(const bf16x8*)(hr + (size_t)((1 * 4 + nt) * 64 + lane) * 16);
            acc[hh][nt] = __builtin_amdgcn_mfma_f32_16x16x32_bf16(Q0, B0, acc[hh][nt], 0, 0, 0); acc[hh][nt] = __builtin_amdgcn_mfma_f32_16x16x32_bf16(Q1, B1, acc[hh][nt], 0, 0, 0); } }
    LAS f32x4* xb = (LAS f32x4*)lds;
#pragma unroll
    for (int hh = 0; hh < 3; ++hh)
#pragma unroll
        for (int nt = 0; nt < 4; ++nt) xb[(((dirw * 3 + hh) * 4 + mt) * 4 + nt) * 64 + lane] = acc[hh][nt];
    __syncthreads();
    const bf16_t* Vg = SCRP(bf16_t, SC_V); const bf16_t* Gg = SCRP(bf16_t, SC_G); const float* BON = SCRP(float, SC_BON); bf16_t* CAT = WSP(bf16_t, WS_CAT);
#pragma unroll
    for (int hh = 0; hh < 3; ++hh) { const int h = hb + hh;
#pragma unroll
        for (int nt = 0; nt < 4; ++nt) acc[hh][nt] += xb[((((1 - dirw) * 3 + hh) * 4 + mt) * 4 + nt) * 64 + lane];
#pragma unroll
        for (int jj = 0; jj < 2; ++jj) { const int j = dirw * 2 + jj; const int row = r0 + mt * 16 + fq * 4 + j;
            const float a0 = j == 0 ? acc[hh][0][0] : j == 1 ? acc[hh][0][1] : j == 2 ? acc[hh][0][2] : acc[hh][0][3], a1 = j == 0 ? acc[hh][1][0] : j == 1 ? acc[hh][1][1] : j == 2 ? acc[hh][1][2] : acc[hh][1][3];
            const float a2 = j == 0 ? acc[hh][2][0] : j == 1 ? acc[hh][2][1] : j == 2 ? acc[hh][2][2] : acc[hh][2][3], a3 = j == 0 ? acc[hh][3][0] : j == 1 ? acc[hh][3][1] : j == 2 ? acc[hh][3][2] : acc[hh][3][3];
            float s = (a0 + a1) + (a2 + a3); s = red16(s); const float mu = s * (1.f / 64.f);
            const float d0 = a0 - mu, d1 = a1 - mu, d2 = a2 - mu, d3 = a3 - mu;
            float v2 = (d0 * d0 + d1 * d1) + (d2 * d2 + d3 * d3); v2 = red16(v2); const float rs = rsqrtf(v2 * (1.f / 64.f) + RW_GN_EPS);
            const float bon = BON[(size_t)row * 8 + h];
            const float dd[4] = {d0, d1, d2, d3};
#pragma unroll
            for (int nt = 0; nt < 4; ++nt) { const int c = h * 64 + nt * 16 + fr; const size_t o = (size_t)row * 384 + c;
                const float yn = dd[nt] * rs * p.in[I_LNXG][l * 384 + c] + p.in[I_LNXB][l * 384 + c];
                CAT[(size_t)row * D + 640 + c] = (bf16_t)f2bf((yn + bon * bf2f(Vg[o])) * bf2f(Gg[o])); } } }
    __syncthreads();
}

#ifndef PHM
#define PHM 0x3ffff
#endif
#ifndef REPM
#define REPM 0
#endif
#ifndef TPH
#define TPH -1
#endif
#define T_BEGIN(id) do { if (TPH == (id)) tph_t0 = __builtin_amdgcn_s_memrealtime(); } while (0)
#define T_END(id) do { if (TPH == (id)) tph_acc += __builtin_amdgcn_s_memrealtime() - tph_t0; } while (0)
constexpr int LDS_TAB_OFF = 131072;
__device__ __forceinline__ int q_fetch(unsigned* head, int n_all, int& shard, int& left) {
    while (left > 0) { const int c = (int)atomicAdd(head + shard * 64, 1u); const int j = c * 8 + shard; if (j < n_all) return j; shard = (shard + 1) & 7; --left; }
    return n_all;
}
#define QUEUE_LOOP(head, n_all, BODY) do { const bool ldr_ = (wave_s == 0 && lane_id_() == 0); int qs_ = (int)(xb_xcc_id() & 7u), ql_ = 8; \
    if (ldr_) qslot[0] = q_fetch((head), (n_all), qs_, ql_); __syncthreads(); \
    for (int k_ = 0;; ++k_) { const int j = qslot[k_ & 1]; if (j >= (n_all)) break; if (ldr_) qslot[(k_ + 1) & 1] = q_fetch((head), (n_all), qs_, ql_); BODY; __syncthreads(); } } while (0)
#define GRID_BAR() do { unsigned char* w_ = p_arg.ws; asm volatile("" : "+s"(w_)); XcdBarrier b_; b_.bar = (unsigned*)(w_ + WS_CTL) + CW_BAR; b_.x = xb_xcc_id(); b_.st = ctlw; b_.w = wave_s; xcd_barrier(b_); if (REPM & 64) xcd_barrier(b_); } while (0)
#define PHASE_BEGIN_G() Params p = p_arg; asm volatile("" : "+s"(p.ws));
#define PHASE_BEGIN() Params p = p_arg; asm volatile("" : "+s"(p.ws)); \
    int tid = wave_s * 64 + lane_id_(); asm volatile("" : "+v"(tid)); const int lane = tid & 63, gw = bx * 8 + wave_s; (void)lane; (void)gw; (void)p;

__global__ void __launch_bounds__(NTHR, 2) fwd_kernel(Params p_arg) {
    extern __shared__ __attribute__((aligned(16))) unsigned char lds_raw[];
    LAS unsigned char* lds = (LAS unsigned char*)lds_raw;
    const int G = gridDim.x, bx = blockIdx.x, ngw = G * 8;
    const int wave_s = WAVE_ID_SGPR();
    unsigned long long tph_t0 = 0ull, tph_acc = 0ull; (void)tph_t0; (void)tph_acc;
    volatile LAS unsigned* ctlw = (volatile LAS unsigned*)(lds + LDS_CTL_OFF);
    if (wave_s == 0) ctlw[lane_id_()] = 0u;
    __syncthreads();
    { PHASE_BEGIN(); (void)xcd_barrier_post(WSP(unsigned, WS_CTL) + CW_BAR, ctlw, wave_s); }
    volatile LAS int* qslot = (volatile LAS int*)(ctlw + 16);
    LAS int* tab = (LAS int*)(lds + LDS_TAB_OFF);

    T_BEGIN(0);
    for (int rep_ = 0; rep_ < ((REPM & 1) ? 2 : 1); ++rep_)
    { PHASE_BEGIN();
#if PHM & 1
      for (int j = bx; j < J_MOD; j += G) mod_job(p, j, (LAS float*)lds, tid);
#endif
#if PHM & 2
      for (int j = bx; j < JW_TOTAL; j += G) conv_job(p, j, (LAS float*)lds, tid);
#endif
      { bf16_t* wt = WSP(bf16_t, WS_RWW);
        for (int i = bx * NTHR + tid; i < 2 * (int)RWW_LAYER; i += G * NTHR) { const int l = i / (int)RWW_LAYER, r = i % (int)RWW_LAYER; float v;
            if (r < 4 * 384 * 64) { const int m = r / (384 * 64), q = r % (384 * 64), n = q >> 6, k = q & 63;
                v = (m < 2 ? p.in[I_W2] : p.in[I_A2])[((size_t)(l * 2 + (m & 1)) * 64 + k) * 384 + n]; }
            else { const int q = r - 4 * 384 * 64, n = q >> 7, k = q & 127; v = p.in[I_G2][((size_t)l * 128 + k) * 384 + n]; }
            wt[i] = (bf16_t)f2bf(v); } }
      { bf16_t* rt = WSP(bf16_t, WS_RTW);
        for (int i = bx * NTHR + tid; i < 2 * 32 * 1024; i += G * NTHR) { const int l = i >> 15, e = (i >> 10) & 31, k = i & 1023; const float v = p.in[I_RW][((size_t)l * 1024 + k) * 32 + e];
            const unsigned hi = f2bf(v); rt[(size_t)l * 65536 + e * 1024 + k] = (bf16_t)hi; rt[(size_t)l * 65536 + 32768 + e * 1024 + k] = (bf16_t)f2bf(v - __builtin_bit_cast(float, hi << 16)); } }
      float* bgu = WSP(float, WS_BGU);
      for (int i = bx * NTHR + tid; i < 2 * 32 * 2048; i += G * NTHR) { const int le = i >> 11, c = i & 2047; bgu[i] = (c & 1) ? p.in[I_MBU][le * 1024 + (c >> 1)] : p.in[I_MBG][le * 1024 + (c >> 1)]; } }
    GRID_BAR(); T_END(0);
    T_BEGIN(1);
#if PHM & 4
    for (int rep_ = 0; rep_ < ((REPM & 32) ? 2 : 1); ++rep_)
    { PHASE_BEGIN(); ln_in_rows(p, gw, ngw, lane); }
#endif
    GRID_BAR(); T_END(1);

#pragma unroll 1
    for (int l = 0; l < 2; ++l) {
        const int nrows = l == 0 ? NTOK : NLAT;
        T_BEGIN(2);
#if PHM & 8
        for (int rep_ = 0; rep_ < ((REPM & 8) ? 2 : 1); ++rep_)
        { PHASE_BEGIN_G();
          pg8::Gemm g{WSP(bf16_t, WS_XM), WSP(bf16_t, WS_WIN) + (size_t)l * DINP * 1024, NTOK, DINP, 1024};
          pg8::StaticOrder S; S.init(NTOK, DINP, 1024, G, bx);
          pg8::EpiBf16 E{WSP(bf16_t, WS_Z), DINP, nullptr, 0};
          pg8::gemm_phase<pg8::EpiBf16, pg8::StaticOrder>(lds, g, S, E, wave_s); }
#endif
        GRID_BAR(); T_END(2);
        T_BEGIN(3);
        for (int rep_ = 0; rep_ < ((REPM & 2) ? 2 : 1); ++rep_)
        { PHASE_BEGIN();
          unsigned* head = WSP(unsigned, WS_CTL) + CW_QHEAD + (l * 8 + 0 + 4 * rep_) * 512;
          const int n_rw1 = 544, n_rw = n_rw1 * ((REPM & 2048) ? 2 : 1), n_gla1 = NCHUNK * 2, n_gla = n_gla1 * ((REPM & 4096) ? 2 : 1), n_da1 = 4 * NKT, n_da = n_da1 * ((REPM & 8192) ? 2 : 1), n_all = n_rw + n_gla + n_da;
          QUEUE_LOOP(head, n_all, {
              if (j < n_rw) { T_BEGIN(20); rw_job(p, l, j % n_rw1, lds, tid, tph_t0, tph_acc); T_END(20); }
              if (j >= n_rw && j < n_rw + n_gla) { const int q = (j - n_rw) % n_gla1; T_BEGIN(21); gla_job(p, l, q >> 1, (q & 1) * 3, lds, tid); T_END(21); }
              if (j >= n_rw + n_gla) { const int q = (j - n_rw - n_gla) % n_da1; T_BEGIN(22); da_job(p, l, q / NKT, q % NKT, lds, tid); T_END(22); }
          }); }
        GRID_BAR(); T_END(3);
        T_BEGIN(4);
        for (int rep_ = 0; rep_ < ((REPM & 32) ? 2 : 1); ++rep_)
        { PHASE_BEGIN();
          { const int n_u = NCHUNK * 12;
            for (int u = bx; u < n_u; u += G) rwa_job(p, u, (u + G < n_u) ? u + G : -1, u == bx, lds, tid, tph_t0, tph_acc); }
          if (bx >= G - 192) g2_job(p, bx - (G - 192), tid); }
        GRID_BAR(); T_END(4);
        T_BEGIN(5);
        for (int rep_ = 0; rep_ < ((REPM & 4) ? 2 : 1); ++rep_)
        { PHASE_BEGIN();
          unsigned* head = WSP(unsigned, WS_CTL) + CW_QHEAD + (l * 8 + 1 + 4 * rep_) * 512;
          const int n_sc = 48, n_att1 = 256 + (l == 0 ? 16 : 0), n_att = n_att1 * ((REPM & 512) ? 2 : 1), n_g31 = (l == 0 ? NCHUNK : 256) * 3, n_g3 = n_g31 * ((REPM & 1024) ? 2 : 1), n_all = n_sc + n_att + n_g3;
          QUEUE_LOOP(head, n_all, {
              if (j < n_sc) { T_BEGIN(25); rwb_job(p, j, tid); T_END(25); }
              if (j >= n_sc && j < n_sc + n_att) { const int q = (j - n_sc) % n_att1; const bool ic = q >= 256; const int c = q - 256;
                  T_BEGIN(23); attn_unit(p, l, ic ? (c >> 2) : (q >> 6), ic ? (c & 3) : ((q >> 4) & 3), ic, ic ? 0 : (q & 15), lds, tid); T_END(23); }
              if (j >= n_sc + n_att) { const int q = (j - n_sc - n_att) % n_g31; T_BEGIN(24); g3_job(p, l, q / 3, (q % 3) * 2, lds, tid); T_END(24); }
          }); }
        GRID_BAR(); T_END(5);
        T_BEGIN(6);
        for (int rep_ = 0; rep_ < ((REPM & 32) ? 2 : 1); ++rep_)
        { PHASE_BEGIN();
          const int n_all = (l == 0 ? NCHUNK : 256) * 2;
          for (int j = bx; j < n_all; j += G) rwc_job(p, l, j >> 1, (j & 1) * 3, lds, tid); }
        GRID_BAR(); T_END(6);
        T_BEGIN(7);
#if PHM & 4096
        for (int rep_ = 0; rep_ < ((REPM & 8) ? 2 : 1); ++rep_)
        { PHASE_BEGIN_G();
          pg8::Gemm g{WSP(bf16_t, WS_CAT), WSP(bf16_t, WS_WOUT) + (size_t)l * 1024 * 1024, nrows, 1024, 1024};
          pg8::StaticOrder S; S.init(nrows, 1024, 1024, G, bx);
          pg8::EpiBf16 E{WSP(bf16_t, WS_Z), 1024, nullptr, 0};
          pg8::gemm_phase<pg8::EpiBf16, pg8::StaticOrder>(lds, g, S, E, wave_s); }
#endif
        GRID_BAR(); T_END(7);
        T_BEGIN(8);
#if PHM & 8192
        for (int rep_ = ((REPM & 128) ? 0 : 1); rep_ < 2; ++rep_)
        { PHASE_BEGIN(); ln1_router(p, l, nrows, lds, tid, G, bx, rep_ == 0); }
#endif
        GRID_BAR(); T_END(8);
        T_BEGIN(9);
        { PHASE_BEGIN();
          moe_tables(p, l, tab, (LAS int*)lds, G, tid);
#if PHM & 16384
          for (int rep_ = 0; rep_ < ((REPM & 32) ? 2 : 1); ++rep_)
          moe_gather(p, l, nrows, tab, (const LAS int*)lds, gw, ngw, lane);
#endif
        }
        GRID_BAR(); T_END(9);
        T_BEGIN(10);
#if PHM & 32768
        for (int rep_ = 0; rep_ < ((REPM & 16) ? 2 : 1); ++rep_)
        { PHASE_BEGIN_G();
          const int nblk = tab[96];
          pg8::Gemm g{SCRP(bf16_t, SC_XB), WSP(bf16_t, WS_WGU) + (size_t)l * 32 * 2048 * 1024, nblk * 256, 2048, 1024};
          pg8::GroupOrder<8> S{G, (G % 8 == 0) ? (bx % 8) * (G / 8) + bx / 8 : bx, nblk, tab + 128};
          pg8::EpiSwiglu E{SCRP(bf16_t, SC_ACT), WSP(float, WS_BGU) + (size_t)l * 32 * 2048};
          pg8::gemm_phase<pg8::EpiSwiglu, pg8::GroupOrder<8>>(lds, g, S, E, wave_s); }
#endif
        GRID_BAR(); T_END(10);
        T_BEGIN(11);
#if PHM & 65536
        for (int rep_ = 0; rep_ < ((REPM & 16) ? 2 : 1); ++rep_)
        { PHASE_BEGIN_G();
          const int nblk = tab[96];
          pg8::Gemm g{SCRP(bf16_t, SC_ACT), WSP(bf16_t, WS_WDN) + (size_t)l * 32 * 1024 * 1024, nblk * 256, 1024, 1024};
          pg8::GroupOrder<4> S{G, (G % 8 == 0) ? (bx % 8) * (G / 8) + bx / 8 : bx, nblk, tab + 128};
          pg8::EpiBf16 E{SCRP(bf16_t, SC_XB), 1024, p.in[I_MBD] + (size_t)l * 32 * 1024, 1024};
          pg8::gemm_phase<pg8::EpiBf16, pg8::GroupOrder<4>>(lds, g, S, E, wave_s); }
#endif
        GRID_BAR(); T_END(11);
        T_BEGIN(12);
#if PHM & 131072
        for (int rep_ = ((REPM & 256) ? 0 : 1); rep_ < 2; ++rep_)
        { PHASE_BEGIN(); ln2_rows(p, l, nrows, gw, ngw, lane, rep_ == 0); }
#endif
        GRID_BAR(); T_END(12);
    }
    if (TPH >= 0 && bx == 0 && wave_s == 0 && lane_id_() == 0) { Params p = p_arg; p.out[0] += (float)tph_acc * 1e-4f; }
}

extern "C" void kernel_launch(void* const* d_in, const int* in_sizes, int n_in, void* d_out, int out_size, void* d_ws, size_t ws_size, hipStream_t stream) {
    (void)in_sizes; (void)n_in; (void)out_size; (void)ws_size;
    static int grid = 0;
    if (!grid) {
        (void)hipFuncSetAttribute((const void*)fwd_kernel, hipFuncAttributeMaxDynamicSharedMemorySize, LDS_BYTES);
        int dev = 0, cus = 0; (void)hipGetDevice(&dev); (void)hipDeviceGetAttribute(&cus, hipDeviceAttributeMultiprocessorCount, dev);
        grid = cus > 0 && cus < 256 ? cus : 256;
    }
    (void)hipMemsetAsync(d_ws, 0, CTL_BYTES, stream);
    Params p{};
    for (int i = 0; i < 41; ++i) p.in[i] = (const float*)d_in[i];
    p.out = (float*)d_out; p.ws = (unsigned char*)d_ws;
    hipLaunchKernelGGL(fwd_kernel, dim3(grid), dim3(NTHR), LDS_BYTES, stream, p);
}
```

```cpp
#include <hip/hip_runtime.h>
#include <cstdint>
#include <cstdio>

#define LAS __attribute__((address_space(3)))
typedef unsigned short bf16_t;
typedef short bf16x8 __attribute__((ext_vector_type(8)));
typedef float f32x4 __attribute__((ext_vector_type(4)));
typedef float f32x2 __attribute__((ext_vector_type(2)));
typedef unsigned u32x4 __attribute__((ext_vector_type(4)));
typedef unsigned u32x2 __attribute__((ext_vector_type(2)));

constexpr int D = 1024, NB = 4, SEQ = 4096, LCX = 256, NLAT = NB * SEQ, NCX = NB * LCX, NTOK = NLAT + NCX;
constexpr int DIN = 3488, DINP = 3584;
constexpr int NE = 32, FF = 1024;
constexpr int CAP_BLK = 304, CAP = CAP_BLK * 256;
constexpr int NTHR = 512;
constexpr int ZQ = 0, ZK = 256, ZV = 512, ZGQ = 768, ZGK = 960, ZGV = 1152, ZGF = 1536, ZGB = 1552, ZGR = 1568, ZRKV = 1952, ZWF = 3104, ZWB = 3168, ZAF = 3232, ZAB = 3296, ZG = 3360;
constexpr int NKT = 136;
constexpr int NCHUNK = 272;
constexpr float LN_EPS = 1e-5f, RW_GN_EPS = 64e-5f;
constexpr float DN_ALPHA = 1.41421356237f;

constexpr size_t MiB = 1u << 20;
constexpr size_t WS_CTL = 0, CTL_BYTES = 1 * MiB;
constexpr size_t WS_MOD = 1 * MiB;
constexpr size_t WS_TOP = 2 * MiB;
constexpr size_t TOP_STRIDE = (size_t)NTOK * 4 * 4;
constexpr size_t WS_CNTWG = 3 * MiB + 768 * 1024;
constexpr size_t WS_RWW = 3 * MiB + 128 * 1024;
constexpr size_t RWW_LAYER = 4 * 384 * 64 + 384 * 128;
static_assert(WS_TOP + 4 * TOP_STRIDE <= WS_RWW && WS_RWW + 2 * RWW_LAYER * 2 <= WS_CNTWG && WS_CNTWG + 2 * 256 * 32 * 4 <= 4 * MiB, "ws map");
constexpr size_t WS_RTW = 4 * MiB + 512 * 1024;
constexpr size_t WS_BGU = 4 * MiB;
constexpr size_t WS_H = 5 * MiB;
constexpr size_t WS_XM = 73 * MiB;
constexpr size_t WS_CAT = 107 * MiB;
constexpr size_t WS_Z = 141 * MiB;
constexpr size_t WS_WIN = 260 * MiB;
constexpr size_t WS_WOUT = 274 * MiB;
constexpr size_t WS_WGU = 278 * MiB;
constexpr size_t WS_WDN = 534 * MiB;
constexpr size_t WS_SCR = 662 * MiB;
constexpr size_t WS_END = 966 * MiB;
constexpr size_t WS_MREC = 966 * MiB, WS_GREC = 992 * MiB, WS_TOTAL = 1018 * MiB;
static_assert(WS_MREC + (size_t)3264 * 8192 <= WS_GREC && WS_GREC + (size_t)3264 * 8192 <= WS_TOTAL && WS_TOTAL <= 1024 * MiB, "ws map");
static_assert(WS_H + (size_t)NTOK * D * 4 <= WS_XM && WS_XM + (size_t)NTOK * D * 2 <= WS_CAT && WS_CAT + (size_t)NTOK * D * 2 <= WS_Z, "ws map");
static_assert(WS_Z + (size_t)NTOK * DINP * 2 <= WS_WIN && WS_WIN + (size_t)2 * DINP * D * 2 <= WS_WOUT && WS_WOUT + (size_t)2 * D * D * 2 <= WS_WGU, "ws map");
static_assert(WS_WGU + (size_t)2 * 32 * 2048 * 1024 * 2 <= WS_WDN && WS_WDN + (size_t)2 * 32 * 1024 * 1024 * 2 <= WS_SCR, "ws map");
constexpr size_t SC_XB = 0, SC_ACT = (size_t)CAP * D * 2;
static_assert(WS_SCR + 2 * SC_ACT <= WS_END, "ws map");
constexpr size_t SZ_T384B = (size_t)NTOK * 384 * 2, SZ_T384F = (size_t)NTOK * 384 * 4, SZ_T192F = (size_t)NTOK * 192 * 4;
constexpr size_t SC_KVREC = 0;
constexpr size_t SC_GBF = SC_KVREC + (size_t)16 * NKT * 8192;
constexpr size_t SC_GBB = SC_GBF + SZ_T192F;
constexpr size_t SC_KVC = SC_GBB + SZ_T192F;
constexpr size_t SZ_KVC = (size_t)NCHUNK * 6 * 2 * 2048 * 4;
constexpr size_t SC_SC = SC_KVC + SZ_KVC;
constexpr size_t SC_DC = SC_SC + SZ_KVC;
constexpr size_t SC_R = SC_DC + (size_t)NCHUNK * 6 * 2 * 32 * 4;
constexpr size_t SC_KK = SC_R + SZ_T384B, SC_V = SC_KK + SZ_T384B, SC_BKF = SC_V + SZ_T384B, SC_BKB = SC_BKF + SZ_T384B, SC_KMF = SC_BKB + SZ_T384B, SC_KMB = SC_KMF + SZ_T384B, SC_G = SC_KMB + SZ_T384B;
constexpr size_t SC_WF = SC_G + SZ_T384B, SC_WB = SC_WF + SZ_T384F, SC_YF = SC_WB + SZ_T384F, SC_YB = SC_YF + SZ_T384F, SC_BON = SC_YB + SZ_T384F;
constexpr size_t SC_MIX_END = SC_BON + (size_t)NTOK * 8 * 4;
static_assert(WS_SCR + SC_MIX_END <= WS_END, "mixer scratch");
constexpr int CW_BAR = 4096, CW_CNT = 8192, CW_QHEAD = 8448  , CW_KMAX = 16896;
static_assert(CW_BAR + 3456 <= CW_CNT && CW_CNT + 128 <= CW_QHEAD && CW_QHEAD + 16 * 512 <= CW_KMAX && (CW_KMAX + 64) * 4 <= (int)CTL_BYTES, "control words");

constexpr int LDS_BYTES = 163840, LDS_CTL_OFF = LDS_BYTES - 256;

__device__ __forceinline__ int lane_id_() { int r; asm volatile("v_mbcnt_lo_u32_b32 %0, -1, 0\n\tv_mbcnt_hi_u32_b32 %0, -1, %0" : "=v"(r)); return r; }
#define WAVE_ID_SGPR() (__builtin_amdgcn_readfirstlane((int)(threadIdx.x >> 6)))

__device__ __forceinline__ unsigned f2bf(float f) { unsigned u = __builtin_bit_cast(unsigned, f); return (u + 0x7fffu + ((u >> 16) & 1u)) >> 16; }
__device__ __forceinline__ unsigned pk2(float lo, float hi) { return f2bf(lo) | (f2bf(hi) << 16); }
__device__ __forceinline__ float bf2f(bf16_t h) { return __builtin_bit_cast(float, (unsigned)h << 16); }
__device__ __forceinline__ float bflo(unsigned u) { return __builtin_bit_cast(float, u << 16); }
__device__ __forceinline__ float bfhi(unsigned u) { return __builtin_bit_cast(float, u & 0xffff0000u); }
__device__ __forceinline__ float wave_sum(float v) {
#pragma unroll
    for (int o = 1; o < 64; o <<= 1) v += __shfl_xor(v, o);
    return v;
}
__device__ __forceinline__ float sigmoidf_(float x) { return __builtin_amdgcn_rcpf(1.f + __expf(-x)); }
__device__ __forceinline__ float siluf_(float x) { return x * __builtin_amdgcn_rcpf(1.f + __expf(-x)); }
__device__ __forceinline__ float tanhf_(float x) { return 1.f - 2.f * __builtin_amdgcn_rcpf(1.f + __expf(2.f * x)); }
template <int CTRL> __device__ __forceinline__ float dpp_f(float v) {
    return __builtin_bit_cast(float, __builtin_amdgcn_update_dpp(0, __builtin_bit_cast(int, v), CTRL, 0xF, 0xF, true));
}
__device__ __forceinline__ float red16(float v) {
    v += dpp_f<0xB1>(v);
    v += dpp_f<0x4E>(v);
    v += dpp_f<0x141>(v);
    v += dpp_f<0x140>(v);
    return v;
}

namespace pg8 {
constexpr int BM = 256, BK = 64, HALF = 128, HTB = HALF * BK * 2, STAGE_BYTES = 8 * HTB, NXCD = 8, WGM = 8;
__host__ __device__ __forceinline__ int lds_byte(int r, int c) { const int st = (r >> 4) * 2 + (c >> 5), rr = r & 15, cc = c & 31, ob = rr * 64 + cc * 2; return st * 1024 + (ob ^ (((ob >> 9) & 1) << 5)); }
__host__ __device__ __forceinline__ void stage_rc(int b, int& R, int& C) { const int st = b / 1024, sb = b % 1024, swz = sb ^ (((sb >> 9) & 1) << 5); R = (st >> 1) * 16 + swz / 64; C = (st & 1) * 32 + (swz % 64) / 2; }
__host__ __device__ __forceinline__ int perm32(int rho) { const int n = rho >> 4, i = rho & 15; return 8 * (i >> 2) + 4 * n + (i & 3); }

struct Unit { int pm, pn, e; size_t boff; };
struct Gemm { const bf16_t* A; const bf16_t* Bt; int M, N, K; };

struct StaticOrder {
    int nM, nN, nwg, G, c; size_t tstep;
    __device__ void init(int M, int N, int K, int G_, int c_) { nM = M / BM; nN = N / BM; nwg = nM * nN; G = G_; c = c_; tstep = (size_t)BM * K * 2; }
    __device__ bool next(int i, Unit& u) const {
        const long L = (long)i * G + c; if (L >= nwg) return false;
        int wgid = (int)L; { const int q = nwg / NXCD, r = nwg % NXCD, xcd = wgid % NXCD, off = wgid / NXCD; wgid = (xcd < r ? xcd * (q + 1) : r * (q + 1) + (xcd - r) * q) + off; }
        const int nig = WGM * nN, gid = wgid / nig, fm = gid * WGM, gsz = (nM - fm) < WGM ? (nM - fm) : WGM;
        u.pm = fm + ((wgid % nig) % gsz); u.pn = (wgid % nig) / gsz; u.e = 0; u.boff = (size_t)u.pn * tstep; return true;
    }
};
template <int NPN> struct GroupOrder {
    int G, c, nblk; const LAS int* blk2e;
    __device__ __forceinline__ bool next(int i, Unit& u) const {
        const int L = i * G + c; if (L >= nblk * NPN) return false;
        const int blk = L / NPN; u.pn = L % NPN; u.pm = blk;
        const int e = blk2e[blk];
        u.e = e; u.boff = (size_t)(e * NPN + u.pn) * ((size_t)256 * 1024 * 2); return true;
    }
};

typedef __bf16 bf16x2_t __attribute__((ext_vector_type(2)));
__device__ __forceinline__ unsigned cvt_pk_bf16(float lo, float hi) { const f32x2 v = {lo, hi}; const bf16x2_t b = __builtin_convertvector(v, bf16x2_t); return __builtin_bit_cast(unsigned, b); }

struct EpiBf16 {
    bf16_t* O; int ldc; const float* bias; int bias_estride;
    __device__ __forceinline__ void operator()(const f32x4 (&acc)[2][2][4][2], const Unit& u, int wr, int wc, int fr, int fq) const {
        const int row0 = u.pm * BM + wr * 64 + fr; const int col0 = u.pn * BM + wc * 32 + 8 * fq;
        f32x4 bv[2][2];
#pragma unroll
        for (int bj = 0; bj < 2; ++bj)
#pragma unroll
            for (int n = 0; n < 2; ++n) bv[bj][n] = bias ? *(const f32x4*)(bias + (size_t)u.e * bias_estride + col0 + bj * HALF + 4 * n) : (f32x4){0.f, 0.f, 0.f, 0.f};
#pragma unroll
        for (int ai = 0; ai < 2; ++ai)
#pragma unroll
            for (int m = 0; m < 4; ++m) { bf16_t* rowp = O + (size_t)(row0 + ai * HALF + m * 16) * ldc + col0;
#pragma unroll
                for (int bj = 0; bj < 2; ++bj) { const f32x4 v0 = acc[ai][bj][m][0] + bv[bj][0], v1 = acc[ai][bj][m][1] + bv[bj][1];
                    u32x4 w; w.x = cvt_pk_bf16(v0[0], v0[1]); w.y = cvt_pk_bf16(v0[2], v0[3]); w.z = cvt_pk_bf16(v1[0], v1[1]); w.w = cvt_pk_bf16(v1[2], v1[3]);
                    *(u32x4*)(rowp + bj * HALF) = w; } }
    }
};
struct EpiSwiglu {
    bf16_t* O; const float* bias;
    __device__ __forceinline__ static float act(float g, float u) {
        g = fminf(g, 7.f); u = fminf(fmaxf(u, -7.f), 7.f);
        return (u + 1.f) * g * __builtin_amdgcn_rcpf(1.f + __expf(-1.702f * g));
    }
    __device__ __forceinline__ void operator()(const f32x4 (&acc)[2][2][4][2], const Unit& u, int wr, int wc, int fr, int fq) const {
        const int row0 = u.pm * BM + wr * 64 + fr; const int col0 = u.pn * BM + wc * 32 + 8 * fq;
        f32x4 bv[2][2];
#pragma unroll
        for (int bj = 0; bj < 2; ++bj)
#pragma unroll
            for (int n = 0; n < 2; ++n) bv[bj][n] = *(const f32x4*)(bias + (size_t)u.e * 2048 + col0 + bj * HALF + 4 * n);
#pragma unroll
        for (int ai = 0; ai < 2; ++ai)
#pragma unroll
            for (int m = 0; m < 4; ++m) { bf16_t* rowp = O + (size_t)(row0 + ai * HALF + m * 16) * 1024 + (col0 >> 1);
#pragma unroll
                for (int bj = 0; bj < 2; ++bj) { const f32x4 v0 = acc[ai][bj][m][0] + bv[bj][0], v1 = acc[ai][bj][m][1] + bv[bj][1];
                    u32x2 w; w.x = cvt_pk_bf16(act(v0[0], v0[1]), act(v0[2], v0[3])); w.y = cvt_pk_bf16(act(v1[0], v1[1]), act(v1[2], v1[3]));
                    *(u32x2*)(rowp + bj * (HALF / 2)) = w; } }
    }
};

template <class Epi, class Sched>
__device__ __forceinline__ void gemm_phase(LAS unsigned char* lds, const Gemm g, const Sched& S, const Epi& E, const int wave_s) {
    int tid = wave_s * 64 + lane_id_(); asm volatile("" : "+v"(tid));
    const int wid = __builtin_amdgcn_readfirstlane(tid >> 6), lane = tid & 63, wr = wid >> 2, wc = wid & 3, fr = lane & 15, fq = lane >> 4;
    const int K = g.K, nt = K / BK;
    unsigned voffA[2], voffB[2];
#pragma unroll
    for (int i = 0; i < 2; ++i) { int R, C; stage_rc(tid * 16 + i * 8192, R, C); const int Rb = (R & ~31) + perm32(R & 31);
        voffA[i] = (unsigned)(R * K + C) * 2u; voffB[i] = (unsigned)(Rb * K + C) * 2u; }
    const size_t kstep = (size_t)(BK * 2);
    const size_t hstep = (size_t)HALF * K * 2;
    const size_t tstep = 2 * hstep;
    const unsigned ldsw = (unsigned)wid * 1024u;
    const int aoff = lds_byte(wr * 64 + fr, fq * 8), boff = lds_byte(wc * 32 + fr, fq * 8);
#define PG8_SA(b, h) (((b) * 2 + (h)) * HTB)
#define PG8_SB(b, h) ((4 + (b) * 2 + (h)) * HTB)
#define PG8_STAGE(bufoff, gbase, voff) do { _Pragma("unroll") for (int _i = 0; _i < 2; ++_i) \
        __builtin_amdgcn_global_load_lds((const unsigned*)((const char*)(gbase) + (voff)[_i]), (LAS unsigned*)(lds + (bufoff) + ldsw + _i * 8192), 16, 0, 0); } while (0)
#define PG8_LDA(dst, b, h) do { _Pragma("unroll") for (int m = 0; m < 4; ++m) _Pragma("unroll") for (int k = 0; k < 2; ++k) dst[m][k] = *(const LAS bf16x8*)(lds + PG8_SA(b, h) + aoff + m * 2048 + k * 1024); } while (0)
#define PG8_LDB(dst, b, h) do { _Pragma("unroll") for (int n = 0; n < 2; ++n) _Pragma("unroll") for (int k = 0; k < 2; ++k) dst[n][k] = *(const LAS bf16x8*)(lds + PG8_SB(b, h) + boff + n * 2048 + k * 1024); } while (0)
#define PG8_MMA(ai, bj, At, Bt) do { __builtin_amdgcn_s_setprio(1); _Pragma("unroll") for (int m = 0; m < 4; ++m) _Pragma("unroll") for (int n = 0; n < 2; ++n) _Pragma("unroll") for (int k = 0; k < 2; ++k) \
        acc[ai][bj][m][n] = __builtin_amdgcn_mfma_f32_16x16x32_bf16(Bt[n][k], At[m][k], acc[ai][bj][m][n], 0, 0, 0); __builtin_amdgcn_s_setprio(0); } while (0)
#define PG8_WAIT_V(n) asm volatile("s_waitcnt vmcnt(" #n ")" ::: "memory")
#define PG8_WAIT_L(n) asm volatile("s_waitcnt lgkmcnt(" #n ")" ::: "memory")
#define PG8_BAR __builtin_amdgcn_s_barrier()
#define PG8_SCHED __builtin_amdgcn_sched_barrier(0)
    Unit cur, nxt; int ui = 0;
    if (!S.next(0, cur)) return;
    f32x4 acc[2][2][4][2];
#pragma unroll
    for (int a = 0; a < 2; ++a)
#pragma unroll
        for (int b = 0; b < 2; ++b)
#pragma unroll
            for (int m = 0; m < 4; ++m)
#pragma unroll
                for (int n = 0; n < 2; ++n) acc[a][b][m][n] = (f32x4){0.f, 0.f, 0.f, 0.f};
    bf16x8 At[4][2], B0[2][2], B1[2][2];
    const char* cA = (const char*)g.A + (size_t)cur.pm * tstep; const char* cB = (const char*)g.Bt + cur.boff;
    PG8_STAGE(PG8_SB(0, 0), cB, voffB); PG8_STAGE(PG8_SB(0, 1), cB + hstep, voffB); PG8_STAGE(PG8_SA(0, 0), cA, voffA); PG8_STAGE(PG8_SA(0, 1), cA + hstep, voffA);
    if (wr == 1) PG8_BAR;
    PG8_WAIT_V(2); PG8_BAR;
    PG8_STAGE(PG8_SB(1, 0), cB + kstep, voffB); PG8_STAGE(PG8_SA(1, 0), cA + kstep, voffA); PG8_STAGE(PG8_SB(1, 1), cB + hstep + kstep, voffB);
    PG8_WAIT_V(6); PG8_BAR;
    for (;;) {
        const bool has_next = S.next(ui + 1, nxt);
        const char* nA = has_next ? (const char*)g.A + (size_t)nxt.pm * tstep : cA; const char* nB = has_next ? (const char*)g.Bt + nxt.boff : cB;
        for (int t = 0; t < nt; t += 2) {
            const bool last = (t == nt - 2);
            const char* a1 = cA + (size_t)(t + 1) * kstep;
            const char* a2 = last ? nA : cA + (size_t)(t + 2) * kstep; const char* b2 = last ? nB : cB + (size_t)(t + 2) * kstep;
            const char* a3 = a2 + kstep; const char* b3 = b2 + kstep;
            PG8_LDB(B0, 0, 0); PG8_LDB(B1, 0, 1); PG8_SCHED; PG8_LDA(At, 0, 0); PG8_STAGE(PG8_SA(1, 1), a1 + hstep, voffA);
            PG8_WAIT_V(8); PG8_WAIT_L(0); PG8_BAR; PG8_MMA(0, 0, At, B0); PG8_MMA(0, 1, At, B1); PG8_BAR; PG8_SCHED;
            PG8_LDA(At, 0, 1); PG8_STAGE(PG8_SB(0, 0), b2, voffB); PG8_STAGE(PG8_SB(0, 1), b2 + hstep, voffB); PG8_STAGE(PG8_SA(0, 0), a2, voffA);
            PG8_WAIT_V(8); PG8_WAIT_L(0); PG8_BAR; PG8_MMA(1, 0, At, B0); PG8_MMA(1, 1, At, B1); PG8_BAR; PG8_SCHED;
            PG8_LDB(B0, 1, 0); PG8_LDB(B1, 1, 1); PG8_SCHED; PG8_LDA(At, 1, 0); PG8_STAGE(PG8_SA(0, 1), a2 + hstep, voffA);
            PG8_WAIT_V(8); PG8_WAIT_L(0); PG8_BAR; PG8_MMA(0, 0, At, B0); PG8_MMA(0, 1, At, B1); PG8_BAR; PG8_SCHED;
            PG8_LDA(At, 1, 1); PG8_STAGE(PG8_SB(1, 0), b3, voffB); PG8_STAGE(PG8_SB(1, 1), b3 + hstep, voffB); PG8_STAGE(PG8_SA(1, 0), a3, voffA);
            PG8_WAIT_V(8); PG8_WAIT_L(0); PG8_BAR; PG8_MMA(1, 0, At, B0); PG8_MMA(1, 1, At, B1); PG8_BAR; PG8_SCHED;
        }
        if (wr == 0) PG8_BAR;
        { int tz = wave_s * 64 + lane_id_(); asm volatile("" : "+v"(tz)); const int l2 = tz & 63; E(acc, cur, wave_s >> 2, wave_s & 3, l2 & 15, l2 >> 4); }
        if (!has_next) break;
#pragma unroll
        for (int a = 0; a < 2; ++a)
#pragma unroll
            for (int b = 0; b < 2; ++b)
#pragma unroll
                for (int m = 0; m < 4; ++m)
#pragma unroll
                    for (int n = 0; n < 2; ++n) acc[a][b][m][n] = (f32x4){0.f, 0.f, 0.f, 0.f};
        cur = nxt; cA = nA; cB = nB; ++ui;
        if (wr == 1) PG8_BAR;
    }
    PG8_WAIT_V(0);
    PG8_BAR;
#undef PG8_SA
#undef PG8_SB
#undef PG8_STAGE
#undef PG8_LDA
#undef PG8_LDB
#undef PG8_MMA
#undef PG8_WAIT_V
#undef PG8_WAIT_L
#undef PG8_BAR
#undef PG8_SCHED
}
}
#define XB_TMO      128
#define XB_XCNT(j)  (256  + 64 * (j))
#define XB_XSUB(j)  (1280 + 64 * (j))
#define XB_XGEN(j)  (2304 + 64 * (j))
#define XB_TOP      3328
#define XB_TOPGEN   3392
#define XCD_BAR_WORDS 3456
#define XB_SPIN_CAP (1u << 18)

__device__ __forceinline__ unsigned xb_ld(unsigned* p)              { return __hip_atomic_load(p, __ATOMIC_RELAXED, __HIP_MEMORY_SCOPE_AGENT); }
__device__ __forceinline__ unsigned xb_add(unsigned* p, unsigned v) { return __hip_atomic_fetch_add(p, v, __ATOMIC_RELAXED, __HIP_MEMORY_SCOPE_AGENT); }
__device__ __forceinline__ unsigned xb_xcc_id() { return (unsigned)__builtin_amdgcn_s_getreg((3 << 11) | 20) & 0xFu; }
#define XB_SPIN(cond, bar) do { unsigned _sp = 0; while (cond) { __builtin_amdgcn_s_sleep(1); \
    if ((++_sp & 255u) == 0u) { if (xb_ld(&(bar)[XB_TMO])) break; if (_sp > XB_SPIN_CAP) { atomicAdd(&(bar)[XB_TMO], 1u); break; } } } } while (0)

struct XcdBarrier {
    unsigned* bar; unsigned x; int w;
    volatile LAS unsigned* st;
};

__device__ __forceinline__ XcdBarrier xcd_barrier_post(unsigned* bar, volatile LAS unsigned* st, int wave_s) {
    XcdBarrier b; b.bar = bar; b.x = xb_xcc_id(); b.st = st; b.w = wave_s;
    if (wave_s == 0 && lane_id_() == 0) (void)xb_add(&bar[XB_XCNT(b.x)], 1u);
    return b;
}
__device__ __forceinline__ void xcd_barrier_complete(unsigned* bar, unsigned x, unsigned& nloc, unsigned& nx) {
    const unsigned G = gridDim.x * gridDim.y * gridDim.z;
    unsigned sum, cnt, mine, sp = 0u;
    for (;;) {
        sum = 0u; cnt = 0u; mine = 0u;
#pragma unroll
        for (unsigned j = 0; j < 16; ++j) { const unsigned c = xb_ld(&bar[XB_XCNT(j)]); sum += c; cnt += (c > 0u) ? 1u : 0u; mine = (j == x) ? c : mine; }
        if (sum == G) break;
        __builtin_amdgcn_s_sleep(1);
        if ((++sp & 255u) == 0u) { if (xb_ld(&bar[XB_TMO])) break; if (sp > XB_SPIN_CAP) { atomicAdd(&bar[XB_TMO], 1u); break; } }
    }
    nloc = mine > 0u ? mine : 1u; nx = cnt > 0u ? cnt : 1u;
}

__device__ __forceinline__ void xcd_barrier(const XcdBarrier& b) {
    asm volatile("s_waitcnt vmcnt(0)" ::: "memory");
    __syncthreads();
    if (b.w == 0 && lane_id_() == 0) {
        unsigned* bar = b.bar;
        __builtin_amdgcn_s_waitcnt(0);
        unsigned nloc = b.st[0], nx = b.st[1];
        if (nloc == 0u) { xcd_barrier_complete(bar, b.x, nloc, nx); b.st[0] = nloc; b.st[1] = nx; }
        const unsigned old = xb_add(&bar[XB_XSUB(b.x)], 1u);
        const unsigned gen = old / nloc;
        if (old + 1u == (gen + 1u) * nloc) {
            __builtin_amdgcn_fence(__ATOMIC_RELEASE, "agent");
            asm volatile("s_waitcnt vmcnt(0)" ::: "memory");
            const unsigned og = xb_add(&bar[XB_TOP], 1u);
            const unsigned tg = og / nx;
            if (og + 1u == (tg + 1u) * nx) xb_add(&bar[XB_TOPGEN], 1u);
            else XB_SPIN(xb_ld(&bar[XB_TOPGEN]) == tg, bar);
            __builtin_amdgcn_fence(__ATOMIC_ACQUIRE, "agent");
            xb_add(&bar[XB_XGEN(b.x)], 1u);
            asm volatile("s_waitcnt vmcnt(0)" ::: "memory");
        } else {
            XB_SPIN(xb_ld(&bar[XB_XGEN(b.x)]) == gen, bar);
            __builtin_amdgcn_fence(__ATOMIC_ACQUIRE, "agent");
            asm volatile("s_waitcnt vmcnt(0)" ::: "memory");
        }
    }
    __syncthreads();
}

__device__ const float ROPE_COS[64][8] = {
1.0f, 1.0f, 1.0f, 1.0f, 1.0f, 1.0f, 1.0f, 1.0f,
0.540302277f, 0.950415254f, 0.995004177f, 0.999500036f, 0.999949992f, 0.999994993f, 0.999999523f, 0.99999994f,
-0.416146845f, 0.806578398f, 0.980066597f, 0.998000681f, 0.999800026f, 0.999979973f, 0.999997973f, 0.999999821f,
-0.989992499f, 0.582753658f, 0.955336511f, 0.995503366f, 0.999550045f, 0.999954998f, 0.99999553f, 0.999999523f,
-0.653643608f, 0.301137477f, 0.921060979f, 0.992010653f, 0.999200106f, 0.999920011f, 0.999992013f, 0.999999225f,
0.2836622f, -0.0103423381f, 0.87758255f, 0.987526f, 0.998750269f, 0.999875009f, 0.999987483f, 0.999998748f,
0.960170269f, -0.3207964f, 0.825335622f, 0.982053936f, 0.998200536f, 0.999819994f, 0.999981999f, 0.999998212f,
0.753902256f, -0.599437475f, 0.764842212f, 0.975599885f, 0.997551024f, 0.999755025f, 0.999975502f, 0.999997556f,
-0.145500034f, -0.818632424f, 0.696706712f, 0.968170285f, 0.996801734f, 0.999680042f, 0.999967992f, 0.999996781f,
-0.91113025f, -0.956644177f, 0.621609926f, 0.959772646f, 0.995952725f, 0.999595046f, 0.999959528f, 0.999995947f,
-0.839071512f, -0.999786079f, 0.540302277f, 0.950415313f, 0.995004177f, 0.999500036f, 0.999949992f, 0.999994993f,
0.00442569796f, -0.943779767f, 0.453596085f, 0.940107584f, 0.993956089f, 0.999395072f, 0.999939501f, 0.99999392f,
0.843853951f, -0.79417938f, 0.362357706f, 0.92885989f, 0.99280864f, 0.999280095f, 0.999927998f, 0.999992788f,
0.907446802f, -0.565820515f, 0.267498761f, 0.916683376f, 0.99156189f, 0.999155104f, 0.999915481f, 0.999991536f,
0.136737213f, -0.28134948f, 0.16996716f, 0.903590262f, 0.990216017f, 0.999020159f, 0.99990201f, 0.999990225f,
-0.759687901f, 0.0310223512f, 0.070737198f, 0.889593601f, 0.988771081f, 0.998875201f, 0.999887526f, 0.999988735f,
-0.957659483f, 0.340318173f, -0.0291995462f, 0.87470746f, 0.987227261f, 0.998720288f, 0.999872029f, 0.999987185f,
-0.275163352f, 0.615864813f, -0.128844544f, 0.858946681f, 0.985584795f, 0.998555362f, 0.999855518f, 0.999985576f,
0.660316706f, 0.830336154f, -0.227202162f, 0.842327058f, 0.983843684f, 0.998380423f, 0.999837995f, 0.999983788f,
0.988704622f, 0.962463796f, -0.323289543f, 0.824865162f, 0.982004225f, 0.998195529f, 0.999819517f, 0.99998194f,
0.408082068f, 0.999144375f, -0.416146845f, 0.806578457f, 0.980066597f, 0.998000681f, 0.999800026f, 0.999979973f,
-0.547729254f, 0.936740458f, -0.504846215f, 0.787485182f, 0.97803092f, 0.99779582f, 0.999779522f, 0.999977946f,
-0.99996084f, 0.781440377f, -0.588501155f, 0.767604589f, 0.975897431f, 0.997581005f, 0.999758005f, 0.999975801f,
-0.53283304f, 0.548645258f, -0.666275978f, 0.746956408f, 0.97366637f, 0.997356176f, 0.999735534f, 0.999973536f,
0.424179018f, 0.261441678f, -0.737393796f, 0.725561321f, 0.971337974f, 0.997121394f, 0.99971199f, 0.999971211f,
0.991202831f, -0.0516893305f, -0.801143587f, 0.703440726f, 0.968912423f, 0.996876657f, 0.999687493f, 0.999968767f,
0.64691931f, -0.359694332f, -0.856888831f, 0.680616796f, 0.966389954f, 0.996621907f, 0.999662042f, 0.999966204f,
-0.292138815f, -0.632028639f, -0.904072165f, 0.6571123f, 0.963770926f, 0.996357203f, 0.999635518f, 0.999963522f,
-0.962605894f, -0.841684937f, -0.942222297f, 0.632950664f, 0.961055458f, 0.996082544f, 0.99960804f, 0.99996078f,
-0.748057544f, -0.967871487f, -0.970958173f, 0.608156204f, 0.958243906f, 0.995797932f, 0.999579549f, 0.999957979f,
0.154251456f, -0.998075247f, -0.989992499f, 0.582753658f, 0.955336511f, 0.995503366f, 0.999550045f, 0.999954998f,
0.914742351f, -0.929300308f, -0.999135137f, 0.556768358f, 0.95233357f, 0.995198846f, 0.999519527f, 0.999951959f,
0.83422339f, -0.768367112f, -0.998294771f, 0.53022635f, 0.949235439f, 0.994884372f, 0.999488056f, 0.9999488f,
-0.0132767474f, -0.531235278f, -0.987479806f, 0.503154159f, 0.946042359f, 0.994559944f, 0.999455571f, 0.999945521f,
-0.848570287f, -0.241421118f, -0.966798186f, 0.475578904f, 0.942754686f, 0.994225562f, 0.999422073f, 0.999942183f,
-0.903692186f, 0.0723346695f, -0.93645668f, 0.447528064f, 0.939372718f, 0.993881226f, 0.999387562f, 0.999938726f,
-0.127963692f, 0.378916174f, -0.896758378f, 0.419029742f, 0.935896814f, 0.993526995f, 0.999352098f, 0.99993521f,
0.765414059f, 0.647921681f, -0.848100007f, 0.39011243f, 0.93232733f, 0.993162811f, 0.99931556f, 0.999931574f,
0.955073655f, 0.852673113f, -0.790967762f, 0.360805035f, 0.928664625f, 0.992788672f, 0.999278069f, 0.999927819f,
0.266642928f, 0.972865343f, -0.72593224f, 0.331136853f, 0.924909055f, 0.99240464f, 0.999239624f, 0.999923944f,
-0.666938066f, 0.996578991f, -0.653643608f, 0.301137596f, 0.921060979f, 0.992010653f, 0.999200106f, 0.999920011f,
-0.987339258f, 0.921462357f, -0.574824035f, 0.270837069f, 0.917120814f, 0.991606772f, 0.999159634f, 0.999915957f,
-0.399985313f, 0.754965365f, -0.490260571f, 0.240265876f, 0.913088918f, 0.991192937f, 0.999118149f, 0.999911785f,
0.555113316f, 0.513598442f, -0.400799006f, 0.209454417f, 0.908965766f, 0.990769207f, 0.999075651f, 0.999907553f,
0.999843299f, 0.221298173f, -0.307332784f, 0.178433523f, 0.904751658f, 0.990335584f, 0.99903214f, 0.999903202f,
0.52532196f, -0.0929481089f, -0.210795805f, 0.147234216f, 0.90044713f, 0.989892066f, 0.998987675f, 0.999898732f,
-0.432177931f, -0.397976756f, -0.112152621f, 0.115887694f, 0.89605248f, 0.989438653f, 0.998942196f, 0.999894202f,
-0.992335498f, -0.663538277f, -0.0123883775f, 0.0844252855f, 0.891568303f, 0.988975346f, 0.998895705f, 0.999889553f,
-0.640144348f, -0.863296509f, 0.0874991715f, 0.0528784581f, 0.886994898f, 0.988502085f, 0.9988482f, 0.999884784f,
0.300592542f, -0.977442741f, 0.18651247f, 0.0212787576f, 0.882332861f, 0.98801899f, 0.998799741f, 0.999879956f,
0.964965999f, -0.994656444f, 0.2836622f, -0.0103422189f, 0.87758255f, 0.987526f, 0.998750269f, 0.999875009f,
0.742154181f, -0.913230121f, 0.377977669f, -0.0419528559f, 0.872744501f, 0.987023175f, 0.998699784f, 0.999869943f,
-0.162990779f, -0.741239965f, 0.468516916f, -0.0735215396f, 0.86781919f, 0.986510456f, 0.998648286f, 0.999864817f,
-0.918282807f, -0.495741814f, 0.554374516f, -0.105016708f, 0.862807095f, 0.985987842f, 0.998595834f, 0.999859571f,
-0.829309821f, -0.201079622f, 0.634692967f, -0.136406869f, 0.857708693f, 0.985455394f, 0.998542368f, 0.999854207f,
0.0221267566f, 0.113521777f, 0.708669782f, -0.167660639f, 0.852524519f, 0.984913111f, 0.99848789f, 0.999848783f,
0.853220105f, 0.416867077f, 0.775565803f, -0.198746875f, 0.847255111f, 0.984360933f, 0.998432398f, 0.99984318f,
0.899866819f, 0.678870201f, 0.834712923f, -0.22963427f, 0.841901004f, 0.983798921f, 0.998375952f, 0.999837577f,
0.119180135f, 0.873550534f, 0.885519624f, -0.260292053f, 0.836462677f, 0.983227074f, 0.998318493f, 0.999831796f,
-0.771080196f, 0.981602073f, 0.927478492f, -0.290689558f, 0.830940723f, 0.982645452f, 0.998260021f, 0.999825954f,
-0.952412963f, 0.992308319f, 0.960170269f, -0.3207964f, 0.825335622f, 0.982053936f, 0.998200536f, 0.999819994f,
-0.258101642f, 0.904607594f, 0.98326844f, -0.350582451f, 0.819648027f, 0.981452644f, 0.998140097f, 0.999813974f,
0.673507154f, 0.727198064f, 0.996542096f, -0.380017966f, 0.813878477f, 0.980841517f, 0.998078644f, 0.999807835f,
0.985896587f, 0.477671444f, 0.999858618f, -0.409073502f, 0.808027506f, 0.980220556f, 0.998016179f, 0.999801576f
};
__device__ const float ROPE_SIN[64][8] = {
0.0f, 0.0f, 0.0f, 0.0f, 0.0f, 0.0f, 0.0f, 0.0f,
0.841470957f, 0.310983598f, 0.0998334214f, 0.0316175036f, 0.00999983307f, 0.00316227227f, 0.000999999931f, 0.000316227757f,
0.909297407f, 0.591127098f, 0.198669329f, 0.0632033944f, 0.0199986659f, 0.00632451288f, 0.0019999987f, 0.000632455456f,
0.141120002f, 0.812648892f, 0.295520216f, 0.0947260857f, 0.0299954992f, 0.00948669016f, 0.0029999956f, 0.000948683126f,
-0.756802499f, 0.953580737f, 0.389418334f, 0.126154065f, 0.0399893336f, 0.0126487734f, 0.00399998948f, 0.00126491068f,
-0.958924294f, 0.999946535f, 0.47942555f, 0.157455876f, 0.0499791652f, 0.0158107281f, 0.0049999794f, 0.00158113812f,
-0.279415488f, 0.947148204f, 0.564642489f, 0.188600272f, 0.0599640049f, 0.0189725272f, 0.0059999642f, 0.00189736532f,
0.656986594f, 0.800421596f, 0.64421767f, 0.219556093f, 0.0699428469f, 0.0221341345f, 0.00699994294f, 0.00221359241f,
0.989358246f, 0.574317753f, 0.717356086f, 0.250292331f, 0.0799146891f, 0.0252955221f, 0.0079999147f, 0.00252981926f,
0.412118495f, 0.291259229f, 0.783326924f, 0.280778319f, 0.0898785442f, 0.0284566563f, 0.00899987947f, 0.00284604589f,
-0.54402113f, -0.0206835698f, 0.841470957f, 0.310983568f, 0.099833414f, 0.0316175036f, 0.009999834f, 0.00316227227f,
-0.999990225f, -0.33057496f, 0.891207397f, 0.340877861f, 0.1097783f, 0.0347780399f, 0.0109997792f, 0.00347849843f,
-0.536572933f, -0.60768342f, 0.932039082f, 0.370431304f, 0.119712204f, 0.0379382223f, 0.0119997123f, 0.00379472389f,
0.420167029f, -0.824528456f, 0.963558197f, 0.399614304f, 0.129634142f, 0.0410980321f, 0.0129996343f, 0.00411094911f,
0.990607381f, -0.959605396f, 0.985449731f, 0.428397775f, 0.139543116f, 0.0442574248f, 0.0139995432f, 0.00442717411f,
0.650287867f, -0.999518692f, 0.997494996f, 0.456752867f, 0.149438128f, 0.0474163815f, 0.0149994381f, 0.00474339863f,
-0.287903309f, -0.940310359f, 0.999573588f, 0.484651238f, 0.159318209f, 0.0505748577f, 0.015999319f, 0.00505962269f,
-0.961397469f, -0.78785187f, 0.991664827f, 0.512064993f, 0.169182345f, 0.0537328273f, 0.0169991814f, 0.00537584582f,
-0.750987232f, -0.557262897f, 0.973847628f, 0.538966715f, 0.179029569f, 0.0568902642f, 0.0179990288f, 0.00569206895f,
0.149877205f, -0.271410108f, 0.946300089f, 0.565329552f, 0.188858896f, 0.060047131f, 0.0189988576f, 0.00600829115f,
0.912945271f, 0.0413582884f, 0.909297407f, 0.591127038f, 0.198669314f, 0.0632033944f, 0.0199986678f, 0.00632451288f,
0.836655617f, 0.35002476f, 0.863209307f, 0.616333544f, 0.208459899f, 0.0663590282f, 0.0209984574f, 0.00664073415f,
-0.00885130931f, 0.623979926f, 0.808496356f, 0.640923738f, 0.218229622f, 0.0695140064f, 0.0219982266f, 0.00695695449f,
-0.846220434f, 0.836055279f, 0.745705247f, 0.664873064f, 0.227977514f, 0.0726682767f, 0.0229979735f, 0.00727317436f,
-0.905578375f, 0.965219259f, 0.67546314f, 0.688157499f, 0.237702623f, 0.0758218244f, 0.0239976961f, 0.0075893933f,
-0.132351756f, 0.998663187f, 0.598472118f, 0.710753918f, 0.247403964f, 0.0789746121f, 0.0249973964f, 0.00790561177f,
0.76255846f, 0.933070183f, 0.515501261f, 0.732639611f, 0.257080555f, 0.0821266174f, 0.0259970706f, 0.00822182931f,
0.956375957f, 0.774945021f, 0.427379847f, 0.753792703f, 0.266731411f, 0.0852777958f, 0.0269967206f, 0.00853804592f,
0.270905793f, 0.539968967f, 0.334988207f, 0.774192095f, 0.276355654f, 0.0884281173f, 0.0279963426f, 0.0088542616f,
-0.663633883f, 0.251445323f, 0.239249229f, 0.793817401f, 0.28595221f, 0.0915775672f, 0.0289959367f, 0.00917047635f,
-0.988031626f, -0.0620148405f, 0.141120002f, 0.812648892f, 0.295520186f, 0.0947260931f, 0.029995501f, 0.00948669016f,
-0.404037654f, -0.369325012f, 0.0415805206f, 0.830667794f, 0.305058628f, 0.0978736654f, 0.0309950355f, 0.00980290305f,
0.551426709f, -0.640009403f, -0.0583741926f, 0.847856104f, 0.314566553f, 0.101020269f, 0.0319945402f, 0.0101191159f,
0.999911845f, -0.847224355f, -0.157745644f, 0.864196658f, 0.324043006f, 0.10416586f, 0.0329940096f, 0.010435327f,
0.529082716f, -0.97042042f, -0.255541205f, 0.879673064f, 0.333487093f, 0.107310407f, 0.0339934528f, 0.010751537f,
-0.428182662f, -0.997380435f, -0.350783229f, 0.894269884f, 0.342897803f, 0.110453881f, 0.034992855f, 0.0110677453f,
-0.991778851f, -0.925431013f, -0.442520559f, 0.907972515f, 0.352274209f, 0.113596253f, 0.0359922275f, 0.0113839535f,
-0.643538117f, -0.761706948f, -0.529836178f, 0.920767248f, 0.361615449f, 0.116737492f, 0.036991559f, 0.0117001599f,
0.296368569f, -0.522444785f, -0.611857831f, 0.932641268f, 0.370920479f, 0.119877554f, 0.0379908569f, 0.0120163653f,
0.963795364f, -0.231372014f, -0.687766254f, 0.943582714f, 0.380188406f, 0.123016424f, 0.0389901139f, 0.0123325698f,
0.745113134f, 0.0826458037f, -0.756802499f, 0.953580678f, 0.389418334f, 0.126154065f, 0.0399893373f, 0.0126487734f,
-0.158622667f, 0.388467699f, -0.818277061f, 0.962625206f, 0.39860931f, 0.129290432f, 0.0409885161f, 0.0129649751f,
-0.916521549f, 0.655764699f, -0.871575892f, 0.970707119f, 0.407760441f, 0.132425532f, 0.0419876575f, 0.0132811759f,
-0.831774771f, 0.858030677f, -0.916166008f, 0.977818429f, 0.416870773f, 0.135559291f, 0.0429867506f, 0.0135973748f,
0.0177019257f, 0.975206196f, -0.951602101f, 0.983951986f, 0.425939471f, 0.138691694f, 0.0439858064f, 0.0139135728f,
0.850903511f, 0.995670974f, -0.977530122f, 0.989101648f, 0.434965521f, 0.141822711f, 0.0449848175f, 0.0142297689f,
0.901788354f, 0.917395473f, -0.993690968f, 0.993262351f, 0.44394809f, 0.144952312f, 0.0459837839f, 0.0145459641f,
0.123573124f, 0.748142362f, -0.999923289f, 0.996429801f, 0.452886283f, 0.148080453f, 0.0469827019f, 0.0148621574f,
-0.768254638f, 0.504697084f, -0.99616462f, 0.99860096f, 0.461779177f, 0.151207119f, 0.0479815714f, 0.0151783489f,
-0.953752637f, 0.211200655f, -0.982452571f, 0.999773562f, 0.470625877f, 0.15433228f, 0.0489803962f, 0.0154945394f,
-0.262374848f, -0.10324046f, -0.958924294f, 0.999946535f, 0.47942555f, 0.157455891f, 0.0499791689f, 0.0158107281f,
0.670229197f, -0.407444149f, -0.925814748f, 0.99911958f, 0.48817724f, 0.160577938f, 0.0509778969f, 0.0161269177f,
0.986627579f, -0.671240151f, -0.883454502f, 0.997293651f, 0.496880114f, 0.163698375f, 0.051976569f, 0.0164431017f,
0.395925164f, -0.868469954f, -0.832267344f, 0.994470477f, 0.505533338f, 0.166817173f, 0.0529751927f, 0.0167592876f,
-0.558789074f, -0.979574919f, -0.772764444f, 0.990652919f, 0.514135957f, 0.169934288f, 0.0539737605f, 0.0170754679f,
-0.999755144f, -0.993535519f, -0.705540299f, 0.985844791f, 0.522687256f, 0.173049718f, 0.0549722798f, 0.01739165f,
-0.521551013f, -0.908967435f, -0.631266713f, 0.980050862f, 0.531186223f, 0.17616342f, 0.0559707358f, 0.0177078284f,
0.436164767f, -0.734258294f, -0.550685287f, 0.973276973f, 0.539632022f, 0.179275364f, 0.0569691435f, 0.0180240069f,
0.992872655f, -0.486733496f, -0.464602023f, 0.965529919f, 0.548023939f, 0.182385504f, 0.0579674877f, 0.0183401816f,
0.636738002f, -0.190938011f, -0.373876572f, 0.956817448f, 0.55636102f, 0.185493827f, 0.0589657798f, 0.0186563563f,
-0.304810613f, 0.12379095f, -0.279415488f, 0.947148204f, 0.564642429f, 0.188600287f, 0.0599640086f, 0.0189725272f,
-0.966117799f, 0.426245421f, -0.182162598f, 0.936531842f, 0.572867453f, 0.191704854f, 0.0609621815f, 0.0192886982f,
-0.739180684f, 0.686427653f, -0.0830891207f, 0.924979091f, 0.581035137f, 0.194807529f, 0.0619602874f, 0.0196048655f,
0.167355701f, 0.878538549f, 0.0168140903f, 0.912501454f, 0.589144766f, 0.197908238f, 0.0629583374f, 0.0199210308f
};

struct Params { const float* in[41]; float* out; unsigned char* ws; };
enum { I_X = 0, I_C, I_CTX, I_CCTX, I_LNG, I_LNB, I_ADAW, I_ADAB, I_WIN, I_LQ1, I_LK1, I_LQ2, I_LK2, I_SUBLN, I_GW2, I_GGB, I_GNG, I_CONV, I_W2, I_W0, I_A2, I_A0, I_G2, I_KK, I_KA, I_RK,
       I_LNXG, I_LNXB, I_WOUT, I_LN1G, I_LN1B, I_RW, I_RB, I_MWG, I_MBG, I_MWU, I_MBU, I_MWD, I_MBD, I_LN2G, I_LN2B };

#define WSP(T, off) ((T*)(p.ws + (off)))
#define SCRP(T, off) ((T*)(p.ws + WS_SCR + (off)))

__device__ __forceinline__ void conv_tile(const float* __restrict__ src, int ld, int nvalid, int k0, int n0, bf16_t* __restrict__ dst, int rs, int ro, LAS float* tile, int tid) {
    {
        const int k = tid >> 3, n8 = (tid & 7) * 8;
        const float* s = src + (size_t)(k0 + k) * ld + n0 + n8;
        f32x4 a[4], b[4];
#pragma unroll
        for (int q = 0; q < 4; ++q) { a[q] = (f32x4){0.f, 0.f, 0.f, 0.f}; b[q] = a[q];
            if (n0 + q * 64 + n8 + 8 <= nvalid) { a[q] = *(const f32x4*)(s + q * 64); b[q] = *(const f32x4*)(s + q * 64 + 4); } }
#pragma unroll
        for (int q = 0; q < 4; ++q) { LAS float* t = tile + k * 261 + q * 65 + n8;
            t[0] = a[q][0]; t[1] = a[q][1]; t[2] = a[q][2]; t[3] = a[q][3]; t[4] = b[q][0]; t[5] = b[q][1]; t[6] = b[q][2]; t[7] = b[q][3]; }
    }
    __syncthreads();
    {
        const int n = tid >> 3, k8 = (tid & 7) * 8;
#pragma unroll
        for (int q = 0; q < 4; ++q) { const LAS float* t = tile + k8 * 261 + q * 65 + n;
            u32x4 o; o.x = pk2(t[0], t[261]); o.y = pk2(t[522], t[783]); o.z = pk2(t[1044], t[1305]); o.w = pk2(t[1566], t[1827]);
            *(u32x4*)(dst + ((size_t)(n0 + q * 64 + n) * rs + ro) * 1024 + k0 + k8) = o; }
    }
    __syncthreads();
}
constexpr int JW_IN = 16 * 14, JW_OUT = 64, JW_LAYER = JW_IN + JW_OUT + 32 * 192, JW_TOTAL = 2 * JW_LAYER, J_MOD = 48;
__device__ __forceinline__ void conv_job(const Params& p, int j, LAS float* tile, int tid) {
    asm volatile("" : "+v"(tid));
    const int l = j / JW_LAYER; int r = j % JW_LAYER;
    if (r < JW_IN) { const int kt = r / 14, nt = r % 14;
        conv_tile(p.in[I_WIN] + (size_t)l * 1024 * DIN, DIN, DIN, kt * 64, nt * 256, WSP(bf16_t, WS_WIN) + (size_t)l * DINP * 1024, 1, 0, tile, tid); return; }
    r -= JW_IN;
    if (r < JW_OUT) { const int kt = r >> 2, nt = r & 3;
        conv_tile(p.in[I_WOUT] + (size_t)l * 1024 * 1024, 1024, 1024, kt * 64, nt * 256, WSP(bf16_t, WS_WOUT) + (size_t)l * 1024 * 1024, 1, 0, tile, tid); return; }
    r -= JW_OUT;
    const int e = r / 192, q = r % 192, which = q >> 6, t = q & 63, kt = t >> 2, nt = t & 3;
    const size_t eo = (size_t)(l * 32 + e) * 1024 * 1024;
    if (which == 0) conv_tile(p.in[I_MWG] + eo, 1024, 1024, kt * 64, nt * 256, WSP(bf16_t, WS_WGU) + 2 * eo, 2, 0, tile, tid);
    else if (which == 1) conv_tile(p.in[I_MWU] + eo, 1024, 1024, kt * 64, nt * 256, WSP(bf16_t, WS_WGU) + 2 * eo, 2, 1, tile, tid);
    else conv_tile(p.in[I_MWD] + eo, 1024, 1024, kt * 64, nt * 256, WSP(bf16_t, WS_WDN) + eo, 1, 0, tile, tid);
}
__device__ __forceinline__ void mod_job(const Params& p, int job, LAS float* lds, int tid) {
    asm volatile("" : "+v"(tid));
    const int l = job / 24, c0 = (job % 24) * 256;
    LAS float* sv = lds;
    LAS float* part = lds + 5120;
    for (int i = tid; i < 5120; i += NTHR) { const int s = i >> 10, k = i & 1023; const float cv = s < 4 ? p.in[I_C][s * 1024 + k] : p.in[I_CCTX][k]; sv[i] = siluf_(cv); }
    __syncthreads();
    const int n = tid & 255, kh = tid >> 8;
    const float* w = p.in[I_ADAW] + (size_t)l * 1024 * 6144 + (size_t)(kh * 512) * 6144 + c0 + n;
    float a0 = 0.f, a1 = 0.f, a2 = 0.f, a3 = 0.f, a4 = 0.f;
    const LAS float* s0 = sv + kh * 512;
#pragma unroll 8
    for (int k = 0; k < 512; ++k) { const float wv = w[(size_t)k * 6144];
        a0 += s0[k] * wv; a1 += s0[1024 + k] * wv; a2 += s0[2048 + k] * wv; a3 += s0[3072 + k] * wv; a4 += s0[4096 + k] * wv; }
    part[(kh * 5 + 0) * 256 + n] = a0; part[(kh * 5 + 1) * 256 + n] = a1; part[(kh * 5 + 2) * 256 + n] = a2; part[(kh * 5 + 3) * 256 + n] = a3; part[(kh * 5 + 4) * 256 + n] = a4;
    __syncthreads();
    if (kh == 0) { const float bb = p.in[I_ADAB][l * 6144 + c0 + n]; float* mo = WSP(float, WS_MOD);
#pragma unroll
        for (int s = 0; s < 5; ++s) mo[(size_t)(l * 5 + s) * 6144 + c0 + n] = part[s * 256 + n] + part[(5 + s) * 256 + n] + bb; }
    __syncthreads();
}

__device__ __forceinline__ void ln_in_rows(const Params& p, int gw, int ngw, int lane) {
    float* H = WSP(float, WS_H); bf16_t* XM = WSP(bf16_t, WS_XM); const float* MOD = WSP(float, WS_MOD);
    for (int row = gw; row < NTOK; row += ngw) {
        const float* src = row < NLAT ? p.in[I_X] + (size_t)row * D : p.in[I_CTX] + (size_t)(row - NLAT) * D;
        f32x4 v[4]; float s = 0.f;
#pragma unroll
        for (int j = 0; j < 4; ++j) { v[j] = *(const f32x4*)(src + lane * 4 + 256 * j); s += (v[j][0] + v[j][1]) + (v[j][2] + v[j][3]); }
        const float mean = wave_sum(s) * (1.f / D); float s2 = 0.f;
#pragma unroll
        for (int j = 0; j < 4; ++j) { v[j] = v[j] - mean; s2 += (v[j][0] * v[j][0] + v[j][1] * v[j][1]) + (v[j][2] * v[j][2] + v[j][3] * v[j][3]); }
        const float rstd = rsqrtf(wave_sum(s2) * (1.f / D) + LN_EPS);
        const int sidx = row < NLAT ? (row >> 12) : 4; const float* mod = MOD + (size_t)sidx * 6144;
#pragma unroll
        for (int j = 0; j < 4; ++j) { const int c = lane * 4 + 256 * j;
            const f32x4 g = *(const f32x4*)(p.in[I_LNG] + c), bb = *(const f32x4*)(p.in[I_LNB] + c);
            const f32x4 y = v[j] * rstd * g + bb;
            *(f32x4*)(H + (size_t)row * D + c) = y;
            const f32x4 sh = *(const f32x4*)(mod + c), sc = *(const f32x4*)(mod + 1024 + c);
            const f32x4 xm = y * (sc + 1.f) + sh;
            u32x2 o; o.x = pk2(xm[0], xm[1]); o.y = pk2(xm[2], xm[3]);
            *(u32x2*)(XM + (size_t)row * D + c) = o; }
    }
}

__device__ __forceinline__ void unpack8(const u32x4 u, float (&f)[8]) {
    f[0] = bflo(u.x); f[1] = bfhi(u.x); f[2] = bflo(u.y); f[3] = bfhi(u.y); f[4] = bflo(u.z); f[5] = bfhi(u.z); f[6] = bflo(u.w); f[7] = bfhi(u.w);
}
__device__ __forceinline__ void da_job(const Params& p, int l, int b, int kt, LAS unsigned char* lds, int tid) {
    asm volatile("" : "+v"(tid));
    LAS bf16_t* kvt = (LAS bf16_t*)lds;
    const bf16_t* Z = WSP(bf16_t, WS_Z);
    const bool isctx = kt < 8;
    const int rowb = isctx ? NLAT + b * 256 + kt * 32 : b * 4096 + (kt - 8) * 32;
    for (int i = tid; i < 2048; i += NTHR) { const int r = i >> 6, c16 = i & 63;
        *(LAS u32x4*)(kvt + r * 512 + c16 * 8) = *(const u32x4*)(Z + (size_t)(rowb + r) * DINP + ZK + c16 * 8); }
    __syncthreads();
    const int w = tid >> 6, L = tid & 63, fr = L & 15, fq = L >> 4;
    unsigned char* rec = SCRP(unsigned char, SC_KVREC);
    unsigned* kmax = WSP(unsigned, WS_CTL) + CW_KMAX + l * 32;
    for (int h = 0; h < 4; ++h) {
        u32x4 o;
        if (w < 4) {
            const int m = w >> 1, ks = w & 1, key = ks * 16 + fr;
            float ov[8], pv[8];
            unpack8(*(const LAS u32x4*)(kvt + key * 512 + h * 64 + m * 32 + fq * 8), ov);
            unpack8(*(const LAS u32x4*)(kvt + key * 512 + h * 64 + m * 32 + (fq ^ 1) * 8), pv);
            if (!isctx) {
                const int t = (kt - 8) * 32 + key, pos = (fq >> 1) ? (t & 63) : (t >> 6);
                const float sg = (fq & 1) ? 1.f : -1.f;
#pragma unroll
                for (int i = 0; i < 8; ++i) ov[i] = ov[i] * ROPE_COS[pos][i] + sg * pv[i] * ROPE_SIN[pos][i];
            }
            o.x = pk2(ov[0], ov[1]); o.y = pk2(ov[2], ov[3]); o.z = pk2(ov[4], ov[5]); o.w = pk2(ov[6], ov[7]);
            float rv[8]; unpack8(o, rv); float n2 = 0.f;
#pragma unroll
            for (int i = 0; i < 8; ++i) n2 += rv[i] * rv[i];
            n2 += __shfl_xor(n2, 16); n2 += __shfl_xor(n2, 32);
#pragma unroll
            for (int x = 1; x < 16; x <<= 1) n2 = fmaxf(n2, __shfl_xor(n2, x));
            if (L == 0) { unsigned* kp = kmax + (b * 4 + h) * 2 + m; const unsigned nb = __builtin_bit_cast(unsigned, n2);
                if (nb > __hip_atomic_load(kp, __ATOMIC_RELAXED, __HIP_MEMORY_SCOPE_AGENT)) atomicMax(kp, nb); }
        } else {
            const int et = w - 4; unsigned short vv[8];
#pragma unroll
            for (int i = 0; i < 8; ++i) { const int key = (i < 4) ? fq * 4 + i : 16 + fq * 4 + (i - 4); vv[i] = kvt[key * 512 + 256 + h * 64 + et * 16 + fr]; }
            o.x = vv[0] | ((unsigned)vv[1] << 16); o.y = vv[2] | ((unsigned)vv[3] << 16); o.z = vv[4] | ((unsigned)vv[5] << 16); o.w = vv[6] | ((unsigned)vv[7] << 16);
        }
        *(u32x4*)(rec + ((size_t)((b * 4 + h) * NKT + kt)) * 8192 + w * 1024 + L * 16) = o;
    }
    __syncthreads();
}

__device__ __forceinline__ int chunk_row0(int cid) { return cid < 256 ? (cid >> 6) * 4096 + (cid & 63) * 64 : NLAT + ((cid - 256) >> 2) * 256 + ((cid - 256) & 3) * 64; }

constexpr int GLA_HL = 43264;
__device__ __forceinline__ void gla_job(const Params& p, int l, int cid, int hb, LAS unsigned char* lds, int tid) {
    asm volatile("" : "+v"(tid));
    const int r0 = chunk_row0(cid), w = tid >> 6, lane = tid & 63, fr = lane & 15, fq = lane >> 4;
    const bf16_t* Z = WSP(bf16_t, WS_Z);
#define GLA_PTRS(hh) LAS float* gi = (LAS float*)(lds + (hh) * GLA_HL); LAS float* GT = gi + 2048; LAS bf16_t* KDT = (LAS bf16_t*)(GT + 2 * 32 * 65); LAS bf16_t* Vt = KDT + 2 * 32 * 72; (void)gi; (void)GT; (void)KDT; (void)Vt;
    LAS bf16_t* KRAW = (LAS bf16_t*)(lds + 3 * GLA_HL + 13056);
    if (tid < 256) { const int pp = tid >> 2, k8 = (tid & 3) * 8;
#pragma unroll
        for (int hh = 0; hh < 3; ++hh) *(LAS u32x4*)(KRAW + (hh * 64 + pp) * 32 + k8) = *(const u32x4*)(Z + (size_t)(r0 + pp) * DINP + ZGK + (hb + hh) * 32 + k8); }
#pragma unroll 1
    for (int hh = 0; hh < 3; ++hh) { const int h = hb + hh; GLA_PTRS(hh)
        if (tid < 256) { const int pp = tid >> 2, k8 = (tid & 3) * 8; float v[8]; unpack8(*(const u32x4*)(Z + (size_t)(r0 + pp) * DINP + ZGF + k8), v);
            *(LAS f32x4*)(gi + pp * 32 + k8) = (f32x4){v[0], v[1], v[2], v[3]}; *(LAS f32x4*)(gi + pp * 32 + k8 + 4) = (f32x4){v[4], v[5], v[6], v[7]}; }
        { const int pp = tid >> 3, v8 = (tid & 7) * 8; const u32x4 u = *(const u32x4*)(Z + (size_t)(r0 + pp) * DINP + ZGV + h * 64 + v8);
          Vt[(v8 + 0) * 72 + pp] = (bf16_t)(u.x & 0xffffu); Vt[(v8 + 1) * 72 + pp] = (bf16_t)(u.x >> 16); Vt[(v8 + 2) * 72 + pp] = (bf16_t)(u.y & 0xffffu); Vt[(v8 + 3) * 72 + pp] = (bf16_t)(u.y >> 16);
          Vt[(v8 + 4) * 72 + pp] = (bf16_t)(u.z & 0xffffu); Vt[(v8 + 5) * 72 + pp] = (bf16_t)(u.z >> 16); Vt[(v8 + 6) * 72 + pp] = (bf16_t)(u.w & 0xffffu); Vt[(v8 + 7) * 72 + pp] = (bf16_t)(u.w >> 16); } }
    LAS float* gwl = (LAS float*)(lds + 3 * GLA_HL);
    for (int i = tid; i < 2 * 17 * 96; i += NTHR) { const int dir = i / (17 * 96), r = (i / 96) % 17, c = i % 96;
        gwl[i] = r < 16 ? p.in[I_GW2][((size_t)(l * 2 + dir) * 16 + r) * 192 + hb * 32 + c] : p.in[I_GGB][(size_t)(l * 2 + dir) * 192 + hb * 32 + c]; }
    __syncthreads();
#pragma unroll 1
    for (int hh = 0; hh < 3; ++hh) { GLA_PTRS(hh)
#pragma unroll 1
        for (int j = 0; j < 8; ++j) { const int i = tid + NTHR * j, dir = i >> 11, k = (i >> 6) & 31, pp = i & 63;
            float x = gwl[(dir * 17 + 16) * 96 + hh * 32 + k];
#pragma unroll
            for (int jj = 0; jj < 16; ++jj) x += gi[pp * 32 + dir * 16 + jj] * gwl[(dir * 17 + jj) * 96 + hh * 32 + k];
            GT[(dir * 32 + k) * 65 + pp] = (fminf(x, 0.f) - __logf(1.f + __expf(-fabsf(x)))) * (1.f / 16.f); } }
    __syncthreads();
#pragma unroll 1
    for (int hh = 0; hh < 3; ++hh) { GLA_PTRS(hh)
#pragma unroll
        for (int c = 0; c < 8; ++c) { const int col = w * 8 + c, dir = col >> 5, pp = dir ? 63 - lane : lane; float x = GT[col * 65 + pp];
#pragma unroll
            for (int o = 1; o < 64; o <<= 1) { const float y = __shfl_up(x, o); if (lane >= o) x += y; }
            GT[col * 65 + pp] = x; } }
    __syncthreads();
    float* GBF = SCRP(float, SC_GBF); float* GBB = SCRP(float, SC_GBB);
#pragma unroll 1
    for (int hh = 0; hh < 3; ++hh) { const int h = hb + hh; GLA_PTRS(hh)
        for (int i = tid; i < 4096; i += NTHR) { const int dir = i >> 11, pp = (i >> 5) & 63, k = i & 31; const float bb = GT[(dir * 32 + k) * 65 + pp];
            (dir ? GBB : GBF)[(size_t)(r0 + pp) * 192 + h * 32 + k] = bb;
            const float kk = bf2f(KRAW[(hh * 64 + pp) * 32 + k]);
            KDT[(dir * 32 + k) * 72 + pp] = (bf16_t)f2bf(kk * __expf(GT[(dir * 32 + k) * 65 + (dir ? 0 : 63)] - bb)); } }
    __syncthreads();
    float* KVC = SCRP(float, SC_KVC); float* DC = SCRP(float, SC_DC);
#pragma unroll 1
    for (int hh = 0; hh < 3; ++hh) { const int h = hb + hh; GLA_PTRS(hh)
#pragma unroll
        for (int q = 0; q < 2; ++q) { const int idx = w * 2 + q, dir = idx >> 3, mt = (idx >> 2) & 1, nt = idx & 3;
            f32x4 acc = {0.f, 0.f, 0.f, 0.f};
#pragma unroll
            for (int ks = 0; ks < 2; ++ks) { const bf16x8 a = *(const LAS bf16x8*)(KDT + (dir * 32 + mt * 16 + fr) * 72 + ks * 32 + fq * 8), b = *(const LAS bf16x8*)(Vt + (nt * 16 + fr) * 72 + ks * 32 + fq * 8);
                acc = __builtin_amdgcn_mfma_f32_16x16x32_bf16(a, b, acc, 0, 0, 0); }
            float* dst = KVC + ((size_t)((cid * 6 + h) * 2 + dir)) * 2048;
#pragma unroll
            for (int j = 0; j < 4; ++j) dst[(mt * 16 + fq * 4 + j) * 64 + nt * 16 + fr] = acc[j]; }
        if (tid < 64) { const int dir = tid >> 5, k = tid & 31; DC[((cid * 6 + h) * 2 + dir) * 32 + k] = __expf(GT[(dir * 32 + k) * 65 + (dir ? 0 : 63)]); } }
#undef GLA_PTRS
    __syncthreads();
}

constexpr int SGS = 136;
#ifndef TPH
#define TPH -1
#endif
#define TB2_(id) do { if (TPH == (id)) tph_t0 = __builtin_amdgcn_s_memrealtime(); } while (0)
#define TE2_(id) do { if (TPH == (id)) tph_acc += __builtin_amdgcn_s_memrealtime() - tph_t0; } while (0)
__device__ __forceinline__ void rw_job(const Params& p, int l, int tt, LAS unsigned char* lds, int tid, unsigned long long& tph_t0, unsigned long long& tph_acc) {
    asm volatile("" : "+v"(tid));
    const int r0 = tt < 512 ? tt * 32 : NLAT + (tt - 512) * 32;
    const int pos = tt < 512 ? (r0 & 4095) : ((r0 - NLAT) & 255), slen = tt < 512 ? 4096 : 256;
    const bool has_prev = pos > 0, has_next = pos + 32 < slen;
    TB2_(40);
    const bf16_t* Z = WSP(bf16_t, WS_Z);
    LAS bf16_t* rkv = (LAS bf16_t*)lds;
    LAS bf16_t* XW = (LAS bf16_t*)(lds + 78336);
    LAS bf16_t* XG = XW + 4 * 32 * 72;
    for (int i = tid; i < 34 * 144; i += NTHR) { const int rr = i / 144, c16 = i % 144; const bool ok = rr == 0 ? has_prev : (rr == 33 ? has_next : true);
        u32x4 v = {0u, 0u, 0u, 0u}; if (ok) v = *(const u32x4*)(Z + (size_t)(r0 - 1 + rr) * DINP + ZRKV + c16 * 8);
        *(LAS u32x4*)(rkv + rr * 1152 + c16 * 8) = v; }
    for (int i = tid; i < 32 * 48; i += NTHR) { const int t = i / 48, c = (i % 48) * 8; float v[8]; unpack8(*(const u32x4*)(Z + (size_t)(r0 + t) * DINP + ZWF + c), v);
        if (c < 128) {
#pragma unroll
            for (int q = 0; q < 8; ++q) v[q] = tanhf_(v[q]); }
        else if (c >= 256) {
#pragma unroll
            for (int q = 0; q < 8; ++q) v[q] = sigmoidf_(v[q]); }
        u32x4 o; o.x = pk2(v[0], v[1]); o.y = pk2(v[2], v[3]); o.z = pk2(v[4], v[5]); o.w = pk2(v[6], v[7]);
        if (c < 256) *(LAS u32x4*)(XW + ((c >> 6) * 32 + t) * 72 + (c & 63)) = o; else *(LAS u32x4*)(XG + t * SGS + (c - 256)) = o; }
    __syncthreads(); TE2_(40); TB2_(41);
    LAS float* PRM = (LAS float*)(XG + 32 * SGS);
    for (int i = tid; i < 16 * 384; i += NTHR) { const int r = i / 384, c = i % 384; float v;
        if (r < 9) v = p.in[I_CONV][(size_t)l * 3 * 1152 + (r % 3) * 1152 + (r / 3) * 384 + c];
        else if (r == 9) v = p.in[I_KK][l * 384 + c]; else if (r == 10) v = p.in[I_KA][l * 384 + c]; else if (r == 11) v = p.in[I_RK][l * 384 + c];
        else if (r < 14) v = p.in[I_W0][(l * 2 + (r - 12)) * 384 + c]; else v = p.in[I_A0][(l * 2 + (r - 14)) * 384 + c];
        PRM[i] = v; }
    __syncthreads(); TE2_(41); TB2_(42);
    const int h = tid >> 6, lane = tid & 63, fr = lane & 15, fq = lane >> 4;
    if (h < 6) {
        const bf16_t* WT = WSP(bf16_t, WS_RWW) + (size_t)l * RWW_LAYER;
        bf16_t* Rg = SCRP(bf16_t, SC_R); bf16_t* KKg = SCRP(bf16_t, SC_KK); bf16_t* Vg = SCRP(bf16_t, SC_V); bf16_t* Gg = SCRP(bf16_t, SC_G); float* BON = SCRP(float, SC_BON);
        bf16_t* BKF = SCRP(bf16_t, SC_BKF); bf16_t* BKB = SCRP(bf16_t, SC_BKB); bf16_t* KMF = SCRP(bf16_t, SC_KMF); bf16_t* KMB = SCRP(bf16_t, SC_KMB);
        float* LWF = SCRP(float, SC_WF); float* LWB = SCRP(float, SC_WB);
#define CONV3(t, off, c, w0, w1, w2) (bf2f(rkv[(t) * 1152 + (off) + (c)]) * (w0) + bf2f(rkv[((t) + 1) * 1152 + (off) + (c)]) * (w1) + bf2f(rkv[((t) + 2) * 1152 + (off) + (c)]) * (w2))
        LAS float* invl = PRM + 16 * 384 + h * 64;
#pragma unroll
        for (int mt = 0; mt < 2; ++mt) { float ss[4] = {0.f, 0.f, 0.f, 0.f};
#pragma unroll
            for (int nt = 0; nt < 4; ++nt) { const int c = h * 64 + nt * 16 + fr; const float ck0 = PRM[3 * 384 + c], ck1 = PRM[4 * 384 + c], ck2 = PRM[5 * 384 + c], kkw = PRM[9 * 384 + c];
#pragma unroll
                for (int j = 0; j < 4; ++j) { const int t = mt * 16 + fq * 4 + j; const float kr = CONV3(t, 384, c, ck0, ck1, ck2) * kkw; ss[j] += kr * kr; } }
#pragma unroll
            for (int j = 0; j < 4; ++j) { const float iv = 1.f / fmaxf(sqrtf(red16(ss[j])), 1e-12f); if (fr == 0) { invl[mt * 16 + fq * 4 + j] = iv; invl[32 + mt * 16 + fq * 4 + j] = 0.f; } } }
        TE2_(42); TB2_(43);
#pragma unroll 1
        for (int np = 0; np < 2; ++np) {
            bf16x8 bw[2][4][2], bg[2][4];
#pragma unroll
            for (int q = 0; q < 2; ++q) { const int c = h * 64 + (np * 2 + q) * 16 + fr;
#pragma unroll
                for (int m = 0; m < 4; ++m)
#pragma unroll
                    for (int ks = 0; ks < 2; ++ks) bw[q][m][ks] = *(const bf16x8*)(WT + (size_t)m * 384 * 64 + (size_t)c * 64 + ks * 32 + fq * 8);
#pragma unroll
                for (int ks = 0; ks < 4; ++ks) bg[q][ks] = *(const bf16x8*)(WT + (size_t)4 * 384 * 64 + (size_t)c * 128 + ks * 32 + fq * 8); }
#pragma unroll 1
            for (int mt = 0; mt < 2; ++mt) {
                bf16x8 ax[4][2], ag[4];
#pragma unroll
                for (int m = 0; m < 4; ++m)
#pragma unroll
                    for (int ks = 0; ks < 2; ++ks) ax[m][ks] = *(const LAS bf16x8*)(XW + ((m * 32 + mt * 16 + fr) * 72) + ks * 32 + fq * 8);
#pragma unroll
                for (int ks = 0; ks < 4; ++ks) ag[ks] = *(const LAS bf16x8*)(XG + (mt * 16 + fr) * SGS + ks * 32 + fq * 8);
#pragma unroll
                for (int q = 0; q < 2; ++q) { const int c = h * 64 + (np * 2 + q) * 16 + fr;
                    f32x4 acc[5];
#pragma unroll
                    for (int m = 0; m < 5; ++m) acc[m] = (f32x4){0.f, 0.f, 0.f, 0.f};
#pragma unroll
                    for (int m = 0; m < 4; ++m)
#pragma unroll
                        for (int ks = 0; ks < 2; ++ks) acc[m] = __builtin_amdgcn_mfma_f32_16x16x32_bf16(ax[m][ks], bw[q][m][ks], acc[m], 0, 0, 0);
#pragma unroll
                    for (int ks = 0; ks < 4; ++ks) acc[4] = __builtin_amdgcn_mfma_f32_16x16x32_bf16(ag[ks], bg[q][ks], acc[4], 0, 0, 0);
                    const float cr0 = PRM[c], cr1 = PRM[384 + c], cr2 = PRM[768 + c], ck0 = PRM[3 * 384 + c], ck1 = PRM[4 * 384 + c], ck2 = PRM[5 * 384 + c], cv0 = PRM[6 * 384 + c], cv1 = PRM[7 * 384 + c], cv2 = PRM[8 * 384 + c];
                    const float kkw = PRM[9 * 384 + c], kaw = PRM[10 * 384 + c], rkw = PRM[11 * 384 + c], w0f = PRM[12 * 384 + c], w0b = PRM[13 * 384 + c], a0f = PRM[14 * 384 + c], a0b = PRM[15 * 384 + c];
#pragma unroll
                    for (int j = 0; j < 4; ++j) { const int t = mt * 16 + fq * 4 + j; const size_t o = (size_t)(r0 + t) * 384 + c;
                        const float r = CONV3(t, 0, c, cr0, cr1, cr2), v = CONV3(t, 768, c, cv0, cv1, cv2), k = CONV3(t, 384, c, ck0, ck1, ck2), kkn = k * kkw * invl[t];
                        const float af = sigmoidf_(a0f + acc[2][j]), ab = sigmoidf_(a0b + acc[3][j]);
                        const float kmf = k * (1.f + (af - 1.f) * kaw), kmb = k * (1.f + (ab - 1.f) * kaw);
                        Rg[o] = (bf16_t)f2bf(r); Vg[o] = (bf16_t)f2bf(v); KKg[o] = (bf16_t)f2bf(kkn);
                        BKF[o] = (bf16_t)f2bf(kkn * af); BKB[o] = (bf16_t)f2bf(kkn * ab); KMF[o] = (bf16_t)f2bf(kmf); KMB[o] = (bf16_t)f2bf(kmb);
                        LWF[o] = -0.6065306597f * sigmoidf_(w0f + acc[0][j]); LWB[o] = -0.6065306597f * sigmoidf_(w0b + acc[1][j]);
                        Gg[o] = (bf16_t)f2bf(acc[4][j]);
                        const float bv = red16(r * (kmf + kmb) * rkw); if (fr == 0) invl[32 + t] += bv; } }
            }
        }
        if (lane < 32) BON[(size_t)(r0 + lane) * 8 + h] = invl[32 + lane];
#undef CONV3
    }
    __syncthreads(); TE2_(43);
}

__device__ __forceinline__ int chain_chunk(int b, int dir, int step) {
    if (step < 4) return 256 + b * 4 + (dir ? 3 - step : step);
    const int cl = step - 4; return b * 64 + (dir ? 63 - cl : cl);
}
__device__ __forceinline__ void g2_job(const Params& p, int job, int tid) {
    asm volatile("" : "+v"(tid));
    const int chain = job >> 2, q = job & 3, b = chain / 12, h = (chain % 12) >> 1, dir = chain & 1, e = q * 512 + tid, k = e >> 6;
    const float* __restrict__ KVC = SCRP(float, SC_KVC); const float* __restrict__ DC = SCRP(float, SC_DC); float* __restrict__ SC = SCRP(float, SC_SC);
    float S = 0.f;
#pragma unroll 1
    for (int s0 = 0; s0 < 68; s0 += 34) {
        float dv[34], kv[34];
#pragma unroll
        for (int u = 0; u < 34; ++u) { const size_t base = (size_t)((chain_chunk(b, dir, s0 + u) * 6 + h) * 2 + dir); dv[u] = DC[base * 32 + k]; kv[u] = KVC[base * 2048 + e]; }
#pragma unroll
        for (int u = 0; u < 34; ++u) { const size_t base = (size_t)((chain_chunk(b, dir, s0 + u) * 6 + h) * 2 + dir); SC[base * 2048 + e] = S; S = S * dv[u] + kv[u]; }
    }
}

__device__ __forceinline__ void attn_unit(const Params& p, int l, int b, int h, bool isctx, int qb, LAS unsigned char* lds, int tid) {
    asm volatile("" : "+v"(tid));
    const int w = tid >> 6, L = tid & 63, fr = L & 15, fq = L >> 4;
    const int qrow0 = (isctx ? NLAT + b * 256 : b * 4096) + qb * 256;
    const int nst = isctx ? 2 : 34;
    const unsigned char* rec = SCRP(unsigned char, SC_KVREC) + (size_t)(b * 4 + h) * NKT * 8192;
    const bf16_t* Z = WSP(bf16_t, WS_Z);
    u32x4 ld[4];
#pragma unroll
    for (int q = 0; q < 4; ++q) ld[q] = *(const u32x4*)(rec + q * 8192 + tid * 16);
    float lam;
    { const float* q1 = p.in[I_LQ1] + l * 32; const float* k1 = p.in[I_LK1] + l * 32; const float* q2 = p.in[I_LQ2] + l * 32; const float* k2 = p.in[I_LK2] + l * 32;
      float s1 = 0.f, s2 = 0.f;
      for (int i = 0; i < 32; ++i) { s1 += q1[i] * k1[i]; s2 += q2[i] * k2[i]; }
      const float lam_init = l == 0 ? 0.2f : 0.35550907f;
      lam = __expf(s1) - __expf(s2) + lam_init; }
    asm volatile("" : "+v"(lam));
    const float one_m_li = l == 0 ? 0.8f : 0.64449093f;
    bf16x8 Qb[2][2]; f32x4 cinit[2][2];
    {
        const unsigned* kmax = WSP(unsigned, WS_CTL) + CW_KMAX + l * 32 + (b * 4 + h) * 2;
#pragma unroll
        for (int sub = 0; sub < 2; ++sub) {
            const int row = qrow0 + w * 32 + sub * 16 + fr, tpos = qb * 256 + w * 32 + sub * 16 + fr;
#pragma unroll
            for (int m = 0; m < 2; ++m) {
                float ov[8], pv[8];
                unpack8(*(const u32x4*)(Z + (size_t)row * DINP + ZQ + h * 64 + m * 32 + fq * 8), ov);
                unpack8(*(const u32x4*)(Z + (size_t)row * DINP + ZQ + h * 64 + m * 32 + (fq ^ 1) * 8), pv);
                if (!isctx) {
                    const int pos = (fq >> 1) ? (tpos & 63) : (tpos >> 6); const float sg = (fq & 1) ? 1.f : -1.f;
#pragma unroll
                    for (int i = 0; i < 8; ++i) ov[i] = ov[i] * ROPE_COS[pos][i] + sg * pv[i] * ROPE_SIN[pos][i];
                }
#pragma unroll
                for (int i = 0; i < 8; ++i) ov[i] *= 0.2550348616f;
                u32x4 o; o.x = pk2(ov[0], ov[1]); o.y = pk2(ov[2], ov[3]); o.z = pk2(ov[4], ov[5]); o.w = pk2(ov[6], ov[7]);
                float rv[8]; unpack8(o, rv); float n2 = 0.f;
#pragma unroll
                for (int i = 0; i < 8; ++i) n2 += rv[i] * rv[i];
                n2 += __shfl_xor(n2, 16); n2 += __shfl_xor(n2, 32);
                const float km = __builtin_bit_cast(float, __hip_atomic_load(kmax + m, __ATOMIC_RELAXED, __HIP_MEMORY_SCOPE_AGENT));
                const float mq = sqrtf(n2) * sqrtf(km);
                Qb[sub][m] = __builtin_bit_cast(bf16x8, o);
                cinit[sub][m] = (f32x4){-mq, -mq, -mq, -mq};
            }
        }
    }
#pragma unroll
    for (int q = 0; q < 4; ++q) *(LAS u32x4*)(lds + q * 8192 + tid * 16) = ld[q];
    __syncthreads();
    f32x4 O[2][2][4], Ls[2][2];
#pragma unroll
    for (int sub = 0; sub < 2; ++sub)
#pragma unroll
        for (int m = 0; m < 2; ++m) { Ls[sub][m] = (f32x4){0.f, 0.f, 0.f, 0.f};
#pragma unroll
            for (int et = 0; et < 4; ++et) O[sub][m][et] = (f32x4){0.f, 0.f, 0.f, 0.f}; }
    const bf16x8 ones = __builtin_bit_cast(bf16x8, (u32x4){0x3f803f80u, 0x3f803f80u, 0x3f803f80u, 0x3f803f80u});
#pragma unroll 1
    for (int st = 0; st < nst; ++st) {
        if (st + 1 < nst) {
#pragma unroll
            for (int q = 0; q < 4; ++q) ld[q] = *(const u32x4*)(rec + (size_t)(st + 1) * 32768 + q * 8192 + tid * 16); }
        const LAS unsigned char* cur = lds + (st & 1) * 32768;
#pragma unroll
        for (int hf = 0; hf < 4; ++hf) {
            const LAS unsigned char* rp = cur + hf * 8192 + L * 16;
            bf16x8 vb[4];
#pragma unroll
            for (int et = 0; et < 4; ++et) vb[et] = *(const LAS bf16x8*)(rp + (4 + et) * 1024);
#pragma unroll
            for (int m = 0; m < 2; ++m) {
                const bf16x8 ka0 = *(const LAS bf16x8*)(rp + (m * 2) * 1024), ka1 = *(const LAS bf16x8*)(rp + (m * 2 + 1) * 1024);
#pragma unroll
                for (int sub = 0; sub < 2; ++sub) {
                    const f32x4 s0 = __builtin_amdgcn_mfma_f32_16x16x32_bf16(ka0, Qb[sub][m], cinit[sub][m], 0, 0, 0);
                    const f32x4 s1 = __builtin_amdgcn_mfma_f32_16x16x32_bf16(ka1, Qb[sub][m], cinit[sub][m], 0, 0, 0);
                    float e[8];
#pragma unroll
                    for (int i = 0; i < 4; ++i) { e[i] = __builtin_amdgcn_exp2f(s0[i]); e[4 + i] = __builtin_amdgcn_exp2f(s1[i]); }
                    u32x4 pk; pk.x = pg8::cvt_pk_bf16(e[0], e[1]); pk.y = pg8::cvt_pk_bf16(e[2], e[3]); pk.z = pg8::cvt_pk_bf16(e[4], e[5]); pk.w = pg8::cvt_pk_bf16(e[6], e[7]);
                    const bf16x8 pa = __builtin_bit_cast(bf16x8, pk);
                    Ls[sub][m] = __builtin_amdgcn_mfma_f32_16x16x32_bf16(pa, ones, Ls[sub][m], 0, 0, 0);
#pragma unroll
                    for (int et = 0; et < 4; ++et) O[sub][m][et] = __builtin_amdgcn_mfma_f32_16x16x32_bf16(pa, vb[et], O[sub][m][et], 0, 0, 0);
                }
            }
        }
        if (st + 1 < nst) { LAS unsigned char* nb = lds + ((st + 1) & 1) * 32768;
#pragma unroll
            for (int q = 0; q < 4; ++q) *(LAS u32x4*)(nb + q * 8192 + tid * 16) = ld[q]; }
        __syncthreads();
    }
    const float* sg = p.in[I_SUBLN] + l * 64; bf16_t* CAT = WSP(bf16_t, WS_CAT);
#pragma unroll
    for (int sub = 0; sub < 2; ++sub)
#pragma unroll
        for (int j = 0; j < 4; ++j) {
            const float i0 = __builtin_amdgcn_rcpf(Ls[sub][0][j]), i1 = lam * __builtin_amdgcn_rcpf(Ls[sub][1][j]);
            float ov[4], ss = 0.f;
#pragma unroll
            for (int et = 0; et < 4; ++et) { ov[et] = O[sub][0][et][j] * i0 - O[sub][1][et][j] * i1; ss += ov[et] * ov[et]; }
#pragma unroll
            for (int x = 1; x < 16; x <<= 1) ss += __shfl_xor(ss, x);
            const float rs = rsqrtf(ss * (1.f / 64.f) + LN_EPS) * one_m_li;
            const size_t ro = (size_t)(qrow0 + w * 32 + sub * 16 + fq * 4 + j) * D + h * 64;
#pragma unroll
            for (int et = 0; et < 4; ++et) CAT[ro + et * 16 + fr] = (bf16_t)f2bf(ov[et] * rs * sg[et * 16 + fr]);
        }
    __syncthreads();
}

constexpr int LS4 = 40;
__device__ __forceinline__ f32x4 mfma_k32(const LAS bf16_t* A, const LAS bf16_t* B, int mt, int nt, int fr, int fq, f32x4 acc) {
    const bf16x8 a = *(const LAS bf16x8*)(A + (mt * 16 + fr) * LS4 + fq * 8), b = *(const LAS bf16x8*)(B + (nt * 16 + fr) * LS4 + fq * 8);
    return __builtin_amdgcn_mfma_f32_16x16x32_bf16(a, b, acc, 0, 0, 0);
}
constexpr int G3_HL = 65536;
__device__ __forceinline__ void g3_job(const Params& p, int l, int cid, int hb, LAS unsigned char* lds, int tid) {
    asm volatile("" : "+v"(tid));
    const int r0 = chunk_row0(cid), w = tid >> 6, lane = tid & 63, fr = lane & 15, fq = lane >> 4;
    const bf16_t* Z = WSP(bf16_t, WS_Z);
#define G3_PTRS(hh) LAS bf16_t* QF = (LAS bf16_t*)(lds + (hh) * G3_HL); LAS bf16_t* KF = QF + 64 * LS4; LAS bf16_t* QB = KF + 64 * LS4; LAS bf16_t* KB = QB + 64 * LS4; \
    LAS bf16_t* SFt = KB + 64 * LS4; LAS bf16_t* SBt = SFt + 64 * LS4; LAS bf16_t* Vt = SBt + 64 * LS4; LAS bf16_t* AT = Vt + 64 * 72; LAS f32x4* xb = (LAS f32x4*)(AT + 64 * 72); \
    (void)QF; (void)KF; (void)QB; (void)KB; (void)SFt; (void)SBt; (void)Vt; (void)AT; (void)xb;
    const float* GBF = SCRP(float, SC_GBF); const float* GBB = SCRP(float, SC_GBB); const float* SC = SCRP(float, SC_SC);
#pragma unroll
    for (int hh = 0; hh < 2; ++hh) { const int h = hb + hh; G3_PTRS(hh)
        { const int pp = tid >> 3, k4 = (tid & 7) * 4; const size_t zr = (size_t)(r0 + pp) * DINP;
          const u32x2 qu = *(const u32x2*)(Z + zr + ZGQ + h * 32 + k4), ku = *(const u32x2*)(Z + zr + ZGK + h * 32 + k4);
          const f32x4 bf = *(const f32x4*)(GBF + (size_t)(r0 + pp) * 192 + h * 32 + k4), bb = *(const f32x4*)(GBB + (size_t)(r0 + pp) * 192 + h * 32 + k4);
          const float q[4] = {bflo(qu.x) * 0.17677669529f, bfhi(qu.x) * 0.17677669529f, bflo(qu.y) * 0.17677669529f, bfhi(qu.y) * 0.17677669529f}, kk[4] = {bflo(ku.x), bfhi(ku.x), bflo(ku.y), bfhi(ku.y)};
          u32x2 o;
          o.x = pk2(q[0] * __expf(bf[0]), q[1] * __expf(bf[1])); o.y = pk2(q[2] * __expf(bf[2]), q[3] * __expf(bf[3])); *(LAS u32x2*)(QF + pp * LS4 + k4) = o;
          o.x = pk2(kk[0] * __expf(-bf[0]), kk[1] * __expf(-bf[1])); o.y = pk2(kk[2] * __expf(-bf[2]), kk[3] * __expf(-bf[3])); *(LAS u32x2*)(KF + pp * LS4 + k4) = o;
          o.x = pk2(q[0] * __expf(bb[0]), q[1] * __expf(bb[1])); o.y = pk2(q[2] * __expf(bb[2]), q[3] * __expf(bb[3])); *(LAS u32x2*)(QB + pp * LS4 + k4) = o;
          o.x = pk2(kk[0] * __expf(-bb[0]), kk[1] * __expf(-bb[1])); o.y = pk2(kk[2] * __expf(-bb[2]), kk[3] * __expf(-bb[3])); *(LAS u32x2*)(KB + pp * LS4 + k4) = o; }
        { const int pp = tid >> 3, v8 = (tid & 7) * 8; const u32x4 u = *(const u32x4*)(Z + (size_t)(r0 + pp) * DINP + ZGV + h * 64 + v8);
          Vt[(v8 + 0) * 72 + pp] = (bf16_t)(u.x & 0xffffu); Vt[(v8 + 1) * 72 + pp] = (bf16_t)(u.x >> 16); Vt[(v8 + 2) * 72 + pp] = (bf16_t)(u.y & 0xffffu); Vt[(v8 + 3) * 72 + pp] = (bf16_t)(u.y >> 16);
          Vt[(v8 + 4) * 72 + pp] = (bf16_t)(u.z & 0xffffu); Vt[(v8 + 5) * 72 + pp] = (bf16_t)(u.z >> 16); Vt[(v8 + 6) * 72 + pp] = (bf16_t)(u.w & 0xffffu); Vt[(v8 + 7) * 72 + pp] = (bf16_t)(u.w >> 16); }
        { const int k = tid >> 4, v4 = (tid & 15) * 4;
          const f32x4 sf = *(const f32x4*)(SC + ((size_t)((cid * 6 + h) * 2 + 0)) * 2048 + k * 64 + v4), sb = *(const f32x4*)(SC + ((size_t)((cid * 6 + h) * 2 + 1)) * 2048 + k * 64 + v4);
#pragma unroll
          for (int q = 0; q < 4; ++q) { SFt[(v4 + q) * LS4 + k] = (bf16_t)f2bf(sf[q]); SBt[(v4 + q) * LS4 + k] = (bf16_t)f2bf(sb[q]); } } }
    __syncthreads();
#pragma unroll
    for (int hh = 0; hh < 2; ++hh) { G3_PTRS(hh)
#pragma unroll
        for (int q = 0; q < 2; ++q) { const int idx = w * 2 + q, mt = idx >> 2, nt = idx & 3;
            f32x4 af = {0.f, 0.f, 0.f, 0.f}, ab = {0.f, 0.f, 0.f, 0.f};
            if (nt <= mt) af = mfma_k32(QF, KF, mt, nt, fr, fq, af);
            if (nt >= mt) ab = mfma_k32(QB, KB, mt, nt, fr, fq, ab);
#pragma unroll
            for (int j = 0; j < 4; ++j) { const int tt = mt * 16 + fq * 4 + j, ss = nt * 16 + fr;
                AT[tt * 72 + ss] = (bf16_t)f2bf((ss <= tt ? af[j] : 0.f) + (ss >= tt ? ab[j] : 0.f)); } } }
    __syncthreads();
    const int mt = w & 3;
    f32x4 acc[2][4];
#pragma unroll
    for (int hh = 0; hh < 2; ++hh) { G3_PTRS(hh)
#pragma unroll
        for (int nt = 0; nt < 4; ++nt) { acc[hh][nt] = (f32x4){0.f, 0.f, 0.f, 0.f};
            if (w < 4) {
#pragma unroll
                for (int ks = 0; ks < 2; ++ks) { const bf16x8 a = *(const LAS bf16x8*)(AT + (mt * 16 + fr) * 72 + ks * 32 + fq * 8), b = *(const LAS bf16x8*)(Vt + (nt * 16 + fr) * 72 + ks * 32 + fq * 8);
                    acc[hh][nt] = __builtin_amdgcn_mfma_f32_16x16x32_bf16(a, b, acc[hh][nt], 0, 0, 0); } }
            else { acc[hh][nt] = mfma_k32(QF, SFt, mt, nt, fr, fq, acc[hh][nt]); acc[hh][nt] = mfma_k32(QB, SBt, mt, nt, fr, fq, acc[hh][nt]); xb[(mt * 4 + nt) * 64 + lane] = acc[hh][nt]; } } }
    __syncthreads();
    if (w < 4) {
        bf16_t* CAT = WSP(bf16_t, WS_CAT);
#pragma unroll
        for (int hh = 0; hh < 2; ++hh) { const int h = hb + hh; G3_PTRS(hh)
#pragma unroll
            for (int nt = 0; nt < 4; ++nt) acc[hh][nt] += xb[(mt * 4 + nt) * 64 + lane];
#pragma unroll
            for (int j = 0; j < 4; ++j) { const int row = r0 + mt * 16 + fq * 4 + j;
                float ss = (acc[hh][0][j] * acc[hh][0][j] + acc[hh][1][j] * acc[hh][1][j]) + (acc[hh][2][j] * acc[hh][2][j] + acc[hh][3][j] * acc[hh][3][j]); ss = red16(ss);
                const float rs = rsqrtf(ss * (1.f / 64.f) + LN_EPS);
#pragma unroll
                for (int nt = 0; nt < 4; ++nt) { const int v = nt * 16 + fr; const float gr = bf2f(Z[(size_t)row * DINP + ZGR + h * 64 + v]);
                    CAT[(size_t)row * D + 256 + h * 64 + v] = (bf16_t)f2bf(acc[hh][nt][j] * rs * p.in[I_GNG][l * 64 + v] * siluf_(gr)); } } }
    }
#undef G3_PTRS
    __syncthreads();
}

constexpr int RA_S = 1032;
__device__ __forceinline__ void ln1_router(const Params& p, int l, int nrows, LAS unsigned char* lds, int tid, int G, int bx, bool dry = false) {
    asm volatile("" : "+v"(tid));
    const int w = tid >> 6, lane = tid & 63, fr = lane & 15, fq = lane >> 4;
    LAS bf16_t* AH = (LAS bf16_t*)lds;
    LAS bf16_t* AL = AH + 16 * RA_S;
    LAS float* part = (LAS float*)(AL + 16 * RA_S);
    LAS float* lgs = part + 8 * 16 * 32;
    LAS unsigned* lcnt = (LAS unsigned*)(lgs + 16 * 32);
    if (tid < 32) lcnt[tid] = 0u;
    float* H = WSP(float, WS_H); bf16_t* XM = WSP(bf16_t, WS_XM); const bf16_t* MIX = WSP(bf16_t, WS_Z); const float* MOD = WSP(float, WS_MOD);
    int* TOPE = WSP(int, WS_TOP); float* TOPG = WSP(float, WS_TOP + TOP_STRIDE); int* TOPR = WSP(int, WS_TOP + 2 * TOP_STRIDE);
    const float* g1p = p.in[I_LN1G] + l * 1024; const float* b1p = p.in[I_LN1B] + l * 1024; const float* rb = p.in[I_RB] + l * 32;
    const bf16_t* RT = WSP(bf16_t, WS_RTW) + (size_t)l * 2 * 32 * 1024;
    bf16x8 bh[4][2], bl[4][2];
#pragma unroll
    for (int ks = 0; ks < 4; ++ks)
#pragma unroll
        for (int nt = 0; nt < 2; ++nt) { const size_t o = (size_t)(nt * 16 + fr) * 1024 + (w * 4 + ks) * 32 + fq * 8; bh[ks][nt] = *(const bf16x8*)(RT + o); bl[ks][nt] = *(const bf16x8*)(RT + 32 * 1024 + o); }
    float alpha = DN_ALPHA; asm volatile("" : "+v"(alpha));
    __syncthreads();
    const int ngroups = nrows >> 4;
    for (int g = bx; g < ngroups; g += G) {
        f32x4 y[2][4]; float s[2] = {0.f, 0.f};
#pragma unroll
        for (int r = 0; r < 2; ++r) { const int row = g * 16 + r * 8 + w; const int sidx = row < NLAT ? (row >> 12) : 4; const float* mod = MOD + (size_t)(l * 5 + sidx) * 6144;
#pragma unroll
            for (int j = 0; j < 4; ++j) { const int c = lane * 4 + 256 * j; const u32x2 mx = *(const u32x2*)(MIX + (size_t)row * D + c);
                y[r][j] = *(const f32x4*)(H + (size_t)row * D + c) * alpha + *(const f32x4*)(mod + 2048 + c) * (f32x4){bflo(mx.x), bfhi(mx.x), bflo(mx.y), bfhi(mx.y)};
                s[r] += (y[r][j][0] + y[r][j][1]) + (y[r][j][2] + y[r][j][3]); } }
#pragma unroll
        for (int r = 0; r < 2; ++r) { const int row = g * 16 + r * 8 + w; const int sidx = row < NLAT ? (row >> 12) : 4; const float* mod = MOD + (size_t)(l * 5 + sidx) * 6144;
            const float mean = wave_sum(s[r]) * (1.f / D); float s2 = 0.f;
#pragma unroll
            for (int j = 0; j < 4; ++j) { y[r][j] = y[r][j] - mean; s2 += (y[r][j][0] * y[r][j][0] + y[r][j][1] * y[r][j][1]) + (y[r][j][2] * y[r][j][2] + y[r][j][3] * y[r][j][3]); }
            const float rstd = rsqrtf(wave_sum(s2) * (1.f / D) + LN_EPS);
#pragma unroll
            for (int j = 0; j < 4; ++j) { const int c = lane * 4 + 256 * j;
                const f32x4 hn = y[r][j] * rstd * *(const f32x4*)(g1p + c) + *(const f32x4*)(b1p + c);
                const f32x4 m = hn * (*(const f32x4*)(mod + 4096 + c) + 1.f) + *(const f32x4*)(mod + 3072 + c);
                if (!dry || m[0] == 123456.789f) { *(f32x4*)(H + (size_t)row * D + c) = hn; u32x2 o; o.x = pk2(m[0], m[1]); o.y = pk2(m[2], m[3]); *(u32x2*)(XM + (size_t)row * D + c) = o; }
                u32x2 hi; hi.x = pk2(m[0], m[1]); hi.y = pk2(m[2], m[3]);
                u32x2 lo; lo.x = pk2(m[0] - bflo(hi.x), m[1] - bfhi(hi.x)); lo.y = pk2(m[2] - bflo(hi.y), m[3] - bfhi(hi.y));
                *(LAS u32x2*)(AH + (r * 8 + w) * RA_S + c) = hi; *(LAS u32x2*)(AL + (r * 8 + w) * RA_S + c) = lo; } }
        __syncthreads();
        {
            f32x4 acc[2] = {{0.f, 0.f, 0.f, 0.f}, {0.f, 0.f, 0.f, 0.f}};
#pragma unroll
            for (int ks = 0; ks < 4; ++ks) { const int ko = fr * RA_S + (w * 4 + ks) * 32 + fq * 8;
                const bf16x8 ah = *(const LAS bf16x8*)(AH + ko), al = *(const LAS bf16x8*)(AL + ko);
#pragma unroll
                for (int nt = 0; nt < 2; ++nt) { acc[nt] = __builtin_amdgcn_mfma_f32_16x16x32_bf16(ah, bh[ks][nt], acc[nt], 0, 0, 0);
                    acc[nt] = __builtin_amdgcn_mfma_f32_16x16x32_bf16(al, bh[ks][nt], acc[nt], 0, 0, 0); acc[nt] = __builtin_amdgcn_mfma_f32_16x16x32_bf16(ah, bl[ks][nt], acc[nt], 0, 0, 0); } }
#pragma unroll
            for (int nt = 0; nt < 2; ++nt)
#pragma unroll
                for (int j = 0; j < 4; ++j) part[(w * 16 + fq * 4 + j) * 32 + nt * 16 + fr] = acc[nt][j];
        }
        __syncthreads();
        { const int rr = lane >> 5, e = lane & 31, rl = rr * 8 + w; float a = rb[e];
#pragma unroll
          for (int ww = 0; ww < 8; ++ww) a += part[(ww * 16 + rl) * 32 + e];
          lgs[rl * 32 + e] = a; }
#pragma unroll
        for (int r = 0; r < 2; ++r) { const int row = g * 16 + r * 8 + w;
            float lg[32];
#pragma unroll
            for (int e4 = 0; e4 < 8; ++e4) { const f32x4 v = *(const LAS f32x4*)(lgs + (r * 8 + w) * 32 + e4 * 4); lg[e4 * 4] = v[0]; lg[e4 * 4 + 1] = v[1]; lg[e4 * 4 + 2] = v[2]; lg[e4 * 4 + 3] = v[3]; }
            float tv[4]; int ti[4];
#pragma unroll
            for (int k = 0; k < 4; ++k) { float best = -3.0e38f; int bi = 0;
#pragma unroll
                for (int e = 0; e < 32; ++e) { if (lg[e] > best) { best = lg[e]; bi = e; } }
                tv[k] = best; ti[k] = bi;
#pragma unroll
                for (int e = 0; e < 32; ++e) lg[e] = (e == bi) ? -3.0e38f : lg[e]; }
            if (lane == 0 && (!dry || tv[0] == 123456.789f)) {
                const float e1 = __expf(tv[1] - tv[0]), e2 = __expf(tv[2] - tv[0]), e3 = __expf(tv[3] - tv[0]); const float inv = 1.f / (1.f + e1 + e2 + e3);
                const float gg[4] = {inv, e1 * inv, e2 * inv, e3 * inv};
#pragma unroll
                for (int k = 0; k < 4; ++k) { TOPE[row * 4 + k] = ti[k]; TOPG[row * 4 + k] = gg[k]; TOPR[row * 4 + k] = (int)atomicAdd((unsigned*)(lcnt + ti[k]), 1u); }
            } }
        __syncthreads();
    }
    __syncthreads();
    if (tid < 32 && !dry) WSP(unsigned, WS_CNTWG)[(size_t)(l * 256 + bx) * 32 + tid] = lcnt[tid];
}

__device__ __forceinline__ int moe_tables(const Params& p, int l, LAS int* tab, LAS int* basew, int G, int tid) {
    const unsigned* cw = WSP(unsigned, WS_CNTWG) + (size_t)l * 256 * 32;
    for (int i = tid; i < G * 32; i += NTHR) basew[i] = (int)cw[i];
    __syncthreads();
    if (tid < 32) { int run = 0; for (int wg = 0; wg < G; ++wg) { const int c = basew[wg * 32 + tid]; basew[wg * 32 + tid] = run; run += c; } tab[32 + tid] = run; }
    __syncthreads();
    if (tid == 0) { int run = 0;
        for (int e = 0; e < 32; ++e) { const int c = tab[32 + e]; tab[e] = run * 256; run += (c + 255) >> 8; tab[64 + e] = run; }
        tab[96] = run; }
    __syncthreads();
    for (int blk = tid; blk < CAP_BLK; blk += NTHR) { int e = 0;
        for (int j = 0; j < 31; ++j) e += (blk >= tab[64 + j]) ? 1 : 0;
        tab[128 + blk] = e; }
    __syncthreads();
    return tab[96];
}

__device__ __forceinline__ void moe_gather(const Params& p, int l, int nrows, LAS int* tab, const LAS int* basew, int gw, int ngw, int lane) {
    const int* TOPE = WSP(int, WS_TOP); const int* TOPR = WSP(int, WS_TOP + 2 * TOP_STRIDE); int* TOPS = WSP(int, WS_TOP + 3 * TOP_STRIDE);
    const bf16_t* XM = WSP(bf16_t, WS_XM); bf16_t* XB = SCRP(bf16_t, SC_XB);
    for (int tok = gw; tok < nrows; tok += ngw) {
        const u32x4 e4 = *(const u32x4*)(TOPE + tok * 4), r4 = *(const u32x4*)(TOPR + tok * 4);
        const int wgp = ((tok >> 4) % (ngw >> 3)) * 32;
        u32x4 sl; sl.x = tab[e4.x] + basew[wgp + e4.x] + r4.x; sl.y = tab[e4.y] + basew[wgp + e4.y] + r4.y; sl.z = tab[e4.z] + basew[wgp + e4.z] + r4.z; sl.w = tab[e4.w] + basew[wgp + e4.w] + r4.w;
        if (lane == 0) *(u32x4*)(TOPS + tok * 4) = sl;
        const u32x4* s = (const u32x4*)(XM + (size_t)tok * D); const u32x4 a = s[lane], b2 = s[64 + lane];
        u32x4* d0 = (u32x4*)(XB + (size_t)sl.x * D); u32x4* d1 = (u32x4*)(XB + (size_t)sl.y * D); u32x4* d2 = (u32x4*)(XB + (size_t)sl.z * D); u32x4* d3 = (u32x4*)(XB + (size_t)sl.w * D);
        d0[lane] = a; d0[64 + lane] = b2; d1[lane] = a; d1[64 + lane] = b2; d2[lane] = a; d2[64 + lane] = b2; d3[lane] = a; d3[64 + lane] = b2; }
}

constexpr int NR2 = 2;
__device__ __forceinline__ void ln2_rows(const Params& p, int l, int nrows, int gw, int ngw, int lane, bool dry = false) {
    float* H = WSP(float, WS_H); bf16_t* XM = WSP(bf16_t, WS_XM); const bf16_t* YB = SCRP(bf16_t, SC_XB); const float* MOD = WSP(float, WS_MOD);
    const float* TOPG = WSP(float, WS_TOP + TOP_STRIDE); const int* TOPS = WSP(int, WS_TOP + 3 * TOP_STRIDE);
    const float* g2p = p.in[I_LN2G] + l * 1024; const float* b2p = p.in[I_LN2B] + l * 1024;
    float alpha = DN_ALPHA; asm volatile("" : "+v"(alpha));
    for (int row0 = gw * NR2; row0 < nrows; row0 += ngw * NR2) {
        f32x4 y[NR2][4]; float s[NR2];
        int slot[NR2][4]; float gt[NR2][4];
#pragma unroll
        for (int r = 0; r < NR2; ++r)
#pragma unroll
            for (int k = 0; k < 4; ++k) { slot[r][k] = TOPS[(row0 + r) * 4 + k]; gt[r][k] = TOPG[(row0 + r) * 4 + k]; }
#pragma unroll
        for (int r = 0; r < NR2; ++r) { const int row = row0 + r;
#pragma unroll
            for (int j = 0; j < 4; ++j) y[r][j] = *(const f32x4*)(H + (size_t)row * D + lane * 4 + 256 * j) * alpha; }
#pragma unroll
        for (int r = 0; r < NR2; ++r) { const int row = row0 + r; const int sidx = row < NLAT ? (row >> 12) : 4; const float* mod = MOD + (size_t)(l * 5 + sidx) * 6144;
#pragma unroll
            for (int k = 0; k < 4; ++k) { const bf16_t* yr = YB + (size_t)slot[r][k] * D;
#pragma unroll
                for (int j = 0; j < 4; ++j) { const int c = lane * 4 + 256 * j; const u32x2 u = *(const u32x2*)(yr + c);
                    y[r][j] += *(const f32x4*)(mod + 5120 + c) * gt[r][k] * (f32x4){bflo(u.x), bfhi(u.x), bflo(u.y), bfhi(u.y)}; } }
            s[r] = 0.f;
#pragma unroll
            for (int j = 0; j < 4; ++j) s[r] += (y[r][j][0] + y[r][j][1]) + (y[r][j][2] + y[r][j][3]); }
#pragma unroll
        for (int r = 0; r < NR2; ++r) { const int row = row0 + r; const int sidx = row < NLAT ? (row >> 12) : 4;
            const float mean = wave_sum(s[r]) * (1.f / D); float s2 = 0.f;
#pragma unroll
            for (int j = 0; j < 4; ++j) { y[r][j] = y[r][j] - mean; s2 += (y[r][j][0] * y[r][j][0] + y[r][j][1] * y[r][j][1]) + (y[r][j][2] * y[r][j][2] + y[r][j][3] * y[r][j][3]); }
            const float rstd = rsqrtf(wave_sum(s2) * (1.f / D) + LN_EPS);
#pragma unroll
            for (int j = 0; j < 4; ++j) { const int c = lane * 4 + 256 * j;
                const f32x4 hn = y[r][j] * rstd * *(const f32x4*)(g2p + c) + *(const f32x4*)(b2p + c);
                if (dry && hn[0] != 123456.789f) continue;
                if (l == 0) { *(f32x4*)(H + (size_t)row * D + c) = hn;
                    const float* mod1 = MOD + (size_t)(5 + sidx) * 6144;
                    const f32x4 xm = hn * (*(const f32x4*)(mod1 + 1024 + c) + 1.f) + *(const f32x4*)(mod1 + c);
                    u32x2 o; o.x = pk2(xm[0], xm[1]); o.y = pk2(xm[2], xm[3]); *(u32x2*)(XM + (size_t)row * D + c) = o; }
                else *(f32x4*)(p.out + (size_t)row * D + c) = hn; } }
    }
}

constexpr int LSB = 72;
constexpr size_t RW_REC = 8192;
__device__ __forceinline__ int kperm_lo(int ks, int fq) { return (2 * ks) * 16 + fq * 4; }
__device__ __forceinline__ f32x4 tile_nt(const LAS bf16_t* A, const LAS bf16_t* B, int mt, int nt, int fr, int fq, f32x4 acc) {
#pragma unroll
    for (int ks = 0; ks < 2; ++ks) {
        const bf16x8 a = *(const LAS bf16x8*)(A + (mt * 16 + fr) * LSB + ks * 32 + fq * 8);
        const bf16x8 b = *(const LAS bf16x8*)(B + (nt * 16 + fr) * LSB + ks * 32 + fq * 8);
        acc = __builtin_amdgcn_mfma_f32_16x16x32_bf16(a, b, acc, 0, 0, 0);
    }
    return acc;
}
__device__ __forceinline__ size_t rwa_goff(int unit, int tid) {
    const int cid = unit / 12, h = (unit % 12) >> 1, dir = unit & 1, t = tid >> 3, k8 = (tid & 7) * 8;
    return (size_t)(chunk_row0(cid) + (dir ? 63 - t : t)) * 384 + h * 64 + k8;
}
#ifndef TPH
#define TPH -1
#endif
#define TB_(id) do { if (TPH == (id)) tph_t0 = __builtin_amdgcn_s_memrealtime(); } while (0)
#define TE_(id) do { if (TPH == (id)) tph_acc += __builtin_amdgcn_s_memrealtime() - tph_t0; } while (0)
__device__ __forceinline__ void rwa_job(const Params& p, int unit, int next_unit, bool first, LAS unsigned char* lds, int tid, unsigned long long& tph_t0, unsigned long long& tph_acc) {
    asm volatile("" : "+v"(tid));
    const int cid = unit / 12, h = (unit % 12) >> 1, dir = unit & 1;
    const int w = tid >> 6, lane = tid & 63, fr = lane & 15, fq = lane >> 4;
    LAS bf16_t* At = (LAS bf16_t*)lds;            LAS bf16_t* Bt = At + 64 * LSB;   LAS bf16_t* Kt = Bt + 64 * LSB;  LAS bf16_t* Rt = Kt + 64 * LSB;
    LAS bf16_t* BHt = Rt + 64 * LSB;              LAS bf16_t* KHt = BHt + 64 * LSB; LAS bf16_t* Vt = KHt + 64 * LSB;
    LAS float* F0 = (LAS float*)(lds + 64512);
    LAS float* PF = (LAS float*)(lds + 81152);
    LAS bf16_t* AAK = (LAS bf16_t*)(lds + 97536);
    LAS bf16_t* ARB = AAK + 64 * LSB;  LAS bf16_t* ARK = ARB + 64 * LSB;
    LAS bf16_t* TAT = ARK + 64 * LSB;  LAS bf16_t* TPT = TAT + 64 * LSB;
    LAS float* gC = (LAS float*)(lds + 143616);
    LAS float* TD = (LAS float*)(lds + 143872);
    LAS bf16_t* ABH = (LAS bf16_t*)(lds + 147968);
    TB_(30);
    const int t = tid >> 3, k8 = (tid & 7) * 8;
    const size_t go = rwa_goff(unit, tid);
    if (first) { const float* Wg = SCRP(float, dir ? SC_WB : SC_WF); const f32x4 a = *(const f32x4*)(Wg + go), b = *(const f32x4*)(Wg + go + 4);
        F0[(k8 + 0) * 65 + t] = a[0]; F0[(k8 + 1) * 65 + t] = a[1]; F0[(k8 + 2) * 65 + t] = a[2]; F0[(k8 + 3) * 65 + t] = a[3];
        F0[(k8 + 4) * 65 + t] = b[0]; F0[(k8 + 5) * 65 + t] = b[1]; F0[(k8 + 6) * 65 + t] = b[2]; F0[(k8 + 7) * 65 + t] = b[3]; }
    const u32x4 in_kk = *(const u32x4*)(SCRP(bf16_t, SC_KK) + go), in_bk = *(const u32x4*)(SCRP(bf16_t, dir ? SC_BKB : SC_BKF) + go), in_km = *(const u32x4*)(SCRP(bf16_t, dir ? SC_KMB : SC_KMF) + go);
    const u32x4 in_rr = *(const u32x4*)(SCRP(bf16_t, SC_R) + go), in_vv = *(const u32x4*)(SCRP(bf16_t, SC_V) + go);
    __syncthreads();
#pragma unroll
    for (int c = 0; c < 8; ++c) { const int k = w * 8 + c; float x = F0[k * 65 + lane];
#pragma unroll
        for (int o = 1; o < 64; o <<= 1) { const float y = __shfl_up(x, o); if (lane >= o) x += y; }
        F0[k * 65 + lane] = x; }
    __syncthreads();
    {
        float kk[8], bk[8], km[8], rr[8];
        unpack8(in_kk, kk); unpack8(in_bk, bk); unpack8(in_km, km); unpack8(in_rr, rr);
        const u32x4 vraw = in_vv;
        float a_[8], b_[8], k_[8], r_[8];
#pragma unroll
        for (int i = 0; i < 8; ++i) { const float L = F0[(k8 + i) * 65 + t], LC = F0[(k8 + i) * 65 + 63], Lm1 = t > 0 ? F0[(k8 + i) * 65 + t - 1] : 0.f;
            const float eL = __expf(L), eN = __expf(-L), eM = __expf(Lm1), eH = __expf(LC - L);
            a_[i] = -kk[i] * eM; b_[i] = bk[i] * eN; k_[i] = km[i] * eN; r_[i] = rr[i] * eL;
            BHt[(k8 + i) * LSB + t] = (bf16_t)f2bf(bk[i] * eH); KHt[(k8 + i) * LSB + t] = (bf16_t)f2bf(km[i] * eH);
            if (t == 63) gC[k8 + i] = __expf(LC); }
        { u32x4 o; o.x = pk2(a_[0], a_[1]); o.y = pk2(a_[2], a_[3]); o.z = pk2(a_[4], a_[5]); o.w = pk2(a_[6], a_[7]); *(LAS u32x4*)(At + t * LSB + k8) = o; }
        { u32x4 o; o.x = pk2(b_[0], b_[1]); o.y = pk2(b_[2], b_[3]); o.z = pk2(b_[4], b_[5]); o.w = pk2(b_[6], b_[7]); *(LAS u32x4*)(Bt + t * LSB + k8) = o; }
        { u32x4 o; o.x = pk2(k_[0], k_[1]); o.y = pk2(k_[2], k_[3]); o.z = pk2(k_[4], k_[5]); o.w = pk2(k_[6], k_[7]); *(LAS u32x4*)(Kt + t * LSB + k8) = o; }
        { u32x4 o; o.x = pk2(r_[0], r_[1]); o.y = pk2(r_[2], r_[3]); o.z = pk2(r_[4], r_[5]); o.w = pk2(r_[6], r_[7]); *(LAS u32x4*)(Rt + t * LSB + k8) = o; }
        Vt[(k8 + 0) * LSB + t] = (bf16_t)(vraw.x & 0xffffu); Vt[(k8 + 1) * LSB + t] = (bf16_t)(vraw.x >> 16); Vt[(k8 + 2) * LSB + t] = (bf16_t)(vraw.y & 0xffffu); Vt[(k8 + 3) * LSB + t] = (bf16_t)(vraw.y >> 16);
        Vt[(k8 + 4) * LSB + t] = (bf16_t)(vraw.z & 0xffffu); Vt[(k8 + 5) * LSB + t] = (bf16_t)(vraw.z >> 16); Vt[(k8 + 6) * LSB + t] = (bf16_t)(vraw.w & 0xffffu); Vt[(k8 + 7) * LSB + t] = (bf16_t)(vraw.w >> 16);
    }
    __syncthreads(); TE_(30); TB_(31);
#pragma unroll
    for (int i8 = 0; i8 < 8; ++i8) { const int pr = i8 >> 1, mt = (w >> 2) + 2 * (i8 & 1), nt = w & 3;
        f32x4 acc = {0.f, 0.f, 0.f, 0.f};
        if (nt <= mt) acc = tile_nt(pr < 2 ? At : Rt, (pr & 1) ? Kt : Bt, mt, nt, fr, fq, acc);
#pragma unroll
        for (int j = 0; j < 4; ++j) { const int tt = mt * 16 + fq * 4 + j, ss = nt * 16 + fr; const bool keep = pr < 2 ? (ss < tt) : (ss <= tt); const float v = keep ? acc[j] : 0.f;
            if (pr == 0) { F0[tt * 64 + ss] = v; ABH[tt * LSB + ss] = (bf16_t)f2bf(v); } else (pr == 1 ? AAK : (pr == 2 ? ARB : ARK))[tt * LSB + ss] = (bf16_t)f2bf(v); } }
    __syncthreads();
#pragma unroll
    for (int q = 0; q < 2; ++q) { const int idx = w * 2 + q, mt = idx >> 2, nt = idx & 3; f32x4 acc = {0.f, 0.f, 0.f, 0.f};
        acc = tile_nt(AAK, Vt, mt, nt, fr, fq, acc);
#pragma unroll
        for (int j = 0; j < 4; ++j) PF[(mt * 16 + fq * 4 + j) * 64 + nt * 16 + fr] = acc[j]; }
    __syncthreads(); TE_(31); TB_(32);
    if (w < 4 && lane < 16) {
        float x[16];
#pragma unroll
        for (int tt = 0; tt < 16; ++tt) { float a0 = (tt == lane) ? 1.f : 0.f;
#pragma unroll
            for (int s2 = 0; s2 < tt; ++s2) a0 += F0[(w * 16 + tt) * 64 + w * 16 + s2] * x[s2];
            x[tt] = a0; TD[(w * 16 + tt) * 16 + lane] = a0; }
    }
    __syncthreads();
    {
        f32x4 X0[4], X[4];
#pragma unroll
        for (int bb = 0; bb < 4; ++bb)
#pragma unroll
            for (int j = 0; j < 4; ++j) { const int tt = bb * 16 + fq * 4 + j; X0[bb][j] = (w < 4) ? bf2f(At[tt * LSB + w * 16 + fr]) : PF[tt * 64 + (w - 4) * 16 + fr]; }
        bf16x8 Tf[4];
#pragma unroll
        for (int bb = 0; bb < 4; ++bb) { const f32x4 tv = *(const LAS f32x4*)(TD + (bb * 16 + fr) * 16 + fq * 4); u32x4 o; o.x = pk2(tv[0], tv[1]); o.y = pk2(tv[2], tv[3]); o.z = 0u; o.w = 0u; Tf[bb] = __builtin_bit_cast(bf16x8, o); }
        const f32x4 zero4 = {0.f, 0.f, 0.f, 0.f};
#pragma unroll
        for (int bb = 0; bb < 4; ++bb) {
            f32x4 rhs = X0[bb];
            if (bb >= 1) {
                const u32x2 a = *(const LAS u32x2*)(ABH + (bb * 16 + fr) * LSB + fq * 4); u32x2 a2 = {0u, 0u};
                if (bb >= 2) a2 = *(const LAS u32x2*)(ABH + (bb * 16 + fr) * LSB + 16 + fq * 4);
                u32x4 af; af.x = a.x; af.y = a.y; af.z = a2.x; af.w = a2.y;
                u32x4 bf; bf.x = pk2(X[0][0], X[0][1]); bf.y = pk2(X[0][2], X[0][3]);
                if (bb >= 2) { bf.z = pk2(X[1][0], X[1][1]); bf.w = pk2(X[1][2], X[1][3]); } else { bf.z = 0u; bf.w = 0u; }
                rhs = __builtin_amdgcn_mfma_f32_16x16x32_bf16(__builtin_bit_cast(bf16x8, af), __builtin_bit_cast(bf16x8, bf), rhs, 0, 0, 0);
            }
            if (bb == 3) {
                const u32x2 a = *(const LAS u32x2*)(ABH + (48 + fr) * LSB + 32 + fq * 4);
                u32x4 af; af.x = a.x; af.y = a.y; af.z = 0u; af.w = 0u;
                u32x4 bf; bf.x = pk2(X[2][0], X[2][1]); bf.y = pk2(X[2][2], X[2][3]); bf.z = 0u; bf.w = 0u;
                rhs = __builtin_amdgcn_mfma_f32_16x16x32_bf16(__builtin_bit_cast(bf16x8, af), __builtin_bit_cast(bf16x8, bf), rhs, 0, 0, 0);
            }
            u32x4 rb; rb.x = pk2(rhs[0], rhs[1]); rb.y = pk2(rhs[2], rhs[3]); rb.z = 0u; rb.w = 0u;
            X[bb] = __builtin_amdgcn_mfma_f32_16x16x32_bf16(Tf[bb], __builtin_bit_cast(bf16x8, rb), zero4, 0, 0, 0);
            LAS bf16_t* dst = ((w < 4) ? TAT : TPT) + ((w & 3) * 16 + fr) * LSB + bb * 16 + fq * 4;
            u32x2 o; o.x = pk2(X[bb][0], X[bb][1]); o.y = pk2(X[bb][2], X[bb][3]); *(LAS u32x2*)dst = o;
        }
    }
    __syncthreads();
    TE_(32); TB_(33);
    f32x4 nw0 = {0.f, 0.f, 0.f, 0.f}, nw1 = {0.f, 0.f, 0.f, 0.f};
    if (next_unit >= 0) { const float* Wn = SCRP(float, (next_unit & 1) ? SC_WB : SC_WF) + rwa_goff(next_unit, tid); nw0 = *(const f32x4*)Wn; nw1 = *(const f32x4*)(Wn + 4); }
    const size_t u = (size_t)((cid * 6 + h) * 2 + dir);
    LAS bf16_t* SQ = AAK; LAS bf16_t* SM = (LAS bf16_t*)PF; LAS float* SY = F0;
    unsigned char* GREC = p.ws + WS_GREC + u * RW_REC;
#pragma unroll
    for (int i8 = 0; i8 < 8; ++i8) { const int pr = i8 >> 1, mt = (w >> 2) + 2 * (i8 & 1), nt = w & 3; f32x4 acc = {0.f, 0.f, 0.f, 0.f};
        if (pr == 0) { acc = tile_nt(ARB, TAT, mt, nt, fr, fq, acc);
#pragma unroll
            for (int j = 0; j < 4; ++j) { const int tt = mt * 16 + fq * 4 + j, kk_ = nt * 16 + fr; SQ[tt * LSB + kk_] = (bf16_t)f2bf(acc[j] + bf2f(Rt[tt * LSB + kk_])); } }
        else if (pr == 1) { acc = tile_nt(ARB, TPT, mt, nt, fr, fq, acc); acc = tile_nt(ARK, Vt, mt, nt, fr, fq, acc);
#pragma unroll
            for (int j = 0; j < 4; ++j) SY[(mt * 16 + fq * 4 + j) * 64 + nt * 16 + fr] = acc[j]; }
        else if (pr == 2) { acc = tile_nt(BHt, TAT, mt, nt, fr, fq, acc);
#pragma unroll
            for (int j = 0; j < 4; ++j) { const int k1 = mt * 16 + fq * 4 + j, k2 = nt * 16 + fr; SM[k1 * LSB + k2] = (bf16_t)f2bf(acc[j] + (k1 == k2 ? gC[k1] : 0.f)); } }
        else { acc = tile_nt(BHt, TPT, mt, nt, fr, fq, acc); acc = tile_nt(KHt, Vt, mt, nt, fr, fq, acc);
            u32x2 o; o.x = pk2(acc[0], acc[1]); o.y = pk2(acc[2], acc[3]); *(u32x2*)(GREC + ((mt * 4 + nt) * 64 + lane) * 8) = o; } }
    __syncthreads();
    {
        const int mt = w >> 1, ks = w & 1, row = mt * 16 + fr, rq = dir ? 63 - row : row;
        u32x4 o; { const u32x2 a = *(const LAS u32x2*)(SQ + rq * LSB + kperm_lo(ks, fq)), b = *(const LAS u32x2*)(SQ + rq * LSB + kperm_lo(ks, fq) + 16); o.x = a.x; o.y = a.y; o.z = b.x; o.w = b.y; }
        *(u32x4*)(SCRP(unsigned char, SC_YF) + u * RW_REC + (size_t)(w * 64 + lane) * 16) = o;
        { const u32x2 a = *(const LAS u32x2*)(SM + row * LSB + kperm_lo(ks, fq)), b = *(const LAS u32x2*)(SM + row * LSB + kperm_lo(ks, fq) + 16); o.x = a.x; o.y = a.y; o.z = b.x; o.w = b.y; }
        *(u32x4*)(p.ws + WS_MREC + u * RW_REC + (size_t)(w * 64 + lane) * 16) = o;
#pragma unroll
        for (int q = 0; q < 2; ++q) { const int tl = w * 2 + q, mt2 = tl >> 2, nt2 = tl & 3; float yv[4];
#pragma unroll
            for (int j = 0; j < 4; ++j) { const int to = mt2 * 16 + fq * 4 + j; yv[j] = SY[(dir ? 63 - to : to) * 64 + nt2 * 16 + fr]; }
            u32x2 oy; oy.x = pk2(yv[0], yv[1]); oy.y = pk2(yv[2], yv[3]);
            *(u32x2*)(SCRP(unsigned char, SC_YB) + u * RW_REC + (size_t)(tl * 64 + lane) * 8) = oy; }
    }
    __syncthreads(); TE_(33);
    if (next_unit >= 0) {
        F0[(k8 + 0) * 65 + t] = nw0[0]; F0[(k8 + 1) * 65 + t] = nw0[1]; F0[(k8 + 2) * 65 + t] = nw0[2]; F0[(k8 + 3) * 65 + t] = nw0[3];
        F0[(k8 + 4) * 65 + t] = nw1[0]; F0[(k8 + 5) * 65 + t] = nw1[1]; F0[(k8 + 6) * 65 + t] = nw1[2]; F0[(k8 + 7) * 65 + t] = nw1[3]; }
}

__device__ __forceinline__ void rwb_job(const Params& p, int chain, int tid) {
    asm volatile("" : "+v"(tid));
    const int b = chain / 12, h = (chain % 12) >> 1, dir = chain & 1, nt = tid >> 6, lane = tid & 63;
    if (nt >= 4) return;
    f32x4 H[4];
#pragma unroll
    for (int mt = 0; mt < 4; ++mt) H[mt] = (f32x4){0.f, 0.f, 0.f, 0.f};
    bf16x8 Mf[4][2]; u32x2 Gf[4];
    auto load = [&](int step) { const size_t u = (size_t)((chain_chunk(b, dir, step) * 6 + h) * 2 + dir);
        const unsigned char* mr = p.ws + WS_MREC + u * RW_REC; const unsigned char* gr = p.ws + WS_GREC + u * RW_REC;
#pragma unroll
        for (int mt = 0; mt < 4; ++mt) { Mf[mt][0] = *(const bf16x8*)(mr + (size_t)((mt * 2) * 64 + lane) * 16); Mf[mt][1] = *(const bf16x8*)(mr + (size_t)((mt * 2 + 1) * 64 + lane) * 16);
            Gf[mt] = *(const u32x2*)(gr + (size_t)((mt * 4 + nt) * 64 + lane) * 8); } };
    load(0);
#pragma unroll 1
    for (int step = 0; step < 68; ++step) {
        const size_t u = (size_t)((chain_chunk(b, dir, step) * 6 + h) * 2 + dir);
        bf16x8 Bh[2], Bl[2];
#pragma unroll
        for (int ks = 0; ks < 2; ++ks) { const f32x4 x0 = H[2 * ks], x1 = H[2 * ks + 1];
            u32x4 hi; hi.x = pk2(x0[0], x0[1]); hi.y = pk2(x0[2], x0[3]); hi.z = pk2(x1[0], x1[1]); hi.w = pk2(x1[2], x1[3]);
            u32x4 lo; lo.x = pk2(x0[0] - bflo(hi.x), x0[1] - bfhi(hi.x)); lo.y = pk2(x0[2] - bflo(hi.y), x0[3] - bfhi(hi.y)); lo.z = pk2(x1[0] - bflo(hi.z), x1[1] - bfhi(hi.z)); lo.w = pk2(x1[2] - bflo(hi.w), x1[3] - bfhi(hi.w));
            Bh[ks] = __builtin_bit_cast(bf16x8, hi); Bl[ks] = __builtin_bit_cast(bf16x8, lo);
            *(u32x4*)(p.ws + WS_XM + u * RW_REC + (size_t)((ks * 4 + nt) * 64 + lane) * 16) = hi; }
        f32x4 acc[4];
#pragma unroll
        for (int mt = 0; mt < 4; ++mt) { acc[mt] = (f32x4){bflo(Gf[mt].x), bfhi(Gf[mt].x), bflo(Gf[mt].y), bfhi(Gf[mt].y)};
#pragma unroll
            for (int ks = 0; ks < 2; ++ks) { acc[mt] = __builtin_amdgcn_mfma_f32_16x16x32_bf16(Mf[mt][ks], Bh[ks], acc[mt], 0, 0, 0); acc[mt] = __builtin_amdgcn_mfma_f32_16x16x32_bf16(Mf[mt][ks], Bl[ks], acc[mt], 0, 0, 0); } }
        if (step + 1 < 68) load(step + 1);
#pragma unroll
        for (int mt = 0; mt < 4; ++mt) H[mt] = acc[mt];
    }
}

__device__ __forceinline__ void rwc_job(const Params& p, int l, int cid, int hb, LAS unsigned char* lds, int tid) {
    asm volatile("" : "+v"(tid));
    const int r0 = chunk_row0(cid), w = tid >> 6, lane = tid & 63, fr = lane & 15, fq = lane >> 4, dirw = w >> 2, mt = w & 3;
    f32x4 acc[3][4];
#pragma unroll
    for (int hh = 0; hh < 3; ++hh) { const int h = hb + hh;
        const size_t u = (size_t)((cid * 6 + h) * 2 + dirw);
        const unsigned char* qr = SCRP(unsigned char, SC_YF) + u * RW_REC; const unsigned char* yr = SCRP(unsigned char, SC_YB) + u * RW_REC; const unsigned char* hr = p.ws + WS_XM + u * RW_REC;
        const bf16x8 Q0 = *(const bf16x8*)(qr + (size_t)((mt * 2) * 64 + lane) * 16), Q1 = *(const bf16x8*)(qr + (size_t)((mt * 2 + 1) * 64 + lane) * 16);
#pragma unroll
        for (int nt = 0; nt < 4; ++nt) { const u32x2 y0 = *(const u32x2*)(yr + (size_t)((mt * 4 + nt) * 64 + lane) * 8);
            acc[hh][nt] = (f32x4){bflo(y0.x), bfhi(y0.x), bflo(y0.y), bfhi(y0.y)};
            const bf16x8 B0 = *(const bf16x8*)(hr + (size_t)((0 * 4 + nt) * 64 + lane) * 16), B1 = *(const bf16x8*)(hr + (size_t)((1 * 4 + nt) * 64 + lane) * 16);
            acc[hh][nt] = __builtin_amdgcn_mfma_f32_16x16x32_bf16(Q0, B0, acc[hh][nt], 0, 0, 0); acc[hh][nt] = __builtin_amdgcn_mfma_f32_16x16x32_bf16(Q1, B1, acc[hh][nt], 0, 0, 0); } }
    LAS f32x4* xb = (LAS f32x4*)lds;
#pragma unroll
    for (int hh = 0; hh < 3; ++hh)
#pragma unroll
        for (int nt = 0; nt < 4; ++nt) xb[(((dirw * 3 + hh) * 4 + mt) * 4 + nt) * 64 + lane] = acc[hh][nt];
    __syncthreads();
    const bf16_t* Vg = SCRP(bf16_t, SC_V); const bf16_t* Gg = SCRP(bf16_t, SC_G); const float* BON = SCRP(float, SC_BON); bf16_t* CAT = WSP(bf16_t, WS_CAT);
#pragma unroll
    for (int hh = 0; hh < 3; ++hh) { const int h = hb + hh;
#pragma unroll
        for (int nt = 0; nt < 4; ++nt) acc[hh][nt] += xb[((((1 - dirw) * 3 + hh) * 4 + mt) * 4 + nt) * 64 + lane];
#pragma unroll
        for (int jj = 0; jj < 2; ++jj) { const int j = dirw * 2 + jj; const int row = r0 + mt * 16 + fq * 4 + j;
            const float a0 = j == 0 ? acc[hh][0][0] : j == 1 ? acc[hh][0][1] : j == 2 ? acc[hh][0][2] : acc[hh][0][3], a1 = j == 0 ? acc[hh][1][0] : j == 1 ? acc[hh][1][1] : j == 2 ? acc[hh][1][2] : acc[hh][1][3];
            const float a2 = j == 0 ? acc[hh][2][0] : j == 1 ? acc[hh][2][1] : j == 2 ? acc[hh][2][2] : acc[hh][2][3], a3 = j == 0 ? acc[hh][3][0] : j == 1 ? acc[hh][3][1] : j == 2 ? acc[hh][3][2] : acc[hh][3][3];
            float s = (a0 + a1) + (a2 + a3); s = red16(s); const float mu = s * (1.f / 64.f);
            const float d0 = a0 - mu, d1 = a1 - mu, d2 = a2 - mu, d3 = a3 - mu;
            float v2 = (d0 * d0 + d1 * d1) + (d2 * d2 + d3 * d3); v2 = red16(v2); const float rs = rsqrtf(v2 * (1.f / 64.f) + RW_GN_EPS);
            const float bon = BON[(size_t)row * 8 + h];
            const float dd[4] = {d0, d1, d2, d3};
#pragma unroll
            for (int nt = 0; nt < 4; ++nt) { const int c = h * 64 + nt * 16 + fr; const size_t o = (size_t)row * 384 + c;
                const float yn = dd[nt] * rs * p.in[I_LNXG][l * 384 + c] + p.in[I_LNXB][l * 384 + c];
                CAT[(size_t)row * D + 640 + c] = (bf16_t)f2bf((yn + bon * bf2f(Vg[o])) * bf2f(Gg[o])); } } }
    __syncthreads();
}

#ifndef PHM
#define PHM 0x3ffff
#endif
#ifndef REPM
#define REPM 0
#endif
#ifndef TPH
#define TPH -1
#endif
#define T_BEGIN(id) do { if (TPH == (id)) tph_t0 = __builtin_amdgcn_s_memrealtime(); } while (0)
#define T_END(id) do { if (TPH == (id)) tph_acc += __builtin_amdgcn_s_memrealtime() - tph_t0; } while (0)
constexpr int LDS_TAB_OFF = 131072;
__device__ __forceinline__ int q_fetch(unsigned* head, int n_all, int& shard, int& left) {
    while (left > 0) { const int c = (int)atomicAdd(head + shard * 64, 1u); const int j = c * 8 + shard; if (j < n_all) return j; shard = (shard + 1) & 7; --left; }
    return n_all;
}
#define QUEUE_LOOP(head, n_all, BODY) do { const bool ldr_ = (wave_s == 0 && lane_id_() == 0); int qs_ = (int)(xb_xcc_id() & 7u), ql_ = 8; \
    if (ldr_) qslot[0] = q_fetch((head), (n_all), qs_, ql_); __syncthreads(); \
    for (int k_ = 0;; ++k_) { const int j = qslot[k_ & 1]; if (j >= (n_all)) break; if (ldr_) qslot[(k_ + 1) & 1] = q_fetch((head), (n_all), qs_, ql_); BODY; __syncthreads(); } } while (0)
#define GRID_BAR() do { unsigned char* w_ = p_arg.ws; asm volatile("" : "+s"(w_)); XcdBarrier b_; b_.bar = (unsigned*)(w_ + WS_CTL) + CW_BAR; b_.x = xb_xcc_id(); b_.st = ctlw; b_.w = wave_s; xcd_barrier(b_); if (REPM & 64) xcd_barrier(b_); } while (0)
#define PHASE_BEGIN_G() Params p = p_arg; asm volatile("" : "+s"(p.ws));
#define PHASE_BEGIN() Params p = p_arg; asm volatile("" : "+s"(p.ws)); \
    int tid = wave_s * 64 + lane_id_(); asm volatile("" : "+v"(tid)); const int lane = tid & 63, gw = bx * 8 + wave_s; (void)lane; (void)gw; (void)p;

__global__ void __launch_bounds__(NTHR, 2) fwd_kernel(Params p_arg) {
    extern __shared__ __attribute__((aligned(16))) unsigned char lds_raw[];
    LAS unsigned char* lds = (LAS unsigned char*)lds_raw;
    const int G = gridDim.x, bx = blockIdx.x, ngw = G * 8;
    const int wave_s = WAVE_ID_SGPR();
    unsigned long long tph_t0 = 0ull, tph_acc = 0ull; (void)tph_t0; (void)tph_acc;
    volatile LAS unsigned* ctlw = (volatile LAS unsigned*)(lds + LDS_CTL_OFF);
    if (wave_s == 0) ctlw[lane_id_()] = 0u;
    __syncthreads();
    { PHASE_BEGIN(); (void)xcd_barrier_post(WSP(unsigned, WS_CTL) + CW_BAR, ctlw, wave_s); }
    volatile LAS int* qslot = (volatile LAS int*)(ctlw + 16);
    LAS int* tab = (LAS int*)(lds + LDS_TAB_OFF);

    T_BEGIN(0);
    for (int rep_ = 0; rep_ < ((REPM & 1) ? 2 : 1); ++rep_)
    { PHASE_BEGIN();
#if PHM & 1
      for (int j = bx; j < J_MOD; j += G) mod_job(p, j, (LAS float*)lds, tid);
#endif
#if PHM & 2
      for (int j = bx; j < 2 * (JW_IN + JW_OUT); j += G) { const int ll = j / (JW_IN + JW_OUT); conv_job(p, ll * JW_LAYER + j % (JW_IN + JW_OUT), (LAS float*)lds, tid); }
#endif
      { bf16_t* wt = WSP(bf16_t, WS_RWW);
        for (int i = bx * NTHR + tid; i < 2 * (int)RWW_LAYER; i += G * NTHR) { const int l = i / (int)RWW_LAYER, r = i % (int)RWW_LAYER; float v;
            if (r < 4 * 384 * 64) { const int m = r / (384 * 64), q = r % (384 * 64), n = q >> 6, k = q & 63;
                v = (m < 2 ? p.in[I_W2] : p.in[I_A2])[((size_t)(l * 2 + (m & 1)) * 64 + k) * 384 + n]; }
            else { const int q = r - 4 * 384 * 64, n = q >> 7, k = q & 127; v = p.in[I_G2][((size_t)l * 128 + k) * 384 + n]; }
            wt[i] = (bf16_t)f2bf(v); } }
      { bf16_t* rt = WSP(bf16_t, WS_RTW);
        for (int i = bx * NTHR + tid; i < 2 * 32 * 1024; i += G * NTHR) { const int l = i >> 15, e = (i >> 10) & 31, k = i & 1023; const float v = p.in[I_RW][((size_t)l * 1024 + k) * 32 + e];
            const unsigned hi = f2bf(v); rt[(size_t)l * 65536 + e * 1024 + k] = (bf16_t)hi; rt[(size_t)l * 65536 + 32768 + e * 1024 + k] = (bf16_t)f2bf(v - __builtin_bit_cast(float, hi << 16)); } }
      float* bgu = WSP(float, WS_BGU);
      for (int i = bx * NTHR + tid; i < 2 * 32 * 2048; i += G * NTHR) { const int le = i >> 11, c = i & 2047; bgu[i] = (c & 1) ? p.in[I_MBU][le * 1024 + (c >> 1)] : p.in[I_MBG][le * 1024 + (c >> 1)]; } }
    GRID_BAR(); T_END(0);
    T_BEGIN(1);
#if PHM & 4
    for (int rep_ = 0; rep_ < ((REPM & 32) ? 2 : 1); ++rep_)
    { PHASE_BEGIN(); ln_in_rows(p, gw, ngw, lane); }
#endif
    GRID_BAR(); T_END(1);

#pragma unroll 1
    for (int l = 0; l < 2; ++l) {
        const int nrows = l == 0 ? NTOK : NLAT;
        T_BEGIN(2);
#if PHM & 8
        for (int rep_ = 0; rep_ < ((REPM & 8) ? 2 : 1); ++rep_)
        { PHASE_BEGIN_G();
          pg8::Gemm g{WSP(bf16_t, WS_XM), WSP(bf16_t, WS_WIN) + (size_t)l * DINP * 1024, NTOK, DINP, 1024};
          pg8::StaticOrder S; S.init(NTOK, DINP, 1024, G, bx);
          pg8::EpiBf16 E{WSP(bf16_t, WS_Z), DINP, nullptr, 0};
          pg8::gemm_phase<pg8::EpiBf16, pg8::StaticOrder>(lds, g, S, E, wave_s); }
#endif
        GRID_BAR(); T_END(2);
        T_BEGIN(3);
        for (int rep_ = 0; rep_ < ((REPM & 2) ? 2 : 1); ++rep_)
        { PHASE_BEGIN();
          unsigned* head = WSP(unsigned, WS_CTL) + CW_QHEAD + (l * 8 + 0 + 4 * rep_) * 512;
          const int n_rw1 = 544, n_rw = n_rw1 * ((REPM & 2048) ? 2 : 1), n_gla1 = NCHUNK * 2, n_gla = n_gla1 * ((REPM & 4096) ? 2 : 1), n_da1 = 4 * NKT, n_da = n_da1 * ((REPM & 8192) ? 2 : 1), n_all = n_rw + n_gla + n_da;
          QUEUE_LOOP(head, n_all, {
              if (j < n_rw) { T_BEGIN(20); rw_job(p, l, j % n_rw1, lds, tid, tph_t0, tph_acc); T_END(20); }
              if (j >= n_rw && j < n_rw + n_gla) { const int q = (j - n_rw) % n_gla1; T_BEGIN(21); gla_job(p, l, q >> 1, (q & 1) * 3, lds, tid); T_END(21); }
              if (j >= n_rw + n_gla) { const int q = (j - n_rw - n_gla) % n_da1; T_BEGIN(22); da_job(p, l, q / NKT, q % NKT, lds, tid); T_END(22); }
          }); }
        GRID_BAR(); T_END(3);
        T_BEGIN(4);
        for (int rep_ = 0; rep_ < ((REPM & 32) ? 2 : 1); ++rep_)
        { PHASE_BEGIN();
          { const int n_u = NCHUNK * 12;
            for (int u = bx; u < n_u; u += G) rwa_job(p, u, (u + G < n_u) ? u + G : -1, u == bx, lds, tid, tph_t0, tph_acc); }
          if (bx >= G - 192) g2_job(p, bx - (G - 192), tid); }
        GRID_BAR(); T_END(4);
        T_BEGIN(5);
        for (int rep_ = 0; rep_ < ((REPM & 4) ? 2 : 1); ++rep_)
        { PHASE_BEGIN();
          unsigned* head = WSP(unsigned, WS_CTL) + CW_QHEAD + (l * 8 + 1 + 4 * rep_) * 512;
          const int n_sc = 48, n_att1 = 256 + (l == 0 ? 16 : 0), n_att = n_att1 * ((REPM & 512) ? 2 : 1), n_g31 = (l == 0 ? NCHUNK : 256) * 3, n_g3 = n_g31 * ((REPM & 1024) ? 2 : 1), n_cv = 32 * 192, n_all = n_sc + n_att + n_g3 + n_cv;
          QUEUE_LOOP(head, n_all, {
              if (j < n_sc) { T_BEGIN(25); rwb_job(p, j, tid); T_END(25); }
              if (j >= n_sc && j < n_sc + n_att) { const int q = (j - n_sc) % n_att1; const bool ic = q >= 256; const int c = q - 256;
                  T_BEGIN(23); attn_unit(p, l, ic ? (c >> 2) : (q >> 6), ic ? (c & 3) : ((q >> 4) & 3), ic, ic ? 0 : (q & 15), lds, tid); T_END(23); }
              if (j >= n_sc + n_att && j < n_sc + n_att + n_g3) { const int q = (j - n_sc - n_att) % n_g31; T_BEGIN(24); g3_job(p, l, q / 3, (q % 3) * 2, lds, tid); T_END(24); }
              if (j >= n_sc + n_att + n_g3) conv_job(p, l * JW_LAYER + JW_IN + JW_OUT + (j - n_sc - n_att - n_g3), (LAS float*)lds, tid);
          }); }
        GRID_BAR(); T_END(5);
        T_BEGIN(6);
        for (int rep_ = 0; rep_ < ((REPM & 32) ? 2 : 1); ++rep_)
        { PHASE_BEGIN();
          const int n_all = (l == 0 ? NCHUNK : 256) * 2;
          for (int j = bx; j < n_all; j += G) rwc_job(p, l, j >> 1, (j & 1) * 3, lds, tid); }
        GRID_BAR(); T_END(6);
        T_BEGIN(7);
#if PHM & 4096
        for (int rep_ = 0; rep_ < ((REPM & 8) ? 2 : 1); ++rep_)
        { PHASE_BEGIN_G();
          pg8::Gemm g{WSP(bf16_t, WS_CAT), WSP(bf16_t, WS_WOUT) + (size_t)l * 1024 * 1024, nrows, 1024, 1024};
          pg8::StaticOrder S; S.init(nrows, 1024, 1024, G, bx);
          pg8::EpiBf16 E{WSP(bf16_t, WS_Z), 1024, nullptr, 0};
          pg8::gemm_phase<pg8::EpiBf16, pg8::StaticOrder>(lds, g, S, E, wave_s); }
#endif
        GRID_BAR(); T_END(7);
        T_BEGIN(8);
#if PHM & 8192
        for (int rep_ = ((REPM & 128) ? 0 : 1); rep_ < 2; ++rep_)
        { PHASE_BEGIN(); ln1_router(p, l, nrows, lds, tid, G, bx, rep_ == 0); }
#endif
        GRID_BAR(); T_END(8);
        T_BEGIN(9);
        { PHASE_BEGIN();
          moe_tables(p, l, tab, (LAS int*)lds, G, tid);
#if PHM & 16384
          for (int rep_ = 0; rep_ < ((REPM & 32) ? 2 : 1); ++rep_)
          moe_gather(p, l, nrows, tab, (const LAS int*)lds, gw, ngw, lane);
#endif
        }
        GRID_BAR(); T_END(9);
        T_BEGIN(10);
#if PHM & 32768
        for (int rep_ = 0; rep_ < ((REPM & 16) ? 2 : 1); ++rep_)
        { PHASE_BEGIN_G();
          const int nblk = tab[96];
          pg8::Gemm g{SCRP(bf16_t, SC_XB), WSP(bf16_t, WS_WGU) + (size_t)l * 32 * 2048 * 1024, nblk * 256, 2048, 1024};
          pg8::GroupOrder<8> S{G, (G % 8 == 0) ? (bx % 8) * (G / 8) + bx / 8 : bx, nblk, tab + 128};
          pg8::EpiSwiglu E{SCRP(bf16_t, SC_ACT), WSP(float, WS_BGU) + (size_t)l * 32 * 2048};
          pg8::gemm_phase<pg8::EpiSwiglu, pg8::GroupOrder<8>>(lds, g, S, E, wave_s); }
#endif
        GRID_BAR(); T_END(10);
        T_BEGIN(11);
#if PHM & 65536
        for (int rep_ = 0; rep_ < ((REPM & 16) ? 2 : 1); ++rep_)
        { PHASE_BEGIN_G();
          const int nblk = tab[96];
          pg8::Gemm g{SCRP(bf16_t, SC_ACT), WSP(bf16_t, WS_WDN) + (size_t)l * 32 * 1024 * 1024, nblk * 256, 1024, 1024};
          pg8::GroupOrder<4> S{G, (G % 8 == 0) ? (bx % 8) * (G / 8) + bx / 8 : bx, nblk, tab + 128};
          pg8::EpiBf16 E{SCRP(bf16_t, SC_XB), 1024, p.in[I_MBD] + (size_t)l * 32 * 1024, 1024};
          pg8::gemm_phase<pg8::EpiBf16, pg8::GroupOrder<4>>(lds, g, S, E, wave_s); }
#endif
        GRID_BAR(); T_END(11);
        T_BEGIN(12);
#if PHM & 131072
        for (int rep_ = ((REPM & 256) ? 0 : 1); rep_ < 2; ++rep_)
        { PHASE_BEGIN(); ln2_rows(p, l, nrows, gw, ngw, lane, rep_ == 0); }
#endif
        GRID_BAR(); T_END(12);
    }
    if (TPH >= 0 && bx == 0 && wave_s == 0 && lane_id_() == 0) { Params p = p_arg; p.out[0] += (float)tph_acc * 1e-4f; }
}

extern "C" void kernel_launch(void* const* d_in, const int* in_sizes, int n_in, void* d_out, int out_size, void* d_ws, size_t ws_size, hipStream_t stream) {
    (void)in_sizes; (void)n_in; (void)out_size; (void)ws_size;
    static int grid = 0;
    if (!grid) {
        (void)hipFuncSetAttribute((const void*)fwd_kernel, hipFuncAttributeMaxDynamicSharedMemorySize, LDS_BYTES);
        int dev = 0, cus = 0; (void)hipGetDevice(&dev); (void)hipDeviceGetAttribute(&cus, hipDeviceAttributeMultiprocessorCount, dev);
        grid = cus > 0 && cus < 256 ? cus : 256;
    }
    (void)hipMemsetAsync(d_ws, 0, CTL_BYTES, stream);
    Params p{};
    for (int i = 0; i < 41; ++i) p.in[i] = (const float*)d_in[i];
    p.out = (float*)d_out; p.ws = (unsigned char*)d_ws;
    hipLaunchKernelGGL(fwd_kernel, dim3(grid), dim3(NTHR), LDS_BYTES, stream, p);
}
```

```cpp
#include <hip/hip_runtime.h>
#include <cstdint>
#include <cstdio>

#define LAS __attribute__((address_space(3)))
typedef unsigned short bf16_t;
typedef short bf16x8 __attribute__((ext_vector_type(8)));
typedef float f32x4 __attribute__((ext_vector_type(4)));
typedef float f32x2 __attribute__((ext_vector_type(2)));
typedef unsigned u32x4 __attribute__((ext_vector_type(4)));
typedef unsigned u32x2 __attribute__((ext_vector_type(2)));

constexpr int D = 1024, NB = 4, SEQ = 4096, LCX = 256, NLAT = NB * SEQ, NCX = NB * LCX, NTOK = NLAT + NCX;
constexpr int DIN = 3488, DINP = 3584;
constexpr int NE = 32, FF = 1024;
constexpr int CAP_BLK = 304, CAP = CAP_BLK * 256;
constexpr int NTHR = 512;
constexpr int ZQ = 0, ZK = 256, ZV = 512, ZGQ = 768, ZGK = 960, ZGV = 1152, ZGF = 1536, ZGB = 1552, ZGR = 1568, ZRKV = 1952, ZWF = 3104, ZWB = 3168, ZAF = 3232, ZAB = 3296, ZG = 3360;
constexpr int NKT = 136;
constexpr int NCHUNK = 272;
constexpr float LN_EPS = 1e-5f, RW_GN_EPS = 64e-5f;
constexpr float DN_ALPHA = 1.41421356237f;

constexpr size_t MiB = 1u << 20;
constexpr size_t WS_CTL = 0, CTL_BYTES = 1 * MiB;
constexpr size_t WS_MOD = 1 * MiB;
constexpr size_t WS_TOP = 2 * MiB;
constexpr size_t TOP_STRIDE = (size_t)NTOK * 4 * 4;
constexpr size_t WS_CNTWG = 3 * MiB + 768 * 1024;
constexpr size_t WS_RWW = 3 * MiB + 128 * 1024;
constexpr size_t RWW_LAYER = 4 * 384 * 64 + 384 * 128;
static_assert(WS_TOP + 4 * TOP_STRIDE <= WS_RWW && WS_RWW + 2 * RWW_LAYER * 2 <= WS_CNTWG && WS_CNTWG + 2 * 256 * 32 * 4 <= 4 * MiB, "ws map");
constexpr size_t WS_RTW = 4 * MiB + 512 * 1024;
constexpr size_t WS_BGU = 4 * MiB;
constexpr size_t WS_H = 5 * MiB;
constexpr size_t WS_XM = 73 * MiB;
constexpr size_t WS_CAT = 107 * MiB;
constexpr size_t WS_Z = 141 * MiB;
constexpr size_t WS_WIN = 260 * MiB;
constexpr size_t WS_WOUT = 274 * MiB;
constexpr size_t WS_WGU = 278 * MiB;
constexpr size_t WS_WDN = 534 * MiB;
constexpr size_t WS_SCR = 662 * MiB;
constexpr size_t WS_END = 966 * MiB;
constexpr size_t WS_MREC = 966 * MiB, WS_GREC = 992 * MiB, WS_TOTAL = 1018 * MiB, WS_ROWTOK = 1018 * MiB  ;
static_assert(WS_MREC + (size_t)3264 * 8192 <= WS_GREC && WS_GREC + (size_t)3264 * 8192 <= WS_TOTAL && WS_TOTAL <= 1024 * MiB && WS_ROWTOK + (size_t)CAP * 4 <= 1024 * MiB, "ws map");
static_assert(WS_H + (size_t)NTOK * D * 4 <= WS_XM && WS_XM + (size_t)NTOK * D * 2 <= WS_CAT && WS_CAT + (size_t)NTOK * D * 2 <= WS_Z, "ws map");
static_assert(WS_Z + (size_t)NTOK * DINP * 2 <= WS_WIN && WS_WIN + (size_t)2 * DINP * D * 2 <= WS_WOUT && WS_WOUT + (size_t)2 * D * D * 2 <= WS_WGU, "ws map");
static_assert(WS_WGU + (size_t)2 * 32 * 2048 * 1024 * 2 <= WS_WDN && WS_WDN + (size_t)2 * 32 * 1024 * 1024 * 2 <= WS_SCR, "ws map");
constexpr size_t SC_XB = 0, SC_ACT = (size_t)CAP * D * 2;
static_assert(WS_SCR + 2 * SC_ACT <= WS_END, "ws map");
constexpr size_t SZ_T384B = (size_t)NTOK * 384 * 2, SZ_T384F = (size_t)NTOK * 384 * 4, SZ_T192F = (size_t)NTOK * 192 * 4;
constexpr size_t SC_KVREC = 0;
constexpr size_t SC_GBF = SC_KVREC + (size_t)16 * NKT * 8192;
constexpr size_t SC_GBB = SC_GBF + SZ_T192F;
constexpr size_t SC_KVC = SC_GBB + SZ_T192F;
constexpr size_t SZ_KVC = (size_t)NCHUNK * 6 * 2 * 2048 * 4;
constexpr size_t SC_SC = SC_KVC + SZ_KVC;
constexpr size_t SC_DC = SC_SC + SZ_KVC;
constexpr size_t SC_R = SC_DC + (size_t)NCHUNK * 6 * 2 * 32 * 4;
constexpr size_t SC_KK = SC_R + SZ_T384B, SC_V = SC_KK + SZ_T384B, SC_BKF = SC_V + SZ_T384B, SC_BKB = SC_BKF + SZ_T384B, SC_KMF = SC_BKB + SZ_T384B, SC_KMB = SC_KMF + SZ_T384B, SC_G = SC_KMB + SZ_T384B;
constexpr size_t SC_WF = SC_G + SZ_T384B, SC_WB = SC_WF + SZ_T384F, SC_YF = SC_WB + SZ_T384F, SC_YB = SC_YF + SZ_T384F, SC_BON = SC_YB + SZ_T384F;
constexpr size_t SC_MIX_END = SC_BON + (size_t)NTOK * 8 * 4;
static_assert(WS_SCR + SC_MIX_END <= WS_END, "mixer scratch");
constexpr int CW_BAR = 4096, CW_CNT = 8192, CW_QHEAD = 8448  , CW_KMAX = 16896;
static_assert(CW_BAR + 3456 <= CW_CNT && CW_CNT + 128 <= CW_QHEAD && CW_QHEAD + 16 * 512 <= CW_KMAX && (CW_KMAX + 64) * 4 <= (int)CTL_BYTES, "control words");

constexpr int LDS_BYTES = 163840, LDS_CTL_OFF = LDS_BYTES - 256;

__device__ __forceinline__ int lane_id_() { int r; asm volatile("v_mbcnt_lo_u32_b32 %0, -1, 0\n\tv_mbcnt_hi_u32_b32 %0, -1, %0" : "=v"(r)); return r; }
#define WAVE_ID_SGPR() (__builtin_amdgcn_readfirstlane((int)(threadIdx.x >> 6)))

typedef __bf16 bf16x2_t __attribute__((ext_vector_type(2)));
__device__ __forceinline__ unsigned pk2(float lo, float hi) { const f32x2 v = {lo, hi}; const bf16x2_t b = __builtin_convertvector(v, bf16x2_t); return __builtin_bit_cast(unsigned, b); }
__device__ __forceinline__ unsigned f2bf(float f) { return pk2(f, 0.f) & 0xffffu; }
__device__ __forceinline__ float bf2f(bf16_t h) { return __builtin_bit_cast(float, (unsigned)h << 16); }
__device__ __forceinline__ float bflo(unsigned u) { return __builtin_bit_cast(float, u << 16); }
__device__ __forceinline__ float bfhi(unsigned u) { return __builtin_bit_cast(float, u & 0xffff0000u); }
__device__ __forceinline__ float wave_sum(float v) {
#pragma unroll
    for (int o = 1; o < 64; o <<= 1) v += __shfl_xor(v, o);
    return v;
}
__device__ __forceinline__ float sigmoidf_(float x) { return __builtin_amdgcn_rcpf(1.f + __expf(-x)); }
__device__ __forceinline__ float siluf_(float x) { return x * __builtin_amdgcn_rcpf(1.f + __expf(-x)); }
__device__ __forceinline__ float tanhf_(float x) { return 1.f - 2.f * __builtin_amdgcn_rcpf(1.f + __expf(2.f * x)); }
template <int CTRL> __device__ __forceinline__ float dpp_f(float v) {
    return __builtin_bit_cast(float, __builtin_amdgcn_update_dpp(0, __builtin_bit_cast(int, v), CTRL, 0xF, 0xF, true));
}
__device__ __forceinline__ float red16(float v) {
    v += dpp_f<0xB1>(v);
    v += dpp_f<0x4E>(v);
    v += dpp_f<0x141>(v);
    v += dpp_f<0x140>(v);
    return v;
}

typedef int v8i_t __attribute__((ext_vector_type(8)));
__device__ __forceinline__ unsigned pk4_fp8(float a, float b, float c, float d) {
    a = __builtin_amdgcn_fmed3f(a, -448.f, 448.f); b = __builtin_amdgcn_fmed3f(b, -448.f, 448.f); c = __builtin_amdgcn_fmed3f(c, -448.f, 448.f); d = __builtin_amdgcn_fmed3f(d, -448.f, 448.f);
    int r = __builtin_amdgcn_cvt_pk_fp8_f32(a, b, 0, false); r = __builtin_amdgcn_cvt_pk_fp8_f32(c, d, r, true); return (unsigned)r; }
namespace pg8 {
constexpr int BM = 256, BK = 64, HALF = 128, HTB = HALF * BK * 2, STAGE_BYTES = 8 * HTB, NXCD = 8, WGM = 8;
__host__ __device__ __forceinline__ int lds_byte(int r, int c) { const int st = (r >> 4) * 2 + (c >> 5), rr = r & 15, cc = c & 31, ob = rr * 64 + cc * 2; return st * 1024 + (ob ^ (((ob >> 9) & 1) << 5)); }
__host__ __device__ __forceinline__ void stage_rc(int b, int& R, int& C) { const int st = b / 1024, sb = b % 1024, swz = sb ^ (((sb >> 9) & 1) << 5); R = (st >> 1) * 16 + swz / 64; C = (st & 1) * 32 + (swz % 64) / 2; }
__host__ __device__ __forceinline__ int perm32(int rho) { const int n = rho >> 4, i = rho & 15; return 8 * (i >> 2) + 4 * n + (i & 3); }

struct Unit { int pm, pn, e; size_t boff; };
struct Gemm { const bf16_t* A; const bf16_t* Bt; int M, N, K; };

struct StaticOrder {
    int nM, nN, nwg, G, c; size_t tstep;
    __device__ void init(int M, int N, int K, int G_, int c_) { nM = M / BM; nN = N / BM; nwg = nM * nN; G = G_; c = c_; tstep = (size_t)BM * K * 2; }
    __device__ bool next(int i, Unit& u) const {
        const long L = (long)i * G + c; if (L >= nwg) return false;
        int wgid = (int)L; { const int q = nwg / NXCD, r = nwg % NXCD, xcd = wgid % NXCD, off = wgid / NXCD; wgid = (xcd < r ? xcd * (q + 1) : r * (q + 1) + (xcd - r) * q) + off; }
        const int nig = WGM * nN, gid = wgid / nig, fm = gid * WGM, gsz = (nM - fm) < WGM ? (nM - fm) : WGM;
        u.pm = fm + ((wgid % nig) % gsz); u.pn = (wgid % nig) / gsz; u.e = 0; u.boff = (size_t)u.pn * tstep; return true;
    }
};
template <int NPN, int ROWB = 2048> struct GroupOrder {
    int G, c, nblk; const LAS int* blk2e;
    __device__ __forceinline__ bool next(int i, Unit& u) const {
        const int L = i * G + c; if (L >= nblk * NPN) return false;
        const int blk = L / NPN; u.pn = L % NPN; u.pm = blk;
        const int e = blk2e[blk];
        u.e = e; u.boff = (size_t)(e * NPN + u.pn) * ((size_t)256 * ROWB); return true;
    }
};

__device__ __forceinline__ unsigned cvt_pk_bf16(float lo, float hi) { return pk2(lo, hi); }

template <bool S32 = false> struct EpiBf16T {
    bf16_t* O; int ldc; const float* bias; int bias_estride;
    __device__ __forceinline__ void operator()(const f32x4 (&acc)[2][2][4][2], const Unit& u, int wr, int wc, int fr, int fq) const {
        const int row0 = u.pm * BM + wr * 64 + fr; const int col0 = u.pn * BM + wc * 32 + 8 * fq;
        f32x4 bv[2][2];
#pragma unroll
        for (int bj = 0; bj < 2; ++bj)
#pragma unroll
            for (int n = 0; n < 2; ++n) bv[bj][n] = bias ? *(const f32x4*)(bias + (size_t)u.e * bias_estride + col0 + bj * HALF + 4 * n) : (f32x4){0.f, 0.f, 0.f, 0.f};
#pragma unroll
        for (int ai = 0; ai < 2; ++ai)
#pragma unroll
            for (int m = 0; m < 4; ++m) { bf16_t* rowp = O + (size_t)(row0 + ai * HALF + m * 16) * ldc + col0;
#pragma unroll
                for (int bj = 0; bj < 2; ++bj) { const float sc = S32 ? 0.03125f : 1.f; const f32x4 v0 = acc[ai][bj][m][0] * sc + bv[bj][0], v1 = acc[ai][bj][m][1] * sc + bv[bj][1];
                    u32x4 w; w.x = cvt_pk_bf16(v0[0], v0[1]); w.y = cvt_pk_bf16(v0[2], v0[3]); w.z = cvt_pk_bf16(v1[0], v1[1]); w.w = cvt_pk_bf16(v1[2], v1[3]);
                    *(u32x4*)(rowp + bj * HALF) = w; } }
    }
};
typedef EpiBf16T<false> EpiBf16;
struct EpiSwiglu {
    bf16_t* O; const float* bias;
    __device__ __forceinline__ static float act(float g, float u) {
        g = fminf(g, 7.f); u = fminf(fmaxf(u, -7.f), 7.f);
        return (u + 1.f) * g * __builtin_amdgcn_rcpf(1.f + __expf(-1.702f * g));
    }
    __device__ __forceinline__ void operator()(const f32x4 (&acc)[2][2][4][2], const Unit& u, int wr, int wc, int fr, int fq) const {
        const int row0 = u.pm * BM + wr * 64 + fr; const int col0 = u.pn * BM + wc * 32 + 8 * fq;
        f32x4 bv[2][2];
#pragma unroll
        for (int bj = 0; bj < 2; ++bj)
#pragma unroll
            for (int n = 0; n < 2; ++n) bv[bj][n] = *(const f32x4*)(bias + (size_t)u.e * 2048 + col0 + bj * HALF + 4 * n);
#pragma unroll
        for (int ai = 0; ai < 2; ++ai)
#pragma unroll
            for (int m = 0; m < 4; ++m) { bf16_t* rowp = O + (size_t)(row0 + ai * HALF + m * 16) * 1024 + (col0 >> 1);
#pragma unroll
                for (int bj = 0; bj < 2; ++bj) { const f32x4 v0 = acc[ai][bj][m][0] + bv[bj][0], v1 = acc[ai][bj][m][1] + bv[bj][1];
                    u32x2 w; w.x = cvt_pk_bf16(act(v0[0], v0[1]), act(v0[2], v0[3])); w.y = cvt_pk_bf16(act(v1[0], v1[1]), act(v1[2], v1[3]));
                    *(u32x2*)(rowp + bj * (HALF / 2)) = w; } }
    }
};

struct EpiSwiglu8 {
    unsigned char* O; const float* bias;
    __device__ __forceinline__ void operator()(const f32x4 (&acc)[2][2][4][2], const Unit& u, int wr, int wc, int fr, int fq) const {
        const int row0 = u.pm * BM + wr * 64 + fr; const int col0 = u.pn * BM + wc * 32 + 8 * fq;
        f32x4 bv[2][2];
#pragma unroll
        for (int bj = 0; bj < 2; ++bj)
#pragma unroll
            for (int n = 0; n < 2; ++n) bv[bj][n] = *(const f32x4*)(bias + (size_t)u.e * 2048 + col0 + bj * HALF + 4 * n);
#pragma unroll
        for (int ai = 0; ai < 2; ++ai)
#pragma unroll
            for (int m = 0; m < 4; ++m) { unsigned char* rowp = O + (size_t)(row0 + ai * HALF + m * 16) * 1024 + (col0 >> 1);
#pragma unroll
                for (int bj = 0; bj < 2; ++bj) { const f32x4 v0 = acc[ai][bj][m][0] * 0.03125f + bv[bj][0], v1 = acc[ai][bj][m][1] * 0.03125f + bv[bj][1];
                    *(unsigned*)(rowp + bj * (HALF / 2)) = pk4_fp8(EpiSwiglu::act(v0[0], v0[1]), EpiSwiglu::act(v0[2], v0[3]), EpiSwiglu::act(v1[0], v1[1]), EpiSwiglu::act(v1[2], v1[3])); } }
    }
};

struct EpiFp8Dn {
    unsigned char* O; const float* bias;
    __device__ __forceinline__ void operator()(const f32x4 (&acc)[2][2][4][2], const Unit& u, int wr, int wc, int fr, int fq) const {
        const int row0 = u.pm * BM + wr * 64 + fr; const int col0 = u.pn * BM + wc * 32 + 8 * fq;
        f32x4 bv[2][2];
#pragma unroll
        for (int bj = 0; bj < 2; ++bj)
#pragma unroll
            for (int n = 0; n < 2; ++n) bv[bj][n] = *(const f32x4*)(bias + (size_t)u.e * 1024 + col0 + bj * HALF + 4 * n) * 16.f;
#pragma unroll
        for (int ai = 0; ai < 2; ++ai)
#pragma unroll
            for (int m = 0; m < 4; ++m) { unsigned char* rowp = O + (size_t)(row0 + ai * HALF + m * 16) * 1024 + col0;
#pragma unroll
                for (int bj = 0; bj < 2; ++bj) { const f32x4 v0 = acc[ai][bj][m][0] * 0.5f + bv[bj][0], v1 = acc[ai][bj][m][1] * 0.5f + bv[bj][1];
                    u32x2 w; w.x = pk4_fp8(v0[0], v0[1], v0[2], v0[3]); w.y = pk4_fp8(v1[0], v1[1], v1[2], v1[3]);
                    *(u32x2*)(rowp + bj * HALF) = w; } }
    }
};

template <class Epi, class Sched, bool GATHER = false, bool F8 = false>
__device__ __forceinline__ void gemm_phase(LAS unsigned char* lds, const Gemm g, const Sched& S, const Epi& E, const int wave_s, const int* rowtok = nullptr) {
    int tid = wave_s * 64 + lane_id_(); asm volatile("" : "+v"(tid));
    const int wid = __builtin_amdgcn_readfirstlane(tid >> 6), lane = tid & 63, wr = wid >> 2, wc = wid & 3, fr = lane & 15, fq = lane >> 4;
    const int K = g.K, nt = K / BK;
    unsigned voffA[2], voffB[2];
#pragma unroll
    for (int i = 0; i < 2; ++i) { int R, C; stage_rc(tid * 16 + i * 8192, R, C); const int Rb = (R & ~31) + perm32(R & 31);
        voffA[i] = (unsigned)(R * K + C) * 2u; voffB[i] = (unsigned)(Rb * K + C) * 2u; }
    const size_t kstep = (size_t)(BK * 2);
    const size_t hstep = (size_t)HALF * K * 2;
    const size_t tstep = 2 * hstep;
    const unsigned ldsw = (unsigned)wid * 1024u;
    const int aoff = lds_byte(wr * 64 + fr, fq * 8), boff = lds_byte(wc * 32 + fr, fq * 8);
#define PG8_SA(b, h) (((b) * 2 + (h)) * HTB)
#define PG8_SB(b, h) ((4 + (b) * 2 + (h)) * HTB)
#define PG8_STAGE(bufoff, gbase, voff) do { _Pragma("unroll") for (int _i = 0; _i < 2; ++_i) \
        __builtin_amdgcn_global_load_lds((const unsigned*)((const char*)(gbase) + (voff)[_i]), (LAS unsigned*)(lds + (bufoff) + ldsw + _i * 8192), 16, 0, 0); } while (0)
#define PG8_LDA(dst, b, h) do { _Pragma("unroll") for (int m = 0; m < 4; ++m) _Pragma("unroll") for (int k = 0; k < 2; ++k) dst[m][k] = *(const LAS bf16x8*)(lds + PG8_SA(b, h) + aoff + m * 2048 + k * 1024); } while (0)
#define PG8_LDB(dst, b, h) do { _Pragma("unroll") for (int n = 0; n < 2; ++n) _Pragma("unroll") for (int k = 0; k < 2; ++k) dst[n][k] = *(const LAS bf16x8*)(lds + PG8_SB(b, h) + boff + n * 2048 + k * 1024); } while (0)
#define PG8_MMA(ai, bj, At, Bt) do { __builtin_amdgcn_s_setprio(1); _Pragma("unroll") for (int m = 0; m < 4; ++m) _Pragma("unroll") for (int n = 0; n < 2; ++n) { \
        if constexpr (F8) { const u32x4 _b0 = __builtin_bit_cast(u32x4, Bt[n][0]), _b1 = __builtin_bit_cast(u32x4, Bt[n][1]), _a0 = __builtin_bit_cast(u32x4, At[m][0]), _a1 = __builtin_bit_cast(u32x4, At[m][1]); \
            const v8i_t _bb = {(int)_b0.x, (int)_b0.y, (int)_b0.z, (int)_b0.w, (int)_b1.x, (int)_b1.y, (int)_b1.z, (int)_b1.w}, _aa = {(int)_a0.x, (int)_a0.y, (int)_a0.z, (int)_a0.w, (int)_a1.x, (int)_a1.y, (int)_a1.z, (int)_a1.w}; \
            asm volatile("v_mfma_f32_16x16x128_f8f6f4 %0, %1, %2, %0" : "+v"(acc[ai][bj][m][n]) : "v"(_bb), "v"(_aa)); }        \
        else { _Pragma("unroll") for (int k = 0; k < 2; ++k) acc[ai][bj][m][n] = __builtin_amdgcn_mfma_f32_16x16x32_bf16(Bt[n][k], At[m][k], acc[ai][bj][m][n], 0, 0, 0); } } \
        __builtin_amdgcn_s_setprio(0); } while (0)
#define PG8_WAIT_V(n) asm volatile("s_waitcnt vmcnt(" #n ")" ::: "memory")
#define PG8_WAIT_L(n) asm volatile("s_waitcnt lgkmcnt(" #n ")" ::: "memory")
#define PG8_BAR __builtin_amdgcn_s_barrier()
#define PG8_SCHED __builtin_amdgcn_sched_barrier(0)
    Unit cur, nxt; int ui = 0;
    if (!S.next(0, cur)) return;
    f32x4 acc[2][2][4][2];
#pragma unroll
    for (int a = 0; a < 2; ++a)
#pragma unroll
        for (int b = 0; b < 2; ++b)
#pragma unroll
            for (int m = 0; m < 4; ++m)
#pragma unroll
                for (int n = 0; n < 2; ++n) acc[a][b][m][n] = (f32x4){0.f, 0.f, 0.f, 0.f};
    bf16x8 At[4][2], B0[2][2], B1[2][2];
    const char* cA = (const char*)g.A + (size_t)cur.pm * tstep; const char* cB = (const char*)g.Bt + cur.boff;
    const char* gA = (const char*)g.A;
    constexpr int RBL = F8 ? 10 : 11;
    unsigned gvc[2], gvn[2];
#define PG8_GV(dst, pm) do { _Pragma("unroll") for (int _h = 0; _h < 2; ++_h) \
        dst[_h] = (unsigned)rowtok[(pm) * 256 + _h * 128 + (int)(voffA[0] >> RBL)] | ((unsigned)rowtok[(pm) * 256 + _h * 128 + (int)(voffA[1] >> RBL)] << 16); } while (0)
    if constexpr (GATHER) { PG8_GV(gvc, cur.pm); } else { gvc[0] = gvc[1] = 0u; }
#define PG8_STAGE_A(bufoff, abase, koff, h) do { if constexpr (GATHER) { const unsigned _t[2] = {((gvc[h] & 0xffffu) << RBL) + (voffA[0] & ((1u << RBL) - 1u)), ((gvc[h] >> 16) << RBL) + (voffA[1] & ((1u << RBL) - 1u))}; PG8_STAGE(bufoff, gA + (koff), _t); } \
        else { PG8_STAGE(bufoff, (abase) + (koff) + (h) * hstep, voffA); } } while (0)
    PG8_STAGE(PG8_SB(0, 0), cB, voffB); PG8_STAGE(PG8_SB(0, 1), cB + hstep, voffB); PG8_STAGE_A(PG8_SA(0, 0), cA, 0, 0); PG8_STAGE_A(PG8_SA(0, 1), cA, 0, 1);
    if (wr == 1) PG8_BAR;
    PG8_WAIT_V(2); PG8_BAR;
    PG8_STAGE(PG8_SB(1, 0), cB + kstep, voffB); PG8_STAGE_A(PG8_SA(1, 0), cA, kstep, 0); PG8_STAGE(PG8_SB(1, 1), cB + hstep + kstep, voffB);
    PG8_WAIT_V(6); PG8_BAR;
    for (;;) {
        const bool has_next = S.next(ui + 1, nxt);
        const char* nA = has_next ? (const char*)g.A + (size_t)nxt.pm * tstep : cA; const char* nB = has_next ? (const char*)g.Bt + nxt.boff : cB;
        if constexpr (GATHER) { PG8_GV(gvn, (has_next ? nxt.pm : cur.pm)); }
#pragma unroll 1
        for (int t = 0; t < nt; t += 2) {
            const bool last = (t == nt - 2);
            const size_t k1 = (size_t)(t + 1) * kstep, k2 = last ? 0 : (size_t)(t + 2) * kstep, k3 = k2 + kstep;
            const char* aN = last ? nA : cA; const char* b2 = last ? nB : cB + (size_t)(t + 2) * kstep; const char* b3 = b2 + kstep;
            PG8_LDB(B0, 0, 0); PG8_LDB(B1, 0, 1); PG8_SCHED; PG8_LDA(At, 0, 0); PG8_STAGE_A(PG8_SA(1, 1), cA, k1, 1);
            if constexpr (GATHER) { if (last) { gvc[0] = gvn[0]; gvc[1] = gvn[1]; } }
            PG8_WAIT_V(8); PG8_WAIT_L(0); PG8_BAR; PG8_MMA(0, 0, At, B0); PG8_MMA(0, 1, At, B1); PG8_BAR; PG8_SCHED;
            PG8_LDA(At, 0, 1); PG8_STAGE(PG8_SB(0, 0), b2, voffB); PG8_STAGE(PG8_SB(0, 1), b2 + hstep, voffB); PG8_STAGE_A(PG8_SA(0, 0), aN, k2, 0);
            PG8_WAIT_V(8); PG8_WAIT_L(0); PG8_BAR; PG8_MMA(1, 0, At, B0); PG8_MMA(1, 1, At, B1); PG8_BAR; PG8_SCHED;
            PG8_LDB(B0, 1, 0); PG8_LDB(B1, 1, 1); PG8_SCHED; PG8_LDA(At, 1, 0); PG8_STAGE_A(PG8_SA(0, 1), aN, k2, 1);
            PG8_WAIT_V(8); PG8_WAIT_L(0); PG8_BAR; PG8_MMA(0, 0, At, B0); PG8_MMA(0, 1, At, B1); PG8_BAR; PG8_SCHED;
            PG8_LDA(At, 1, 1); PG8_STAGE(PG8_SB(1, 0), b3, voffB); PG8_STAGE(PG8_SB(1, 1), b3 + hstep, voffB); PG8_STAGE_A(PG8_SA(1, 0), aN, k3, 0);
            PG8_WAIT_V(8); PG8_WAIT_L(0); PG8_BAR; PG8_MMA(1, 0, At, B0); PG8_MMA(1, 1, At, B1); PG8_BAR; PG8_SCHED;
        }
        if (wr == 0) PG8_BAR;
        if constexpr (F8) asm volatile("s_nop 15\n\ts_nop 7" ::: "memory");
        { int tz = wave_s * 64 + lane_id_(); asm volatile("" : "+v"(tz)); const int l2 = tz & 63; E(acc, cur, wave_s >> 2, wave_s & 3, l2 & 15, l2 >> 4); }
        if (!has_next) break;
#pragma unroll
        for (int a = 0; a < 2; ++a)
#pragma unroll
            for (int b = 0; b < 2; ++b)
#pragma unroll
                for (int m = 0; m < 4; ++m)
#pragma unroll
                    for (int n = 0; n < 2; ++n) acc[a][b][m][n] = (f32x4){0.f, 0.f, 0.f, 0.f};
        cur = nxt; cA = nA; cB = nB; ++ui;
        if (wr == 1) PG8_BAR;
    }
    PG8_WAIT_V(0);
    PG8_BAR;
#undef PG8_SA
#undef PG8_GV
#undef PG8_STAGE_A
#undef PG8_SB
#undef PG8_STAGE
#undef PG8_LDA
#undef PG8_LDB
#undef PG8_MMA
#undef PG8_WAIT_V
#undef PG8_WAIT_L
#undef PG8_BAR
#undef PG8_SCHED
}
}
#define XB_TMO      128
#define XB_XCNT(j)  (256  + 64 * (j))
#define XB_XSUB(j)  (1280 + 64 * (j))
#define XB_XGEN(j)  (2304 + 64 * (j))
#define XB_TOP      3328
#define XB_TOPGEN   3392
#define XCD_BAR_WORDS 3456
#define XB_SPIN_CAP (1u << 18)

__device__ __forceinline__ unsigned xb_ld(unsigned* p)              { return __hip_atomic_load(p, __ATOMIC_RELAXED, __HIP_MEMORY_SCOPE_AGENT); }
__device__ __forceinline__ unsigned xb_add(unsigned* p, unsigned v) { return __hip_atomic_fetch_add(p, v, __ATOMIC_RELAXED, __HIP_MEMORY_SCOPE_AGENT); }
__device__ __forceinline__ unsigned xb_xcc_id() { return (unsigned)__builtin_amdgcn_s_getreg((3 << 11) | 20) & 0xFu; }
#define XB_SPIN(cond, bar) do { unsigned _sp = 0; while (cond) { __builtin_amdgcn_s_sleep(1); \
    if ((++_sp & 255u) == 0u) { if (xb_ld(&(bar)[XB_TMO])) break; if (_sp > XB_SPIN_CAP) { atomicAdd(&(bar)[XB_TMO], 1u); break; } } } } while (0)

struct XcdBarrier {
    unsigned* bar; unsigned x; int w;
    volatile LAS unsigned* st;
};

__device__ __forceinline__ XcdBarrier xcd_barrier_post(unsigned* bar, volatile LAS unsigned* st, int wave_s) {
    XcdBarrier b; b.bar = bar; b.x = xb_xcc_id(); b.st = st; b.w = wave_s;
    if (wave_s == 0 && lane_id_() == 0) (void)xb_add(&bar[XB_XCNT(b.x)], 1u);
    return b;
}
__device__ __forceinline__ void xcd_barrier_complete(unsigned* bar, unsigned x, unsigned& nloc, unsigned& nx) {
    const unsigned G = gridDim.x * gridDim.y * gridDim.z;
    unsigned sum, cnt, mine, sp = 0u;
    for (;;) {
        sum = 0u; cnt = 0u; mine = 0u;
#pragma unroll
        for (unsigned j = 0; j < 16; ++j) { const unsigned c = xb_ld(&bar[XB_XCNT(j)]); sum += c; cnt += (c > 0u) ? 1u : 0u; mine = (j == x) ? c : mine; }
        if (sum == G) break;
        __builtin_amdgcn_s_sleep(1);
        if ((++sp & 255u) == 0u) { if (xb_ld(&bar[XB_TMO])) break; if (sp > XB_SPIN_CAP) { atomicAdd(&bar[XB_TMO], 1u); break; } }
    }
    nloc = mine > 0u ? mine : 1u; nx = cnt > 0u ? cnt : 1u;
}

__device__ __forceinline__ void xcd_barrier(const XcdBarrier& b) {
    asm volatile("s_waitcnt vmcnt(0)" ::: "memory");
    __syncthreads();
    if (b.w == 0 && lane_id_() == 0) {
        unsigned* bar = b.bar;
        __builtin_amdgcn_s_waitcnt(0);
        unsigned nloc = b.st[0], nx = b.st[1];
        if (nloc == 0u) { xcd_barrier_complete(bar, b.x, nloc, nx); b.st[0] = nloc; b.st[1] = nx; }
        const unsigned old = xb_add(&bar[XB_XSUB(b.x)], 1u);
        const unsigned gen = old / nloc;
        if (old + 1u == (gen + 1u) * nloc) {
            __builtin_amdgcn_fence(__ATOMIC_RELEASE, "agent");
            asm volatile("s_waitcnt vmcnt(0)" ::: "memory");
            const unsigned og = xb_add(&bar[XB_TOP], 1u);
            const unsigned tg = og / nx;
            if (og + 1u == (tg + 1u) * nx) xb_add(&bar[XB_TOPGEN], 1u);
            else XB_SPIN(xb_ld(&bar[XB_TOPGEN]) == tg, bar);
            __builtin_amdgcn_fence(__ATOMIC_ACQUIRE, "agent");
            xb_add(&bar[XB_XGEN(b.x)], 1u);
            asm volatile("s_waitcnt vmcnt(0)" ::: "memory");
        } else {
            XB_SPIN(xb_ld(&bar[XB_XGEN(b.x)]) == gen, bar);
            __builtin_amdgcn_fence(__ATOMIC_ACQUIRE, "agent");
            asm volatile("s_waitcnt vmcnt(0)" ::: "memory");
        }
    }
    __syncthreads();
}

__device__ const float ROPE_COS[64][8] = {
1.0f, 1.0f, 1.0f, 1.0f, 1.0f, 1.0f, 1.0f, 1.0f,
0.540302277f, 0.950415254f, 0.995004177f, 0.999500036f, 0.999949992f, 0.999994993f, 0.999999523f, 0.99999994f,
-0.416146845f, 0.806578398f, 0.980066597f, 0.998000681f, 0.999800026f, 0.999979973f, 0.999997973f, 0.999999821f,
-0.989992499f, 0.582753658f, 0.955336511f, 0.995503366f, 0.999550045f, 0.999954998f, 0.99999553f, 0.999999523f,
-0.653643608f, 0.301137477f, 0.921060979f, 0.992010653f, 0.999200106f, 0.999920011f, 0.999992013f, 0.999999225f,
0.2836622f, -0.0103423381f, 0.87758255f, 0.987526f, 0.998750269f, 0.999875009f, 0.999987483f, 0.999998748f,
0.960170269f, -0.3207964f, 0.825335622f, 0.982053936f, 0.998200536f, 0.999819994f, 0.999981999f, 0.999998212f,
0.753902256f, -0.599437475f, 0.764842212f, 0.975599885f, 0.997551024f, 0.999755025f, 0.999975502f, 0.999997556f,
-0.145500034f, -0.818632424f, 0.696706712f, 0.968170285f, 0.996801734f, 0.999680042f, 0.999967992f, 0.999996781f,
-0.91113025f, -0.956644177f, 0.621609926f, 0.959772646f, 0.995952725f, 0.999595046f, 0.999959528f, 0.999995947f,
-0.839071512f, -0.999786079f, 0.540302277f, 0.950415313f, 0.995004177f, 0.999500036f, 0.999949992f, 0.999994993f,
0.00442569796f, -0.943779767f, 0.453596085f, 0.940107584f, 0.993956089f, 0.999395072f, 0.999939501f, 0.99999392f,
0.843853951f, -0.79417938f, 0.362357706f, 0.92885989f, 0.99280864f, 0.999280095f, 0.999927998f, 0.999992788f,
0.907446802f, -0.565820515f, 0.267498761f, 0.916683376f, 0.99156189f, 0.999155104f, 0.999915481f, 0.999991536f,
0.136737213f, -0.28134948f, 0.16996716f, 0.903590262f, 0.990216017f, 0.999020159f, 0.99990201f, 0.999990225f,
-0.759687901f, 0.0310223512f, 0.070737198f, 0.889593601f, 0.988771081f, 0.998875201f, 0.999887526f, 0.999988735f,
-0.957659483f, 0.340318173f, -0.0291995462f, 0.87470746f, 0.987227261f, 0.998720288f, 0.999872029f, 0.999987185f,
-0.275163352f, 0.615864813f, -0.128844544f, 0.858946681f, 0.985584795f, 0.998555362f, 0.999855518f, 0.999985576f,
0.660316706f, 0.830336154f, -0.227202162f, 0.842327058f, 0.983843684f, 0.998380423f, 0.999837995f, 0.999983788f,
0.988704622f, 0.962463796f, -0.323289543f, 0.824865162f, 0.982004225f, 0.998195529f, 0.999819517f, 0.99998194f,
0.408082068f, 0.999144375f, -0.416146845f, 0.806578457f, 0.980066597f, 0.998000681f, 0.999800026f, 0.999979973f,
-0.547729254f, 0.936740458f, -0.504846215f, 0.787485182f, 0.97803092f, 0.99779582f, 0.999779522f, 0.999977946f,
-0.99996084f, 0.781440377f, -0.588501155f, 0.767604589f, 0.975897431f, 0.997581005f, 0.999758005f, 0.999975801f,
-0.53283304f, 0.548645258f, -0.666275978f, 0.746956408f, 0.97366637f, 0.997356176f, 0.999735534f, 0.999973536f,
0.424179018f, 0.261441678f, -0.737393796f, 0.725561321f, 0.971337974f, 0.997121394f, 0.99971199f, 0.999971211f,
0.991202831f, -0.0516893305f, -0.801143587f, 0.703440726f, 0.968912423f, 0.996876657f, 0.999687493f, 0.999968767f,
0.64691931f, -0.359694332f, -0.856888831f, 0.680616796f, 0.966389954f, 0.996621907f, 0.999662042f, 0.999966204f,
-0.292138815f, -0.632028639f, -0.904072165f, 0.6571123f, 0.963770926f, 0.996357203f, 0.999635518f, 0.999963522f,
-0.962605894f, -0.841684937f, -0.942222297f, 0.632950664f, 0.961055458f, 0.996082544f, 0.99960804f, 0.99996078f,
-0.748057544f, -0.967871487f, -0.970958173f, 0.608156204f, 0.958243906f, 0.995797932f, 0.999579549f, 0.999957979f,
0.154251456f, -0.998075247f, -0.989992499f, 0.582753658f, 0.955336511f, 0.995503366f, 0.999550045f, 0.999954998f,
0.914742351f, -0.929300308f, -0.999135137f, 0.556768358f, 0.95233357f, 0.995198846f, 0.999519527f, 0.999951959f,
0.83422339f, -0.768367112f, -0.998294771f, 0.53022635f, 0.949235439f, 0.994884372f, 0.999488056f, 0.9999488f,
-0.0132767474f, -0.531235278f, -0.987479806f, 0.503154159f, 0.946042359f, 0.994559944f, 0.999455571f, 0.999945521f,
-0.848570287f, -0.241421118f, -0.966798186f, 0.475578904f, 0.942754686f, 0.994225562f, 0.999422073f, 0.999942183f,
-0.903692186f, 0.0723346695f, -0.93645668f, 0.447528064f, 0.939372718f, 0.993881226f, 0.999387562f, 0.999938726f,
-0.127963692f, 0.378916174f, -0.896758378f, 0.419029742f, 0.935896814f, 0.993526995f, 0.999352098f, 0.99993521f,
0.765414059f, 0.647921681f, -0.848100007f, 0.39011243f, 0.93232733f, 0.993162811f, 0.99931556f, 0.999931574f,
0.955073655f, 0.852673113f, -0.790967762f, 0.360805035f, 0.928664625f, 0.992788672f, 0.999278069f, 0.999927819f,
0.266642928f, 0.972865343f, -0.72593224f, 0.331136853f, 0.924909055f, 0.99240464f, 0.999239624f, 0.999923944f,
-0.666938066f, 0.996578991f, -0.653643608f, 0.301137596f, 0.921060979f, 0.992010653f, 0.999200106f, 0.999920011f,
-0.987339258f, 0.921462357f, -0.574824035f, 0.270837069f, 0.917120814f, 0.991606772f, 0.999159634f, 0.999915957f,
-0.399985313f, 0.754965365f, -0.490260571f, 0.240265876f, 0.913088918f, 0.991192937f, 0.999118149f, 0.999911785f,
0.555113316f, 0.513598442f, -0.400799006f, 0.209454417f, 0.908965766f, 0.990769207f, 0.999075651f, 0.999907553f,
0.999843299f, 0.221298173f, -0.307332784f, 0.178433523f, 0.904751658f, 0.990335584f, 0.99903214f, 0.999903202f,
0.52532196f, -0.0929481089f, -0.210795805f, 0.147234216f, 0.90044713f, 0.989892066f, 0.998987675f, 0.999898732f,
-0.432177931f, -0.397976756f, -0.112152621f, 0.115887694f, 0.89605248f, 0.989438653f, 0.998942196f, 0.999894202f,
-0.992335498f, -0.663538277f, -0.0123883775f, 0.0844252855f, 0.891568303f, 0.988975346f, 0.998895705f, 0.999889553f,
-0.640144348f, -0.863296509f, 0.0874991715f, 0.0528784581f, 0.886994898f, 0.988502085f, 0.9988482f, 0.999884784f,
0.300592542f, -0.977442741f, 0.18651247f, 0.0212787576f, 0.882332861f, 0.98801899f, 0.998799741f, 0.999879956f,
0.964965999f, -0.994656444f, 0.2836622f, -0.0103422189f, 0.87758255f, 0.987526f, 0.998750269f, 0.999875009f,
0.742154181f, -0.913230121f, 0.377977669f, -0.0419528559f, 0.872744501f, 0.987023175f, 0.998699784f, 0.999869943f,
-0.162990779f, -0.741239965f, 0.468516916f, -0.0735215396f, 0.86781919f, 0.986510456f, 0.998648286f, 0.999864817f,
-0.918282807f, -0.495741814f, 0.554374516f, -0.105016708f, 0.862807095f, 0.985987842f, 0.998595834f, 0.999859571f,
-0.829309821f, -0.201079622f, 0.634692967f, -0.136406869f, 0.857708693f, 0.985455394f, 0.998542368f, 0.999854207f,
0.0221267566f, 0.113521777f, 0.708669782f, -0.167660639f, 0.852524519f, 0.984913111f, 0.99848789f, 0.999848783f,
0.853220105f, 0.416867077f, 0.775565803f, -0.198746875f, 0.847255111f, 0.984360933f, 0.998432398f, 0.99984318f,
0.899866819f, 0.678870201f, 0.834712923f, -0.22963427f, 0.841901004f, 0.983798921f, 0.998375952f, 0.999837577f,
0.119180135f, 0.873550534f, 0.885519624f, -0.260292053f, 0.836462677f, 0.983227074f, 0.998318493f, 0.999831796f,
-0.771080196f, 0.981602073f, 0.927478492f, -0.290689558f, 0.830940723f, 0.982645452f, 0.998260021f, 0.999825954f,
-0.952412963f, 0.992308319f, 0.960170269f, -0.3207964f, 0.825335622f, 0.982053936f, 0.998200536f, 0.999819994f,
-0.258101642f, 0.904607594f, 0.98326844f, -0.350582451f, 0.819648027f, 0.981452644f, 0.998140097f, 0.999813974f,
0.673507154f, 0.727198064f, 0.996542096f, -0.380017966f, 0.813878477f, 0.980841517f, 0.998078644f, 0.999807835f,
0.985896587f, 0.477671444f, 0.999858618f, -0.409073502f, 0.808027506f, 0.980220556f, 0.998016179f, 0.999801576f
};
__device__ const float ROPE_SIN[64][8] = {
0.0f, 0.0f, 0.0f, 0.0f, 0.0f, 0.0f, 0.0f, 0.0f,
0.841470957f, 0.310983598f, 0.0998334214f, 0.0316175036f, 0.00999983307f, 0.00316227227f, 0.000999999931f, 0.000316227757f,
0.909297407f, 0.591127098f, 0.198669329f, 0.0632033944f, 0.0199986659f, 0.00632451288f, 0.0019999987f, 0.000632455456f,
0.141120002f, 0.812648892f, 0.295520216f, 0.0947260857f, 0.0299954992f, 0.00948669016f, 0.0029999956f, 0.000948683126f,
-0.756802499f, 0.953580737f, 0.389418334f, 0.126154065f, 0.0399893336f, 0.0126487734f, 0.00399998948f, 0.00126491068f,
-0.958924294f, 0.999946535f, 0.47942555f, 0.157455876f, 0.0499791652f, 0.0158107281f, 0.0049999794f, 0.00158113812f,
-0.279415488f, 0.947148204f, 0.564642489f, 0.188600272f, 0.0599640049f, 0.0189725272f, 0.0059999642f, 0.00189736532f,
0.656986594f, 0.800421596f, 0.64421767f, 0.219556093f, 0.0699428469f, 0.0221341345f, 0.00699994294f, 0.00221359241f,
0.989358246f, 0.574317753f, 0.717356086f, 0.250292331f, 0.0799146891f, 0.0252955221f, 0.0079999147f, 0.00252981926f,
0.412118495f, 0.291259229f, 0.783326924f, 0.280778319f, 0.0898785442f, 0.0284566563f, 0.00899987947f, 0.00284604589f,
-0.54402113f, -0.0206835698f, 0.841470957f, 0.310983568f, 0.099833414f, 0.0316175036f, 0.009999834f, 0.00316227227f,
-0.999990225f, -0.33057496f, 0.891207397f, 0.340877861f, 0.1097783f, 0.0347780399f, 0.0109997792f, 0.00347849843f,
-0.536572933f, -0.60768342f, 0.932039082f, 0.370431304f, 0.119712204f, 0.0379382223f, 0.0119997123f, 0.00379472389f,
0.420167029f, -0.824528456f, 0.963558197f, 0.399614304f, 0.129634142f, 0.0410980321f, 0.0129996343f, 0.00411094911f,
0.990607381f, -0.959605396f, 0.985449731f, 0.428397775f, 0.139543116f, 0.0442574248f, 0.0139995432f, 0.00442717411f,
0.650287867f, -0.999518692f, 0.997494996f, 0.456752867f, 0.149438128f, 0.0474163815f, 0.0149994381f, 0.00474339863f,
-0.287903309f, -0.940310359f, 0.999573588f, 0.484651238f, 0.159318209f, 0.0505748577f, 0.015999319f, 0.00505962269f,
-0.961397469f, -0.78785187f, 0.991664827f, 0.512064993f, 0.169182345f, 0.0537328273f, 0.0169991814f, 0.00537584582f,
-0.750987232f, -0.557262897f, 0.973847628f, 0.538966715f, 0.179029569f, 0.0568902642f, 0.0179990288f, 0.00569206895f,
0.149877205f, -0.271410108f, 0.946300089f, 0.565329552f, 0.188858896f, 0.060047131f, 0.0189988576f, 0.00600829115f,
0.912945271f, 0.0413582884f, 0.909297407f, 0.591127038f, 0.198669314f, 0.0632033944f, 0.0199986678f, 0.00632451288f,
0.836655617f, 0.35002476f, 0.863209307f, 0.616333544f, 0.208459899f, 0.0663590282f, 0.0209984574f, 0.00664073415f,
-0.00885130931f, 0.623979926f, 0.808496356f, 0.640923738f, 0.218229622f, 0.0695140064f, 0.0219982266f, 0.00695695449f,
-0.846220434f, 0.836055279f, 0.745705247f, 0.664873064f, 0.227977514f, 0.0726682767f, 0.0229979735f, 0.00727317436f,
-0.905578375f, 0.965219259f, 0.67546314f, 0.688157499f, 0.237702623f, 0.0758218244f, 0.0239976961f, 0.0075893933f,
-0.132351756f, 0.998663187f, 0.598472118f, 0.710753918f, 0.247403964f, 0.0789746121f, 0.0249973964f, 0.00790561177f,
0.76255846f, 0.933070183f, 0.515501261f, 0.732639611f, 0.257080555f, 0.0821266174f, 0.0259970706f, 0.00822182931f,
0.956375957f, 0.774945021f, 0.427379847f, 0.753792703f, 0.266731411f, 0.0852777958f, 0.0269967206f, 0.00853804592f,
0.270905793f, 0.539968967f, 0.334988207f, 0.774192095f, 0.276355654f, 0.0884281173f, 0.0279963426f, 0.0088542616f,
-0.663633883f, 0.251445323f, 0.239249229f, 0.793817401f, 0.28595221f, 0.0915775672f, 0.0289959367f, 0.00917047635f,
-0.988031626f, -0.0620148405f, 0.141120002f, 0.812648892f, 0.295520186f, 0.0947260931f, 0.029995501f, 0.00948669016f,
-0.404037654f, -0.369325012f, 0.0415805206f, 0.830667794f, 0.305058628f, 0.0978736654f, 0.0309950355f, 0.00980290305f,
0.551426709f, -0.640009403f, -0.0583741926f, 0.847856104f, 0.314566553f, 0.101020269f, 0.0319945402f, 0.0101191159f,
0.999911845f, -0.847224355f, -0.157745644f, 0.864196658f, 0.324043006f, 0.10416586f, 0.0329940096f, 0.010435327f,
0.529082716f, -0.97042042f, -0.255541205f, 0.879673064f, 0.333487093f, 0.107310407f, 0.0339934528f, 0.010751537f,
-0.428182662f, -0.997380435f, -0.350783229f, 0.894269884f, 0.342897803f, 0.110453881f, 0.034992855f, 0.0110677453f,
-0.991778851f, -0.925431013f, -0.442520559f, 0.907972515f, 0.352274209f, 0.113596253f, 0.0359922275f, 0.0113839535f,
-0.643538117f, -0.761706948f, -0.529836178f, 0.920767248f, 0.361615449f, 0.116737492f, 0.036991559f, 0.0117001599f,
0.296368569f, -0.522444785f, -0.611857831f, 0.932641268f, 0.370920479f, 0.119877554f, 0.0379908569f, 0.0120163653f,
0.963795364f, -0.231372014f, -0.687766254f, 0.943582714f, 0.380188406f, 0.123016424f, 0.0389901139f, 0.0123325698f,
0.745113134f, 0.0826458037f, -0.756802499f, 0.953580678f, 0.389418334f, 0.126154065f, 0.0399893373f, 0.0126487734f,
-0.158622667f, 0.388467699f, -0.818277061f, 0.962625206f, 0.39860931f, 0.129290432f, 0.0409885161f, 0.0129649751f,
-0.916521549f, 0.655764699f, -0.871575892f, 0.970707119f, 0.407760441f, 0.132425532f, 0.0419876575f, 0.0132811759f,
-0.831774771f, 0.858030677f, -0.916166008f, 0.977818429f, 0.416870773f, 0.135559291f, 0.0429867506f, 0.0135973748f,
0.0177019257f, 0.975206196f, -0.951602101f, 0.983951986f, 0.425939471f, 0.138691694f, 0.0439858064f, 0.0139135728f,
0.850903511f, 0.995670974f, -0.977530122f, 0.989101648f, 0.434965521f, 0.141822711f, 0.0449848175f, 0.0142297689f,
0.901788354f, 0.917395473f, -0.993690968f, 0.993262351f, 0.44394809f, 0.144952312f, 0.0459837839f, 0.0145459641f,
0.123573124f, 0.748142362f, -0.999923289f, 0.996429801f, 0.452886283f, 0.148080453f, 0.0469827019f, 0.0148621574f,
-0.768254638f, 0.504697084f, -0.99616462f, 0.99860096f, 0.461779177f, 0.151207119f, 0.0479815714f, 0.0151783489f,
-0.953752637f, 0.211200655f, -0.982452571f, 0.999773562f, 0.470625877f, 0.15433228f, 0.0489803962f, 0.0154945394f,
-0.262374848f, -0.10324046f, -0.958924294f, 0.999946535f, 0.47942555f, 0.157455891f, 0.0499791689f, 0.0158107281f,
0.670229197f, -0.407444149f, -0.925814748f, 0.99911958f, 0.48817724f, 0.160577938f, 0.0509778969f, 0.0161269177f,
0.986627579f, -0.671240151f, -0.883454502f, 0.997293651f, 0.496880114f, 0.163698375f, 0.051976569f, 0.0164431017f,
0.395925164f, -0.868469954f, -0.832267344f, 0.994470477f, 0.505533338f, 0.166817173f, 0.0529751927f, 0.0167592876f,
-0.558789074f, -0.979574919f, -0.772764444f, 0.990652919f, 0.514135957f, 0.169934288f, 0.0539737605f, 0.0170754679f,
-0.999755144f, -0.993535519f, -0.705540299f, 0.985844791f, 0.522687256f, 0.173049718f, 0.0549722798f, 0.01739165f,
-0.521551013f, -0.908967435f, -0.631266713f, 0.980050862f, 0.531186223f, 0.17616342f, 0.0559707358f, 0.0177078284f,
0.436164767f, -0.734258294f, -0.550685287f, 0.973276973f, 0.539632022f, 0.179275364f, 0.0569691435f, 0.0180240069f,
0.992872655f, -0.486733496f, -0.464602023f, 0.965529919f, 0.548023939f, 0.182385504f, 0.0579674877f, 0.0183401816f,
0.636738002f, -0.190938011f, -0.373876572f, 0.956817448f, 0.55636102f, 0.185493827f, 0.0589657798f, 0.0186563563f,
-0.304810613f, 0.12379095f, -0.279415488f, 0.947148204f, 0.564642429f, 0.188600287f, 0.0599640086f, 0.0189725272f,
-0.966117799f, 0.426245421f, -0.182162598f, 0.936531842f, 0.572867453f, 0.191704854f, 0.0609621815f, 0.0192886982f,
-0.739180684f, 0.686427653f, -0.0830891207f, 0.924979091f, 0.581035137f, 0.194807529f, 0.0619602874f, 0.0196048655f,
0.167355701f, 0.878538549f, 0.0168140903f, 0.912501454f, 0.589144766f, 0.197908238f, 0.0629583374f, 0.0199210308f
};

struct Params { const float* in[41]; float* out; unsigned char* ws; };
enum { I_X = 0, I_C, I_CTX, I_CCTX, I_LNG, I_LNB, I_ADAW, I_ADAB, I_WIN, I_LQ1, I_LK1, I_LQ2, I_LK2, I_SUBLN, I_GW2, I_GGB, I_GNG, I_CONV, I_W2, I_W0, I_A2, I_A0, I_G2, I_KK, I_KA, I_RK,
       I_LNXG, I_LNXB, I_WOUT, I_LN1G, I_LN1B, I_RW, I_RB, I_MWG, I_MBG, I_MWU, I_MBU, I_MWD, I_MBD, I_LN2G, I_LN2B };

#define WSP(T, off) ((T*)(p.ws + (off)))
#define SCRP(T, off) ((T*)(p.ws + WS_SCR + (off)))

template <bool F8 = false>
__device__ __forceinline__ void conv_tile(const float* __restrict__ src, int ld, int nvalid, int k0, int n0, bf16_t* __restrict__ dst, int rs, int ro, LAS float* tile, int tid) {
    {
        const int k = tid >> 3, n8 = (tid & 7) * 8;
        const float* s = src + (size_t)(k0 + k) * ld + n0 + n8;
        f32x4 a[4], b[4];
#pragma unroll
        for (int q = 0; q < 4; ++q) { a[q] = (f32x4){0.f, 0.f, 0.f, 0.f}; b[q] = a[q];
            if (n0 + q * 64 + n8 + 8 <= nvalid) { a[q] = *(const f32x4*)(s + q * 64); b[q] = *(const f32x4*)(s + q * 64 + 4); } }
#pragma unroll
        for (int q = 0; q < 4; ++q) { LAS float* t = tile + k * 261 + q * 65 + n8;
            t[0] = a[q][0]; t[1] = a[q][1]; t[2] = a[q][2]; t[3] = a[q][3]; t[4] = b[q][0]; t[5] = b[q][1]; t[6] = b[q][2]; t[7] = b[q][3]; }
    }
    __syncthreads();
    {
        const int n = tid >> 3, k8 = (tid & 7) * 8;
#pragma unroll
        for (int q = 0; q < 4; ++q) { const LAS float* t = tile + k8 * 261 + q * 65 + n;
            if constexpr (F8) { u32x2 o; o.x = pk4_fp8(32.f * t[0], 32.f * t[261], 32.f * t[522], 32.f * t[783]); o.y = pk4_fp8(32.f * t[1044], 32.f * t[1305], 32.f * t[1566], 32.f * t[1827]);
                *(u32x2*)((unsigned char*)dst + ((size_t)(n0 + q * 64 + n) * rs + ro) * 1024 + k0 + k8) = o; }
            else { u32x4 o; o.x = pk2(t[0], t[261]); o.y = pk2(t[522], t[783]); o.z = pk2(t[1044], t[1305]); o.w = pk2(t[1566], t[1827]);
                *(u32x4*)(dst + ((size_t)(n0 + q * 64 + n) * rs + ro) * 1024 + k0 + k8) = o; } }
    }
    __syncthreads();
}
constexpr int JW_IN = 16 * 14, JW_OUT = 64, JW_LAYER = JW_IN + JW_OUT + 32 * 192, JW_TOTAL = 2 * JW_LAYER, J_MOD = 192;
__device__ __forceinline__ void conv_job(const Params& p, int j, LAS float* tile, int tid) {
    asm volatile("" : "+v"(tid));
    const int l = j / JW_LAYER; int r = j % JW_LAYER;
    if (r < JW_IN) { const int kt = r / 14, nt = r % 14;
        conv_tile(p.in[I_WIN] + (size_t)l * 1024 * DIN, DIN, DIN, kt * 64, nt * 256, WSP(bf16_t, WS_WIN) + (size_t)l * DINP * 1024, 1, 0, tile, tid); return; }
    r -= JW_IN;
    if (r < JW_OUT) { const int kt = r >> 2, nt = r & 3;
        conv_tile(p.in[I_WOUT] + (size_t)l * 1024 * 1024, 1024, 1024, kt * 64, nt * 256, WSP(bf16_t, WS_WOUT) + (size_t)l * 1024 * 1024, 1, 0, tile, tid); return; }
    r -= JW_OUT;
    const int e = r / 192, q = r % 192, which = q >> 6, t = q & 63, kt = t >> 2, nt = t & 3;
    const size_t eo = (size_t)(l * 32 + e) * 1024 * 1024;
    if (which == 0) conv_tile<true>(p.in[I_MWG] + eo, 1024, 1024, kt * 64, nt * 256, (bf16_t*)(WSP(unsigned char, WS_WGU) + 2 * eo), 2, 0, tile, tid);
    else if (which == 1) conv_tile<true>(p.in[I_MWU] + eo, 1024, 1024, kt * 64, nt * 256, (bf16_t*)(WSP(unsigned char, WS_WGU) + 2 * eo), 2, 1, tile, tid);
    else conv_tile<true>(p.in[I_MWD] + eo, 1024, 1024, kt * 64, nt * 256, (bf16_t*)(WSP(unsigned char, WS_WDN) + eo), 1, 0, tile, tid);
}
__device__ __forceinline__ void mod_job(const Params& p, int job, LAS float* lds, int tid) {
    asm volatile("" : "+v"(tid));
    const int l = job / 96, c0 = (job % 96) * 64;
    LAS float* sv = lds;
    LAS float* part = lds + 5120;
    for (int i = tid; i < 5120; i += NTHR) { const int s = i >> 10, k = i & 1023; const float cv = s < 4 ? p.in[I_C][s * 1024 + k] : p.in[I_CCTX][k]; sv[i] = siluf_(cv); }
    __syncthreads();
    const int n = tid & 63, kh = tid >> 6;
    const float* w = p.in[I_ADAW] + (size_t)l * 1024 * 6144 + (size_t)(kh * 128) * 6144 + c0 + n;
    float a0 = 0.f, a1 = 0.f, a2 = 0.f, a3 = 0.f, a4 = 0.f;
    const LAS float* s0 = sv + kh * 128;
#pragma unroll 16
    for (int k = 0; k < 128; ++k) { const float wv = w[(size_t)k * 6144];
        a0 += s0[k] * wv; a1 += s0[1024 + k] * wv; a2 += s0[2048 + k] * wv; a3 += s0[3072 + k] * wv; a4 += s0[4096 + k] * wv; }
    part[(kh * 5 + 0) * 64 + n] = a0; part[(kh * 5 + 1) * 64 + n] = a1; part[(kh * 5 + 2) * 64 + n] = a2; part[(kh * 5 + 3) * 64 + n] = a3; part[(kh * 5 + 4) * 64 + n] = a4;
    __syncthreads();
    if (tid < 320) { const int s = tid >> 6, nn = tid & 63; float acc = p.in[I_ADAB][l * 6144 + c0 + nn];
#pragma unroll
        for (int q = 0; q < 8; ++q) acc += part[(q * 5 + s) * 64 + nn];
        WSP(float, WS_MOD)[(size_t)(l * 5 + s) * 6144 + c0 + nn] = acc; }
    __syncthreads();
}

__device__ __forceinline__ void ln_in_rows(const Params& p, int gw, int ngw, int lane) {
    bf16_t* H = WSP(bf16_t, WS_H);        bf16_t* XM = WSP(bf16_t, WS_XM); const float* MOD = WSP(float, WS_MOD);
    const float* const xin = p.in[I_X]; const float* const cin = p.in[I_CTX];
    f32x4 nv[4];
#define LNI_PRE(rw_) do { const float* s_ = (rw_) < NLAT ? xin + (size_t)(rw_) * D : cin + (size_t)((rw_) - NLAT) * D; _Pragma("unroll") for (int j = 0; j < 4; ++j) nv[j] = *(const f32x4*)(s_ + lane * 4 + 256 * j); } while (0)
    if (gw < NTOK) LNI_PRE(gw);
    for (int row = gw; row < NTOK; row += ngw) {
        f32x4 v[4]; float s = 0.f;
#pragma unroll
        for (int j = 0; j < 4; ++j) { v[j] = nv[j]; s += (v[j][0] + v[j][1]) + (v[j][2] + v[j][3]); }
        if (row + ngw < NTOK) LNI_PRE(row + ngw);
        const float mean = wave_sum(s) * (1.f / D); float s2 = 0.f;
#pragma unroll
        for (int j = 0; j < 4; ++j) { v[j] = v[j] - mean; s2 += (v[j][0] * v[j][0] + v[j][1] * v[j][1]) + (v[j][2] * v[j][2] + v[j][3] * v[j][3]); }
        const float rstd = rsqrtf(wave_sum(s2) * (1.f / D) + LN_EPS);
        const int sidx = row < NLAT ? (row >> 12) : 4; const float* mod = MOD + (size_t)sidx * 6144;
#pragma unroll
        for (int j = 0; j < 4; ++j) { const int c = lane * 4 + 256 * j;
            const f32x4 g = *(const f32x4*)(p.in[I_LNG] + c), bb = *(const f32x4*)(p.in[I_LNB] + c);
            const f32x4 y = v[j] * rstd * g + bb;
            { u32x2 hb; hb.x = pk2(y[0], y[1]); hb.y = pk2(y[2], y[3]); *(u32x2*)(H + (size_t)row * D + c) = hb; }
            const f32x4 sh = *(const f32x4*)(mod + c), sc = *(const f32x4*)(mod + 1024 + c);
            const f32x4 xm = y * (sc + 1.f) + sh;
            u32x2 o; o.x = pk2(xm[0], xm[1]); o.y = pk2(xm[2], xm[3]);
            *(u32x2*)(XM + (size_t)row * D + c) = o; }
    }
#undef LNI_PRE
}

__device__ __forceinline__ void unpack8(const u32x4 u, float (&f)[8]) {
    f[0] = bflo(u.x); f[1] = bfhi(u.x); f[2] = bflo(u.y); f[3] = bfhi(u.y); f[4] = bflo(u.z); f[5] = bfhi(u.z); f[6] = bflo(u.w); f[7] = bfhi(u.w);
}
__device__ __forceinline__ void da_job(const Params& p, int l, int b, int kt2, LAS unsigned char* lds, int tid) {
    asm volatile("" : "+v"(tid));
    LAS bf16_t* kvt = (LAS bf16_t*)lds;
    const bf16_t* Z = WSP(bf16_t, WS_Z);
    const bool isctx = kt2 < 2;
    const int rowb = isctx ? NLAT + b * 256 + kt2 * 128 : b * 4096 + (kt2 - 2) * 128;
    { u32x4 v_[16];
#pragma unroll
      for (int q = 0; q < 16; ++q) { const int i = tid + q * NTHR, r = i >> 6, c16 = i & 63; v_[q] = *(const u32x4*)(Z + (size_t)(rowb + r) * DINP + ZK + c16 * 8); }
#pragma unroll
      for (int q = 0; q < 16; ++q) { const int i = tid + q * NTHR, r = i >> 6, c16 = i & 63; *(LAS u32x4*)(kvt + r * 512 + c16 * 8) = v_[q]; } }
    __syncthreads();
    const int w = tid >> 6, L = tid & 63, fr = L & 15, fq = L >> 4;
    unsigned char* rec = SCRP(unsigned char, SC_KVREC);
    unsigned* kmax = WSP(unsigned, WS_CTL) + CW_KMAX + l * 32;
    LAS unsigned* nm = (LAS unsigned*)(lds + LDS_CTL_OFF + 128);
    for (int t2 = 0; t2 < 4; ++t2) { const int kt = kt2 * 4 + t2;
      float rc[8], rs_[8];
      { const int key_ = t2 * 32 + (w & 1) * 16 + fr, t_ = (kt2 - 2) * 128 + key_, pos_ = (fq >> 1) ? (t_ & 63) : (t_ >> 6); const bool need = w < 4 && !isctx;
#pragma unroll
        for (int i = 0; i < 8; ++i) { rc[i] = need ? ROPE_COS[pos_][i] : 1.f; rs_[i] = need ? ROPE_SIN[pos_][i] : 0.f; } }
      for (int h = 0; h < 4; ++h) {
        u32x4 o;
        if (w < 4) {
            const int m = w >> 1, ks = w & 1, key = t2 * 32 + ks * 16 + fr;
            float ov[8], pv[8];
            unpack8(*(const LAS u32x4*)(kvt + key * 512 + h * 64 + m * 32 + fq * 8), ov);
            unpack8(*(const LAS u32x4*)(kvt + key * 512 + h * 64 + m * 32 + (fq ^ 1) * 8), pv);
            if (!isctx) {
                const float sg = (fq & 1) ? 1.f : -1.f;
#pragma unroll
                for (int i = 0; i < 8; ++i) ov[i] = ov[i] * rc[i] + sg * pv[i] * rs_[i];
            }
            o.x = pk2(ov[0], ov[1]); o.y = pk2(ov[2], ov[3]); o.z = pk2(ov[4], ov[5]); o.w = pk2(ov[6], ov[7]);
            float rv[8]; unpack8(o, rv); float n2 = 0.f;
#pragma unroll
            for (int i = 0; i < 8; ++i) n2 += rv[i] * rv[i];
            n2 += __shfl_xor(n2, 16); n2 += __shfl_xor(n2, 32);
#pragma unroll
            for (int x = 1; x < 16; x <<= 1) n2 = fmaxf(n2, __shfl_xor(n2, x));
            if (L == 0) __hip_atomic_fetch_max(nm + h * 2 + m, __builtin_bit_cast(unsigned, n2), __ATOMIC_RELAXED, __HIP_MEMORY_SCOPE_WORKGROUP);
        } else {
            const int et = w - 4; unsigned short vv[8];
#pragma unroll
            for (int i = 0; i < 8; ++i) { const int key = t2 * 32 + ((i < 4) ? fq * 4 + i : 16 + fq * 4 + (i - 4)); vv[i] = kvt[key * 512 + 256 + h * 64 + et * 16 + fr]; }
            o.x = vv[0] | ((unsigned)vv[1] << 16); o.y = vv[2] | ((unsigned)vv[3] << 16); o.z = vv[4] | ((unsigned)vv[5] << 16); o.w = vv[6] | ((unsigned)vv[7] << 16);
        }
        *(u32x4*)(rec + ((size_t)((b * 4 + h) * NKT + kt)) * 8192 + w * 1024 + L * 16) = o;
      }
    }
    __syncthreads();
    if (tid < 8) { const unsigned nb = nm[tid]; nm[tid] = 0u; unsigned* kp = kmax + b * 8 + tid;
        if (nb > __hip_atomic_load(kp, __ATOMIC_RELAXED, __HIP_MEMORY_SCOPE_AGENT)) atomicMax(kp, nb); }
}

__device__ __forceinline__ int chunk_row0(int cid) { return cid < 256 ? (cid >> 6) * 4096 + (cid & 63) * 64 : NLAT + ((cid - 256) >> 2) * 256 + ((cid - 256) & 3) * 64; }

constexpr int GLA_HL = 43264;
__device__ __forceinline__ void gla_job(const Params& p, int l, int cid, int hb, LAS unsigned char* lds, int tid) {
    asm volatile("" : "+v"(tid));
    const int r0 = chunk_row0(cid), w = tid >> 6, lane = tid & 63, fr = lane & 15, fq = lane >> 4;
    const bf16_t* Z = WSP(bf16_t, WS_Z);
#define GLA_PTRS(hh) LAS float* gi = (LAS float*)(lds + (hh) * GLA_HL); LAS float* GT = gi + 2048; LAS bf16_t* KDT = (LAS bf16_t*)(GT + 2 * 32 * 65); LAS bf16_t* Vt = KDT + 2 * 32 * 72; (void)gi; (void)GT; (void)KDT; (void)Vt;
    LAS bf16_t* KRAW = (LAS bf16_t*)(lds + 3 * GLA_HL + 13056);
    if (tid < 256) { const int pp = tid >> 2, k8 = (tid & 3) * 8;
#pragma unroll
        for (int hh = 0; hh < 3; ++hh) *(LAS u32x4*)(KRAW + (hh * 64 + pp) * 32 + k8) = *(const u32x4*)(Z + (size_t)(r0 + pp) * DINP + ZGK + (hb + hh) * 32 + k8); }
#pragma unroll 1
    for (int hh = 0; hh < 3; ++hh) { const int h = hb + hh; GLA_PTRS(hh)
        if (tid < 256) { const int pp = tid >> 2, k8 = (tid & 3) * 8; float v[8]; unpack8(*(const u32x4*)(Z + (size_t)(r0 + pp) * DINP + ZGF + k8), v);
            *(LAS f32x4*)(gi + pp * 32 + k8) = (f32x4){v[0], v[1], v[2], v[3]}; *(LAS f32x4*)(gi + pp * 32 + k8 + 4) = (f32x4){v[4], v[5], v[6], v[7]}; }
        { const int pp = tid >> 3, v8 = (tid & 7) * 8; const u32x4 u = *(const u32x4*)(Z + (size_t)(r0 + pp) * DINP + ZGV + h * 64 + v8);
          Vt[(v8 + 0) * 72 + pp] = (bf16_t)(u.x & 0xffffu); Vt[(v8 + 1) * 72 + pp] = (bf16_t)(u.x >> 16); Vt[(v8 + 2) * 72 + pp] = (bf16_t)(u.y & 0xffffu); Vt[(v8 + 3) * 72 + pp] = (bf16_t)(u.y >> 16);
          Vt[(v8 + 4) * 72 + pp] = (bf16_t)(u.z & 0xffffu); Vt[(v8 + 5) * 72 + pp] = (bf16_t)(u.z >> 16); Vt[(v8 + 6) * 72 + pp] = (bf16_t)(u.w & 0xffffu); Vt[(v8 + 7) * 72 + pp] = (bf16_t)(u.w >> 16); } }
    LAS float* gwl = (LAS float*)(lds + 3 * GLA_HL);
    { float gv[7];
      const float* gw2p = p.in[I_GW2]; const float* ggbp = p.in[I_GGB];
#pragma unroll
      for (int q = 0; q < 7; ++q) { const int i = tid + q * NTHR; const int dir = i / (17 * 96), r = (i / 96) % 17, c = i % 96; gv[q] = 0.f;
          if (i < 2 * 17 * 96) { const float* src = r < 16 ? gw2p + ((size_t)(l * 2 + dir) * 16 + r) * 192 + hb * 32 + c : ggbp + (size_t)(l * 2 + dir) * 192 + hb * 32 + c; gv[q] = *src; } }
#pragma unroll
      for (int q = 0; q < 7; ++q) { const int i = tid + q * NTHR; if (i < 2 * 17 * 96) gwl[i] = gv[q]; } }
    __syncthreads();
#pragma unroll 1
    for (int hh = 0; hh < 3; ++hh) { GLA_PTRS(hh)
#pragma unroll
        for (int q = 0; q < 2; ++q) { const int idx = w * 2 + q, dir = idx >> 3, mt = (idx >> 1) & 3, nt = idx & 1, kc = hh * 32 + nt * 16 + fr;
            const float bias = gwl[(dir * 17 + 16) * 96 + kc];
            f32x4 acc = {bias, bias, bias, bias};
            const f32x4 a = *(const LAS f32x4*)(gi + (mt * 16 + fr) * 32 + dir * 16 + fq * 4);
#pragma unroll
            for (int s = 0; s < 4; ++s) acc = __builtin_amdgcn_mfma_f32_16x16x4f32(a[s], gwl[(dir * 17 + fq * 4 + s) * 96 + kc], acc, 0, 0, 0);
#pragma unroll
            for (int j = 0; j < 4; ++j) { const float x = acc[j]; GT[(dir * 32 + nt * 16 + fr) * 65 + mt * 16 + fq * 4 + j] = (fminf(x, 0.f) - __logf(1.f + __expf(-fabsf(x)))) * (1.f / 16.f); } } }
    __syncthreads();
#pragma unroll 1
    for (int hh = 0; hh < 3; ++hh) { GLA_PTRS(hh)
#pragma unroll
        for (int c = 0; c < 8; ++c) { const int col = w * 8 + c, dir = col >> 5, pp = dir ? 63 - lane : lane; float x = GT[col * 65 + pp];
            x += __builtin_bit_cast(float, __builtin_amdgcn_update_dpp(0, __builtin_bit_cast(int, x), 0x111, 0xF, 0xF, false));
            x += __builtin_bit_cast(float, __builtin_amdgcn_update_dpp(0, __builtin_bit_cast(int, x), 0x112, 0xF, 0xF, false));
            x += __builtin_bit_cast(float, __builtin_amdgcn_update_dpp(0, __builtin_bit_cast(int, x), 0x114, 0xF, 0xF, false));
            x += __builtin_bit_cast(float, __builtin_amdgcn_update_dpp(0, __builtin_bit_cast(int, x), 0x118, 0xF, 0xF, false));
            x += __builtin_bit_cast(float, __builtin_amdgcn_update_dpp(0, __builtin_bit_cast(int, x), 0x142, 0xA, 0xF, false));
            x += __builtin_bit_cast(float, __builtin_amdgcn_update_dpp(0, __builtin_bit_cast(int, x), 0x143, 0xC, 0xF, false));
            GT[col * 65 + pp] = x; } }
    __syncthreads();
    float* GBF = SCRP(float, SC_GBF); float* GBB = SCRP(float, SC_GBB);
#pragma unroll 1
    for (int hh = 0; hh < 3; ++hh) { const int h = hb + hh; GLA_PTRS(hh)
        for (int i = tid; i < 4096; i += NTHR) { const int dir = i >> 11, pp = (i >> 5) & 63, k = i & 31; const float bb = GT[(dir * 32 + k) * 65 + pp];
            (dir ? GBB : GBF)[(size_t)(r0 + pp) * 192 + h * 32 + k] = bb;
            const float kk = bf2f(KRAW[(hh * 64 + pp) * 32 + k]);
            KDT[(dir * 32 + k) * 72 + pp] = (bf16_t)f2bf(kk * __expf(GT[(dir * 32 + k) * 65 + (dir ? 0 : 63)] - bb)); } }
    __syncthreads();
    float* KVC = SCRP(float, SC_KVC); float* DC = SCRP(float, SC_DC);
#pragma unroll 1
    for (int hh = 0; hh < 3; ++hh) { const int h = hb + hh; GLA_PTRS(hh)
#pragma unroll
        for (int q = 0; q < 2; ++q) { const int idx = w * 2 + q, dir = idx >> 3, mt = (idx >> 2) & 1, nt = idx & 3;
            f32x4 acc = {0.f, 0.f, 0.f, 0.f};
#pragma unroll
            for (int ks = 0; ks < 2; ++ks) { const bf16x8 a = *(const LAS bf16x8*)(KDT + (dir * 32 + mt * 16 + fr) * 72 + ks * 32 + fq * 8), b = *(const LAS bf16x8*)(Vt + (nt * 16 + fr) * 72 + ks * 32 + fq * 8);
                acc = __builtin_amdgcn_mfma_f32_16x16x32_bf16(a, b, acc, 0, 0, 0); }
            float* dst = KVC + ((size_t)((cid * 6 + h) * 2 + dir)) * 2048;
#pragma unroll
            for (int j = 0; j < 4; ++j) dst[(mt * 16 + fq * 4 + j) * 64 + nt * 16 + fr] = acc[j]; }
        if (tid < 64) { const int dir = tid >> 5, k = tid & 31; DC[((cid * 6 + h) * 2 + dir) * 32 + k] = __expf(GT[(dir * 32 + k) * 65 + (dir ? 0 : 63)]); } }
#undef GLA_PTRS
    __syncthreads();
}

constexpr int SGS = 136;
#ifndef TPH
#define TPH -1
#endif
#define TB2_(id) do { if (TPH == (id)) tph_t0 = __builtin_amdgcn_s_memrealtime(); } while (0)
#define TE2_(id) do { if (TPH == (id)) tph_acc += __builtin_amdgcn_s_memrealtime() - tph_t0; } while (0)
__device__ __forceinline__ void rw_job(const Params& p, int l, int tt, LAS unsigned char* lds, int tid, unsigned long long& tph_t0, unsigned long long& tph_acc) {
    asm volatile("" : "+v"(tid));
    const int r0 = tt < 512 ? tt * 32 : NLAT + (tt - 512) * 32;
    const int pos = tt < 512 ? (r0 & 4095) : ((r0 - NLAT) & 255), slen = tt < 512 ? 4096 : 256;
    const bool has_prev = pos > 0, has_next = pos + 32 < slen;
    TB2_(40);
    const bf16_t* Z = WSP(bf16_t, WS_Z);
    LAS bf16_t* rkv = (LAS bf16_t*)lds;
    LAS bf16_t* XW = (LAS bf16_t*)(lds + 78336);
    LAS bf16_t* XG = XW + 4 * 32 * 72;
    { u32x4 rv_[10];
#pragma unroll
      for (int q = 0; q < 10; ++q) { const int i = tid + q * NTHR; const int rr = i / 144, c16 = i % 144; const bool ok = i < 34 * 144 && (rr == 0 ? has_prev : (rr == 33 ? has_next : true));
          rv_[q] = (u32x4){0u, 0u, 0u, 0u}; if (ok) rv_[q] = *(const u32x4*)(Z + (size_t)(r0 - 1 + rr) * DINP + ZRKV + c16 * 8); }
#pragma unroll
      for (int q = 0; q < 10; ++q) { const int i = tid + q * NTHR; if (i < 34 * 144) *(LAS u32x4*)(rkv + (i / 144) * 1152 + (i % 144) * 8) = rv_[q]; } }
    for (int i = tid; i < 32 * 48; i += NTHR) { const int t = i / 48, c = (i % 48) * 8; float v[8]; unpack8(*(const u32x4*)(Z + (size_t)(r0 + t) * DINP + ZWF + c), v);
        if (c < 128) {
#pragma unroll
            for (int q = 0; q < 8; ++q) v[q] = tanhf_(v[q]); }
        else if (c >= 256) {
#pragma unroll
            for (int q = 0; q < 8; ++q) v[q] = sigmoidf_(v[q]); }
        u32x4 o; o.x = pk2(v[0], v[1]); o.y = pk2(v[2], v[3]); o.z = pk2(v[4], v[5]); o.w = pk2(v[6], v[7]);
        if (c < 256) *(LAS u32x4*)(XW + ((c >> 6) * 32 + t) * 72 + (c & 63)) = o; else *(LAS u32x4*)(XG + t * SGS + (c - 256)) = o; }
    __syncthreads(); TE2_(40); TB2_(41);
    LAS float* PRM = (LAS float*)(XG + 32 * SGS);
    { float pv_[12];
      const float* cwp = p.in[I_CONV] + (size_t)l * 3 * 1152; const float* kkp = p.in[I_KK] + l * 384; const float* kap = p.in[I_KA] + l * 384; const float* rkp = p.in[I_RK] + l * 384;
      const float* w0p = p.in[I_W0] + (size_t)l * 2 * 384; const float* a0p = p.in[I_A0] + (size_t)l * 2 * 384;
#pragma unroll
      for (int q = 0; q < 12; ++q) { const int i = tid + q * NTHR, r = i / 384, c = i % 384;
          const float* src = r < 9 ? cwp + (r % 3) * 1152 + (r / 3) * 384 + c : (r == 9 ? kkp + c : (r == 10 ? kap + c : (r == 11 ? rkp + c : (r < 14 ? w0p + (r - 12) * 384 + c : a0p + (r - 14) * 384 + c))));
          pv_[q] = *src; }
#pragma unroll
      for (int q = 0; q < 12; ++q) PRM[tid + q * NTHR] = pv_[q]; }
    __syncthreads(); TE2_(41); TB2_(42);
    const int h = tid >> 6, lane = tid & 63, fr = lane & 15, fq = lane >> 4;
    if (h < 6) {
        const bf16_t* WT = WSP(bf16_t, WS_RWW) + (size_t)l * RWW_LAYER;
        bf16_t* Rg = SCRP(bf16_t, SC_R); bf16_t* KKg = SCRP(bf16_t, SC_KK); bf16_t* Vg = SCRP(bf16_t, SC_V); bf16_t* Gg = SCRP(bf16_t, SC_G); float* BON = SCRP(float, SC_BON);
        bf16_t* BKF = SCRP(bf16_t, SC_BKF); bf16_t* BKB = SCRP(bf16_t, SC_BKB); bf16_t* KMF = SCRP(bf16_t, SC_KMF); bf16_t* KMB = SCRP(bf16_t, SC_KMB);
        float* LWF = SCRP(float, SC_WF); float* LWB = SCRP(float, SC_WB);
#define CONV3(t, off, c, w0, w1, w2) (bf2f(rkv[(t) * 1152 + (off) + (c)]) * (w0) + bf2f(rkv[((t) + 1) * 1152 + (off) + (c)]) * (w1) + bf2f(rkv[((t) + 2) * 1152 + (off) + (c)]) * (w2))
        LAS float* invl = PRM + 16 * 384 + h * 64;
#pragma unroll
        for (int mt = 0; mt < 2; ++mt) { float ss[4] = {0.f, 0.f, 0.f, 0.f};
#pragma unroll
            for (int nt = 0; nt < 4; ++nt) { const int c = h * 64 + nt * 16 + fr; const float ck0 = PRM[3 * 384 + c], ck1 = PRM[4 * 384 + c], ck2 = PRM[5 * 384 + c], kkw = PRM[9 * 384 + c];
#pragma unroll
                for (int j = 0; j < 4; ++j) { const int t = mt * 16 + fq * 4 + j; const float kr = CONV3(t, 384, c, ck0, ck1, ck2) * kkw; ss[j] += kr * kr; } }
#pragma unroll
            for (int j = 0; j < 4; ++j) { const float iv = 1.f / fmaxf(sqrtf(red16(ss[j])), 1e-12f); if (fr == 0) { invl[mt * 16 + fq * 4 + j] = iv; invl[32 + mt * 16 + fq * 4 + j] = 0.f; } } }
        TE2_(42); TB2_(43);
#pragma unroll 1
        for (int np = 0; np < 2; ++np) {
            bf16x8 bw[2][4][2], bg[2][4];
#pragma unroll
            for (int q = 0; q < 2; ++q) { const int c = h * 64 + (np * 2 + q) * 16 + fr;
#pragma unroll
                for (int m = 0; m < 4; ++m)
#pragma unroll
                    for (int ks = 0; ks < 2; ++ks) bw[q][m][ks] = *(const bf16x8*)(WT + (size_t)m * 384 * 64 + (size_t)c * 64 + ks * 32 + fq * 8);
#pragma unroll
                for (int ks = 0; ks < 4; ++ks) bg[q][ks] = *(const bf16x8*)(WT + (size_t)4 * 384 * 64 + (size_t)c * 128 + ks * 32 + fq * 8); }
#pragma unroll 1
            for (int mt = 0; mt < 2; ++mt) {
                bf16x8 ax[4][2], ag[4];
#pragma unroll
                for (int m = 0; m < 4; ++m)
#pragma unroll
                    for (int ks = 0; ks < 2; ++ks) ax[m][ks] = *(const LAS bf16x8*)(XW + ((m * 32 + mt * 16 + fr) * 72) + ks * 32 + fq * 8);
#pragma unroll
                for (int ks = 0; ks < 4; ++ks) ag[ks] = *(const LAS bf16x8*)(XG + (mt * 16 + fr) * SGS + ks * 32 + fq * 8);
#pragma unroll
                for (int q = 0; q < 2; ++q) { const int c = h * 64 + (np * 2 + q) * 16 + fr;
                    f32x4 acc[5];
#pragma unroll
                    for (int m = 0; m < 5; ++m) acc[m] = (f32x4){0.f, 0.f, 0.f, 0.f};
#pragma unroll
                    for (int m = 0; m < 4; ++m)
#pragma unroll
                        for (int ks = 0; ks < 2; ++ks) acc[m] = __builtin_amdgcn_mfma_f32_16x16x32_bf16(ax[m][ks], bw[q][m][ks], acc[m], 0, 0, 0);
#pragma unroll
                    for (int ks = 0; ks < 4; ++ks) acc[4] = __builtin_amdgcn_mfma_f32_16x16x32_bf16(ag[ks], bg[q][ks], acc[4], 0, 0, 0);
                    const float cr0 = PRM[c], cr1 = PRM[384 + c], cr2 = PRM[768 + c], ck0 = PRM[3 * 384 + c], ck1 = PRM[4 * 384 + c], ck2 = PRM[5 * 384 + c], cv0 = PRM[6 * 384 + c], cv1 = PRM[7 * 384 + c], cv2 = PRM[8 * 384 + c];
                    const float kkw = PRM[9 * 384 + c], kaw = PRM[10 * 384 + c], rkw = PRM[11 * 384 + c], w0f = PRM[12 * 384 + c], w0b = PRM[13 * 384 + c], a0f = PRM[14 * 384 + c], a0b = PRM[15 * 384 + c];
#pragma unroll
                    for (int j = 0; j < 4; ++j) { const int t = mt * 16 + fq * 4 + j; const unsigned ob = ((unsigned)(r0 + t) * 384u + (unsigned)c) * 2u;
#define ST2(P_, val_) (*(bf16_t*)((unsigned char*)(P_) + ob) = (bf16_t)f2bf(val_))
                        const float r = CONV3(t, 0, c, cr0, cr1, cr2), v = CONV3(t, 768, c, cv0, cv1, cv2), k = CONV3(t, 384, c, ck0, ck1, ck2), kkn = k * kkw * invl[t];
                        const float af = sigmoidf_(a0f + acc[2][j]), ab = sigmoidf_(a0b + acc[3][j]);
                        const float kmf = k * (1.f + (af - 1.f) * kaw), kmb = k * (1.f + (ab - 1.f) * kaw);
                        ST2(Rg, r); ST2(Vg, v); ST2(KKg, kkn);
                        ST2(BKF, kkn * af); ST2(BKB, kkn * ab); ST2(KMF, kmf); ST2(KMB, kmb);
                        *(float*)((unsigned char*)LWF + 2u * ob) = -0.6065306597f * sigmoidf_(w0f + acc[0][j]); *(float*)((unsigned char*)LWB + 2u * ob) = -0.6065306597f * sigmoidf_(w0b + acc[1][j]);
                        ST2(Gg, acc[4][j]);
#undef ST2
                        const float bv = red16(r * (kmf + kmb) * rkw); if (fr == 0) invl[32 + t] += bv; } }
            }
        }
        if (lane < 32) BON[(size_t)(r0 + lane) * 8 + h] = invl[32 + lane];
#undef CONV3
    }
    __syncthreads(); TE2_(43);
}

__device__ __forceinline__ int chain_chunk(int b, int dir, int step) {
    if (step < 4) return 256 + b * 4 + (dir ? 3 - step : step);
    const int cl = step - 4; return b * 64 + (dir ? 63 - cl : cl);
}
__device__ __forceinline__ void g2_job(const Params& p, int job, int tid) {
    asm volatile("" : "+v"(tid));
    const int chain = job >> 2, q = job & 3, b = chain / 12, h = (chain % 12) >> 1, dir = chain & 1, e = q * 512 + tid, k = e >> 6;
    const float* __restrict__ KVC = SCRP(float, SC_KVC); const float* __restrict__ DC = SCRP(float, SC_DC); float* __restrict__ SC = SCRP(float, SC_SC);
    float S = 0.f;
#pragma unroll 1
    for (int s0 = 0; s0 < 68; s0 += 34) {
        float dv[34], kv[34];
#pragma unroll
        for (int u = 0; u < 34; ++u) { const size_t base = (size_t)((chain_chunk(b, dir, s0 + u) * 6 + h) * 2 + dir); dv[u] = DC[base * 32 + k]; kv[u] = KVC[base * 2048 + e]; }
#pragma unroll
        for (int u = 0; u < 34; ++u) { const size_t base = (size_t)((chain_chunk(b, dir, s0 + u) * 6 + h) * 2 + dir); SC[base * 2048 + e] = S; S = S * dv[u] + kv[u]; }
    }
}

__device__ __forceinline__ void attn_unit(const Params& p, int l, int b, int h, bool isctx, int qb, LAS unsigned char* lds, int tid) {
    asm volatile("" : "+v"(tid));
    const int w = tid >> 6, L = tid & 63, fr = L & 15, fq = L >> 4;
    const int qrow0 = (isctx ? NLAT + b * 256 : b * 4096) + qb * 256;
    const int nst = isctx ? 1 : 17;
    const unsigned char* rec = SCRP(unsigned char, SC_KVREC) + (size_t)(b * 4 + h) * NKT * 8192;
    const bf16_t* Z = WSP(bf16_t, WS_Z);
    u32x4 ld[8];
#pragma unroll
    for (int q = 0; q < 8; ++q) ld[q] = *(const u32x4*)(rec + q * 8192 + tid * 16);
    float lam;
    { const float* q1 = p.in[I_LQ1] + l * 32; const float* k1 = p.in[I_LK1] + l * 32; const float* q2 = p.in[I_LQ2] + l * 32; const float* k2 = p.in[I_LK2] + l * 32;
      float s1 = 0.f, s2 = 0.f;
      for (int i = 0; i < 32; ++i) { s1 += q1[i] * k1[i]; s2 += q2[i] * k2[i]; }
      const float lam_init = l == 0 ? 0.2f : 0.35550907f;
      lam = __expf(s1) - __expf(s2) + lam_init; }
    asm volatile("" : "+v"(lam));
    const float one_m_li = l == 0 ? 0.8f : 0.64449093f;
    bf16x8 Qb[2][2]; f32x4 cinit[2][2];
    {
        const unsigned* kmax = WSP(unsigned, WS_CTL) + CW_KMAX + l * 32 + (b * 4 + h) * 2;
#pragma unroll
        for (int sub = 0; sub < 2; ++sub) {
            const int row = qrow0 + w * 32 + sub * 16 + fr, tpos = qb * 256 + w * 32 + sub * 16 + fr;
#pragma unroll
            for (int m = 0; m < 2; ++m) {
                float ov[8], pv[8];
                unpack8(*(const u32x4*)(Z + (size_t)row * DINP + ZQ + h * 64 + m * 32 + fq * 8), ov);
                unpack8(*(const u32x4*)(Z + (size_t)row * DINP + ZQ + h * 64 + m * 32 + (fq ^ 1) * 8), pv);
                if (!isctx) {
                    const int pos = (fq >> 1) ? (tpos & 63) : (tpos >> 6); const float sg = (fq & 1) ? 1.f : -1.f;
#pragma unroll
                    for (int i = 0; i < 8; ++i) ov[i] = ov[i] * ROPE_COS[pos][i] + sg * pv[i] * ROPE_SIN[pos][i];
                }
#pragma unroll
                for (int i = 0; i < 8; ++i) ov[i] *= 0.2550348616f;
                u32x4 o; o.x = pk2(ov[0], ov[1]); o.y = pk2(ov[2], ov[3]); o.z = pk2(ov[4], ov[5]); o.w = pk2(ov[6], ov[7]);
                float rv[8]; unpack8(o, rv); float n2 = 0.f;
#pragma unroll
                for (int i = 0; i < 8; ++i) n2 += rv[i] * rv[i];
                n2 += __shfl_xor(n2, 16); n2 += __shfl_xor(n2, 32);
                const float km = __builtin_bit_cast(float, __hip_atomic_load(kmax + m, __ATOMIC_RELAXED, __HIP_MEMORY_SCOPE_AGENT));
                const float mq = sqrtf(n2) * sqrtf(km);
                Qb[sub][m] = __builtin_bit_cast(bf16x8, o);
                cinit[sub][m] = (f32x4){-mq, -mq, -mq, -mq};
            }
        }
    }
#pragma unroll
    for (int q = 0; q < 8; ++q) *(LAS u32x4*)(lds + q * 8192 + tid * 16) = ld[q];
    __syncthreads();
    f32x4 O[2][2][4], Ls[2][2];
#pragma unroll
    for (int sub = 0; sub < 2; ++sub)
#pragma unroll
        for (int m = 0; m < 2; ++m) { Ls[sub][m] = (f32x4){0.f, 0.f, 0.f, 0.f};
#pragma unroll
            for (int et = 0; et < 4; ++et) O[sub][m][et] = (f32x4){0.f, 0.f, 0.f, 0.f}; }
    const bf16x8 ones = __builtin_bit_cast(bf16x8, (u32x4){0x3f803f80u, 0x3f803f80u, 0x3f803f80u, 0x3f803f80u});
#pragma unroll 1
    for (int st = 0; st < nst; ++st) {
        if (st + 1 < nst) {
#pragma unroll
            for (int q = 0; q < 8; ++q) ld[q] = *(const u32x4*)(rec + (size_t)(st + 1) * 65536 + q * 8192 + tid * 16); }
        const LAS unsigned char* cur = lds + (st & 1) * 65536;
#pragma unroll
        for (int hf = 0; hf < 8; ++hf) {
            const LAS unsigned char* rp = cur + hf * 8192 + L * 16;
            bf16x8 vb[4], ka[2][2];
#pragma unroll
            for (int et = 0; et < 4; ++et) vb[et] = *(const LAS bf16x8*)(rp + (4 + et) * 1024);
#pragma unroll
            for (int m = 0; m < 2; ++m) { ka[m][0] = *(const LAS bf16x8*)(rp + (m * 2) * 1024); ka[m][1] = *(const LAS bf16x8*)(rp + (m * 2 + 1) * 1024); }
            f32x4 S[2][2][2];
#pragma unroll
            for (int m = 0; m < 2; ++m)
#pragma unroll
                for (int sub = 0; sub < 2; ++sub) { S[m][sub][0] = __builtin_amdgcn_mfma_f32_16x16x32_bf16(ka[m][0], Qb[sub][m], cinit[sub][m], 0, 0, 0); S[m][sub][1] = __builtin_amdgcn_mfma_f32_16x16x32_bf16(ka[m][1], Qb[sub][m], cinit[sub][m], 0, 0, 0); }
            __builtin_amdgcn_sched_barrier(0x01B0);
#pragma unroll
            for (int m = 0; m < 2; ++m)
#pragma unroll
                for (int sub = 0; sub < 2; ++sub)
#pragma unroll
                    for (int ks = 0; ks < 2; ++ks)
#pragma unroll
                        for (int i = 0; i < 4; ++i) S[m][sub][ks][i] = __builtin_amdgcn_exp2f(S[m][sub][ks][i]);
            __builtin_amdgcn_sched_barrier(0x01B0);
            bf16x8 pa[2][2];
#pragma unroll
            for (int m = 0; m < 2; ++m)
#pragma unroll
                for (int sub = 0; sub < 2; ++sub) { u32x4 pk; pk.x = pg8::cvt_pk_bf16(S[m][sub][0][0], S[m][sub][0][1]); pk.y = pg8::cvt_pk_bf16(S[m][sub][0][2], S[m][sub][0][3]);
                    pk.z = pg8::cvt_pk_bf16(S[m][sub][1][0], S[m][sub][1][1]); pk.w = pg8::cvt_pk_bf16(S[m][sub][1][2], S[m][sub][1][3]); pa[m][sub] = __builtin_bit_cast(bf16x8, pk); }
            __builtin_amdgcn_sched_barrier(0x01B0);
#pragma unroll
            for (int m = 0; m < 2; ++m)
#pragma unroll
                for (int sub = 0; sub < 2; ++sub) { Ls[sub][m] = __builtin_amdgcn_mfma_f32_16x16x32_bf16(pa[m][sub], ones, Ls[sub][m], 0, 0, 0);
#pragma unroll
                    for (int et = 0; et < 4; ++et) O[sub][m][et] = __builtin_amdgcn_mfma_f32_16x16x32_bf16(pa[m][sub], vb[et], O[sub][m][et], 0, 0, 0); }
            __builtin_amdgcn_sched_barrier(0x01B0);
        }
        if (st + 1 < nst) { LAS unsigned char* nb = lds + ((st + 1) & 1) * 65536;
#pragma unroll
            for (int q = 0; q < 8; ++q) *(LAS u32x4*)(nb + q * 8192 + tid * 16) = ld[q]; }
        __syncthreads();
    }
    const float* sg = p.in[I_SUBLN] + l * 64; bf16_t* CAT = WSP(bf16_t, WS_CAT);
#pragma unroll
    for (int sub = 0; sub < 2; ++sub)
#pragma unroll
        for (int j = 0; j < 4; ++j) {
            const float i0 = __builtin_amdgcn_rcpf(Ls[sub][0][j]), i1 = lam * __builtin_amdgcn_rcpf(Ls[sub][1][j]);
            float ov[4], ss = 0.f;
#pragma unroll
            for (int et = 0; et < 4; ++et) { ov[et] = O[sub][0][et][j] * i0 - O[sub][1][et][j] * i1; ss += ov[et] * ov[et]; }
#pragma unroll
            for (int x = 1; x < 16; x <<= 1) ss += __shfl_xor(ss, x);
            const float rs = rsqrtf(ss * (1.f / 64.f) + LN_EPS) * one_m_li;
            const size_t ro = (size_t)(qrow0 + w * 32 + sub * 16 + fq * 4 + j) * D + h * 64;
#pragma unroll
            for (int et = 0; et < 4; ++et) CAT[ro + et * 16 + fr] = (bf16_t)f2bf(ov[et] * rs * sg[et * 16 + fr]);
        }
    __syncthreads();
}

__device__ __forceinline__ void cv_piece_addr(const Params& p, int l, int pc, int ct, const float*& src, bf16_t*& dst, int& rs) {
    const int e = pc / 1536, r = pc % 1536, which = r >> 9, kt = (r & 511) >> 5, np = r & 31;
    const size_t eo = (size_t)(l * 32 + e) * 1024 * 1024;
    const float* const wg_ = p.in[I_MWG]; const float* const wu_ = p.in[I_MWU]; const float* const wd_ = p.in[I_MWD];
    const float* w = which == 0 ? wg_ : (which == 1 ? wu_ : wd_);
    src = w + eo + (size_t)(kt * 64 + (ct >> 2)) * 1024 + np * 32 + (ct & 3) * 8;
    rs = which == 2 ? 1 : 2; const int ro = which == 1 ? 1 : 0;
    bf16_t* d0 = which == 2 ? WSP(bf16_t, WS_WDN) + eo : WSP(bf16_t, WS_WGU) + 2 * eo;
    dst = d0 + ((size_t)(np * 32 + (ct >> 3)) * rs + ro) * 1024 + kt * 64 + (ct & 7) * 8;
}
__device__ __forceinline__ void attn_conv_unit(const Params& p, int l, int b, int h, bool isctx, int qb, int cvbase, LAS unsigned char* lds, int tid) {
    asm volatile("" : "+v"(tid));
    const int w = tid >> 6, L = tid & 63, fr = L & 15, fq = L >> 4;
    const bool att = w < 4;
    const int ct = tid & 255;
    const int qrow0 = (isctx ? NLAT + b * 256 : b * 4096) + qb * 128;
    const int nst = isctx ? 2 : 34;
    const unsigned char* rec = SCRP(unsigned char, SC_KVREC) + (size_t)(b * 4 + h) * NKT * 8192;
    const bf16_t* Z = WSP(bf16_t, WS_Z);
    LAS float* cvt = (LAS float*)(lds + 65536);
    u32x4 ld[8];
    float lam = 0.f; const float one_m_li = l == 0 ? 0.8f : 0.64449093f;
    bf16x8 Qb[2][2]; f32x4 cinit[2][2];
    if (att) {
#pragma unroll
        for (int q = 0; q < 8; ++q) ld[q] = *(const u32x4*)(rec + q * 4096 + ct * 16);
        { const float* q1 = p.in[I_LQ1] + l * 32; const float* k1 = p.in[I_LK1] + l * 32; const float* q2 = p.in[I_LQ2] + l * 32; const float* k2 = p.in[I_LK2] + l * 32;
          float s1 = 0.f, s2 = 0.f;
          for (int i = 0; i < 32; ++i) { s1 += q1[i] * k1[i]; s2 += q2[i] * k2[i]; }
          lam = __expf(s1) - __expf(s2) + (l == 0 ? 0.2f : 0.35550907f); }
        asm volatile("" : "+v"(lam));
        const unsigned* kmax = WSP(unsigned, WS_CTL) + CW_KMAX + l * 32 + (b * 4 + h) * 2;
#pragma unroll
        for (int sub = 0; sub < 2; ++sub) {
            const int row = qrow0 + w * 32 + sub * 16 + fr, tpos = qb * 128 + w * 32 + sub * 16 + fr;
#pragma unroll
            for (int m = 0; m < 2; ++m) {
                float ov[8], pv[8];
                unpack8(*(const u32x4*)(Z + (size_t)row * DINP + ZQ + h * 64 + m * 32 + fq * 8), ov);
                unpack8(*(const u32x4*)(Z + (size_t)row * DINP + ZQ + h * 64 + m * 32 + (fq ^ 1) * 8), pv);
                if (!isctx) {
                    const int pos = (fq >> 1) ? (tpos & 63) : (tpos >> 6); const float sg = (fq & 1) ? 1.f : -1.f;
#pragma unroll
                    for (int i = 0; i < 8; ++i) ov[i] = ov[i] * ROPE_COS[pos][i] + sg * pv[i] * ROPE_SIN[pos][i];
                }
#pragma unroll
                for (int i = 0; i < 8; ++i) ov[i] *= 0.2550348616f;
                u32x4 o; o.x = pk2(ov[0], ov[1]); o.y = pk2(ov[2], ov[3]); o.z = pk2(ov[4], ov[5]); o.w = pk2(ov[6], ov[7]);
                float rv[8]; unpack8(o, rv); float n2 = 0.f;
#pragma unroll
                for (int i = 0; i < 8; ++i) n2 += rv[i] * rv[i];
                n2 += __shfl_xor(n2, 16); n2 += __shfl_xor(n2, 32);
                const float km = __builtin_bit_cast(float, __hip_atomic_load(kmax + m, __ATOMIC_RELAXED, __HIP_MEMORY_SCOPE_AGENT));
                const float mq = sqrtf(n2) * sqrtf(km);
                Qb[sub][m] = __builtin_bit_cast(bf16x8, o);
                cinit[sub][m] = (f32x4){-mq, -mq, -mq, -mq};
            }
        }
#pragma unroll
        for (int q = 0; q < 8; ++q) *(LAS u32x4*)(lds + q * 4096 + ct * 16) = ld[q];
    } else if (cvbase >= 0) {
#pragma unroll
        for (int i = 0; i < 3; ++i) { const float* src; bf16_t* dst; int rs; cv_piece_addr(p, l, cvbase + i, ct, src, dst, rs); ld[2 * i] = *(const u32x4*)src; ld[2 * i + 1] = *(const u32x4*)(src + 4); }
    }
    __syncthreads();
    f32x4 O[2][2][4], Ls[2][2];
#pragma unroll
    for (int sub = 0; sub < 2; ++sub)
#pragma unroll
        for (int m = 0; m < 2; ++m) { Ls[sub][m] = (f32x4){0.f, 0.f, 0.f, 0.f};
#pragma unroll
            for (int et = 0; et < 4; ++et) O[sub][m][et] = (f32x4){0.f, 0.f, 0.f, 0.f}; }
    const bf16x8 ones = __builtin_bit_cast(bf16x8, (u32x4){0x3f803f80u, 0x3f803f80u, 0x3f803f80u, 0x3f803f80u});
#pragma unroll 1
    for (int st = 0; st < nst; ++st) {
        if (att) {
            if (st + 1 < nst) {
#pragma unroll
                for (int q = 0; q < 8; ++q) ld[q] = *(const u32x4*)(rec + (size_t)(st + 1) * 32768 + q * 4096 + ct * 16); }
            const LAS unsigned char* cur = lds + (st & 1) * 32768;
#pragma unroll
            for (int hf = 0; hf < 4; ++hf) {
                const LAS unsigned char* rp = cur + hf * 8192 + L * 16;
                bf16x8 vb[4];
#pragma unroll
                for (int et = 0; et < 4; ++et) vb[et] = *(const LAS bf16x8*)(rp + (4 + et) * 1024);
#pragma unroll
                for (int m = 0; m < 2; ++m) {
                    const bf16x8 ka0 = *(const LAS bf16x8*)(rp + (m * 2) * 1024), ka1 = *(const LAS bf16x8*)(rp + (m * 2 + 1) * 1024);
#pragma unroll
                    for (int sub = 0; sub < 2; ++sub) {
                        const f32x4 s0 = __builtin_amdgcn_mfma_f32_16x16x32_bf16(ka0, Qb[sub][m], cinit[sub][m], 0, 0, 0);
                        const f32x4 s1 = __builtin_amdgcn_mfma_f32_16x16x32_bf16(ka1, Qb[sub][m], cinit[sub][m], 0, 0, 0);
                        float e[8];
#pragma unroll
                        for (int i = 0; i < 4; ++i) { e[i] = __builtin_amdgcn_exp2f(s0[i]); e[4 + i] = __builtin_amdgcn_exp2f(s1[i]); }
                        u32x4 pk; pk.x = pg8::cvt_pk_bf16(e[0], e[1]); pk.y = pg8::cvt_pk_bf16(e[2], e[3]); pk.z = pg8::cvt_pk_bf16(e[4], e[5]); pk.w = pg8::cvt_pk_bf16(e[6], e[7]);
                        const bf16x8 pa = __builtin_bit_cast(bf16x8, pk);
                        Ls[sub][m] = __builtin_amdgcn_mfma_f32_16x16x32_bf16(pa, ones, Ls[sub][m], 0, 0, 0);
#pragma unroll
                        for (int et = 0; et < 4; ++et) O[sub][m][et] = __builtin_amdgcn_mfma_f32_16x16x32_bf16(pa, vb[et], O[sub][m][et], 0, 0, 0);
                    }
                }
            }
            if (st + 1 < nst) { LAS unsigned char* nb = lds + ((st + 1) & 1) * 32768;
#pragma unroll
                for (int q = 0; q < 8; ++q) *(LAS u32x4*)(nb + q * 4096 + ct * 16) = ld[q]; }
        } else if (cvbase >= 0) {
            if (st >= 1) { const LAS float* tb = cvt + ((st - 1) & 1) * (3 * 64 * 33);
#pragma unroll
                for (int i = 0; i < 3; ++i) { const int pc = 3 * (st - 1) + i; if (pc < 96) { const float* src; bf16_t* dst; int rs; cv_piece_addr(p, l, cvbase + pc, ct, src, dst, rs);
                    const LAS float* t = tb + i * (64 * 33) + ((ct & 7) * 8) * 33 + (ct >> 3);
                    u32x4 o; o.x = pk2(t[0], t[33]); o.y = pk2(t[66], t[99]); o.z = pk2(t[132], t[165]); o.w = pk2(t[198], t[231]); *(u32x4*)dst = o; } } }
            { LAS float* tb = cvt + (st & 1) * (3 * 64 * 33);
#pragma unroll
              for (int i = 0; i < 3; ++i) { if (3 * st + i < 96) { LAS float* t = tb + i * (64 * 33) + (ct >> 2) * 33 + (ct & 3) * 8;
                  LAS unsigned* tu = (LAS unsigned*)t; tu[0] = ld[2 * i].x; tu[1] = ld[2 * i].y; tu[2] = ld[2 * i].z; tu[3] = ld[2 * i].w; tu[4] = ld[2 * i + 1].x; tu[5] = ld[2 * i + 1].y; tu[6] = ld[2 * i + 1].z; tu[7] = ld[2 * i + 1].w; } } }
#pragma unroll
            for (int i = 0; i < 3; ++i) { const int pc = 3 * (st + 1) + i; if (st + 1 < nst && pc < 96) { const float* src; bf16_t* dst; int rs; cv_piece_addr(p, l, cvbase + pc, ct, src, dst, rs); ld[2 * i] = *(const u32x4*)src; ld[2 * i + 1] = *(const u32x4*)(src + 4); } }
        }
        __syncthreads();
    }
    if (att) {
        const float* sg = p.in[I_SUBLN] + l * 64; bf16_t* CAT = WSP(bf16_t, WS_CAT);
#pragma unroll
        for (int sub = 0; sub < 2; ++sub)
#pragma unroll
            for (int j = 0; j < 4; ++j) {
                const float i0 = __builtin_amdgcn_rcpf(Ls[sub][0][j]), i1 = lam * __builtin_amdgcn_rcpf(Ls[sub][1][j]);
                float ov[4], ss = 0.f;
#pragma unroll
                for (int et = 0; et < 4; ++et) { ov[et] = O[sub][0][et][j] * i0 - O[sub][1][et][j] * i1; ss += ov[et] * ov[et]; }
#pragma unroll
                for (int x = 1; x < 16; x <<= 1) ss += __shfl_xor(ss, x);
                const float rs = rsqrtf(ss * (1.f / 64.f) + LN_EPS) * one_m_li;
                const size_t ro = (size_t)(qrow0 + w * 32 + sub * 16 + fq * 4 + j) * D + h * 64;
#pragma unroll
                for (int et = 0; et < 4; ++et) CAT[ro + et * 16 + fr] = (bf16_t)f2bf(ov[et] * rs * sg[et * 16 + fr]);
            }
    } else if (cvbase >= 0) {
        const LAS float* tb = cvt + ((nst - 1) & 1) * (3 * 64 * 33);
#pragma unroll
        for (int i = 0; i < 3; ++i) { const int pc = 3 * (nst - 1) + i; if (pc < 96) { const float* src; bf16_t* dst; int rs; cv_piece_addr(p, l, cvbase + pc, ct, src, dst, rs);
            const LAS float* t = tb + i * (64 * 33) + ((ct & 7) * 8) * 33 + (ct >> 3);
            u32x4 o; o.x = pk2(t[0], t[33]); o.y = pk2(t[66], t[99]); o.z = pk2(t[132], t[165]); o.w = pk2(t[198], t[231]); *(u32x4*)dst = o; } }
    }
    __syncthreads();
}

constexpr int LS4 = 40;
__device__ __forceinline__ f32x4 mfma_k32(const LAS bf16_t* A, const LAS bf16_t* B, int mt, int nt, int fr, int fq, f32x4 acc) {
    const bf16x8 a = *(const LAS bf16x8*)(A + (mt * 16 + fr) * LS4 + fq * 8), b = *(const LAS bf16x8*)(B + (nt * 16 + fr) * LS4 + fq * 8);
    return __builtin_amdgcn_mfma_f32_16x16x32_bf16(a, b, acc, 0, 0, 0);
}
constexpr int G3_HL = 65536;
__device__ __forceinline__ void g3_job(const Params& p, int l, int cid, int hb, LAS unsigned char* lds, int tid) {
    asm volatile("" : "+v"(tid));
    const int r0 = chunk_row0(cid), w = tid >> 6, lane = tid & 63, fr = lane & 15, fq = lane >> 4;
    const bf16_t* Z = WSP(bf16_t, WS_Z);
#define G3_PTRS(hh) LAS bf16_t* QF = (LAS bf16_t*)(lds + (hh) * G3_HL); LAS bf16_t* KF = QF + 64 * LS4; LAS bf16_t* QB = KF + 64 * LS4; LAS bf16_t* KB = QB + 64 * LS4; \
    LAS bf16_t* SFt = KB + 64 * LS4; LAS bf16_t* SBt = SFt + 64 * LS4; LAS bf16_t* Vt = SBt + 64 * LS4; LAS bf16_t* AT = Vt + 64 * 72; LAS f32x4* xb = (LAS f32x4*)(AT + 64 * 72); \
    (void)QF; (void)KF; (void)QB; (void)KB; (void)SFt; (void)SBt; (void)Vt; (void)AT; (void)xb;
    const float* GBF = SCRP(float, SC_GBF); const float* GBB = SCRP(float, SC_GBB); const float* SC = SCRP(float, SC_SC);
    bf16_t grr[4][4]; float gng[4];
    { const int mt_ = w & 3, h_ = hb + (w >> 2);
#pragma unroll
      for (int nt = 0; nt < 4; ++nt) { gng[nt] = p.in[I_GNG][l * 64 + nt * 16 + fr];
#pragma unroll
          for (int j = 0; j < 4; ++j) grr[j][nt] = Z[(size_t)(r0 + mt_ * 16 + fq * 4 + j) * DINP + ZGR + h_ * 64 + nt * 16 + fr]; } }
#pragma unroll
    for (int hh = 0; hh < 2; ++hh) { const int h = hb + hh; G3_PTRS(hh)
        { const int pp = tid >> 3, k4 = (tid & 7) * 4; const size_t zr = (size_t)(r0 + pp) * DINP;
          const u32x2 qu = *(const u32x2*)(Z + zr + ZGQ + h * 32 + k4), ku = *(const u32x2*)(Z + zr + ZGK + h * 32 + k4);
          const f32x4 bf = *(const f32x4*)(GBF + (size_t)(r0 + pp) * 192 + h * 32 + k4), bb = *(const f32x4*)(GBB + (size_t)(r0 + pp) * 192 + h * 32 + k4);
          const float q[4] = {bflo(qu.x) * 0.17677669529f, bfhi(qu.x) * 0.17677669529f, bflo(qu.y) * 0.17677669529f, bfhi(qu.y) * 0.17677669529f}, kk[4] = {bflo(ku.x), bfhi(ku.x), bflo(ku.y), bfhi(ku.y)};
          u32x2 o;
          o.x = pk2(q[0] * __expf(bf[0]), q[1] * __expf(bf[1])); o.y = pk2(q[2] * __expf(bf[2]), q[3] * __expf(bf[3])); *(LAS u32x2*)(QF + pp * LS4 + k4) = o;
          o.x = pk2(kk[0] * __expf(-bf[0]), kk[1] * __expf(-bf[1])); o.y = pk2(kk[2] * __expf(-bf[2]), kk[3] * __expf(-bf[3])); *(LAS u32x2*)(KF + pp * LS4 + k4) = o;
          o.x = pk2(q[0] * __expf(bb[0]), q[1] * __expf(bb[1])); o.y = pk2(q[2] * __expf(bb[2]), q[3] * __expf(bb[3])); *(LAS u32x2*)(QB + pp * LS4 + k4) = o;
          o.x = pk2(kk[0] * __expf(-bb[0]), kk[1] * __expf(-bb[1])); o.y = pk2(kk[2] * __expf(-bb[2]), kk[3] * __expf(-bb[3])); *(LAS u32x2*)(KB + pp * LS4 + k4) = o; }
        { const int pp = tid >> 3, v8 = (tid & 7) * 8; const u32x4 u = *(const u32x4*)(Z + (size_t)(r0 + pp) * DINP + ZGV + h * 64 + v8);
          Vt[(v8 + 0) * 72 + pp] = (bf16_t)(u.x & 0xffffu); Vt[(v8 + 1) * 72 + pp] = (bf16_t)(u.x >> 16); Vt[(v8 + 2) * 72 + pp] = (bf16_t)(u.y & 0xffffu); Vt[(v8 + 3) * 72 + pp] = (bf16_t)(u.y >> 16);
          Vt[(v8 + 4) * 72 + pp] = (bf16_t)(u.z & 0xffffu); Vt[(v8 + 5) * 72 + pp] = (bf16_t)(u.z >> 16); Vt[(v8 + 6) * 72 + pp] = (bf16_t)(u.w & 0xffffu); Vt[(v8 + 7) * 72 + pp] = (bf16_t)(u.w >> 16); }
        { const int k = tid >> 4, v4 = (tid & 15) * 4;
          const f32x4 sf = *(const f32x4*)(SC + ((size_t)((cid * 6 + h) * 2 + 0)) * 2048 + k * 64 + v4), sb = *(const f32x4*)(SC + ((size_t)((cid * 6 + h) * 2 + 1)) * 2048 + k * 64 + v4);
#pragma unroll
          for (int q = 0; q < 4; ++q) { SFt[(v4 + q) * LS4 + k] = (bf16_t)f2bf(sf[q]); SBt[(v4 + q) * LS4 + k] = (bf16_t)f2bf(sb[q]); } } }
    __syncthreads();
#pragma unroll
    for (int hh = 0; hh < 2; ++hh) { G3_PTRS(hh)
#pragma unroll
        for (int q = 0; q < 2; ++q) { const int idx = w * 2 + q, mt = idx >> 2, nt = idx & 3;
            f32x4 af = {0.f, 0.f, 0.f, 0.f}, ab = {0.f, 0.f, 0.f, 0.f};
            if (nt <= mt) af = mfma_k32(QF, KF, mt, nt, fr, fq, af);
            if (nt >= mt) ab = mfma_k32(QB, KB, mt, nt, fr, fq, ab);
#pragma unroll
            for (int j = 0; j < 4; ++j) { const int tt = mt * 16 + fq * 4 + j, ss = nt * 16 + fr;
                AT[tt * 72 + ss] = (bf16_t)f2bf((ss <= tt ? af[j] : 0.f) + (ss >= tt ? ab[j] : 0.f)); } } }
    __syncthreads();
    {   const int mt = w & 3, hh = w >> 2, h = hb + hh; G3_PTRS(hh)
        f32x4 acc[4];
#pragma unroll
        for (int nt = 0; nt < 4; ++nt) { acc[nt] = (f32x4){0.f, 0.f, 0.f, 0.f};
#pragma unroll
            for (int ks = 0; ks < 2; ++ks) { const bf16x8 a = *(const LAS bf16x8*)(AT + (mt * 16 + fr) * 72 + ks * 32 + fq * 8), b = *(const LAS bf16x8*)(Vt + (nt * 16 + fr) * 72 + ks * 32 + fq * 8);
                acc[nt] = __builtin_amdgcn_mfma_f32_16x16x32_bf16(a, b, acc[nt], 0, 0, 0); }
            acc[nt] = mfma_k32(QF, SFt, mt, nt, fr, fq, acc[nt]); acc[nt] = mfma_k32(QB, SBt, mt, nt, fr, fq, acc[nt]); }
        bf16_t* CAT = WSP(bf16_t, WS_CAT);
#pragma unroll
        for (int j = 0; j < 4; ++j) { const int row = r0 + mt * 16 + fq * 4 + j;
            float ss = (acc[0][j] * acc[0][j] + acc[1][j] * acc[1][j]) + (acc[2][j] * acc[2][j] + acc[3][j] * acc[3][j]); ss = red16(ss);
            const float rs = rsqrtf(ss * (1.f / 64.f) + LN_EPS);
#pragma unroll
            for (int nt = 0; nt < 4; ++nt) { const int v = nt * 16 + fr; const float gr = bf2f(grr[j][nt]);
                CAT[(size_t)row * D + 256 + h * 64 + v] = (bf16_t)f2bf(acc[nt][j] * rs * gng[nt] * siluf_(gr)); } }
    }
#undef G3_PTRS
    __syncthreads();
}

constexpr int RA_S = 1032;
__device__ __forceinline__ void ln1_router(const Params& p, int l, int nrows, LAS unsigned char* lds, int tid, int G, int bx, bool dry = false) {
    asm volatile("" : "+v"(tid));
    const int w = tid >> 6, lane = tid & 63, fr = lane & 15, fq = lane >> 4;
    LAS bf16_t* AH = (LAS bf16_t*)lds;
    LAS bf16_t* AL = AH + 16 * RA_S;
    LAS float* part = (LAS float*)(AL + 16 * RA_S);
    LAS float* lgs = part + 8 * 16 * 32;
    LAS unsigned* lcnt = (LAS unsigned*)(lgs + 16 * 32);
    if (tid < 32) lcnt[tid] = 0u;
    bf16_t* H = WSP(bf16_t, WS_H);        bf16_t* XM = WSP(bf16_t, WS_XM); const bf16_t* MIX = WSP(bf16_t, WS_Z); const float* MOD = WSP(float, WS_MOD);
    int* TOPE = WSP(int, WS_TOP); float* TOPG = WSP(float, WS_TOP + TOP_STRIDE); int* TOPR = WSP(int, WS_TOP + 2 * TOP_STRIDE);
    const float* g1p = p.in[I_LN1G] + l * 1024; const float* b1p = p.in[I_LN1B] + l * 1024; const float* rb = p.in[I_RB] + l * 32;
    const bf16_t* RT = WSP(bf16_t, WS_RTW) + (size_t)l * 2 * 32 * 1024;
    bf16x8 bh[4][2], bl[4][2];
#pragma unroll
    for (int ks = 0; ks < 4; ++ks)
#pragma unroll
        for (int nt = 0; nt < 2; ++nt) { const size_t o = (size_t)(nt * 16 + fr) * 1024 + (w * 4 + ks) * 32 + fq * 8; bh[ks][nt] = *(const bf16x8*)(RT + o); bl[ks][nt] = *(const bf16x8*)(RT + 32 * 1024 + o); }
    float alpha = DN_ALPHA; asm volatile("" : "+v"(alpha));
    __syncthreads();
    const int ngroups = nrows >> 4;
    u32x2 pmx[2][4], phb[2][4];
#define LN1_LOAD(gg) do { _Pragma("unroll") for (int r = 0; r < 2; ++r) { const int row_ = (gg) * 16 + r * 8 + w; _Pragma("unroll") for (int j = 0; j < 4; ++j) { const int c_ = lane * 4 + 256 * j; \
        pmx[r][j] = *(const u32x2*)(MIX + (size_t)row_ * D + c_); phb[r][j] = *(const u32x2*)(H + (size_t)row_ * D + c_); } } } while (0)
    if (bx < ngroups) LN1_LOAD(bx);
    for (int g = bx; g < ngroups; g += G) {
        f32x4 y[2][4]; float s[2] = {0.f, 0.f};
#pragma unroll
        for (int r = 0; r < 2; ++r) { const int row = g * 16 + r * 8 + w; const int sidx = row < NLAT ? (row >> 12) : 4; const float* mod = MOD + (size_t)(l * 5 + sidx) * 6144;
#pragma unroll
            for (int j = 0; j < 4; ++j) { const int c = lane * 4 + 256 * j; const u32x2 mx = pmx[r][j];
                const u32x2 hb = phb[r][j];
                y[r][j] = (f32x4){bflo(hb.x), bfhi(hb.x), bflo(hb.y), bfhi(hb.y)} * alpha + *(const f32x4*)(mod + 2048 + c) * (f32x4){bflo(mx.x), bfhi(mx.x), bflo(mx.y), bfhi(mx.y)};
                s[r] += (y[r][j][0] + y[r][j][1]) + (y[r][j][2] + y[r][j][3]); } }
#pragma unroll
        for (int r = 0; r < 2; ++r) { const int row = g * 16 + r * 8 + w; const int sidx = row < NLAT ? (row >> 12) : 4; const float* mod = MOD + (size_t)(l * 5 + sidx) * 6144;
            const float mean = wave_sum(s[r]) * (1.f / D); float s2 = 0.f;
#pragma unroll
            for (int j = 0; j < 4; ++j) { y[r][j] = y[r][j] - mean; s2 += (y[r][j][0] * y[r][j][0] + y[r][j][1] * y[r][j][1]) + (y[r][j][2] * y[r][j][2] + y[r][j][3] * y[r][j][3]); }
            const float rstd = rsqrtf(wave_sum(s2) * (1.f / D) + LN_EPS);
#pragma unroll
            for (int j = 0; j < 4; ++j) { const int c = lane * 4 + 256 * j;
                const f32x4 hn = y[r][j] * rstd * *(const f32x4*)(g1p + c) + *(const f32x4*)(b1p + c);
                const f32x4 m = hn * (*(const f32x4*)(mod + 4096 + c) + 1.f) + *(const f32x4*)(mod + 3072 + c);
                if (!dry || m[0] == 123456.789f) { u32x2 hb; hb.x = pk2(hn[0], hn[1]); hb.y = pk2(hn[2], hn[3]); *(u32x2*)(H + (size_t)row * D + c) = hb; *(unsigned*)((unsigned char*)XM + (size_t)row * D + c) = pk4_fp8(m[0], m[1], m[2], m[3]); }
                u32x2 hi; hi.x = pk2(m[0], m[1]); hi.y = pk2(m[2], m[3]);
                u32x2 lo; lo.x = pk2(m[0] - bflo(hi.x), m[1] - bfhi(hi.x)); lo.y = pk2(m[2] - bflo(hi.y), m[3] - bfhi(hi.y));
                *(LAS u32x2*)(AH + (r * 8 + w) * RA_S + c) = hi; *(LAS u32x2*)(AL + (r * 8 + w) * RA_S + c) = lo; } }
        if (g + G < ngroups) LN1_LOAD(g + G);
        __syncthreads();
        {
            f32x4 acc[2] = {{0.f, 0.f, 0.f, 0.f}, {0.f, 0.f, 0.f, 0.f}};
#pragma unroll
            for (int ks = 0; ks < 4; ++ks) { const int ko = fr * RA_S + (w * 4 + ks) * 32 + fq * 8;
                const bf16x8 ah = *(const LAS bf16x8*)(AH + ko), al = *(const LAS bf16x8*)(AL + ko);
#pragma unroll
                for (int nt = 0; nt < 2; ++nt) { acc[nt] = __builtin_amdgcn_mfma_f32_16x16x32_bf16(ah, bh[ks][nt], acc[nt], 0, 0, 0);
                    acc[nt] = __builtin_amdgcn_mfma_f32_16x16x32_bf16(al, bh[ks][nt], acc[nt], 0, 0, 0); acc[nt] = __builtin_amdgcn_mfma_f32_16x16x32_bf16(ah, bl[ks][nt], acc[nt], 0, 0, 0); } }
#pragma unroll
            for (int nt = 0; nt < 2; ++nt)
#pragma unroll
                for (int j = 0; j < 4; ++j) part[(w * 16 + fq * 4 + j) * 32 + nt * 16 + fr] = acc[nt][j];
        }
        __syncthreads();
        { const int rr = lane >> 5, e = lane & 31, rl = rr * 8 + w; float a = rb[e];
#pragma unroll
          for (int ww = 0; ww < 8; ++ww) a += part[(ww * 16 + rl) * 32 + e];
          const int row = g * 16 + rl;
          float tv[4]; int ti[4];
#pragma unroll
          for (int k = 0; k < 4; ++k) { float m = a;
              m = fmaxf(m, dpp_f<0xB1>(m)); m = fmaxf(m, dpp_f<0x4E>(m)); m = fmaxf(m, dpp_f<0x141>(m)); m = fmaxf(m, dpp_f<0x140>(m));
              m = fmaxf(m, __shfl_xor(m, 16));
              const unsigned long long bal = __ballot(a == m);
              const int bi = __builtin_ctz(rr ? (unsigned)(bal >> 32) : (unsigned)bal);
              tv[k] = m; ti[k] = bi;
              if (e == bi) a = -3.0e38f; }
          if (e == 0 && (!dry || tv[0] == 123456.789f)) {
              const float e1 = __expf(tv[1] - tv[0]), e2 = __expf(tv[2] - tv[0]), e3 = __expf(tv[3] - tv[0]); const float inv = 1.f / (1.f + e1 + e2 + e3);
              const float gg[4] = {inv, e1 * inv, e2 * inv, e3 * inv};
#pragma unroll
              for (int k = 0; k < 4; ++k) { TOPE[row * 4 + k] = ti[k]; TOPG[row * 4 + k] = gg[k]; TOPR[row * 4 + k] = (int)atomicAdd((unsigned*)(lcnt + ti[k]), 1u); }
          } }
        __syncthreads();
    }
#undef LN1_LOAD
    __syncthreads();
    if (tid < 32 && !dry) WSP(unsigned, WS_CNTWG)[(size_t)(l * 256 + bx) * 32 + tid] = lcnt[tid];
}

__device__ __forceinline__ int moe_tables(const Params& p, int l, LAS int* tab, LAS int* basew, int G, int tid) {
    const unsigned* cw = WSP(unsigned, WS_CNTWG) + (size_t)l * 256 * 32;
    { unsigned cv_[16];
#pragma unroll
      for (int q = 0; q < 16; ++q) { const int i = tid + q * NTHR; cv_[q] = i < G * 32 ? cw[i] : 0u; }
#pragma unroll
      for (int q = 0; q < 16; ++q) { const int i = tid + q * NTHR; if (i < G * 32) basew[i] = (int)cv_[q]; } }
    __syncthreads();
    if (tid < 32) { int run = 0; for (int wg = 0; wg < G; ++wg) { const int c = basew[wg * 32 + tid]; basew[wg * 32 + tid] = run; run += c; } tab[32 + tid] = run; }
    __syncthreads();
    if (tid == 0) { int run = 0;
        for (int e = 0; e < 32; ++e) { const int c = tab[32 + e]; tab[e] = run * 256; run += (c + 255) >> 8; tab[64 + e] = run; }
        tab[96] = run; }
    __syncthreads();
    for (int blk = tid; blk < CAP_BLK; blk += NTHR) { int e = 0;
        for (int j = 0; j < 31; ++j) e += (blk >= tab[64 + j]) ? 1 : 0;
        tab[128 + blk] = e; }
    __syncthreads();
    return tab[96];
}

__device__ __forceinline__ void moe_gather(const Params& p, int l, int nrows, LAS int* tab, const LAS int* basew, int gw, int ngw, int lane) {
    const int* TOPE = WSP(int, WS_TOP); const int* TOPR = WSP(int, WS_TOP + 2 * TOP_STRIDE); int* TOPS = WSP(int, WS_TOP + 3 * TOP_STRIDE); int* ROWTOK = WSP(int, WS_ROWTOK);
    for (int t0 = gw * 16; t0 < nrows; t0 += ngw * 16) { const int it = t0 * 4 + lane, tok = it >> 2;
        const int e = TOPE[it], slot = tab[e] + basew[((tok >> 4) % (ngw >> 3)) * 32 + e] + TOPR[it];
        TOPS[it] = slot; ROWTOK[slot] = tok; }
    for (int it = gw * 64 + lane; it < 32 * 256; it += ngw * 64) { const int e = it >> 8, i = it & 255, c = tab[32 + e], row = tab[e] + c + i, pend = tab[e] + (((c + 255) >> 8) << 8);
        if (row < pend) ROWTOK[row] = 0; }
}

constexpr int NR2 = 2;
__device__ __forceinline__ void ln2_rows(const Params& p, int l, int nrows, int gw, int ngw, int lane, bool dry = false) {
    bf16_t* H = WSP(bf16_t, WS_H);        bf16_t* XM = WSP(bf16_t, WS_XM); const unsigned char* YB = SCRP(unsigned char, SC_XB); const float* MOD = WSP(float, WS_MOD);
    const float* TOPG = WSP(float, WS_TOP + TOP_STRIDE); const int* TOPS = WSP(int, WS_TOP + 3 * TOP_STRIDE);
    const float* g2p = p.in[I_LN2G] + l * 1024; const float* b2p = p.in[I_LN2B] + l * 1024;
    float alpha = DN_ALPHA; asm volatile("" : "+v"(alpha));
    int nslot[NR2][4]; float ngt[NR2][4]; u32x2 nhb[NR2][4];
#define LN2_PRE(rb_) do { _Pragma("unroll") for (int r = 0; r < NR2; ++r) { _Pragma("unroll") for (int k = 0; k < 4; ++k) { nslot[r][k] = TOPS[((rb_) + r) * 4 + k]; ngt[r][k] = TOPG[((rb_) + r) * 4 + k] * 0.0625f; } \
        _Pragma("unroll") for (int j = 0; j < 4; ++j) nhb[r][j] = *(const u32x2*)(H + (size_t)((rb_) + r) * D + lane * 4 + 256 * j); } } while (0)
    if (gw * NR2 < nrows) LN2_PRE(gw * NR2);
    for (int row0 = gw * NR2; row0 < nrows; row0 += ngw * NR2) {
        f32x4 y[NR2][4]; float s[NR2];
        int slot[NR2][4]; float gt[NR2][4];
#pragma unroll
        for (int r = 0; r < NR2; ++r) {
#pragma unroll
            for (int k = 0; k < 4; ++k) { slot[r][k] = nslot[r][k]; gt[r][k] = ngt[r][k]; }
#pragma unroll
            for (int j = 0; j < 4; ++j) { const u32x2 hb = nhb[r][j]; y[r][j] = (f32x4){bflo(hb.x), bfhi(hb.x), bflo(hb.y), bfhi(hb.y)} * alpha; } }
        int yv[NR2][4][4];
#pragma unroll
        for (int r = 0; r < NR2; ++r)
#pragma unroll
            for (int k = 0; k < 4; ++k)
#pragma unroll
                for (int j = 0; j < 4; ++j) yv[r][k][j] = *(const int*)(YB + (size_t)slot[r][k] * D + lane * 4 + 256 * j);
        if (row0 + ngw * NR2 < nrows) LN2_PRE(row0 + ngw * NR2);
#pragma unroll
        for (int r = 0; r < NR2; ++r) { const int row = row0 + r; const int sidx = row < NLAT ? (row >> 12) : 4; const float* mod = MOD + (size_t)(l * 5 + sidx) * 6144;
#pragma unroll
            for (int k = 0; k < 4; ++k) {
#pragma unroll
                for (int j = 0; j < 4; ++j) { const int c = lane * 4 + 256 * j; const int u = yv[r][k][j];
                    const f32x2 lo = __builtin_amdgcn_cvt_pk_f32_fp8(u, false), hi = __builtin_amdgcn_cvt_pk_f32_fp8(u, true);
                    y[r][j] += *(const f32x4*)(mod + 5120 + c) * gt[r][k] * (f32x4){lo[0], lo[1], hi[0], hi[1]}; } }
            s[r] = 0.f;
#pragma unroll
            for (int j = 0; j < 4; ++j) s[r] += (y[r][j][0] + y[r][j][1]) + (y[r][j][2] + y[r][j][3]); }
#pragma unroll
        for (int r = 0; r < NR2; ++r) { const int row = row0 + r; const int sidx = row < NLAT ? (row >> 12) : 4;
            const float mean = wave_sum(s[r]) * (1.f / D); float s2 = 0.f;
#pragma unroll
            for (int j = 0; j < 4; ++j) { y[r][j] = y[r][j] - mean; s2 += (y[r][j][0] * y[r][j][0] + y[r][j][1] * y[r][j][1]) + (y[r][j][2] * y[r][j][2] + y[r][j][3] * y[r][j][3]); }
            const float rstd = rsqrtf(wave_sum(s2) * (1.f / D) + LN_EPS);
#pragma unroll
            for (int j = 0; j < 4; ++j) { const int c = lane * 4 + 256 * j;
                const f32x4 hn = y[r][j] * rstd * *(const f32x4*)(g2p + c) + *(const f32x4*)(b2p + c);
                if (dry && hn[0] != 123456.789f) continue;
                if (l == 0) { { u32x2 hb; hb.x = pk2(hn[0], hn[1]); hb.y = pk2(hn[2], hn[3]); *(u32x2*)(H + (size_t)row * D + c) = hb; }
                    const float* mod1 = MOD + (size_t)(5 + sidx) * 6144;
                    const f32x4 xm = hn * (*(const f32x4*)(mod1 + 1024 + c) + 1.f) + *(const f32x4*)(mod1 + c);
                    u32x2 o; o.x = pk2(xm[0], xm[1]); o.y = pk2(xm[2], xm[3]); *(u32x2*)(XM + (size_t)row * D + c) = o; }
                else __builtin_nontemporal_store(hn, (f32x4*)(p.out + (size_t)row * D + c)); } }
    }
#undef LN2_PRE
}

constexpr int LSB = 72;
constexpr size_t RW_REC = 8192;
__device__ __forceinline__ int kperm_lo(int ks, int fq) { return (2 * ks) * 16 + fq * 4; }
__device__ __forceinline__ f32x4 tile_nt(const LAS bf16_t* A, const LAS bf16_t* B, int mt, int nt, int fr, int fq, f32x4 acc) {
#pragma unroll
    for (int ks = 0; ks < 2; ++ks) {
        const bf16x8 a = *(const LAS bf16x8*)(A + (mt * 16 + fr) * LSB + ks * 32 + fq * 8);
        const bf16x8 b = *(const LAS bf16x8*)(B + (nt * 16 + fr) * LSB + ks * 32 + fq * 8);
        acc = __builtin_amdgcn_mfma_f32_16x16x32_bf16(a, b, acc, 0, 0, 0);
    }
    return acc;
}
__device__ __forceinline__ void tr_store8(LAS bf16_t* M, const u32x4 wds, int k8, int lane) {
    const bool odd = lane & 1; const int tb = lane & ~1;
#pragma unroll
    for (int j = 0; j < 4; ++j) { const unsigned own = wds[j], rcv = (unsigned)__builtin_amdgcn_update_dpp(0, (int)own, 0xB1, 0xF, 0xF, true);
        const unsigned out = odd ? ((rcv >> 16) | (own & 0xffff0000u)) : ((own & 0xffffu) | (rcv << 16));
        *(LAS unsigned*)(M + (k8 + 2 * j + (odd ? 1 : 0)) * LSB + tb) = out; }
}
__device__ __forceinline__ size_t rwa_goff(int unit, int tid) {
    const int cid = unit / 12, h = (unit % 12) >> 1, dir = unit & 1, t = tid & 63, k8 = (tid >> 6) * 8;
    return (size_t)(chunk_row0(cid) + (dir ? 63 - t : t)) * 384 + h * 64 + k8;
}
#ifndef TPH
#define TPH -1
#endif
#define TB_(id) do { if (TPH == (id)) tph_t0 = __builtin_amdgcn_s_memrealtime(); } while (0)
#define TE_(id) do { if (TPH == (id)) tph_acc += __builtin_amdgcn_s_memrealtime() - tph_t0; } while (0)
__device__ __forceinline__ void rwa_job(const Params& p, int unit, int next_unit, bool first, f32x4& nw0, f32x4& nw1, LAS unsigned char* lds, int tid, unsigned long long& tph_t0, unsigned long long& tph_acc) {
    asm volatile("" : "+v"(tid));
    const int cid = unit / 12, h = (unit % 12) >> 1, dir = unit & 1;
    const int w = tid >> 6, lane = tid & 63, fr = lane & 15, fq = lane >> 4;
    LAS bf16_t* At = (LAS bf16_t*)lds;            LAS bf16_t* Bt = At + 64 * LSB;   LAS bf16_t* Kt = Bt + 64 * LSB;  LAS bf16_t* Rt = Kt + 64 * LSB;
    LAS bf16_t* BHt = Rt + 64 * LSB;              LAS bf16_t* KHt = BHt + 64 * LSB; LAS bf16_t* Vt = KHt + 64 * LSB;
    LAS float* F0 = (LAS float*)(lds + 64512);
    LAS float* PF = (LAS float*)(lds + 81152);
    LAS bf16_t* AAK = (LAS bf16_t*)(lds + 97536);
    LAS bf16_t* ARB = AAK + 64 * LSB;  LAS bf16_t* ARK = ARB + 64 * LSB;
    LAS bf16_t* TAT = ARK + 64 * LSB;  LAS bf16_t* TPT = TAT + 64 * LSB;
    LAS float* gC = (LAS float*)(lds + 143616);
    LAS float* TD = (LAS float*)(lds + 143872);
    LAS bf16_t* ABH = (LAS bf16_t*)(lds + 147968);
    TB_(30);
    const int t = lane, k8 = w * 8;
    const size_t go = rwa_goff(unit, tid);
    if (first) { const float* Wg = SCRP(float, dir ? SC_WB : SC_WF); nw0 = *(const f32x4*)(Wg + go); nw1 = *(const f32x4*)(Wg + go + 4); }
    const u32x4 in_kk = *(const u32x4*)(SCRP(bf16_t, SC_KK) + go), in_bk = *(const u32x4*)(SCRP(bf16_t, dir ? SC_BKB : SC_BKF) + go), in_km = *(const u32x4*)(SCRP(bf16_t, dir ? SC_KMB : SC_KMF) + go);
    const u32x4 in_rr = *(const u32x4*)(SCRP(bf16_t, SC_R) + go), in_vv = *(const u32x4*)(SCRP(bf16_t, SC_V) + go);
    float Lr[8] = {nw0[0], nw0[1], nw0[2], nw0[3], nw1[0], nw1[1], nw1[2], nw1[3]}, Lc[8];
#pragma unroll
    for (int c = 0; c < 8; ++c) { float x = Lr[c];
        x += __builtin_bit_cast(float, __builtin_amdgcn_update_dpp(0, __builtin_bit_cast(int, x), 0x111, 0xF, 0xF, false));
        x += __builtin_bit_cast(float, __builtin_amdgcn_update_dpp(0, __builtin_bit_cast(int, x), 0x112, 0xF, 0xF, false));
        x += __builtin_bit_cast(float, __builtin_amdgcn_update_dpp(0, __builtin_bit_cast(int, x), 0x114, 0xF, 0xF, false));
        x += __builtin_bit_cast(float, __builtin_amdgcn_update_dpp(0, __builtin_bit_cast(int, x), 0x118, 0xF, 0xF, false));
        x += __builtin_bit_cast(float, __builtin_amdgcn_update_dpp(0, __builtin_bit_cast(int, x), 0x142, 0xA, 0xF, false));
        x += __builtin_bit_cast(float, __builtin_amdgcn_update_dpp(0, __builtin_bit_cast(int, x), 0x143, 0xC, 0xF, false));
        Lc[c] = x; }
    {
        float kk[8], bk[8], km[8], rr[8];
        unpack8(in_kk, kk); unpack8(in_bk, bk); unpack8(in_km, km); unpack8(in_rr, rr);
        float a_[8], b_[8], k_[8], r_[8], bh[8], kh[8];
#pragma unroll
        for (int i = 0; i < 8; ++i) { const float L = Lc[i];
            const float eL = __expf(L), eN = __expf(-L);
            const float eM = __builtin_bit_cast(float, __builtin_amdgcn_update_dpp(0x3f800000, __builtin_bit_cast(int, eL), 0x138, 0xF, 0xF, false));
            const float eC = __builtin_bit_cast(float, __builtin_amdgcn_readlane(__builtin_bit_cast(int, eL), 63)), eH = eC * eN;
            a_[i] = -kk[i] * eM; b_[i] = bk[i] * eN; k_[i] = km[i] * eN; r_[i] = rr[i] * eL; bh[i] = bk[i] * eH; kh[i] = km[i] * eH;
            if (t == 63) gC[k8 + i] = eC; }
        { u32x4 o; o.x = pk2(a_[0], a_[1]); o.y = pk2(a_[2], a_[3]); o.z = pk2(a_[4], a_[5]); o.w = pk2(a_[6], a_[7]); *(LAS u32x4*)(At + t * LSB + k8) = o; }
        { u32x4 o; o.x = pk2(b_[0], b_[1]); o.y = pk2(b_[2], b_[3]); o.z = pk2(b_[4], b_[5]); o.w = pk2(b_[6], b_[7]); *(LAS u32x4*)(Bt + t * LSB + k8) = o; }
        { u32x4 o; o.x = pk2(k_[0], k_[1]); o.y = pk2(k_[2], k_[3]); o.z = pk2(k_[4], k_[5]); o.w = pk2(k_[6], k_[7]); *(LAS u32x4*)(Kt + t * LSB + k8) = o; }
        { u32x4 o; o.x = pk2(r_[0], r_[1]); o.y = pk2(r_[2], r_[3]); o.z = pk2(r_[4], r_[5]); o.w = pk2(r_[6], r_[7]); *(LAS u32x4*)(Rt + t * LSB + k8) = o; }
        { u32x4 o; o.x = pk2(bh[0], bh[1]); o.y = pk2(bh[2], bh[3]); o.z = pk2(bh[4], bh[5]); o.w = pk2(bh[6], bh[7]); tr_store8(BHt, o, k8, lane); }
        { u32x4 o; o.x = pk2(kh[0], kh[1]); o.y = pk2(kh[2], kh[3]); o.z = pk2(kh[4], kh[5]); o.w = pk2(kh[6], kh[7]); tr_store8(KHt, o, k8, lane); }
        tr_store8(Vt, in_vv, k8, lane);
    }
    __syncthreads(); TE_(30); TB_(31);
#pragma unroll
    for (int i8 = 0; i8 < 8; ++i8) { const int pr = i8 >> 1, mt = (w >> 2) + 2 * (i8 & 1), nt = w & 3;
        f32x4 acc = {0.f, 0.f, 0.f, 0.f};
        if (nt <= mt) acc = tile_nt(pr < 2 ? At : Rt, (pr & 1) ? Kt : Bt, mt, nt, fr, fq, acc);
#pragma unroll
        for (int j = 0; j < 4; ++j) { const int tt = mt * 16 + fq * 4 + j, ss = nt * 16 + fr; const bool keep = pr < 2 ? (ss < tt) : (ss <= tt); const float v = keep ? acc[j] : 0.f;
            if (pr == 0) { F0[tt * 64 + ss] = v; ABH[tt * LSB + ss] = (bf16_t)f2bf(v); } else (pr == 1 ? AAK : (pr == 2 ? ARB : ARK))[tt * LSB + ss] = (bf16_t)f2bf(v); } }
    __syncthreads();
#pragma unroll
    for (int q = 0; q < 2; ++q) { const int idx = w * 2 + q, mt = idx >> 2, nt = idx & 3; f32x4 acc = {0.f, 0.f, 0.f, 0.f};
        acc = tile_nt(AAK, Vt, mt, nt, fr, fq, acc);
#pragma unroll
        for (int j = 0; j < 4; ++j) PF[(mt * 16 + fq * 4 + j) * 64 + nt * 16 + fr] = acc[j]; }
    __syncthreads(); TE_(31); TB_(32);
    if (w < 4 && lane < 16) {
        float x[16];
#pragma unroll
        for (int tt = 0; tt < 16; ++tt) { float a0 = (tt == lane) ? 1.f : 0.f;
#pragma unroll
            for (int s2 = 0; s2 < tt; ++s2) a0 += F0[(w * 16 + tt) * 64 + w * 16 + s2] * x[s2];
            x[tt] = a0; TD[(w * 16 + tt) * 16 + lane] = a0; }
    }
    __syncthreads();
    {
        f32x4 X0[4], X[4];
#pragma unroll
        for (int bb = 0; bb < 4; ++bb)
#pragma unroll
            for (int j = 0; j < 4; ++j) { const int tt = bb * 16 + fq * 4 + j; X0[bb][j] = (w < 4) ? bf2f(At[tt * LSB + w * 16 + fr]) : PF[tt * 64 + (w - 4) * 16 + fr]; }
        bf16x8 Tf[4];
#pragma unroll
        for (int bb = 0; bb < 4; ++bb) { const f32x4 tv = *(const LAS f32x4*)(TD + (bb * 16 + fr) * 16 + fq * 4); u32x4 o; o.x = pk2(tv[0], tv[1]); o.y = pk2(tv[2], tv[3]); o.z = 0u; o.w = 0u; Tf[bb] = __builtin_bit_cast(bf16x8, o); }
        const f32x4 zero4 = {0.f, 0.f, 0.f, 0.f};
#pragma unroll
        for (int bb = 0; bb < 4; ++bb) {
            f32x4 rhs = X0[bb];
            if (bb >= 1) {
                const u32x2 a = *(const LAS u32x2*)(ABH + (bb * 16 + fr) * LSB + fq * 4); u32x2 a2 = {0u, 0u};
                if (bb >= 2) a2 = *(const LAS u32x2*)(ABH + (bb * 16 + fr) * LSB + 16 + fq * 4);
                u32x4 af; af.x = a.x; af.y = a.y; af.z = a2.x; af.w = a2.y;
                u32x4 bf; bf.x = pk2(X[0][0], X[0][1]); bf.y = pk2(X[0][2], X[0][3]);
                if (bb >= 2) { bf.z = pk2(X[1][0], X[1][1]); bf.w = pk2(X[1][2], X[1][3]); } else { bf.z = 0u; bf.w = 0u; }
                rhs = __builtin_amdgcn_mfma_f32_16x16x32_bf16(__builtin_bit_cast(bf16x8, af), __builtin_bit_cast(bf16x8, bf), rhs, 0, 0, 0);
            }
            if (bb == 3) {
                const u32x2 a = *(const LAS u32x2*)(ABH + (48 + fr) * LSB + 32 + fq * 4);
                u32x4 af; af.x = a.x; af.y = a.y; af.z = 0u; af.w = 0u;
                u32x4 bf; bf.x = pk2(X[2][0], X[2][1]); bf.y = pk2(X[2][2], X[2][3]); bf.z = 0u; bf.w = 0u;
                rhs = __builtin_amdgcn_mfma_f32_16x16x32_bf16(__builtin_bit_cast(bf16x8, af), __builtin_bit_cast(bf16x8, bf), rhs, 0, 0, 0);
            }
            u32x4 rb; rb.x = pk2(rhs[0], rhs[1]); rb.y = pk2(rhs[2], rhs[3]); rb.z = 0u; rb.w = 0u;
            X[bb] = __builtin_amdgcn_mfma_f32_16x16x32_bf16(Tf[bb], __builtin_bit_cast(bf16x8, rb), zero4, 0, 0, 0);
            LAS bf16_t* dst = ((w < 4) ? TAT : TPT) + ((w & 3) * 16 + fr) * LSB + bb * 16 + fq * 4;
            u32x2 o; o.x = pk2(X[bb][0], X[bb][1]); o.y = pk2(X[bb][2], X[bb][3]); *(LAS u32x2*)dst = o;
        }
    }
    __syncthreads();
    TE_(32); TB_(33);
    if (next_unit >= 0) { const float* Wn = SCRP(float, (next_unit & 1) ? SC_WB : SC_WF) + rwa_goff(next_unit, tid); nw0 = *(const f32x4*)Wn; nw1 = *(const f32x4*)(Wn + 4); }
    const size_t u = (size_t)((cid * 6 + h) * 2 + dir);
    LAS bf16_t* SQ = AAK; LAS bf16_t* SM = (LAS bf16_t*)PF; LAS float* SY = F0;
    unsigned char* GREC = p.ws + WS_GREC + u * RW_REC;
#pragma unroll
    for (int i8 = 0; i8 < 8; ++i8) { const int pr = i8 >> 1, mt = (w >> 2) + 2 * (i8 & 1), nt = w & 3; f32x4 acc = {0.f, 0.f, 0.f, 0.f};
        if (pr == 0) { acc = tile_nt(ARB, TAT, mt, nt, fr, fq, acc);
#pragma unroll
            for (int j = 0; j < 4; ++j) { const int tt = mt * 16 + fq * 4 + j, kk_ = nt * 16 + fr; SQ[tt * LSB + kk_] = (bf16_t)f2bf(acc[j] + bf2f(Rt[tt * LSB + kk_])); } }
        else if (pr == 1) { acc = tile_nt(ARB, TPT, mt, nt, fr, fq, acc); acc = tile_nt(ARK, Vt, mt, nt, fr, fq, acc);
#pragma unroll
            for (int j = 0; j < 4; ++j) SY[(mt * 16 + fq * 4 + j) * 64 + nt * 16 + fr] = acc[j]; }
        else if (pr == 2) { acc = tile_nt(BHt, TAT, mt, nt, fr, fq, acc);
#pragma unroll
            for (int j = 0; j < 4; ++j) { const int k1 = mt * 16 + fq * 4 + j, k2 = nt * 16 + fr; SM[k1 * LSB + k2] = (bf16_t)f2bf(acc[j] + (k1 == k2 ? gC[k1] : 0.f)); } }
        else { acc = tile_nt(BHt, TPT, mt, nt, fr, fq, acc); acc = tile_nt(KHt, Vt, mt, nt, fr, fq, acc);
            u32x2 o; o.x = pk2(acc[0], acc[1]); o.y = pk2(acc[2], acc[3]); *(u32x2*)(GREC + ((mt * 4 + nt) * 64 + lane) * 8) = o; } }
    __syncthreads();
    {
        const int mt = w >> 1, ks = w & 1, row = mt * 16 + fr, rq = dir ? 63 - row : row;
        u32x4 o; { const u32x2 a = *(const LAS u32x2*)(SQ + rq * LSB + kperm_lo(ks, fq)), b = *(const LAS u32x2*)(SQ + rq * LSB + kperm_lo(ks, fq) + 16); o.x = a.x; o.y = a.y; o.z = b.x; o.w = b.y; }
        *(u32x4*)(SCRP(unsigned char, SC_YF) + u * RW_REC + (size_t)(w * 64 + lane) * 16) = o;
        { const u32x2 a = *(const LAS u32x2*)(SM + row * LSB + kperm_lo(ks, fq)), b = *(const LAS u32x2*)(SM + row * LSB + kperm_lo(ks, fq) + 16); o.x = a.x; o.y = a.y; o.z = b.x; o.w = b.y; }
        *(u32x4*)(p.ws + WS_MREC + u * RW_REC + (size_t)(w * 64 + lane) * 16) = o;
#pragma unroll
        for (int q = 0; q < 2; ++q) { const int tl = w * 2 + q, mt2 = tl >> 2, nt2 = tl & 3; float yv[4];
#pragma unroll
            for (int j = 0; j < 4; ++j) { const int to = mt2 * 16 + fq * 4 + j; yv[j] = SY[(dir ? 63 - to : to) * 64 + nt2 * 16 + fr]; }
            u32x2 oy; oy.x = pk2(yv[0], yv[1]); oy.y = pk2(yv[2], yv[3]);
            *(u32x2*)(SCRP(unsigned char, SC_YB) + u * RW_REC + (size_t)(tl * 64 + lane) * 8) = oy; }
    }
    __syncthreads(); TE_(33);
}

__device__ __forceinline__ void rwb_job(const Params& p, int job, int tid) {
    asm volatile("" : "+v"(tid));
    const int chain = job * 2 + (tid >> 8);
    const int b = chain / 12, h = (chain % 12) >> 1, dir = chain & 1, nt = (tid >> 6) & 3, lane = tid & 63;
    f32x4 H[4];
#pragma unroll
    for (int mt = 0; mt < 4; ++mt) H[mt] = (f32x4){0.f, 0.f, 0.f, 0.f};
    bf16x8 Mf[4][2]; u32x2 Gf[4];
#define RWB_LOAD(step) do { const size_t u = (size_t)((chain_chunk(b, dir, step) * 6 + h) * 2 + dir); \
        const unsigned char* mr = p.ws + WS_MREC + u * RW_REC; const unsigned char* gr = p.ws + WS_GREC + u * RW_REC; \
_Pragma("unroll") \
        for (int mt = 0; mt < 4; ++mt) { Mf[mt][0] = *(const bf16x8*)(mr + (size_t)((mt * 2) * 64 + lane) * 16); Mf[mt][1] = *(const bf16x8*)(mr + (size_t)((mt * 2 + 1) * 64 + lane) * 16); \
            Gf[mt] = *(const u32x2*)(gr + (size_t)((mt * 4 + nt) * 64 + lane) * 8); } } while (0)
    RWB_LOAD(0);
#pragma unroll 1
    for (int step = 0; step < 68; ++step) {
        const size_t u = (size_t)((chain_chunk(b, dir, step) * 6 + h) * 2 + dir);
        bf16x8 Bh[2], Bl[2];
#pragma unroll
        for (int ks = 0; ks < 2; ++ks) { const f32x4 x0 = H[2 * ks], x1 = H[2 * ks + 1];
            u32x4 hi; hi.x = pk2(x0[0], x0[1]); hi.y = pk2(x0[2], x0[3]); hi.z = pk2(x1[0], x1[1]); hi.w = pk2(x1[2], x1[3]);
            u32x4 lo; lo.x = pk2(x0[0] - bflo(hi.x), x0[1] - bfhi(hi.x)); lo.y = pk2(x0[2] - bflo(hi.y), x0[3] - bfhi(hi.y)); lo.z = pk2(x1[0] - bflo(hi.z), x1[1] - bfhi(hi.z)); lo.w = pk2(x1[2] - bflo(hi.w), x1[3] - bfhi(hi.w));
            Bh[ks] = __builtin_bit_cast(bf16x8, hi); Bl[ks] = __builtin_bit_cast(bf16x8, lo);
            *(u32x4*)(p.ws + WS_XM + u * RW_REC + (size_t)((ks * 4 + nt) * 64 + lane) * 16) = hi; }
        f32x4 acc[4];
#pragma unroll
        for (int mt = 0; mt < 4; ++mt) { acc[mt] = (f32x4){bflo(Gf[mt].x), bfhi(Gf[mt].x), bflo(Gf[mt].y), bfhi(Gf[mt].y)};
#pragma unroll
            for (int ks = 0; ks < 2; ++ks) { acc[mt] = __builtin_amdgcn_mfma_f32_16x16x32_bf16(Mf[mt][ks], Bh[ks], acc[mt], 0, 0, 0); acc[mt] = __builtin_amdgcn_mfma_f32_16x16x32_bf16(Mf[mt][ks], Bl[ks], acc[mt], 0, 0, 0); } }
        if (step + 1 < 68) RWB_LOAD(step + 1);
#pragma unroll
        for (int mt = 0; mt < 4; ++mt) H[mt] = acc[mt];
    }
}

template <int NH> __device__ __forceinline__ void rwc_job(const Params& p, int l, int cid, int hb, LAS unsigned char* lds, int tid) {
    asm volatile("" : "+v"(tid));
    const int r0 = chunk_row0(cid), w = tid >> 6, lane = tid & 63, fr = lane & 15, fq = lane >> 4, dirw = w >> 2, mt = w & 3;
    f32x4 acc[NH][4];
#pragma unroll
    for (int hh = 0; hh < NH; ++hh) { const int h = hb + hh;
        const size_t u = (size_t)((cid * 6 + h) * 2 + dirw);
        const unsigned char* qr = SCRP(unsigned char, SC_YF) + u * RW_REC; const unsigned char* yr = SCRP(unsigned char, SC_YB) + u * RW_REC; const unsigned char* hr = p.ws + WS_XM + u * RW_REC;
        const bf16x8 Q0 = *(const bf16x8*)(qr + (size_t)((mt * 2) * 64 + lane) * 16), Q1 = *(const bf16x8*)(qr + (size_t)((mt * 2 + 1) * 64 + lane) * 16);
#pragma unroll
        for (int nt = 0; nt < 4; ++nt) { const u32x2 y0 = *(const u32x2*)(yr + (size_t)((mt * 4 + nt) * 64 + lane) * 8);
            acc[hh][nt] = (f32x4){bflo(y0.x), bfhi(y0.x), bflo(y0.y), bfhi(y0.y)};
            const bf16x8 B0 = *(const bf16x8*)(hr + (size_t)((0 * 4 + nt) * 64 + lane) * 16), B1 = *(const bf16x8*)(hr + (size_t)((1 * 4 + nt) * 64 + lane) * 16);
            acc[hh][nt] = __builtin_amdgcn_mfma_f32_16x16x32_bf16(Q0, B0, acc[hh][nt], 0, 0, 0); acc[hh][nt] = __builtin_amdgcn_mfma_f32_16x16x32_bf16(Q1, B1, acc[hh][nt], 0, 0, 0); } }
    const bf16_t* Vg = SCRP(bf16_t, SC_V); const bf16_t* Gg = SCRP(bf16_t, SC_G); const float* BON = SCRP(float, SC_BON); bf16_t* CAT = WSP(bf16_t, WS_CAT);
    bf16_t vgr[NH][2][4], ggr[NH][2][4]; float bonr[NH][2], lgr[NH][4], lbr[NH][4];
#pragma unroll
    for (int hh = 0; hh < NH; ++hh) { const int h = hb + hh;
#pragma unroll
        for (int nt = 0; nt < 4; ++nt) { const int c = h * 64 + nt * 16 + fr; lgr[hh][nt] = p.in[I_LNXG][l * 384 + c]; lbr[hh][nt] = p.in[I_LNXB][l * 384 + c]; }
#pragma unroll
        for (int jj = 0; jj < 2; ++jj) { const int row = r0 + mt * 16 + fq * 4 + dirw * 2 + jj; bonr[hh][jj] = BON[(size_t)row * 8 + h];
#pragma unroll
            for (int nt = 0; nt < 4; ++nt) { const size_t o = (size_t)row * 384 + h * 64 + nt * 16 + fr; vgr[hh][jj][nt] = Vg[o]; ggr[hh][jj][nt] = Gg[o]; } } }
    LAS f32x4* xb = (LAS f32x4*)lds;
#pragma unroll
    for (int hh = 0; hh < NH; ++hh)
#pragma unroll
        for (int nt = 0; nt < 4; ++nt) xb[(((dirw * NH + hh) * 4 + mt) * 4 + nt) * 64 + lane] = acc[hh][nt];
    __syncthreads();
#pragma unroll
    for (int hh = 0; hh < NH; ++hh) { const int h = hb + hh;
#pragma unroll
        for (int nt = 0; nt < 4; ++nt) acc[hh][nt] += xb[((((1 - dirw) * NH + hh) * 4 + mt) * 4 + nt) * 64 + lane];
#pragma unroll
        for (int jj = 0; jj < 2; ++jj) { const int j = dirw * 2 + jj; const int row = r0 + mt * 16 + fq * 4 + j;
            const float a0 = j == 0 ? acc[hh][0][0] : j == 1 ? acc[hh][0][1] : j == 2 ? acc[hh][0][2] : acc[hh][0][3], a1 = j == 0 ? acc[hh][1][0] : j == 1 ? acc[hh][1][1] : j == 2 ? acc[hh][1][2] : acc[hh][1][3];
            const float a2 = j == 0 ? acc[hh][2][0] : j == 1 ? acc[hh][2][1] : j == 2 ? acc[hh][2][2] : acc[hh][2][3], a3 = j == 0 ? acc[hh][3][0] : j == 1 ? acc[hh][3][1] : j == 2 ? acc[hh][3][2] : acc[hh][3][3];
            float s = (a0 + a1) + (a2 + a3); s = red16(s); const float mu = s * (1.f / 64.f);
            const float d0 = a0 - mu, d1 = a1 - mu, d2 = a2 - mu, d3 = a3 - mu;
            float v2 = (d0 * d0 + d1 * d1) + (d2 * d2 + d3 * d3); v2 = red16(v2); const float rs = rsqrtf(v2 * (1.f / 64.f) + RW_GN_EPS);
            const float bon = bonr[hh][jj];
            const float dd[4] = {d0, d1, d2, d3};
#pragma unroll
            for (int nt = 0; nt < 4; ++nt) { const int c = h * 64 + nt * 16 + fr; const size_t o = (size_t)row * 384 + c;
                const float yn = dd[nt] * rs * lgr[hh][nt] + lbr[hh][nt]; (void)o;
                CAT[(size_t)row * D + 640 + c] = (bf16_t)f2bf((yn + bon * bf2f(vgr[hh][jj][nt])) * bf2f(ggr[hh][jj][nt])); } } }
    __syncthreads();
}

#ifndef PHM
#define PHM 0x3ffff
#endif
#ifndef REPM
#define REPM 0
#endif
#ifndef NCV2
#define NCV2 0
#endif
#ifndef TPH
#define TPH -1
#endif
#ifndef NCVW
#define NCVW 96
#endif
#define T_BEGIN(id) do { if (TPH == (id)) tph_t0 = __builtin_amdgcn_s_memrealtime(); } while (0)
#define T_END(id) do { if (TPH == (id)) tph_acc += __builtin_amdgcn_s_memrealtime() - tph_t0; } while (0)
constexpr int LDS_TAB_OFF = 131072;
__device__ __forceinline__ int q_fetch(unsigned* head, int n_all, int& shard, int& left) {
    while (left > 0) { const int c = (int)atomicAdd(head + shard * 64, 1u); const int j = c * 8 + shard; if (j < n_all) return j; shard = (shard + 1) & 7; --left; }
    return n_all;
}
#define QUEUE_LOOP(head, n_all, BODY) do { const bool ldr_ = (wave_s == 0 && lane_id_() == 0); int qs_ = (int)(xb_xcc_id() & 7u), ql_ = 8; \
    if (ldr_) qslot[0] = q_fetch((head), (n_all), qs_, ql_); __syncthreads(); \
    for (int k_ = 0;; ++k_) { const int j = __builtin_amdgcn_readfirstlane(qslot[k_ & 1]); if (j >= (n_all)) break; if (ldr_) qslot[(k_ + 1) & 1] = q_fetch((head), (n_all), qs_, ql_); BODY; __syncthreads(); } } while (0)
#define GRID_BAR() do { unsigned char* w_ = load_params_().ws; XcdBarrier b_; b_.bar = (unsigned*)(w_ + WS_CTL) + CW_BAR; b_.x = xb_xcc_id(); b_.st = ctlw; b_.w = wave_s; xcd_barrier(b_); if (REPM & 64) xcd_barrier(b_); } while (0)
__device__ __forceinline__ Params load_params_() {
    Params q{};
#if defined(__HIP_DEVICE_COMPILE__)
    const __attribute__((address_space(4))) Params* kp = (const __attribute__((address_space(4))) Params*)__builtin_amdgcn_kernarg_segment_ptr();
    asm volatile("" : "+s"(kp));
    q.in[0] = kp->in[0];    q.in[1] = kp->in[1];    q.in[2] = kp->in[2];    q.in[3] = kp->in[3];
    q.in[4] = kp->in[4];    q.in[5] = kp->in[5];    q.in[6] = kp->in[6];    q.in[7] = kp->in[7];
    q.in[8] = kp->in[8];    q.in[9] = kp->in[9];    q.in[10] = kp->in[10];    q.in[11] = kp->in[11];
    q.in[12] = kp->in[12];    q.in[13] = kp->in[13];    q.in[14] = kp->in[14];    q.in[15] = kp->in[15];
    q.in[16] = kp->in[16];    q.in[17] = kp->in[17];    q.in[18] = kp->in[18];    q.in[19] = kp->in[19];
    q.in[20] = kp->in[20];    q.in[21] = kp->in[21];    q.in[22] = kp->in[22];    q.in[23] = kp->in[23];
    q.in[24] = kp->in[24];    q.in[25] = kp->in[25];    q.in[26] = kp->in[26];    q.in[27] = kp->in[27];
    q.in[28] = kp->in[28];    q.in[29] = kp->in[29];    q.in[30] = kp->in[30];    q.in[31] = kp->in[31];
    q.in[32] = kp->in[32];    q.in[33] = kp->in[33];    q.in[34] = kp->in[34];    q.in[35] = kp->in[35];
    q.in[36] = kp->in[36];    q.in[37] = kp->in[37];    q.in[38] = kp->in[38];    q.in[39] = kp->in[39];
    q.in[40] = kp->in[40];
    q.out = kp->out; q.ws = kp->ws;
#endif
    return q;
}
#define LOAD_PARAMS() const Params p = load_params_();
#define PHASE_BEGIN_G() LOAD_PARAMS()
#define PHASE_BEGIN() LOAD_PARAMS() \
    int tid = wave_s * 64 + lane_id_(); asm volatile("" : "+v"(tid)); const int lane = tid & 63, gw = bx * 8 + wave_s; (void)lane; (void)gw; (void)p;

__global__ void __launch_bounds__(NTHR, 2) fwd_kernel(Params p_arg) {
    extern __shared__ __attribute__((aligned(16))) unsigned char lds_raw[];
    LAS unsigned char* lds = (LAS unsigned char*)lds_raw;
    const int G = gridDim.x, bx = blockIdx.x, ngw = G * 8;
    const int wave_s = WAVE_ID_SGPR();
    unsigned long long tph_t0 = 0ull, tph_acc = 0ull; (void)tph_t0; (void)tph_acc;
    volatile LAS unsigned* ctlw = (volatile LAS unsigned*)(lds + LDS_CTL_OFF);
    if (wave_s == 0) ctlw[lane_id_()] = 0u;
    __syncthreads();
    { PHASE_BEGIN(); (void)xcd_barrier_post(WSP(unsigned, WS_CTL) + CW_BAR, ctlw, wave_s); }
    volatile LAS int* qslot = (volatile LAS int*)(ctlw + 16);
    LAS int* tab = (LAS int*)(lds + LDS_TAB_OFF);

    T_BEGIN(0);
    for (int rep_ = 0; rep_ < ((REPM & 1) ? 2 : 1); ++rep_)
    { PHASE_BEGIN();
#if PHM & 1
      for (int j = bx; j < J_MOD; j += G) mod_job(p, j, (LAS float*)lds, tid);
#endif
#if PHM & 2
      for (int j = bx; j < 2 * (JW_IN + JW_OUT); j += G) { const int ll = j / (JW_IN + JW_OUT); conv_job(p, ll * JW_LAYER + j % (JW_IN + JW_OUT), (LAS float*)lds, tid); }
#endif
      { bf16_t* wt = WSP(bf16_t, WS_RWW);
        for (int i = bx * NTHR + tid; i < 2 * (int)RWW_LAYER; i += G * NTHR) { const int l = i / (int)RWW_LAYER, r = i % (int)RWW_LAYER; float v;
            if (r < 4 * 384 * 64) { const int m = r / (384 * 64), q = r % (384 * 64), n = q >> 6, k = q & 63;
                v = (m < 2 ? p.in[I_W2] : p.in[I_A2])[((size_t)(l * 2 + (m & 1)) * 64 + k) * 384 + n]; }
            else { const int q = r - 4 * 384 * 64, n = q >> 7, k = q & 127; v = p.in[I_G2][((size_t)l * 128 + k) * 384 + n]; }
            wt[i] = (bf16_t)f2bf(v); } }
      { bf16_t* rt = WSP(bf16_t, WS_RTW);
        for (int i = bx * NTHR + tid; i < 2 * 32 * 1024; i += G * NTHR) { const int l = i >> 15, e = (i >> 10) & 31, k = i & 1023; const float v = p.in[I_RW][((size_t)l * 1024 + k) * 32 + e];
            const unsigned hi = f2bf(v); rt[(size_t)l * 65536 + e * 1024 + k] = (bf16_t)hi; rt[(size_t)l * 65536 + 32768 + e * 1024 + k] = (bf16_t)f2bf(v - __builtin_bit_cast(float, hi << 16)); } }
      float* bgu = WSP(float, WS_BGU);
      for (int i = bx * NTHR + tid; i < 2 * 32 * 2048; i += G * NTHR) { const int le = i >> 11, c = i & 2047; bgu[i] = (c & 1) ? p.in[I_MBU][le * 1024 + (c >> 1)] : p.in[I_MBG][le * 1024 + (c >> 1)]; } }
    GRID_BAR(); T_END(0);
    T_BEGIN(1);
#if PHM & 4
    for (int rep_ = 0; rep_ < ((REPM & 32) ? 2 : 1); ++rep_)
    { PHASE_BEGIN(); ln_in_rows(p, gw, ngw, lane); }
#endif
    GRID_BAR(); T_END(1);

#pragma unroll 1
    for (int l = 0; l < 2; ++l) {
        const int nrows = l == 0 ? NTOK : NLAT;
        T_BEGIN(2);
#if PHM & 8
        for (int rep_ = 0; rep_ < ((REPM & 8) ? 2 : 1); ++rep_)
        { PHASE_BEGIN_G();
          pg8::Gemm g{WSP(bf16_t, WS_XM), WSP(bf16_t, WS_WIN) + (size_t)l * DINP * 1024, NTOK, DINP, 1024};
          pg8::StaticOrder S; S.init(NTOK, DINP, 1024, G, bx);
          pg8::EpiBf16 E{WSP(bf16_t, WS_Z), DINP, nullptr, 0};
          pg8::gemm_phase<pg8::EpiBf16, pg8::StaticOrder>(lds, g, S, E, wave_s); }
#endif
        GRID_BAR(); T_END(2);
        T_BEGIN(3);
        for (int rep_ = 0; rep_ < ((REPM & 2) ? 2 : 1); ++rep_)
        { PHASE_BEGIN();
          unsigned* head = WSP(unsigned, WS_CTL) + CW_QHEAD + (l * 8 + 0 + 4 * rep_) * 512;
          const int n_rw1 = 544, n_rw = n_rw1 * ((REPM & 2048) ? 2 : 1), n_gla1 = NCHUNK * 2, n_gla = n_gla1 * ((REPM & 4096) ? 2 : 1), n_da1 = 4 * (NKT / 4), n_da = n_da1 * ((REPM & 8192) ? 2 : 1), n_cv2 = NCV2, n_all = n_rw + n_gla + n_da + n_cv2;
          QUEUE_LOOP(head, n_all, {
              if (j < n_rw) { T_BEGIN(20); rw_job(p, l, j % n_rw1, lds, tid, tph_t0, tph_acc); T_END(20); }
              if (j >= n_rw && j < n_rw + n_da) { const int q = (j - n_rw) % n_da1; T_BEGIN(22); da_job(p, l, q / (NKT / 4), q % (NKT / 4), lds, tid); T_END(22); }
              if (j >= n_rw + n_da && j < n_rw + n_da + n_gla) { const int q = (j - n_rw - n_da) % n_gla1; T_BEGIN(21); gla_job(p, l, q >> 1, (q & 1) * 3, lds, tid); T_END(21); }
              if (j >= n_rw + n_gla + n_da) conv_job(p, l * JW_LAYER + JW_IN + JW_OUT + (j - n_rw - n_gla - n_da), (LAS float*)lds, tid);
          }); }
        GRID_BAR(); T_END(3);
        T_BEGIN(4);
        for (int rep_ = 0; rep_ < ((REPM & 32) ? 2 : 1); ++rep_)
        { PHASE_BEGIN();
          { const int n_u = NCHUNK * 12;
            f32x4 nw0 = {0.f, 0.f, 0.f, 0.f}, nw1 = nw0;
            for (int u = bx; u < n_u; u += G) rwa_job(p, u, (u + G < n_u) ? u + G : -1, u == bx, nw0, nw1, lds, tid, tph_t0, tph_acc); }
          if (bx >= G - 192) g2_job(p, bx - (G - 192), tid); }
        GRID_BAR(); T_END(4);
        T_BEGIN(5);
        for (int rep_ = 0; rep_ < ((REPM & 4) ? 2 : 1); ++rep_)
        { PHASE_BEGIN();
          unsigned* headm = WSP(unsigned, WS_CTL) + CW_QHEAD + (l * 8 + 1 + 4 * rep_) * 512;
          unsigned* headc = WSP(unsigned, WS_CTL) + CW_QHEAD + (l * 8 + 2 + 4 * rep_) * 512;
          const int n_sc = 24, n_att1 = 256 + (l == 0 ? 16 : 0), n_att = n_att1 * ((REPM & 512) ? 2 : 1), n_g31 = (l == 0 ? NCHUNK : 256) * 3, n_g3 = n_g31 * ((REPM & 1024) ? 2 : 1), n_cv = 32 * 192, n_main = n_sc + n_att + n_g3;
          const bool cvf = (((bx >> 3) + 1) * (NCVW / 8)) / 32 != ((bx >> 3) * (NCVW / 8)) / 32;
#pragma unroll 1
          for (int ph_ = 0; ph_ < 2; ++ph_) { const bool cv = (ph_ == 0) == cvf; unsigned* head = cv ? headc : headm; const int n_all = cv ? n_cv : n_main;
          QUEUE_LOOP(head, n_all, {
              if (cv) conv_job(p, l * JW_LAYER + JW_IN + JW_OUT + j, (LAS float*)lds, tid);
              else {
              if (j < n_sc) { T_BEGIN(25); rwb_job(p, j, tid); T_END(25); }
              if (j >= n_sc && j < n_sc + n_att) { const int q = (j - n_sc) % n_att1; const bool ic = q >= 256; const int c = q - 256;
                  T_BEGIN(23); attn_unit(p, l, ic ? (c >> 2) : (q >> 6), ic ? (c & 3) : ((q >> 4) & 3), ic, ic ? 0 : (q & 15), lds, tid); T_END(23); }
              if (j >= n_sc + n_att) { const int q = (j - n_sc - n_att) % n_g31; T_BEGIN(24); g3_job(p, l, q / 3, (q % 3) * 2, lds, tid); T_END(24); } }
          }); __syncthreads(); } }
        GRID_BAR(); T_END(5);
        T_BEGIN(6);
        for (int rep_ = 0; rep_ < ((REPM & 32) ? 2 : 1); ++rep_)
        { PHASE_BEGIN();
          const int n3 = (l == 0 ? NCHUNK : 256) * 2, n3full = (n3 / G) * G;
          for (int j = bx; j < n3full; j += G) rwc_job<3>(p, l, j >> 1, (j & 1) * 3, lds, tid);
          for (int j = bx; j < (n3 - n3full) * 3; j += G) { const int q = n3full + j / 3; rwc_job<1>(p, l, q >> 1, (q & 1) * 3 + j % 3, lds, tid); } }
        GRID_BAR(); T_END(6);
        T_BEGIN(7);
#if PHM & 4096
        for (int rep_ = 0; rep_ < ((REPM & 8) ? 2 : 1); ++rep_)
        { PHASE_BEGIN_G();
          pg8::Gemm g{WSP(bf16_t, WS_CAT), WSP(bf16_t, WS_WOUT) + (size_t)l * 1024 * 1024, nrows, 1024, 1024};
          pg8::StaticOrder S; S.init(nrows, 1024, 1024, G, bx);
          pg8::EpiBf16 E{WSP(bf16_t, WS_Z), 1024, nullptr, 0};
          pg8::gemm_phase<pg8::EpiBf16, pg8::StaticOrder>(lds, g, S, E, wave_s); }
#endif
        GRID_BAR(); T_END(7);
        T_BEGIN(8);
#if PHM & 8192
        for (int rep_ = ((REPM & 128) ? 0 : 1); rep_ < 2; ++rep_)
        { PHASE_BEGIN(); ln1_router(p, l, nrows, lds, tid, G, bx, rep_ == 0); }
#endif
        GRID_BAR(); T_END(8);
        T_BEGIN(9);
        { PHASE_BEGIN();
          moe_tables(p, l, tab, (LAS int*)lds, G, tid);
#if PHM & 16384
          for (int rep_ = 0; rep_ < ((REPM & 32) ? 2 : 1); ++rep_)
          moe_gather(p, l, nrows, tab, (const LAS int*)lds, gw, ngw, lane);
#endif
        }
        GRID_BAR(); T_END(9);
        T_BEGIN(10);
#if PHM & 32768
        for (int rep_ = 0; rep_ < ((REPM & 16) ? 2 : 1); ++rep_)
        { PHASE_BEGIN_G();
          const int nblk = tab[96];
          pg8::Gemm g{WSP(bf16_t, WS_XM), (const bf16_t*)(WSP(unsigned char, WS_WGU) + (size_t)l * 32 * 2048 * 1024), nblk * 256, 2048, 512};
          pg8::GroupOrder<8, 1024> S{G, (G % 8 == 0) ? (bx % 8) * (G / 8) + bx / 8 : bx, nblk, tab + 128};
          pg8::EpiSwiglu8 E{SCRP(unsigned char, SC_ACT), WSP(float, WS_BGU) + (size_t)l * 32 * 2048};
          pg8::gemm_phase<pg8::EpiSwiglu8, pg8::GroupOrder<8, 1024>, true, true>(lds, g, S, E, wave_s, WSP(int, WS_ROWTOK)); }
#endif
        GRID_BAR(); T_END(10);
        T_BEGIN(11);
#if PHM & 65536
        for (int rep_ = 0; rep_ < ((REPM & 16) ? 2 : 1); ++rep_)
        { PHASE_BEGIN_G();
          const int nblk = tab[96];
          pg8::Gemm g{SCRP(bf16_t, SC_ACT), (const bf16_t*)(WSP(unsigned char, WS_WDN) + (size_t)l * 32 * 1024 * 1024), nblk * 256, 1024, 512};
          pg8::GroupOrder<4, 1024> S{G, (G % 8 == 0) ? (bx % 8) * (G / 8) + bx / 8 : bx, nblk, tab + 128};
          pg8::EpiFp8Dn E{SCRP(unsigned char, SC_XB), p.in[I_MBD] + (size_t)l * 32 * 1024};
          pg8::gemm_phase<pg8::EpiFp8Dn, pg8::GroupOrder<4, 1024>, false, true>(lds, g, S, E, wave_s); }
#endif
        GRID_BAR(); T_END(11);
        T_BEGIN(12);
#if PHM & 131072
        for (int rep_ = ((REPM & 256) ? 0 : 1); rep_ < 2; ++rep_)
        { PHASE_BEGIN(); ln2_rows(p, l, nrows, gw, ngw, lane, rep_ == 0); }
#endif
        GRID_BAR(); T_END(12);
    }
    if (TPH >= 0 && bx == 0 && wave_s == 0 && lane_id_() == 0) { LOAD_PARAMS() p.out[0] += (float)tph_acc * 1e-4f; }
}

extern "C" void kernel_launch(void* const* d_in, const int* in_sizes, int n_in, void* d_out, int out_size, void* d_ws, size_t ws_size, hipStream_t stream) {
    (void)in_sizes; (void)n_in; (void)out_size; (void)ws_size;
    static int grid = 0;
    if (!grid) {
        (void)hipFuncSetAttribute((const void*)fwd_kernel, hipFuncAttributeMaxDynamicSharedMemorySize, LDS_BYTES);
        int dev = 0, cus = 0; (void)hipGetDevice(&dev); (void)hipDeviceGetAttribute(&cus, hipDeviceAttributeMultiprocessorCount, dev);
        grid = cus > 0 && cus < 256 ? cus : 256;
    }
    (void)hipMemsetAsync(d_ws, 0, CTL_BYTES, stream);
    Params p{};
    for (int i = 0; i < 41; ++i) p.in[i] = (const float*)d_in[i];
    p.out = (float*)d_out; p.ws = (unsigned char*)d_ws;
    hipLaunchKernelGGL(fwd_kernel, dim3(grid), dim3(NTHR), LDS_BYTES, stream, p);
}
```
